# Optimizing an MI355X kernel written in HIP

```python
import math
import jax, jax.numpy as jnp
from jax import lax
import numpy as np

D_MODEL = 2048
BATCH = 4
SEQ = 4096
DEPTH = 4

HEAD_DIM = 128
ROPE_THETA = 10000.0
NEG_INF = -1e30
LN_EPS = 1e-5
SUBLN_EPS = 1e-5
DIL_PAIRS = ((128, 1), (512, 4), (2048, 16))
A_HEADS_PER_GROUP = 6
A_HEADS = len(DIL_PAIRS) * A_HEADS_PER_GROUP
DIL_BLOCK = 64
B_HEADS = 8
B_DIM = 64
DENSE_Q_BLOCK = 128
C_Q_HEADS = 8
C_KV_HEADS = 2
C_HALF_WINDOW = 128
C_BLOCK = 128
D_HEADS = 8
GRID_W = 64
NA_WIN_H = 8
NA_WIN_W = 16
N_BRANCHES = 4
N_EXPERTS = 16
EC_CAPACITY_FACTOR = 2
D_EXPERT = D_MODEL // 2

A_W = A_HEADS * HEAD_DIM
B_W = B_HEADS * 2 * B_DIM
C_Q_W = C_Q_HEADS * HEAD_DIM
C_KV_W = C_KV_HEADS * HEAD_DIM
D_W = D_HEADS * HEAD_DIM
IN_WIDTHS = (A_W, A_W, A_W, B_W, B_W, B_W, C_Q_W, C_KV_W, C_KV_W, D_W, D_W, D_W, N_BRANCHES * D_MODEL)
VALUE_SLOTS = (2, 5, 8, 11)
IN_TOTAL = sum(IN_WIDTHS)
BRANCH_WIDTHS = (A_HEADS_PER_GROUP * HEAD_DIM, B_W, C_Q_W, D_W)
BRANCH_TOTAL = sum(BRANCH_WIDTHS)

kernel_name = "hybrid_dilated_diff_window_na_ec_encoder"


def _offsets(widths):
    offs = [0]
    for w in widths:
        offs.append(offs[-1] + w)
    return offs


def layer_norm(x, g, b):
    xf = x.astype(jnp.float32)
    mu = jnp.mean(xf, axis=-1, keepdims=True)
    var = jnp.mean(jnp.square(xf - mu), axis=-1, keepdims=True)
    return ((xf - mu) * lax.rsqrt(var + LN_EPS) * g.astype(jnp.float32) + b.astype(jnp.float32)).astype(x.dtype)


def rope(x, pos):
    half = x.shape[-1] // 2
    inv = ROPE_THETA ** (-jnp.arange(half, dtype=jnp.float32) / half)
    ang = pos.astype(jnp.float32)[:, None] * inv[None, :]
    cos = jnp.cos(ang)[:, None, :]
    sin = jnp.sin(ang)[:, None, :]
    xf = x.astype(jnp.float32)
    x1, x2 = xf[..., :half], xf[..., half:]
    return jnp.concatenate([x1 * cos - x2 * sin, x2 * cos + x1 * sin], axis=-1).astype(x.dtype)


def banded_attention(q, k, v, half_width, block, sink=None):
    N, L, Hq, d = q.shape
    Hkv = k.shape[2]
    G = Hq // Hkv
    nb = -(-L // block)
    Lp = nb * block
    qb = jnp.pad(q, ((0, 0), (0, Lp - L), (0, 0), (0, 0))).reshape(N, nb, block, Hkv, G, d)

    def band(t):
        tp = jnp.pad(t, ((0, 0), (block, Lp - L + block), (0, 0), (0, 0))).reshape(N, nb + 2, block, Hkv, d)
        return jnp.concatenate([tp[:, :nb], tp[:, 1:nb + 1], tp[:, 2:]], axis=2)

    kb, vb = band(k), band(v)
    s = jnp.einsum('nbqhgd,nbkhd->nbhgqk', qb, kb, preferred_element_type=jnp.float32) * (d ** -0.5)
    qpos = jnp.arange(nb)[:, None] * block + jnp.arange(block)[None, :]
    kpos = (jnp.arange(nb)[:, None] - 1) * block + jnp.arange(3 * block)[None, :]
    valid = ((jnp.abs(qpos[:, :, None] - kpos[:, None, :]) <= half_width)
             & (kpos[:, None, :] >= 0) & (kpos[:, None, :] < L))
    s = jnp.where(valid[None, :, None, None], s, NEG_INF)
    m = jnp.max(s, axis=-1)
    if sink is not None:
        sk = sink.astype(jnp.float32).reshape(Hkv, G)[None, None, :, :, None]
        m = jnp.maximum(m, sk)
    p = jnp.exp(s - m[..., None])
    denom = jnp.sum(p, axis=-1)
    if sink is not None:
        denom = denom + jnp.exp(sk - m)
    o = jnp.einsum('nbhgqk,nbkhd->nbqhgd', (p / denom[..., None]).astype(v.dtype), vb)
    o = o.reshape(N, Lp, Hq, d)[:, :L]
    lse = (m + jnp.log(denom)).transpose(0, 1, 4, 2, 3).reshape(N, Lp, Hq)[:, :L]
    return o, lse


def dilated_attention(q, k, v):
    B, S = q.shape[:2]
    hg = A_HEADS_PER_GROUP
    outs, lses = [], []
    for g, (w, r) in enumerate(DIL_PAIRS):
        hs = slice(g * hg, (g + 1) * hg)
        n_side = (w // 2) // r
        L = S // r

        def to_sub(t):
            t = t[:, :, hs].reshape(B, L, r, hg, HEAD_DIM).transpose(0, 2, 1, 3, 4)
            return t.reshape(B * r, L, hg, HEAD_DIM)

        o, lse = banded_attention(to_sub(q), to_sub(k), to_sub(v), n_side, DIL_BLOCK)
        outs.append(o.reshape(B, r, L, hg, HEAD_DIM).transpose(0, 2, 1, 3, 4).reshape(B, S, hg, HEAD_DIM))
        lses.append(lse.reshape(B, r, L, hg).transpose(0, 2, 1, 3).reshape(B, S, hg))
    wts = jax.nn.softmax(jnp.stack(lses, axis=0), axis=0)
    out = jnp.einsum('gbsh,gbshd->bshd', wts.astype(q.dtype), jnp.stack(outs, axis=0))
    return out.reshape(B, S, hg * HEAD_DIM)


def diff_attention(q, k, v, lam, subln_w, lambda_init):
    B, S = q.shape[:2]
    lamf = lam.astype(jnp.float32)
    lmbda = jnp.exp(jnp.sum(lamf[0] * lamf[1])) - jnp.exp(jnp.sum(lamf[2] * lamf[3])) + lambda_init
    nq = S // DENSE_Q_BLOCK
    qblocks = q.reshape(B, nq, DENSE_Q_BLOCK, B_HEADS, 2, B_DIM).transpose(1, 0, 2, 3, 4, 5)
    scale = B_DIM ** -0.5

    def block_fn(qblk):
        s = jnp.einsum('bqhmd,bkhmd->bhmqk', qblk, k, preferred_element_type=jnp.float32) * scale
        a = jax.nn.softmax(s, axis=-1)
        a = a[:, :, 0] - lmbda * a[:, :, 1]
        return jnp.einsum('bhqk,bkhe->bqhe', a.astype(v.dtype), v)

    o = lax.map(block_fn, qblocks)
    of = o.transpose(1, 0, 2, 3, 4).reshape(B, S, B_HEADS, 2 * B_DIM).astype(jnp.float32)
    of = of * lax.rsqrt(jnp.mean(of * of, axis=-1, keepdims=True) + SUBLN_EPS) * subln_w.astype(jnp.float32)
    return (of * (1.0 - lambda_init)).astype(q.dtype).reshape(B, S, B_W)


def neighborhood_attention(q, k, v, rpb):
    B, S, H, d = q.shape
    rows = S // GRID_W
    kh = min(NA_WIN_H, rows)
    kw = NA_WIN_W
    r = jnp.arange(rows)
    c = jnp.arange(GRID_W)
    row_idx = jnp.clip(r - kh // 2, 0, rows - kh)[:, None] + jnp.arange(kh)[None, :]
    col_start = jnp.clip(c - kw // 2, 0, GRID_W - kw)
    col_ok = (c[None, :] >= col_start[:, None]) & (c[None, :] < col_start[:, None] + kw)
    qg = q.reshape(B, rows, GRID_W, H, d)
    kband = k.reshape(B, rows, GRID_W, H, d)[:, row_idx]
    vband = v.reshape(B, rows, GRID_W, H, d)[:, row_idx]
    s = jnp.einsum('brchd,brkwhd->brhckw', qg, kband, preferred_element_type=jnp.float32) * (d ** -0.5)
    roff = row_idx - r[:, None] + (NA_WIN_H - 1)
    coff = jnp.clip(c[None, :] - c[:, None], -(kw - 1), kw - 1) + (NA_WIN_W - 1)
    bias = rpb.astype(jnp.float32)[:, roff[:, None, :, None], coff[None, :, None, :]]
    s = s + bias.transpose(1, 0, 2, 3, 4)[None]
    s = jnp.where(col_ok[:, None, :], s, NEG_INF)
    p = jax.nn.softmax(s.reshape(B, rows, H, GRID_W, kh * GRID_W), axis=-1)
    o = jnp.einsum('brhcK,brKhd->brchd', p.astype(v.dtype), vband.reshape(B, rows, kh * GRID_W, H, d))
    return o.reshape(B, S, H * d)


def expert_choice_ffn(x, w_router, w_gate, w_up, w_down):
    B, N, D = x.shape
    cap = EC_CAPACITY_FACTOR * N // N_EXPERTS
    aff = jax.nn.softmax(jnp.einsum('bnd,de->bne', x, w_router, preferred_element_type=jnp.float32), axis=-1)
    g, idx = lax.top_k(aff.transpose(0, 2, 1), cap)
    xin = jax.vmap(lambda xb, ib: xb[ib])(x, idx)
    h = jax.nn.silu(jnp.einsum('becd,edf->becf', xin, w_gate)) * jnp.einsum('becd,edf->becf', xin, w_up)
    y = jnp.einsum('becf,efd->becd', h, w_down) * g[..., None].astype(x.dtype)
    return jax.vmap(lambda yb, ib: jnp.zeros((N, D), yb.dtype).at[ib.reshape(-1)].add(yb.reshape(-1, D)))(y, idx)


def setup_inputs(seed: int = 0) -> dict:
    key = jax.random.key(seed)
    ks = jax.random.split(key, 15)
    f32 = jnp.float32
    beta = (8.0 * DEPTH) ** -0.25
    in_offs = _offsets(IN_WIDTHS)
    col_scale = np.full((IN_TOTAL,), D_MODEL ** -0.5, dtype=np.float32)
    for slot in VALUE_SLOTS:
        col_scale[in_offs[slot]:in_offs[slot + 1]] *= beta
    br_offs = _offsets(BRANCH_WIDTHS)
    row_scale = np.zeros((BRANCH_TOTAL,), dtype=np.float32)
    for i, w in enumerate(BRANCH_WIDTHS):
        row_scale[br_offs[i]:br_offs[i + 1]] = beta * w ** -0.5
    x = jax.random.normal(ks[0], (BATCH, SEQ, D_MODEL), f32)
    w_in = jax.random.normal(ks[1], (DEPTH, D_MODEL, IN_TOTAL), f32) * jnp.asarray(col_scale)
    b_gate = 0.02 * jax.random.normal(ks[2], (DEPTH, N_BRANCHES * D_MODEL), f32)
    w_branch = jax.random.normal(ks[3], (DEPTH, BRANCH_TOTAL, D_MODEL), f32) * jnp.asarray(row_scale)[:, None]
    w_out = jax.random.normal(ks[4], (DEPTH, D_MODEL, D_MODEL), f32) * (beta * D_MODEL ** -0.5)
    diff_lambda = 0.1 * jax.random.normal(ks[5], (DEPTH, 4, B_DIM), f32)
    diff_subln = 1.0 + 0.02 * jax.random.normal(ks[6], (DEPTH, 2 * B_DIM), f32)
    sink_logit = 0.5 * jax.random.normal(ks[7], (DEPTH, C_Q_HEADS), f32)
    na_rpb = 0.1 * jax.random.normal(ks[8], (DEPTH, D_HEADS, 2 * NA_WIN_H - 1, 2 * NA_WIN_W - 1), f32)
    w_router = jax.random.normal(ks[9], (DEPTH, D_MODEL, N_EXPERTS), f32) * D_MODEL ** -0.5
    w_exp_gate = jax.random.normal(ks[10], (DEPTH, N_EXPERTS, D_MODEL, D_EXPERT), f32) * D_MODEL ** -0.5
    w_exp_up = jax.random.normal(ks[11], (DEPTH, N_EXPERTS, D_MODEL, D_EXPERT), f32) * (beta * D_MODEL ** -0.5)
    w_exp_down = jax.random.normal(ks[12], (DEPTH, N_EXPERTS, D_EXPERT, D_MODEL), f32) * (beta * D_EXPERT ** -0.5)
    ln_gain = 1.0 + 0.02 * jax.random.normal(ks[13], (DEPTH, 2, D_MODEL), f32)
    ln_bias = 0.02 * jax.random.normal(ks[14], (DEPTH, 2, D_MODEL), f32)
    return {"x": x, "w_in": w_in, "b_gate": b_gate, "w_branch": w_branch, "w_out": w_out,
            "diff_lambda": diff_lambda, "diff_subln": diff_subln, "sink_logit": sink_logit,
            "na_rpb": na_rpb, "w_router": w_router, "w_exp_gate": w_exp_gate, "w_exp_up": w_exp_up,
            "w_exp_down": w_exp_down, "ln_gain": ln_gain, "ln_bias": ln_bias}


def reference(x, w_in, b_gate, w_branch, w_out, diff_lambda, diff_subln, sink_logit, na_rpb,
              w_router, w_exp_gate, w_exp_up, w_exp_down, ln_gain, ln_bias):
    B, S, D = x.shape
    pos = jnp.arange(S, dtype=jnp.int32)
    alpha = (2.0 * DEPTH) ** 0.25
    in_offs = _offsets(IN_WIDTHS)
    br_offs = _offsets(BRANCH_WIDTHS)
    for l in range(DEPTH):
        lambda_init = 0.8 - 0.6 * math.exp(-0.3 * l)
        proj = jnp.einsum('bsd,dn->bsn', x, w_in[l])
        parts = [proj[..., in_offs[i]:in_offs[i + 1]] for i in range(len(IN_WIDTHS))]
        q_a, k_a, v_a, q_b, k_b, v_b, q_c, k_c, v_c, q_d, k_d, v_d, gate_pre = parts
        o_a = dilated_attention(rope(q_a.reshape(B, S, A_HEADS, HEAD_DIM), pos),
                                rope(k_a.reshape(B, S, A_HEADS, HEAD_DIM), pos),
                                v_a.reshape(B, S, A_HEADS, HEAD_DIM))
        qb = rope(q_b.reshape(B, S, B_HEADS * 2, B_DIM), pos).reshape(B, S, B_HEADS, 2, B_DIM)
        kb = rope(k_b.reshape(B, S, B_HEADS * 2, B_DIM), pos).reshape(B, S, B_HEADS, 2, B_DIM)
        o_b = diff_attention(qb, kb, v_b.reshape(B, S, B_HEADS, 2 * B_DIM), diff_lambda[l], diff_subln[l], lambda_init)
        o_c, _ = banded_attention(rope(q_c.reshape(B, S, C_Q_HEADS, HEAD_DIM), pos),
                                  rope(k_c.reshape(B, S, C_KV_HEADS, HEAD_DIM), pos),
                                  v_c.reshape(B, S, C_KV_HEADS, HEAD_DIM),
                                  C_HALF_WINDOW, C_BLOCK, sink_logit[l])
        o_c = o_c.reshape(B, S, C_Q_W)
        o_d = neighborhood_attention(q_d.reshape(B, S, D_HEADS, HEAD_DIM), k_d.reshape(B, S, D_HEADS, HEAD_DIM),
                                     v_d.reshape(B, S, D_HEADS, HEAD_DIM), na_rpb[l])
        gates = jax.nn.sigmoid(gate_pre + b_gate[l]).reshape(B, S, N_BRANCHES, D)
        mixed = None
        for i, o in enumerate((o_a, o_b, o_c, o_d)):
            term = gates[:, :, i] * jnp.einsum('bsk,kd->bsd', o, w_branch[l, br_offs[i]:br_offs[i + 1]])
            mixed = term if mixed is None else mixed + term
        x = layer_norm(alpha * x + jnp.einsum('bsd,de->bse', mixed, w_out[l]), ln_gain[l, 0], ln_bias[l, 0])
        x = layer_norm(alpha * x + expert_choice_ffn(x, w_router[l], w_exp_gate[l], w_exp_up[l], w_exp_down[l]),
                       ln_gain[l, 1], ln_bias[l, 1])
    return x
```

```cpp
#include <hip/hip_runtime.h>
#include <cstdio>
#include <cstdint>
#include <cmath>
namespace pg8 {
#define PG8_LAS __attribute__((address_space(3)))
typedef unsigned short bf16_t;
typedef short bf16x8 __attribute__((ext_vector_type(8)));
typedef float f32x4 __attribute__((ext_vector_type(4)));
typedef unsigned u32x4 __attribute__((ext_vector_type(4)));
constexpr int BM = 256, BK = 64, HALF = 128, HTB = HALF * BK * 2  , STAGE_BYTES = 8 * HTB, NXCD = 8, WGM = 8;

__host__ __device__ __forceinline__ int lds_byte(int r, int c) { const int st = (r >> 4) * 2 + (c >> 5), rr = r & 15, cc = c & 31, ob = rr * 64 + cc * 2; return st * 1024 + (ob ^ (((ob >> 9) & 1) << 5)); }
__host__ __device__ __forceinline__ void stage_rc(int b, int& R, int& C) { const int st = b / 1024, sb = b % 1024, swz = sb ^ (((sb >> 9) & 1) << 5); R = (st >> 1) * 16 + swz / 64; C = (st & 1) * 32 + (swz % 64) / 2; }
__host__ __device__ __forceinline__ int perm32(int rho) { const int n = rho >> 4, i = rho & 15; return 8 * (i >> 2) + 4 * n + (i & 3); }

struct Unit { int pm, pn; };
struct Gemm { const bf16_t* A; const bf16_t* Bt; int M, N, K; size_t gstride; };

struct StaticOrder {
    int nM, nN, nwg, G, c;
    __host__ __device__ void init(int M, int N, int G_, int c_) { nM = M / BM; nN = N / BM; nwg = nM * nN; G = G_; c = c_; }
    __host__ __device__ bool next(int i, Unit& u) const {
        const long L = (long)i * G + c; if (L >= nwg) return false;
        int wgid = (int)L; { const int q = nwg / NXCD, r = nwg % NXCD, xcd = wgid % NXCD, off = wgid / NXCD; wgid = (xcd < r ? xcd * (q + 1) : r * (q + 1) + (xcd - r) * q) + off; }
        const int nig = WGM * nN, gid = wgid / nig, fm = gid * WGM, gsz = (nM - fm) < WGM ? (nM - fm) : WGM;
        u.pm = fm + ((wgid % nig) % gsz); u.pn = (wgid % nig) / gsz; return true;
    }
    __device__ __forceinline__ void a_ready(const Unit&) const {}
    __device__ __forceinline__ void done(const Unit&) const {}
};


__device__ __forceinline__ unsigned cvt_pk_bf16(float lo, float hi) { unsigned r; asm volatile("v_cvt_pk_bf16_f32 %0, %1, %2" : "=v"(r) : "v"(lo), "v"(hi)); return r; }
__device__ __forceinline__ float bflo(unsigned w) { return __uint_as_float(w << 16); }
__device__ __forceinline__ float bfhi(unsigned w) { return __uint_as_float(w & 0xffff0000u); }
__device__ __forceinline__ float sigmoidf_(float x) { return 1.0f / (1.0f + __expf(-x)); }

struct EpiProj {
    static constexpr bool PERM = true, AFTER_DRAIN = false;
    bf16_t* O; const float* bgate; const float* rope128; const float* rope64;
    __device__ __forceinline__ void operator()(const f32x4 (&acc)[2][2][4][2], const Unit& u, int wr, int wc, int fr, int fq) const {
        const int colt = u.pn * BM;
        int mode;
        if (colt < 4608) mode = 1; else if (colt < 6912) mode = 0; else if (colt < 8960) mode = 2; else if (colt < 9984) mode = 0; else if (colt < 11264) mode = 1; else if (colt < 14592) mode = 0; else mode = 3;
        const int row0 = u.pm * BM + wr * 64 + fr, col0 = colt + wc * 32 + 8 * fq;
        const int i128 = 16 * wc + 4 * fq, i64 = 16 * (wc & 1) + 4 * fq;
        f32x4 gb[2][2];
        if (mode == 3) {
#pragma unroll
            for (int bj = 0; bj < 2; ++bj)
#pragma unroll
                for (int n = 0; n < 2; ++n) gb[bj][n] = *(const f32x4*)(bgate + (col0 - 14592) + bj * HALF + 4 * n);
        }
#pragma unroll
        for (int ai = 0; ai < 2; ++ai)
#pragma unroll
            for (int m = 0; m < 4; ++m) {
                const int row = row0 + ai * HALF + m * 16; const int pos = row & 4095;
                bf16_t* rowp = O + (size_t)row * 22784 + col0;
                f32x4 cs0 = {1.f, 0.f, 1.f, 0.f}, cs1 = {1.f, 0.f, 1.f, 0.f};
                if (mode == 1) { const f32x4* t = (const f32x4*)(rope128 + ((size_t)pos * 64 + i128) * 2); cs0 = t[0]; cs1 = t[1]; }
                if (mode == 2) { const f32x4* t = (const f32x4*)(rope64 + ((size_t)pos * 32 + i64) * 2); cs0 = t[0]; cs1 = t[1]; }
#pragma unroll
                for (int bj = 0; bj < 2; ++bj) {
                    f32x4 v0 = acc[ai][bj][m][0], v1 = acc[ai][bj][m][1];
                    if (mode == 1 || mode == 2) {
                        f32x4 r0, r1;
                        r0[0] = v0[0] * cs0[0] - v0[1] * cs0[1]; r0[1] = v0[1] * cs0[0] + v0[0] * cs0[1];
                        r0[2] = v0[2] * cs0[2] - v0[3] * cs0[3]; r0[3] = v0[3] * cs0[2] + v0[2] * cs0[3];
                        r1[0] = v1[0] * cs1[0] - v1[1] * cs1[1]; r1[1] = v1[1] * cs1[0] + v1[0] * cs1[1];
                        r1[2] = v1[2] * cs1[2] - v1[3] * cs1[3]; r1[3] = v1[3] * cs1[2] + v1[2] * cs1[3];
                        v0 = r0; v1 = r1;
                    }
                    if (mode == 3) {
                        v0 = v0 + gb[bj][0]; v1 = v1 + gb[bj][1];
#pragma unroll
                        for (int j = 0; j < 4; ++j) { v0[j] = sigmoidf_(v0[j]); v1[j] = sigmoidf_(v1[j]); }
                    }
                    u32x4 w; w.x = cvt_pk_bf16(v0[0], v0[1]); w.y = cvt_pk_bf16(v0[2], v0[3]); w.z = cvt_pk_bf16(v1[0], v1[1]); w.w = cvt_pk_bf16(v1[2], v1[3]);
                    *(u32x4*)(rowp + bj * HALF) = w;
                }
            }
    }
};
struct EpiGate {
    static constexpr bool PERM = true, AFTER_DRAIN = false;
    bf16_t* mixed; const bf16_t* gate; int first;
    __device__ __forceinline__ void operator()(const f32x4 (&acc)[2][2][4][2], const Unit& u, int wr, int wc, int fr, int fq) const {
        const int row0 = u.pm * BM + wr * 64 + fr, col0 = u.pn * BM + wc * 32 + 8 * fq;
#pragma unroll
        for (int ai = 0; ai < 2; ++ai)
#pragma unroll
            for (int m = 0; m < 4; ++m) {
                const int row = row0 + ai * HALF + m * 16;
                const bf16_t* gp = gate + (size_t)row * 22784 + col0; bf16_t* mp = mixed + (size_t)row * 2048 + col0;
#pragma unroll
                for (int bj = 0; bj < 2; ++bj) {
                    const u32x4 g = *(const u32x4*)(gp + bj * HALF);
                    u32x4 p = {0u, 0u, 0u, 0u}; if (!first) p = *(const u32x4*)(mp + bj * HALF);
                    const f32x4 v0 = acc[ai][bj][m][0], v1 = acc[ai][bj][m][1];
                    u32x4 w;
                    w.x = cvt_pk_bf16(bflo(p.x) + bflo(g.x) * v0[0], bfhi(p.x) + bfhi(g.x) * v0[1]);
                    w.y = cvt_pk_bf16(bflo(p.y) + bflo(g.y) * v0[2], bfhi(p.y) + bfhi(g.y) * v0[3]);
                    w.z = cvt_pk_bf16(bflo(p.z) + bflo(g.z) * v1[0], bfhi(p.z) + bfhi(g.z) * v1[1]);
                    w.w = cvt_pk_bf16(bflo(p.w) + bflo(g.w) * v1[2], bfhi(p.w) + bfhi(g.w) * v1[3]);
                    *(u32x4*)(mp + bj * HALF) = w;
                }
            }
    }
};
struct EpiResid {
    static constexpr bool PERM = false, AFTER_DRAIN = false;
    float* out; const float* xf; float alpha;
    __device__ __forceinline__ void operator()(const f32x4 (&acc)[2][2][4][2], const Unit& u, int wr, int wc, int fr, int fq) const {
        const int row0 = u.pm * BM + wr * 64 + fr, col0 = u.pn * BM + wc * 32 + 4 * fq;
#pragma unroll
        for (int ai = 0; ai < 2; ++ai)
#pragma unroll
            for (int m = 0; m < 4; ++m) {
                const size_t off = (size_t)(row0 + ai * HALF + m * 16) * 2048 + col0;
#pragma unroll
                for (int bj = 0; bj < 2; ++bj)
#pragma unroll
                    for (int n = 0; n < 2; ++n) { const f32x4 x = *(const f32x4*)(xf + off + bj * HALF + n * 16); *(f32x4*)(out + off + bj * HALF + n * 16) = x * alpha + acc[ai][bj][m][n]; }
            }
    }
};
struct EpiSwiGLU {
    static constexpr bool PERM = true, AFTER_DRAIN = false;
    bf16_t* H;
    __device__ __forceinline__ void operator()(const f32x4 (&acc)[2][2][4][2], const Unit& u, int wr, int wc, int fr, int fq) const {
        const int row0 = u.pm * BM + wr * 64 + fr, col0 = u.pn * HALF + wc * 32 + 8 * fq;
#pragma unroll
        for (int ai = 0; ai < 2; ++ai)
#pragma unroll
            for (int m = 0; m < 4; ++m) {
                bf16_t* hp = H + (size_t)(row0 + ai * HALF + m * 16) * 1024 + col0;
                f32x4 h0, h1;
#pragma unroll
                for (int j = 0; j < 4; ++j) { const float g0 = acc[ai][0][m][0][j], g1 = acc[ai][0][m][1][j];
                    h0[j] = g0 * sigmoidf_(g0) * acc[ai][1][m][0][j]; h1[j] = g1 * sigmoidf_(g1) * acc[ai][1][m][1][j]; }
                u32x4 w; w.x = cvt_pk_bf16(h0[0], h0[1]); w.y = cvt_pk_bf16(h0[2], h0[3]); w.z = cvt_pk_bf16(h1[0], h1[1]); w.w = cvt_pk_bf16(h1[2], h1[3]);
                *(u32x4*)hp = w;
            }
    }
};
struct EpiDown {
    static constexpr bool PERM = true, AFTER_DRAIN = false;
    bf16_t* Y; const float* gv;
    __device__ __forceinline__ void operator()(const f32x4 (&acc)[2][2][4][2], const Unit& u, int wr, int wc, int fr, int fq) const {
        const int row0 = u.pm * BM + wr * 64 + fr, col0 = u.pn * BM + wc * 32 + 8 * fq;
#pragma unroll
        for (int ai = 0; ai < 2; ++ai)
#pragma unroll
            for (int m = 0; m < 4; ++m) {
                const int row = row0 + ai * HALF + m * 16; const float s = gv[row];
                bf16_t* yp = Y + (size_t)row * 2048 + col0;
#pragma unroll
                for (int bj = 0; bj < 2; ++bj) { const f32x4 v0 = acc[ai][bj][m][0] * s, v1 = acc[ai][bj][m][1] * s;
                    u32x4 w; w.x = cvt_pk_bf16(v0[0], v0[1]); w.y = cvt_pk_bf16(v0[2], v0[3]); w.z = cvt_pk_bf16(v1[0], v1[1]); w.w = cvt_pk_bf16(v1[2], v1[3]);
                    *(u32x4*)(yp + bj * HALF) = w; }
            }
    }
};

template <class Epi, class Sched, bool ALIGN_EPI = false, bool SP2 = false>
__device__ __forceinline__ void gemm_phase(PG8_LAS unsigned char* lds, const Gemm g, const Sched& S, const Epi& E, const int tid) {
    const int wid = __builtin_amdgcn_readfirstlane(tid >> 6), lane = tid & 63, wr = wid >> 2, wc = wid & 3, fr = lane & 15, fq = lane >> 4;
    const int K = g.K, nt = K / BK;
    unsigned voffA[2], voffB[2];
#pragma unroll
    for (int i = 0; i < 2; ++i) { int R, C; stage_rc(tid * 16 + i * 8192, R, C); const int Rb = Epi::PERM ? ((R & ~31) + perm32(R & 31)) : R;
        voffA[i] = (unsigned)(R * K + C) * 2u; voffB[i] = (unsigned)(Rb * K + C) * 2u; }
    const size_t kstep = (size_t)(BK * 2);
    const size_t hstep = (size_t)HALF * K * 2;
    const size_t tstep = 2 * hstep;
    const unsigned ldsw = (unsigned)wid * 1024u;
    const int aoff = lds_byte(wr * 64 + fr, fq * 8), boff = lds_byte(wc * 32 + fr, fq * 8);
#define PG8_SA(b, h) (((b) * 2 + (h)) * HTB)
#define PG8_SB(b, h) ((4 + (b) * 2 + (h)) * HTB)
#define PG8_STAGE(bufoff, gbase, voff) do { _Pragma("unroll") for (int _i = 0; _i < 2; ++_i) \
        __builtin_amdgcn_global_load_lds((const unsigned*)((const char*)(gbase) + (voff)[_i]), (PG8_LAS unsigned*)(lds + (bufoff) + ldsw + _i * 8192), 16, 0, 0); } while (0)
#define PG8_LDA(dst, b, h) do { _Pragma("unroll") for (int m = 0; m < 4; ++m) _Pragma("unroll") for (int k = 0; k < 2; ++k) dst[m][k] = *(const PG8_LAS bf16x8*)(lds + PG8_SA(b, h) + aoff + m * 2048 + k * 1024); } while (0)
#define PG8_LDB(dst, b, h) do { _Pragma("unroll") for (int n = 0; n < 2; ++n) _Pragma("unroll") for (int k = 0; k < 2; ++k) dst[n][k] = *(const PG8_LAS bf16x8*)(lds + PG8_SB(b, h) + boff + n * 2048 + k * 1024); } while (0)
#define PG8_MMA(ai, bj, At, Bt) do { __builtin_amdgcn_s_setprio(1); _Pragma("unroll") for (int m = 0; m < 4; ++m) _Pragma("unroll") for (int n = 0; n < 2; ++n) _Pragma("unroll") for (int k = 0; k < 2; ++k) \
        acc[ai][bj][m][n] = __builtin_amdgcn_mfma_f32_16x16x32_bf16(Bt[n][k], At[m][k], acc[ai][bj][m][n], 0, 0, 0); __builtin_amdgcn_s_setprio(0); } while (0)
#define PG8_WAIT_V(n) asm volatile("s_waitcnt vmcnt(" #n ")" ::: "memory")
#define PG8_WAIT_L(n) asm volatile("s_waitcnt lgkmcnt(" #n ")" ::: "memory")
#define PG8_BAR __builtin_amdgcn_s_barrier()
#define PG8_SCHED __builtin_amdgcn_sched_barrier(0)
    Unit cur, nxt; int ui = 0;
    if (!S.next(0, cur)) return;
    f32x4 acc[2][2][4][2];
#pragma unroll
    for (int a = 0; a < 2; ++a)
#pragma unroll
        for (int b = 0; b < 2; ++b)
#pragma unroll
            for (int m = 0; m < 4; ++m)
#pragma unroll
                for (int n = 0; n < 2; ++n) acc[a][b][m][n] = (f32x4){0.f, 0.f, 0.f, 0.f};
    bf16x8 At[4][2], B0[2][2], B1[2][2];
    const char* cA = (const char*)g.A + (size_t)cur.pm * tstep; const char* cB = (const char*)g.Bt + (size_t)((cur.pm >> 1) & 15) * g.gstride + (size_t)cur.pn * tstep;
    S.a_ready(cur);
    if constexpr (SP2) {
        PG8_STAGE(PG8_SB(0, 0), cB, voffB); PG8_STAGE(PG8_SB(0, 1), cB + hstep, voffB); PG8_STAGE(PG8_SA(0, 0), cA, voffA); PG8_STAGE(PG8_SA(0, 1), cA + hstep, voffA);
        if (wr == 1) PG8_BAR;
        PG8_WAIT_V(2); PG8_BAR;
        PG8_STAGE(PG8_SB(1, 0), cB + kstep, voffB); PG8_STAGE(PG8_SA(1, 0), cA + kstep, voffA); PG8_STAGE(PG8_SB(1, 1), cB + hstep + kstep, voffB);
        PG8_WAIT_V(6); PG8_BAR;
    } else {
        PG8_STAGE(PG8_SB(0, 0), cB, voffB); PG8_STAGE(PG8_SA(0, 0), cA, voffA); PG8_STAGE(PG8_SB(0, 1), cB + hstep, voffB); PG8_STAGE(PG8_SA(0, 1), cA + hstep, voffA);
        if (wr == 1) PG8_BAR;
        PG8_WAIT_V(4); PG8_BAR;
        PG8_STAGE(PG8_SB(1, 0), cB + kstep, voffB); PG8_STAGE(PG8_SA(1, 0), cA + kstep, voffA); PG8_STAGE(PG8_SB(1, 1), cB + hstep + kstep, voffB);
        PG8_WAIT_V(6); PG8_BAR;
    }
    for (;;) {
        const bool has_next = S.next(ui + 1, nxt);
        const char* nA = has_next ? (const char*)g.A + (size_t)nxt.pm * tstep : cA; const char* nB = has_next ? (const char*)g.Bt + (size_t)((nxt.pm >> 1) & 15) * g.gstride + (size_t)nxt.pn * tstep : cB;
        for (int t = 0; t < nt; t += 2) {
            const bool last = (t == nt - 2);
            const char* a1 = cA + (size_t)(t + 1) * kstep;
            const char* a2 = last ? nA : cA + (size_t)(t + 2) * kstep; const char* b2 = last ? nB : cB + (size_t)(t + 2) * kstep;
            const char* a3 = a2 + kstep; const char* b3 = b2 + kstep;
            if (last && has_next) S.a_ready(nxt);
            if constexpr (SP2) {
            PG8_LDB(B0, 0, 0); PG8_LDB(B1, 0, 1); PG8_SCHED; PG8_LDA(At, 0, 0); PG8_STAGE(PG8_SA(1, 1), a1 + hstep, voffA);
            PG8_WAIT_V(8); PG8_WAIT_L(0); PG8_BAR; PG8_MMA(0, 0, At, B0); PG8_MMA(0, 1, At, B1); PG8_BAR; PG8_SCHED;
            PG8_LDA(At, 0, 1); PG8_STAGE(PG8_SB(0, 0), b2, voffB); PG8_STAGE(PG8_SB(0, 1), b2 + hstep, voffB); PG8_STAGE(PG8_SA(0, 0), a2, voffA);
            PG8_WAIT_V(8); PG8_WAIT_L(0); PG8_BAR; PG8_MMA(1, 0, At, B0); PG8_MMA(1, 1, At, B1); PG8_BAR; PG8_SCHED;
            PG8_LDB(B0, 1, 0); PG8_LDB(B1, 1, 1); PG8_SCHED; PG8_LDA(At, 1, 0); PG8_STAGE(PG8_SA(0, 1), a2 + hstep, voffA);
            PG8_WAIT_V(8); PG8_WAIT_L(0); PG8_BAR; PG8_MMA(0, 0, At, B0); PG8_MMA(0, 1, At, B1); PG8_BAR; PG8_SCHED;
            PG8_LDA(At, 1, 1); PG8_STAGE(PG8_SB(1, 0), b3, voffB); PG8_STAGE(PG8_SB(1, 1), b3 + hstep, voffB); PG8_STAGE(PG8_SA(1, 0), a3, voffA);
            PG8_WAIT_V(8); PG8_WAIT_L(0); PG8_BAR; PG8_MMA(1, 0, At, B0); PG8_MMA(1, 1, At, B1); PG8_BAR; PG8_SCHED;
            } else {
            PG8_LDB(B0, 0, 0); PG8_SCHED; PG8_LDA(At, 0, 0); PG8_STAGE(PG8_SA(1, 1), a1 + hstep, voffA);
            PG8_WAIT_L(8); PG8_BAR; PG8_WAIT_L(0); PG8_MMA(0, 0, At, B0); PG8_BAR; PG8_SCHED;
            PG8_LDB(B1, 0, 1); PG8_STAGE(PG8_SB(0, 0), b2, voffB);
            PG8_BAR; PG8_WAIT_L(0); PG8_MMA(0, 1, At, B1); PG8_BAR;
            PG8_LDA(At, 0, 1); PG8_STAGE(PG8_SA(0, 0), a2, voffA);
            PG8_BAR; PG8_WAIT_L(0); PG8_MMA(1, 0, At, B0); PG8_BAR; PG8_SCHED;
            PG8_STAGE(PG8_SB(0, 1), b2 + hstep, voffB);
            PG8_WAIT_V(6); PG8_BAR; PG8_MMA(1, 1, At, B1); PG8_BAR;
            PG8_LDB(B0, 1, 0); PG8_SCHED; PG8_LDA(At, 1, 0); PG8_STAGE(PG8_SA(0, 1), a2 + hstep, voffA);
            PG8_WAIT_L(8); PG8_BAR; PG8_WAIT_L(0); PG8_MMA(0, 0, At, B0); PG8_BAR; PG8_SCHED;
            PG8_LDB(B1, 1, 1); PG8_STAGE(PG8_SB(1, 0), b3, voffB);
            PG8_BAR; PG8_WAIT_L(0); PG8_MMA(0, 1, At, B1); PG8_BAR;
            PG8_LDA(At, 1, 1); PG8_STAGE(PG8_SA(1, 0), a3, voffA);
            PG8_BAR; PG8_WAIT_L(0); PG8_MMA(1, 0, At, B0); PG8_BAR; PG8_SCHED;
            PG8_STAGE(PG8_SB(1, 1), b3 + hstep, voffB);
            PG8_WAIT_V(6); PG8_BAR; PG8_MMA(1, 1, At, B1); PG8_BAR;
            }
        }
        if constexpr (ALIGN_EPI) { if (wr == 0) PG8_BAR; }
        if constexpr (!Epi::AFTER_DRAIN) { E(acc, cur, wr, wc, fr, fq); S.done(cur); }
        if (!has_next) break;
#pragma unroll
        for (int a = 0; a < 2; ++a)
#pragma unroll
            for (int b = 0; b < 2; ++b)
#pragma unroll
                for (int m = 0; m < 4; ++m)
#pragma unroll
                    for (int n = 0; n < 2; ++n) acc[a][b][m][n] = (f32x4){0.f, 0.f, 0.f, 0.f};
        cur = nxt; cA = nA; cB = nB; ++ui;
        if constexpr (ALIGN_EPI) { if (wr == 1) PG8_BAR; }
    }
    PG8_WAIT_V(0);
    if constexpr (!ALIGN_EPI) { if (wr == 0) PG8_BAR; }
    PG8_BAR;
    if constexpr (Epi::AFTER_DRAIN) { E.fused(acc, cur, wr, wc, fr, fq, lds, wid, lane); S.done(cur); }
#undef PG8_SA
#undef PG8_SB
#undef PG8_STAGE
#undef PG8_LDA
#undef PG8_LDB
#undef PG8_MMA
#undef PG8_WAIT_V
#undef PG8_WAIT_L
#undef PG8_BAR
#undef PG8_SCHED
}
}

constexpr int DM = 2048, NBATCH = 4, SEQ = 4096, DEPTH = 4, MTOK = NBATCH * SEQ;
constexpr int IN_TOTAL = 22784;
constexpr int OFF_QA = 0, OFF_KA = 2304, OFF_VA = 4608, OFF_QB = 6912, OFF_KB = 7936, OFF_VB = 8960, OFF_QC = 9984, OFF_KC = 11008, OFF_VC = 11264, OFF_QD = 11520, OFF_KD = 12544, OFF_VD = 13568, OFF_GATE = 14592;
constexpr int BR_TOTAL = 3840;
constexpr int NEXP = 16, CAP = 512, DEXP = 1024, NGRP = NBATCH * NEXP;
constexpr float LN_EPS = 1e-5f, SUBLN_EPS = 1e-5f;
constexpr float ALPHA = 1.6817928305074290f;
constexpr size_t MiB = 1u << 20;
constexpr size_t WS_CTL = 0, CTL_ZERO_BYTES = 1 * MiB;
constexpr size_t WS_ROPE128 = 1 * MiB, WS_ROPE64 = 3 * MiB, WS_AFF = 4 * MiB, WS_IDX = 5 * MiB, WS_GV = 5 * MiB + 131072, WS_SLOT = 6 * MiB, WS_LSE = 7 * MiB;
constexpr size_t WS_XF = 16 * MiB, WS_XB = 144 * MiB;
constexpr size_t WS_OA = 208 * MiB, WS_OB = 232 * MiB, WS_OC = 264 * MiB, WS_OD = 296 * MiB;
constexpr size_t WS_AG = 328 * MiB;
constexpr size_t WS_BSCR = 400 * MiB;
constexpr size_t WS_MIXED = 432 * MiB;
constexpr size_t WS_PRELN = 496 * MiB;
constexpr size_t WS_PROJ = 624 * MiB;
constexpr size_t WS_XG = WS_PROJ, WS_H = WS_PROJ + 128 * MiB, WS_Y = WS_PROJ + 192 * MiB;
constexpr size_t WS_WIN = 1336 * MiB;
constexpr size_t WS_WBR = 1692 * MiB;
constexpr size_t WS_WOUT = 1752 * MiB;
constexpr size_t WS_WGU = 1784 * MiB;
constexpr size_t WS_WDN = 2296 * MiB;
constexpr size_t WS_END = 2552 * MiB;
static_assert(WS_PROJ + (size_t)MTOK * IN_TOTAL * 2 == WS_WIN, "ws map");
constexpr int CW_BAR = 4096;
constexpr int LDS_BYTES = 147456, LDSCTL_OFF = 146944;
constexpr int NWAVES = 8;
constexpr int NPL = 11, NPHASES = 1 + DEPTH * NPL;

#define GAS __attribute__((address_space(1)))
#define LAS __attribute__((address_space(3)))
typedef unsigned short bf16_t;
typedef float f32x4 __attribute__((ext_vector_type(4)));
typedef float f32x2 __attribute__((ext_vector_type(2)));
typedef unsigned u32x4 __attribute__((ext_vector_type(4)));
typedef unsigned u32x2 __attribute__((ext_vector_type(2)));
using pg8::cvt_pk_bf16; using pg8::bflo; using pg8::bfhi;
__device__ __forceinline__ float bf2f(bf16_t h) { return __uint_as_float(((unsigned)h) << 16); }
__device__ __forceinline__ float wave_sum(float v) {
#pragma unroll
    for (int o = 1; o < 64; o <<= 1) v += __shfl_xor(v, o);
    return v;
}
__device__ __forceinline__ float wave_max(float v) {
#pragma unroll
    for (int o = 1; o < 64; o <<= 1) v = fmaxf(v, __shfl_xor(v, o));
    return v;
}
__device__ __forceinline__ int wave_sum_i(int v) {
#pragma unroll
    for (int o = 1; o < 64; o <<= 1) v += __shfl_xor(v, o);
    return v;
}

#define XB_TMO      128
#define XB_XCNT(j)  (256  + 64 * (j))
#define XB_XSUB(j)  (1280 + 64 * (j))
#define XB_XGEN(j)  (2304 + 64 * (j))
#define XB_TOP      3328
#define XB_TOPGEN   3392
#define XCD_BAR_WORDS 3456
#define XB_SPIN_CAP (1u << 23)

__device__ __forceinline__ unsigned xb_ld(unsigned* p)              { return __hip_atomic_load(p, __ATOMIC_RELAXED, __HIP_MEMORY_SCOPE_AGENT); }
__device__ __forceinline__ unsigned xb_add(unsigned* p, unsigned v) { return __hip_atomic_fetch_add(p, v, __ATOMIC_RELAXED, __HIP_MEMORY_SCOPE_AGENT); }
__device__ __forceinline__ unsigned xb_xcc_id() { return (unsigned)__builtin_amdgcn_s_getreg((3 << 11) | 20) & 0xFu; }
#define XB_SPIN(cond, bar) do { unsigned _sp = 0; while (cond) { __builtin_amdgcn_s_sleep(1); \
    if ((++_sp & 255u) == 0u) { if (xb_ld(&(bar)[XB_TMO])) break; if (_sp > XB_SPIN_CAP) { atomicAdd(&(bar)[XB_TMO], 1u); break; } } } } while (0)

struct XcdBarrier {
    unsigned* bar; unsigned x;
    volatile LAS unsigned* st;
};
__device__ __forceinline__ XcdBarrier xcd_barrier_post(unsigned* bar, volatile LAS unsigned* st) {
    XcdBarrier b; b.bar = bar; b.x = xb_xcc_id(); b.st = st;
    if (threadIdx.x == 0) (void)xb_add(&bar[XB_XCNT(b.x)], 1u);
    return b;
}
__device__ __forceinline__ void xcd_barrier_complete(unsigned* bar, unsigned x, unsigned& nloc, unsigned& nx) {
    const unsigned G = gridDim.x * gridDim.y * gridDim.z;
    unsigned sum, cnt, mine, sp = 0u;
    for (;;) {
        sum = 0u; cnt = 0u; mine = 0u;
#pragma unroll
        for (unsigned j = 0; j < 16; ++j) { const unsigned c = xb_ld(&bar[XB_XCNT(j)]); sum += c; cnt += (c > 0u) ? 1u : 0u; mine = (j == x) ? c : mine; }
        if (sum == G) break;
        __builtin_amdgcn_s_sleep(1);
        if ((++sp & 255u) == 0u) { if (xb_ld(&bar[XB_TMO])) break; if (sp > XB_SPIN_CAP) { atomicAdd(&bar[XB_TMO], 1u); break; } }
    }
    nloc = mine > 0u ? mine : 1u; nx = cnt > 0u ? cnt : 1u;
}
__device__ __forceinline__ void xcd_barrier(const XcdBarrier& b) {
    asm volatile("s_waitcnt vmcnt(0)" ::: "memory");
    __syncthreads();
    if (threadIdx.x == 0) {
        unsigned* bar = b.bar;
        __builtin_amdgcn_s_waitcnt(0);
        unsigned nloc = b.st[0], nx = b.st[1];
        if (nloc == 0u) { xcd_barrier_complete(bar, b.x, nloc, nx); b.st[0] = nloc; b.st[1] = nx; }
        const unsigned old = xb_add(&bar[XB_XSUB(b.x)], 1u);
        const unsigned gen = old / nloc;
        if (old + 1u == (gen + 1u) * nloc) {
            __builtin_amdgcn_fence(__ATOMIC_RELEASE, "agent");
            asm volatile("s_waitcnt vmcnt(0)" ::: "memory");
            const unsigned og = xb_add(&bar[XB_TOP], 1u);
            const unsigned tg = og / nx;
            if (og + 1u == (tg + 1u) * nx) xb_add(&bar[XB_TOPGEN], 1u);
            else XB_SPIN(xb_ld(&bar[XB_TOPGEN]) == tg, bar);
            __builtin_amdgcn_fence(__ATOMIC_ACQUIRE, "agent");
            xb_add(&bar[XB_XGEN(b.x)], 1u);
            asm volatile("s_waitcnt vmcnt(0)" ::: "memory");
        } else {
            XB_SPIN(xb_ld(&bar[XB_XGEN(b.x)]) == gen, bar);
            __builtin_amdgcn_fence(__ATOMIC_ACQUIRE, "agent");
            asm volatile("s_waitcnt vmcnt(0)" ::: "memory");
        }
    }
    __syncthreads();
}

__device__ __forceinline__ int win_src_col(int n) {
    if (n < OFF_VA || (n >= OFF_QC && n < OFF_VC)) { const int hb = n & ~127, j = n & 127; return hb + (j >> 1) + (j & 1) * 64; }
    if (n >= OFF_QB && n < OFF_VB) { const int hb = n & ~63, j = n & 63; return hb + (j >> 1) + (j & 1) * 32; }
    return n;
}
__device__ __forceinline__ void tr_item(const float* __restrict__ src, size_t ld, int srccol, int k0, bf16_t* __restrict__ dst) {
    const float* p = src + (size_t)k0 * ld + srccol;
#pragma unroll
    for (int kk = 0; kk < 8; ++kk) {
        float v[8];
#pragma unroll
        for (int j = 0; j < 8; ++j) v[j] = __builtin_nontemporal_load(p + (size_t)(kk * 8 + j) * ld);
        u32x4 w; w.x = cvt_pk_bf16(v[0], v[1]); w.y = cvt_pk_bf16(v[2], v[3]); w.z = cvt_pk_bf16(v[4], v[5]); w.w = cvt_pk_bf16(v[6], v[7]);
        *(u32x4*)(dst + k0 + kk * 8) = w;
    }
}

struct KeyA { int s, r;
    __device__ __forceinline__ int pos(int idx, float& bias) const { bias = 0.f; const int p = s + r * (idx - 64); return (p >= 0 && p < SEQ) ? p : -1; } };
struct KeyB {
    __device__ __forceinline__ int pos(int idx, float& bias) const { bias = 0.f; return idx; } };
struct KeyC { int s;
    __device__ __forceinline__ int pos(int idx, float& bias) const { bias = 0.f; const int p = s + idx - 128; return (p >= 0 && p < SEQ) ? p : -1; } };
struct KeyD { int r, c, rs, cs; const float* rpb;
    __device__ __forceinline__ int pos(int idx, float& bias) const { const int kr = rs + (idx >> 4), kc = cs + (idx & 15); int dc = kc - c; dc = dc < -15 ? -15 : (dc > 15 ? 15 : dc);
        bias = rpb[(kr - r + 7) * 31 + dc + 15]; return kr * 64 + kc; } };

template <int DK, class KF>
__device__ __forceinline__ void sattn(const bf16_t* q, const bf16_t* kb, const bf16_t* vb, const KF& kf, int nkeys, float scale, bool has_sink, float sink,
                                      LAS float* sq, LAS float* ss, int lane, float& o0, float& o1, float& m_out, float& l_out) {
    for (int d = lane; d < DK; d += 64) sq[d] = bf2f(q[d]);
    asm volatile("s_waitcnt lgkmcnt(0)" ::: "memory");
    float mx = -1e30f;
    for (int idx = lane; idx < nkeys; idx += 64) {
        float bias; const int p = kf.pos(idx, bias); float s = -1e30f;
        if (p >= 0) {
            const u32x4* kr = (const u32x4*)(kb + (size_t)p * IN_TOTAL); float acc = 0.f;
#pragma unroll
            for (int d8 = 0; d8 < DK / 8; ++d8) { const u32x4 w = kr[d8]; const LAS f32x4* qq = (const LAS f32x4*)(sq + d8 * 8); const f32x4 qa = qq[0], qb = qq[1];
                acc += qa[0] * bflo(w.x) + qa[1] * bfhi(w.x) + qa[2] * bflo(w.y) + qa[3] * bfhi(w.y) + qb[0] * bflo(w.z) + qb[1] * bfhi(w.z) + qb[2] * bflo(w.w) + qb[3] * bfhi(w.w); }
            s = acc * scale + bias;
        }
        ss[idx] = s; mx = fmaxf(mx, s);
    }
    mx = wave_max(mx); if (has_sink) mx = fmaxf(mx, sink);
    float sum = 0.f;
    for (int idx = lane; idx < nkeys; idx += 64) { const float s = ss[idx]; const float p = (s > -1e29f) ? __expf(s - mx) : 0.f; ss[idx] = p; sum += p; }
    sum = wave_sum(sum); if (has_sink) sum += __expf(sink - mx);
    asm volatile("s_waitcnt lgkmcnt(0)" ::: "memory");
    o0 = 0.f; o1 = 0.f;
    for (int idx = 0; idx < nkeys; ++idx) {
        const float p = ss[idx];
        if (p != 0.f) { float bias; const int pp = kf.pos(idx, bias); const unsigned w = *(const unsigned*)(vb + (size_t)pp * IN_TOTAL + 2 * lane); o0 += p * bflo(w); o1 += p * bfhi(w); }
    }
    const float inv = 1.0f / sum; o0 *= inv; o1 *= inv; m_out = mx; l_out = sum;
    asm volatile("s_waitcnt lgkmcnt(0)" ::: "memory");
}

struct AttnPtrs { const bf16_t* proj; bf16_t* ag; float* lse; bf16_t* ob; bf16_t* oc; bf16_t* od; const float* lam; const float* subln; const float* sink; const float* rpb; float lambda_init; };

template <int WHICH>
__device__ __forceinline__ void scalar_attn_phase(const AttnPtrs& P, LAS unsigned char* lds, int gw, int NGW, int wave, int lane) {
    LAS float* sq = (LAS float*)(lds + wave * 16896); LAS float* ss = sq + 128;
    constexpr int NH = WHICH == 0 ? 18 : 8;
    float lmbda = 0.f;
    if constexpr (WHICH == 1) { const float d01 = wave_sum(P.lam[lane] * P.lam[64 + lane]), d23 = wave_sum(P.lam[128 + lane] * P.lam[192 + lane]); lmbda = __expf(d01) - __expf(d23) + P.lambda_init; }
    for (int task = gw; task < NH * MTOK; task += NGW) {
        const int hs = task / MTOK, row = task % MTOK, b = row >> 12, s = row & 4095;
        const bf16_t* prow = P.proj + (size_t)row * IN_TOTAL; const bf16_t* pb = P.proj + (size_t)(b * SEQ) * IN_TOTAL;
        float o0, o1, mm, ll;
        if constexpr (WHICH == 0) {
            const int hh = hs, g = hh / 6, r = (g == 0) ? 1 : ((g == 1) ? 4 : 16); KeyA kf{s, r};
            sattn<128>(prow + OFF_QA + hh * 128, pb + OFF_KA + hh * 128, pb + OFF_VA + hh * 128, kf, 129, 0.08838834764831845f, false, 0.f, sq, ss, lane, o0, o1, mm, ll);
            *(unsigned*)(P.ag + ((size_t)g * MTOK + row) * 768 + (hh % 6) * 128 + 2 * lane) = cvt_pk_bf16(o0, o1);
            if (lane == 0) P.lse[((size_t)g * MTOK + row) * 6 + (hh % 6)] = mm + __logf(ll);
        } else if constexpr (WHICH == 1) {
            const int h = hs; KeyB kf; float a0, a1, b0, b1;
            sattn<64>(prow + OFF_QB + (2 * h) * 64, pb + OFF_KB + (2 * h) * 64, pb + OFF_VB + h * 128, kf, SEQ, 0.125f, false, 0.f, sq, ss, lane, a0, a1, mm, ll);
            sattn<64>(prow + OFF_QB + (2 * h + 1) * 64, pb + OFF_KB + (2 * h + 1) * 64, pb + OFF_VB + h * 128, kf, SEQ, 0.125f, false, 0.f, sq, ss, lane, b0, b1, mm, ll);
            const float v0 = a0 - lmbda * b0, v1 = a1 - lmbda * b1;
            const float rinv = rsqrtf(wave_sum(v0 * v0 + v1 * v1) * (1.0f / 128.0f) + SUBLN_EPS) * (1.0f - P.lambda_init);
            *(unsigned*)(P.ob + (size_t)row * 1024 + h * 128 + 2 * lane) = cvt_pk_bf16(v0 * rinv * P.subln[2 * lane], v1 * rinv * P.subln[2 * lane + 1]);
        } else if constexpr (WHICH == 2) {
            const int qh = hs, kvh = qh >> 2; KeyC kf{s};
            sattn<128>(prow + OFF_QC + qh * 128, pb + OFF_KC + kvh * 128, pb + OFF_VC + kvh * 128, kf, 257, 0.08838834764831845f, true, P.sink[qh], sq, ss, lane, o0, o1, mm, ll);
            *(unsigned*)(P.oc + (size_t)row * 1024 + qh * 128 + 2 * lane) = cvt_pk_bf16(o0, o1);
        } else {
            const int h = hs, r = s >> 6, c = s & 63; int rs = r - 4; rs = rs < 0 ? 0 : (rs > 56 ? 56 : rs); int cs = c - 8; cs = cs < 0 ? 0 : (cs > 48 ? 48 : cs);
            KeyD kf{r, c, rs, cs, P.rpb + h * 465};
            sattn<128>(prow + OFF_QD + h * 128, pb + OFF_KD + h * 128, pb + OFF_VD + h * 128, kf, 128, 0.08838834764831845f, false, 0.f, sq, ss, lane, o0, o1, mm, ll);
            *(unsigned*)(P.od + (size_t)row * 1024 + h * 128 + 2 * lane) = cvt_pk_bf16(o0, o1);
        }
    }
}

__device__ __forceinline__ void combine_a_phase(const bf16_t* ag, const float* lse, bf16_t* oa, int gw, int NGW, int lane) {
    for (int row = gw; row < MTOK; row += NGW) {
#pragma unroll
        for (int j = 0; j < 3; ++j) {
            const int e = 4 * lane + 256 * j, head = e >> 7;
            const float l0 = lse[((size_t)0 * MTOK + row) * 6 + head], l1 = lse[((size_t)1 * MTOK + row) * 6 + head], l2 = lse[((size_t)2 * MTOK + row) * 6 + head];
            const float mx = fmaxf(l0, fmaxf(l1, l2)); float w0 = __expf(l0 - mx), w1 = __expf(l1 - mx), w2 = __expf(l2 - mx); const float inv = 1.0f / (w0 + w1 + w2); w0 *= inv; w1 *= inv; w2 *= inv;
            const u32x2 a0 = *(const u32x2*)(ag + ((size_t)0 * MTOK + row) * 768 + e), a1 = *(const u32x2*)(ag + ((size_t)1 * MTOK + row) * 768 + e), a2 = *(const u32x2*)(ag + ((size_t)2 * MTOK + row) * 768 + e);
            u32x2 o;
            o.x = cvt_pk_bf16(w0 * bflo(a0.x) + w1 * bflo(a1.x) + w2 * bflo(a2.x), w0 * bfhi(a0.x) + w1 * bfhi(a1.x) + w2 * bfhi(a2.x));
            o.y = cvt_pk_bf16(w0 * bflo(a0.y) + w1 * bflo(a1.y) + w2 * bflo(a2.y), w0 * bfhi(a0.y) + w1 * bfhi(a1.y) + w2 * bfhi(a2.y));
            *(u32x2*)(oa + (size_t)row * 768 + e) = o;
        }
    }
}
__device__ __forceinline__ void ln1_router_phase(const float* preln, const float* gain, const float* bias, const float* wr, float* xf, bf16_t* xb, float* aff,
                                                 LAS unsigned char* lds, int tid, int gw, int NGW, int lane) {
    LAS float* W = (LAS float*)lds;
    for (int i = tid; i < DM * NEXP; i += NWAVES * 64) { const int k = i >> 4, e = i & 15; W[e * DM + k] = wr[i]; }
    __syncthreads();
    f32x4 g[8], bb[8];
#pragma unroll
    for (int j = 0; j < 8; ++j) { g[j] = *(const f32x4*)(gain + 256 * j + 4 * lane); bb[j] = *(const f32x4*)(bias + 256 * j + 4 * lane); }
    for (int row = gw; row < MTOK; row += NGW) {
        const float* pr = preln + (size_t)row * DM + 4 * lane;
        f32x4 v[8]; float s = 0.f;
#pragma unroll
        for (int j = 0; j < 8; ++j) { v[j] = *(const f32x4*)(pr + 256 * j); s += (v[j][0] + v[j][1]) + (v[j][2] + v[j][3]); }
        const float mean = wave_sum(s) * (1.0f / DM); float q = 0.f;
#pragma unroll
        for (int j = 0; j < 8; ++j) { v[j] = v[j] - mean; q += (v[j][0] * v[j][0] + v[j][1] * v[j][1]) + (v[j][2] * v[j][2] + v[j][3] * v[j][3]); }
        const float rstd = rsqrtf(wave_sum(q) * (1.0f / DM) + LN_EPS);
        float* xo = xf + (size_t)row * DM + 4 * lane; bf16_t* xbo = xb + (size_t)row * DM + 4 * lane;
#pragma unroll
        for (int j = 0; j < 8; ++j) { v[j] = v[j] * rstd * g[j] + bb[j]; *(f32x4*)(xo + 256 * j) = v[j];
            u32x2 w; w.x = cvt_pk_bf16(v[j][0], v[j][1]); w.y = cvt_pk_bf16(v[j][2], v[j][3]); *(u32x2*)(xbo + 256 * j) = w; }
        float lg[16];
#pragma unroll
        for (int e = 0; e < 16; ++e) { float a = 0.f;
#pragma unroll
            for (int j = 0; j < 8; ++j) { const f32x4 w = *(const LAS f32x4*)(W + e * DM + 256 * j + 4 * lane); a += (v[j][0] * w[0] + v[j][1] * w[1]) + (v[j][2] * w[2] + v[j][3] * w[3]); }
            lg[e] = wave_sum(a); }
        float mx = lg[0];
#pragma unroll
        for (int e = 1; e < 16; ++e) mx = fmaxf(mx, lg[e]);
        float den = 0.f;
#pragma unroll
        for (int e = 0; e < 16; ++e) { lg[e] = expf(lg[e] - mx); den += lg[e]; }
        float mine = 0.f;
#pragma unroll
        for (int e = 0; e < 16; ++e) mine = (lane == e) ? lg[e] : mine;
        if (lane < 16) aff[((size_t)(row >> 12) * NEXP + lane) * SEQ + (row & 4095)] = mine / den;
    }
    __syncthreads();
}
__device__ __forceinline__ void topk_phase(const float* aff, int* idxo, float* gvo, int* sloto, LAS unsigned char* lds, int tid, int wave, int lane, int wg, int G) {
    LAS int* cnt = (LAS int*)lds;
    for (int be = wg; be < NGRP; be += G) {
        const float* a = aff + (size_t)be * SEQ + tid * 8;
        const f32x4 a0 = *(const f32x4*)a, a1 = *(const f32x4*)(a + 4);
        unsigned v[8] = {__float_as_uint(a0[0]), __float_as_uint(a0[1]), __float_as_uint(a0[2]), __float_as_uint(a0[3]), __float_as_uint(a1[0]), __float_as_uint(a1[1]), __float_as_uint(a1[2]), __float_as_uint(a1[3])};
        unsigned T = 0u;
        for (int bit = 30; bit >= 0; --bit) {
            const unsigned cand = T | (1u << bit); int c = 0;
#pragma unroll
            for (int k = 0; k < 8; ++k) c += (v[k] >= cand) ? 1 : 0;
            c = wave_sum_i(c);
            if (lane == 0) cnt[(bit & 1) * 8 + wave] = c;
            __syncthreads();
            int tot = 0;
#pragma unroll
            for (int w = 0; w < 8; ++w) tot += cnt[(bit & 1) * 8 + w];
            if (tot >= CAP) T = cand;
        }
        int ngt = 0, neq = 0;
#pragma unroll
        for (int k = 0; k < 8; ++k) { ngt += (v[k] > T) ? 1 : 0; neq += (v[k] == T) ? 1 : 0; }
        int sgt = ngt, seq = neq;
#pragma unroll
        for (int o = 1; o < 64; o <<= 1) { const int tg = __shfl_up(sgt, o), te = __shfl_up(seq, o); if (lane >= o) { sgt += tg; seq += te; } }
        __syncthreads();
        if (lane == 63) { cnt[64 + wave] = sgt; cnt[64 + 8 + wave] = seq; }
        __syncthreads();
        int pgt = sgt - ngt, peq = seq - neq, totgt = 0;
#pragma unroll
        for (int w = 0; w < 8; ++w) { const int tg = cnt[64 + w], te = cnt[64 + 8 + w]; if (w < wave) { pgt += tg; peq += te; } totgt += tg; }
        const int need = CAP - totgt;
        const int b = be >> 4, e = be & 15;
#pragma unroll
        for (int k = 0; k < 8; ++k) {
            const bool gt = v[k] > T, eq = v[k] == T; const bool sel = gt || (eq && peq < need);
            const int slot = pgt + (peq < need ? peq : need);
            const int tok = tid * 8 + k;
            if (sel) { idxo[be * CAP + slot] = tok; gvo[be * CAP + slot] = __uint_as_float(v[k]); }
            sloto[((size_t)b * SEQ + tok) * NEXP + e] = sel ? slot : -1;
            pgt += gt ? 1 : 0; peq += eq ? 1 : 0;
        }
        __syncthreads();
    }
}
__device__ __forceinline__ void gather_phase(const bf16_t* xb, const int* idx, bf16_t* xg, int gw, int NGW, int lane) {
    for (int r = gw; r < NGRP * CAP; r += NGW) {
        const int be = r >> 9, b = be >> 4; const int tok = idx[r];
        const u32x4* src = (const u32x4*)(xb + ((size_t)b * SEQ + tok) * DM); u32x4* dst = (u32x4*)(xg + (size_t)r * DM);
#pragma unroll
        for (int j = 0; j < 4; ++j) dst[64 * j + lane] = src[64 * j + lane];
    }
}
__device__ __forceinline__ void ln2_phase(const float* x1, const bf16_t* y, const int* slot, const float* gain, const float* bias, float* xo_base, bf16_t* xb, int gw, int NGW, int lane) {
    f32x4 g[8], bb[8];
#pragma unroll
    for (int j = 0; j < 8; ++j) { g[j] = *(const f32x4*)(gain + 256 * j + 4 * lane); bb[j] = *(const f32x4*)(bias + 256 * j + 4 * lane); }
    for (int row = gw; row < MTOK; row += NGW) {
        const int b = row >> 12;
        const int myslot = slot[(size_t)row * NEXP + (lane & 15)];
        f32x4 acc[8];
#pragma unroll
        for (int j = 0; j < 8; ++j) acc[j] = (f32x4){0.f, 0.f, 0.f, 0.f};
        for (int e = 0; e < NEXP; ++e) {
            const int sl = __shfl(myslot, e);
            if (sl >= 0) {
                const bf16_t* yr = y + ((size_t)(b * NEXP + e) * CAP + sl) * DM + 4 * lane;
#pragma unroll
                for (int j = 0; j < 8; ++j) { const u32x2 w = *(const u32x2*)(yr + 256 * j); acc[j][0] += bflo(w.x); acc[j][1] += bfhi(w.x); acc[j][2] += bflo(w.y); acc[j][3] += bfhi(w.y); }
            }
        }
        const float* pr = x1 + (size_t)row * DM + 4 * lane; float s = 0.f;
#pragma unroll
        for (int j = 0; j < 8; ++j) { const f32x4 x = *(const f32x4*)(pr + 256 * j); acc[j] = x * ALPHA + acc[j]; s += (acc[j][0] + acc[j][1]) + (acc[j][2] + acc[j][3]); }
        const float mean = wave_sum(s) * (1.0f / DM); float q = 0.f;
#pragma unroll
        for (int j = 0; j < 8; ++j) { acc[j] = acc[j] - mean; q += (acc[j][0] * acc[j][0] + acc[j][1] * acc[j][1]) + (acc[j][2] * acc[j][2] + acc[j][3] * acc[j][3]); }
        const float rstd = rsqrtf(wave_sum(q) * (1.0f / DM) + LN_EPS);
        float* xo = xo_base + (size_t)row * DM + 4 * lane; bf16_t* xbo = xb + (size_t)row * DM + 4 * lane;
#pragma unroll
        for (int j = 0; j < 8; ++j) { const f32x4 o = acc[j] * rstd * g[j] + bb[j]; *(f32x4*)(xo + 256 * j) = o;
            u32x2 w; w.x = cvt_pk_bf16(o[0], o[1]); w.y = cvt_pk_bf16(o[2], o[3]); *(u32x2*)(xbo + 256 * j) = w; }
    }
}

struct InPtrs { const float *x, *w_in, *b_gate, *w_branch, *w_out, *diff_lambda, *diff_subln, *sink_logit, *na_rpb, *w_router, *w_exp_gate, *w_exp_up, *w_exp_down, *ln_gain, *ln_bias; };

__device__ __forceinline__ void prologue_phase(const InPtrs& I, unsigned char* ws, int gw, int NGW, int lane) {
    { const f32x4* xs = (const f32x4*)I.x; f32x4* xf = (f32x4*)(ws + WS_XF); u32x4* xb = (u32x4*)(ws + WS_XB);
      for (size_t i = (size_t)gw * 64 + lane; i < (size_t)MTOK * DM / 8; i += (size_t)NGW * 64) {
          const f32x4 a = xs[2 * i], b = xs[2 * i + 1]; xf[2 * i] = a; xf[2 * i + 1] = b;
          u32x4 w; w.x = cvt_pk_bf16(a[0], a[1]); w.y = cvt_pk_bf16(a[2], a[3]); w.z = cvt_pk_bf16(b[0], b[1]); w.w = cvt_pk_bf16(b[2], b[3]); xb[i] = w; } }
    { float* r128 = (float*)(ws + WS_ROPE128); float* r64 = (float*)(ws + WS_ROPE64);
      for (int i = gw * 64 + lane; i < SEQ * 64 + SEQ * 32; i += NGW * 64) {
          int pos, ii, half; float* dst;
          if (i < SEQ * 64) { pos = i >> 6; ii = i & 63; half = 64; dst = r128 + 2 * (size_t)i; } else { const int k = i - SEQ * 64; pos = k >> 5; ii = k & 31; half = 32; dst = r64 + 2 * (size_t)k; }
          const float inv = (float)pow(10000.0, -(double)ii / (double)half); const float ang = (float)pos * inv;
          dst[0] = (float)cos((double)ang); dst[1] = (float)sin((double)ang); } }
    bf16_t* WIN = (bf16_t*)(ws + WS_WIN); bf16_t* WBR = (bf16_t*)(ws + WS_WBR); bf16_t* WOUT = (bf16_t*)(ws + WS_WOUT); bf16_t* WGU = (bf16_t*)(ws + WS_WGU); bf16_t* WDN = (bf16_t*)(ws + WS_WDN);
    constexpr int N1 = DEPTH * 32 * 356, N2 = DEPTH * 60 * 32, N3 = DEPTH * 32 * 32, N4 = DEPTH * NEXP * 32 * 32, N5 = DEPTH * NEXP * 16 * 32;
    for (int it = gw; it < N1 + N2 + N3 + N4 + N5; it += NGW) {
        int r = it;
        if (r < N1) { const int nb = r % 356, kb = (r / 356) % 32, l = r / (356 * 32); const int n = nb * 64 + lane;
            tr_item(I.w_in + (size_t)l * DM * IN_TOTAL, IN_TOTAL, win_src_col(n), kb * 64, WIN + ((size_t)l * IN_TOTAL + n) * DM); continue; }
        r -= N1;
        if (r < N2) { const int nb = r % 32, kbg = (r / 32) % 60, l = r / (32 * 60); const int n = nb * 64 + lane;
            int ro, Kb, kb; if (kbg < 12) { ro = 0; Kb = 768; kb = kbg; } else { const int q = (kbg - 12) >> 4; ro = 768 + 1024 * q; Kb = 1024; kb = (kbg - 12) & 15; }
            tr_item(I.w_branch + ((size_t)l * BR_TOTAL + ro) * DM, DM, n, kb * 64, WBR + ((size_t)l * BR_TOTAL + ro) * DM + (size_t)n * Kb); continue; }
        r -= N2;
        if (r < N3) { const int nb = r % 32, kb = (r / 32) % 32, l = r / (32 * 32); const int n = nb * 64 + lane;
            tr_item(I.w_out + (size_t)l * DM * DM, DM, n, kb * 64, WOUT + ((size_t)l * DM + n) * DM); continue; }
        r -= N3;
        if (r < N4) { const int nb = r % 32, kb = (r / 32) % 32, le = r / (32 * 32); const int n = nb * 64 + lane, pn = n >> 8, bj = (n >> 7) & 1, jj = n & 127;
            tr_item((bj ? I.w_exp_up : I.w_exp_gate) + (size_t)le * DM * DEXP, DEXP, pn * 128 + jj, kb * 64, WGU + ((size_t)le * 2048 + n) * DM); continue; }
        r -= N4;
        { const int nb = r % 32, kb = (r / 32) % 16, le = r / (32 * 16); const int n = nb * 64 + lane;
            tr_item(I.w_exp_down + (size_t)le * DEXP * DM, DM, n, kb * 64, WDN + ((size_t)le * DM + n) * DEXP); }
    }
}

struct Args { const float* in[15]; float* out; unsigned char* ws; int ph_lo, ph_hi; };
__global__ void __launch_bounds__(NWAVES * 64, 2) fwd(Args args) {
    extern __shared__ __attribute__((aligned(16))) unsigned char lds_raw[];
    LAS unsigned char* lds = (LAS unsigned char*)lds_raw;
    for (int u = threadIdx.x; u < (LDS_BYTES - LDSCTL_OFF) / 4; u += NWAVES * 64) ((LAS unsigned*)(lds + LDSCTL_OFF))[u] = 0u;
    __syncthreads();
    unsigned* ctl = (unsigned*)(args.ws + WS_CTL);
    XcdBarrier bar = xcd_barrier_post(ctl + CW_BAR, (volatile LAS unsigned*)(lds + LDSCTL_OFF));
    const int lo = args.ph_lo, hi = args.ph_hi;
#ifndef PH_MASK
#define PH_MASK 0xFFFF
#endif
#define PHON(k) ((PH_MASK >> (k)) & 1)
#define IN(k) (lo <= (k) && (k) < hi)
#define PHASE_LOCALS long zz = 0; asm volatile("" : "+s"(zz)); unsigned char* const ws = args.ws + zz; int tid = threadIdx.x; asm volatile("" : "+v"(tid)); int bx = blockIdx.x, G = gridDim.x; asm volatile("" : "+s"(bx), "+s"(G)); \
    const int lane = tid & 63, wave = __builtin_amdgcn_readfirstlane(tid >> 6); const int vcu = (G % 8 == 0) ? (bx % 8) * (G / 8) + bx / 8 : bx; \
    const int gw = vcu * NWAVES + wave, NGW = G * NWAVES; (void)lane; (void)gw; (void)NGW
#define SEAM(k) do { if (IN(k) && IN((k) + 1)) xcd_barrier(bar); } while (0)

#define XF ((float*)(ws + WS_XF))
#define XB ((bf16_t*)(ws + WS_XB))
#define PROJ ((bf16_t*)(ws + WS_PROJ))
#define OA ((bf16_t*)(ws + WS_OA))
#define OB ((bf16_t*)(ws + WS_OB))
#define OC ((bf16_t*)(ws + WS_OC))
#define OD ((bf16_t*)(ws + WS_OD))
#define AG ((bf16_t*)(ws + WS_AG))
#define LSE ((float*)(ws + WS_LSE))
#define MIXED ((bf16_t*)(ws + WS_MIXED))
#define PRELN ((float*)(ws + WS_PRELN))
#define XG ((bf16_t*)(ws + WS_XG))
#define HB ((bf16_t*)(ws + WS_H))
#define YB ((bf16_t*)(ws + WS_Y))
#define AFF ((float*)(ws + WS_AFF))
#define IDX ((int*)(ws + WS_IDX))
#define GV ((float*)(ws + WS_GV))
#define SLOT ((int*)(ws + WS_SLOT))

    if (PHON(0) && IN(0)) { PHASE_LOCALS;
        InPtrs I; I.x = args.in[0 + zz]; I.w_in = args.in[1 + zz]; I.b_gate = args.in[2 + zz]; I.w_branch = args.in[3 + zz]; I.w_out = args.in[4 + zz]; I.diff_lambda = args.in[5 + zz]; I.diff_subln = args.in[6 + zz];
        I.sink_logit = args.in[7 + zz]; I.na_rpb = args.in[8 + zz]; I.w_router = args.in[9 + zz]; I.w_exp_gate = args.in[10 + zz]; I.w_exp_up = args.in[11 + zz]; I.w_exp_down = args.in[12 + zz]; I.ln_gain = args.in[13 + zz]; I.ln_bias = args.in[14 + zz];
        prologue_phase(I, ws, gw, NGW, lane); SEAM(0); }

    for (int l = 0; l < DEPTH; ++l) {
        const int pb = 1 + l * NPL;
        if (PHON(1) && IN(pb + 0)) { PHASE_LOCALS;
            pg8::Gemm g{XB, (const bf16_t*)(ws + WS_WIN) + (size_t)l * IN_TOTAL * DM, MTOK, IN_TOTAL, DM, 0}; pg8::StaticOrder S; S.init(MTOK, IN_TOTAL, G, bx);
            pg8::EpiProj E{PROJ, args.in[2 + zz] + (size_t)l * 8192, (const float*)(ws + WS_ROPE128), (const float*)(ws + WS_ROPE64)};
            pg8::gemm_phase<pg8::EpiProj, pg8::StaticOrder, true, true>(lds, g, S, E, tid);
            SEAM(pb + 0);
        }
        if (PHON(2) && IN(pb + 1)) { PHASE_LOCALS;
            const float li = l == 0 ? 0.2f : (l == 1 ? 0.35550906759096926f : (l == 2 ? 0.47071301834358416f : 0.5560582041556405f));
            { AttnPtrs P{PROJ, AG, LSE, nullptr, nullptr, nullptr, nullptr, nullptr, nullptr, nullptr, li}; scalar_attn_phase<0>(P, lds, gw, NGW, wave, lane); }
            { AttnPtrs P{PROJ, nullptr, nullptr, OB, nullptr, nullptr, args.in[5 + zz] + l * 256, args.in[6 + zz] + l * 128, nullptr, nullptr, li}; scalar_attn_phase<1>(P, lds, gw, NGW, wave, lane); }
            { AttnPtrs P{PROJ, nullptr, nullptr, nullptr, OC, nullptr, nullptr, nullptr, args.in[7 + zz] + l * 8, nullptr, li}; scalar_attn_phase<2>(P, lds, gw, NGW, wave, lane); }
            { AttnPtrs P{PROJ, nullptr, nullptr, nullptr, nullptr, OD, nullptr, nullptr, nullptr, args.in[8 + zz] + (size_t)l * 8 * 465, li}; scalar_attn_phase<3>(P, lds, gw, NGW, wave, lane); }
            SEAM(pb + 1);
        }
        if (PHON(3) && IN(pb + 2)) { PHASE_LOCALS; combine_a_phase(AG, LSE, OA, gw, NGW, lane); SEAM(pb + 2); }
        if (PHON(4) && IN(pb + 3)) { PHASE_LOCALS;
            const bf16_t* wbr = (const bf16_t*)(ws + WS_WBR) + (size_t)l * BR_TOTAL * DM;
            for (int br = 0; br < 4; ++br) {
                const bf16_t* A = br == 0 ? OA : (br == 1 ? OB : (br == 2 ? OC : OD)); const int Kb = br == 0 ? 768 : 1024; const int ro = br == 0 ? 0 : 768 + 1024 * (br - 1);
                pg8::Gemm g{A, wbr + (size_t)ro * DM, MTOK, DM, Kb, 0}; pg8::StaticOrder S; S.init(MTOK, DM, G, bx);
                pg8::EpiGate E{MIXED, PROJ + OFF_GATE + br * DM, br == 0 ? 1 : 0};
                pg8::gemm_phase<pg8::EpiGate, pg8::StaticOrder, true, true>(lds, g, S, E, tid);
                asm volatile("s_waitcnt vmcnt(0)" ::: "memory");
            }
            SEAM(pb + 3);
        }
        if (PHON(5) && IN(pb + 4)) { PHASE_LOCALS;
            pg8::Gemm g{MIXED, (const bf16_t*)(ws + WS_WOUT) + (size_t)l * DM * DM, MTOK, DM, DM, 0}; pg8::StaticOrder S; S.init(MTOK, DM, G, bx);
            pg8::EpiResid E{PRELN, XF, ALPHA};
            pg8::gemm_phase<pg8::EpiResid, pg8::StaticOrder, true, true>(lds, g, S, E, tid);
            SEAM(pb + 4);
        }
        if (PHON(6) && IN(pb + 5)) { PHASE_LOCALS; ln1_router_phase(PRELN, args.in[13 + zz] + (size_t)(l * 2) * DM, args.in[14 + zz] + (size_t)(l * 2) * DM, args.in[9 + zz] + (size_t)l * DM * NEXP, XF, XB, AFF, lds, tid, gw, NGW, lane); SEAM(pb + 5); }
        if (PHON(7) && IN(pb + 6)) { PHASE_LOCALS; topk_phase(AFF, IDX, GV, SLOT, lds, tid, wave, lane, bx, G); SEAM(pb + 6); }
        if (PHON(8) && IN(pb + 7)) { PHASE_LOCALS; gather_phase(XB, IDX, XG, gw, NGW, lane); SEAM(pb + 7); }
        if (PHON(9) && IN(pb + 8)) { PHASE_LOCALS;
            pg8::Gemm g{XG, (const bf16_t*)(ws + WS_WGU) + (size_t)l * NEXP * 2048 * DM, NGRP * CAP, 2048, DM, (size_t)2048 * DM * 2}; pg8::StaticOrder S; S.init(NGRP * CAP, 2048, G, bx);
            pg8::EpiSwiGLU E{HB};
            pg8::gemm_phase<pg8::EpiSwiGLU, pg8::StaticOrder, true, true>(lds, g, S, E, tid);
            SEAM(pb + 8);
        }
        if (PHON(10) && IN(pb + 9)) { PHASE_LOCALS;
            pg8::Gemm g{HB, (const bf16_t*)(ws + WS_WDN) + (size_t)l * NEXP * DM * DEXP, NGRP * CAP, DM, DEXP, (size_t)DM * DEXP * 2}; pg8::StaticOrder S; S.init(NGRP * CAP, DM, G, bx);
            pg8::EpiDown E{YB, GV};
            pg8::gemm_phase<pg8::EpiDown, pg8::StaticOrder, true, true>(lds, g, S, E, tid);
            SEAM(pb + 9);
        }
        if (PHON(11) && IN(pb + 10)) { PHASE_LOCALS;
            ln2_phase(XF, YB, SLOT, args.in[13 + zz] + (size_t)(l * 2 + 1) * DM, args.in[14 + zz] + (size_t)(l * 2 + 1) * DM, (l == DEPTH - 1) ? args.out : XF, XB, gw, NGW, lane);
            SEAM(pb + 10);
        }
    }
#undef IN
#undef SEAM
}

#ifndef MK_ONE_LAUNCH
#define MK_ONE_LAUNCH 1
#endif
extern "C" void kernel_launch(void* const* d_in, const int* in_sizes, int n_in, void* d_out, int out_size, void* d_ws, size_t ws_size, hipStream_t stream) {
    static int grid = 0;
    if (grid == 0) {
        if (n_in != 15 || out_size != MTOK * DM || ws_size < WS_END) { fprintf(stderr, "kernel_launch: unexpected shapes (n_in %d out %d ws %zu, need ws >= %zu)\n", n_in, out_size, ws_size, (size_t)WS_END); grid = -1; return; }
        int dev = 0, cus = 0, per_cu = 0;
        if (hipGetDevice(&dev) != hipSuccess || hipDeviceGetAttribute(&cus, hipDeviceAttributeMultiprocessorCount, dev) != hipSuccess) { grid = -1; return; }
        if (hipFuncSetAttribute((const void*)fwd, hipFuncAttributeMaxDynamicSharedMemorySize, LDS_BYTES) != hipSuccess) { fprintf(stderr, "kernel_launch: hipFuncSetAttribute failed\n"); grid = -1; return; }
        if (hipOccupancyMaxActiveBlocksPerMultiprocessor(&per_cu, (const void*)fwd, NWAVES * 64, LDS_BYTES) != hipSuccess || per_cu < 1) { fprintf(stderr, "kernel_launch: occupancy query says %d\n", per_cu); }
        (void)hipGetLastError();
        grid = cus;
    }
    if (grid < 0) return;
    if (hipMemsetAsync((char*)d_ws + WS_CTL, 0, CTL_ZERO_BYTES, stream) != hipSuccess) return;
    Args a{};
    for (int i = 0; i < 15; ++i) a.in[i] = (const float*)d_in[i];
    a.out = (float*)d_out; a.ws = (unsigned char*)d_ws;
#if MK_ONE_LAUNCH
    a.ph_lo = 0; a.ph_hi = NPHASES;
    hipLaunchKernelGGL(fwd, dim3(grid), dim3(NWAVES * 64), LDS_BYTES, stream, a);
#else
    for (int p = 0; p < NPHASES; ++p) { a.ph_lo = p; a.ph_hi = p + 1; hipLaunchKernelGGL(fwd, dim3(grid), dim3(NWAVES * 64), LDS_BYTES, stream, a); }
#endif
}
```

```cpp
#include <hip/hip_runtime.h>
#include <cstdio>
#include <cstdint>
#include <cmath>
namespace pg8 {
#define PG8_LAS __attribute__((address_space(3)))
typedef unsigned short bf16_t;
typedef short bf16x8 __attribute__((ext_vector_type(8)));
typedef float f32x4 __attribute__((ext_vector_type(4)));
typedef unsigned u32x4 __attribute__((ext_vector_type(4)));
constexpr int BM = 256, BK = 64, HALF = 128, HTB = HALF * BK * 2  , STAGE_BYTES = 8 * HTB, NXCD = 8, WGM = 8;

__host__ __device__ __forceinline__ int lds_byte(int r, int c) { const int st = (r >> 4) * 2 + (c >> 5), rr = r & 15, cc = c & 31, ob = rr * 64 + cc * 2; return st * 1024 + (ob ^ (((ob >> 9) & 1) << 5)); }
__host__ __device__ __forceinline__ void stage_rc(int b, int& R, int& C) { const int st = b / 1024, sb = b % 1024, swz = sb ^ (((sb >> 9) & 1) << 5); R = (st >> 1) * 16 + swz / 64; C = (st & 1) * 32 + (swz % 64) / 2; }
__host__ __device__ __forceinline__ int perm32(int rho) { const int n = rho >> 4, i = rho & 15; return 8 * (i >> 2) + 4 * n + (i & 3); }

struct Unit { int pm, pn; };
struct Gemm { const bf16_t* A; const bf16_t* Bt; int M, N, K; size_t gstride; };

struct StaticOrder {
    int nM, nN, nwg, G, c;
    __host__ __device__ void init(int M, int N, int G_, int c_) { nM = M / BM; nN = N / BM; nwg = nM * nN; G = G_; c = c_; }
    __host__ __device__ bool next(int i, Unit& u) const {
        const long L = (long)i * G + c; if (L >= nwg) return false;
        int wgid = (int)L; { const int q = nwg / NXCD, r = nwg % NXCD, xcd = wgid % NXCD, off = wgid / NXCD; wgid = (xcd < r ? xcd * (q + 1) : r * (q + 1) + (xcd - r) * q) + off; }
        const int nig = WGM * nN, gid = wgid / nig, fm = gid * WGM, gsz = (nM - fm) < WGM ? (nM - fm) : WGM;
        u.pm = fm + ((wgid % nig) % gsz); u.pn = (wgid % nig) / gsz; return true;
    }
    __device__ __forceinline__ void a_ready(const Unit&) const {}
    __device__ __forceinline__ void done(const Unit&) const {}
};


__device__ __forceinline__ unsigned cvt_pk_bf16(float lo, float hi) { unsigned r; asm volatile("v_cvt_pk_bf16_f32 %0, %1, %2" : "=v"(r) : "v"(lo), "v"(hi)); return r; }
__device__ __forceinline__ float bflo(unsigned w) { return __uint_as_float(w << 16); }
__device__ __forceinline__ float bfhi(unsigned w) { return __uint_as_float(w & 0xffff0000u); }
__device__ __forceinline__ float sigmoidf_(float x) { return 1.0f / (1.0f + __expf(-x)); }

struct EpiProj {
    static constexpr bool PERM = true, AFTER_DRAIN = false;
    bf16_t* O; const float* bgate; const float* rope128; const float* rope64;
    __device__ __forceinline__ void operator()(const f32x4 (&acc)[2][2][4][2], const Unit& u, int wr, int wc, int fr, int fq) const {
        const int colt = u.pn * BM;
        int mode;
        if (colt < 4608) mode = 1; else if (colt < 6912) mode = 0; else if (colt < 8960) mode = 2; else if (colt < 9984) mode = 0; else if (colt < 11264) mode = 1; else if (colt < 14592) mode = 0; else mode = 3;
        const int row0 = u.pm * BM + wr * 64 + fr, col0 = colt + wc * 32 + 8 * fq;
        const int i128 = 16 * wc + 4 * fq, i64 = 16 * (wc & 1) + 4 * fq;
        f32x4 gb[2][2];
        if (mode == 3) {
#pragma unroll
            for (int bj = 0; bj < 2; ++bj)
#pragma unroll
                for (int n = 0; n < 2; ++n) gb[bj][n] = *(const f32x4*)(bgate + (col0 - 14592) + bj * HALF + 4 * n);
        }
#pragma unroll
        for (int ai = 0; ai < 2; ++ai)
#pragma unroll
            for (int m = 0; m < 4; ++m) {
                const int row = row0 + ai * HALF + m * 16; const int pos = row & 4095;
                bf16_t* rowp = O + (size_t)row * 22784 + col0;
                f32x4 cs0 = {1.f, 0.f, 1.f, 0.f}, cs1 = {1.f, 0.f, 1.f, 0.f};
                if (mode == 1) { const f32x4* t = (const f32x4*)(rope128 + ((size_t)pos * 64 + i128) * 2); cs0 = t[0]; cs1 = t[1]; }
                if (mode == 2) { const f32x4* t = (const f32x4*)(rope64 + ((size_t)pos * 32 + i64) * 2); cs0 = t[0]; cs1 = t[1]; }
#pragma unroll
                for (int bj = 0; bj < 2; ++bj) {
                    f32x4 v0 = acc[ai][bj][m][0], v1 = acc[ai][bj][m][1];
                    if (mode == 1 || mode == 2) {
                        f32x4 r0, r1;
                        r0[0] = v0[0] * cs0[0] - v0[1] * cs0[1]; r0[1] = v0[1] * cs0[0] + v0[0] * cs0[1];
                        r0[2] = v0[2] * cs0[2] - v0[3] * cs0[3]; r0[3] = v0[3] * cs0[2] + v0[2] * cs0[3];
                        r1[0] = v1[0] * cs1[0] - v1[1] * cs1[1]; r1[1] = v1[1] * cs1[0] + v1[0] * cs1[1];
                        r1[2] = v1[2] * cs1[2] - v1[3] * cs1[3]; r1[3] = v1[3] * cs1[2] + v1[2] * cs1[3];
                        v0 = r0; v1 = r1;
                    }
                    if (mode == 3) {
                        v0 = v0 + gb[bj][0]; v1 = v1 + gb[bj][1];
#pragma unroll
                        for (int j = 0; j < 4; ++j) { v0[j] = sigmoidf_(v0[j]); v1[j] = sigmoidf_(v1[j]); }
                    }
                    u32x4 w; w.x = cvt_pk_bf16(v0[0], v0[1]); w.y = cvt_pk_bf16(v0[2], v0[3]); w.z = cvt_pk_bf16(v1[0], v1[1]); w.w = cvt_pk_bf16(v1[2], v1[3]);
                    *(u32x4*)(rowp + bj * HALF) = w;
                }
            }
    }
};
struct EpiGate {
    static constexpr bool PERM = true, AFTER_DRAIN = false;
    bf16_t* mixed; const bf16_t* gate; int first;
    __device__ __forceinline__ void operator()(const f32x4 (&acc)[2][2][4][2], const Unit& u, int wr, int wc, int fr, int fq) const {
        const int row0 = u.pm * BM + wr * 64 + fr, col0 = u.pn * BM + wc * 32 + 8 * fq;
#pragma unroll
        for (int ai = 0; ai < 2; ++ai)
#pragma unroll
            for (int m = 0; m < 4; ++m) {
                const int row = row0 + ai * HALF + m * 16;
                const bf16_t* gp = gate + (size_t)row * 22784 + col0; bf16_t* mp = mixed + (size_t)row * 2048 + col0;
#pragma unroll
                for (int bj = 0; bj < 2; ++bj) {
                    const u32x4 g = *(const u32x4*)(gp + bj * HALF);
                    u32x4 p = {0u, 0u, 0u, 0u}; if (!first) p = *(const u32x4*)(mp + bj * HALF);
                    const f32x4 v0 = acc[ai][bj][m][0], v1 = acc[ai][bj][m][1];
                    u32x4 w;
                    w.x = cvt_pk_bf16(bflo(p.x) + bflo(g.x) * v0[0], bfhi(p.x) + bfhi(g.x) * v0[1]);
                    w.y = cvt_pk_bf16(bflo(p.y) + bflo(g.y) * v0[2], bfhi(p.y) + bfhi(g.y) * v0[3]);
                    w.z = cvt_pk_bf16(bflo(p.z) + bflo(g.z) * v1[0], bfhi(p.z) + bfhi(g.z) * v1[1]);
                    w.w = cvt_pk_bf16(bflo(p.w) + bflo(g.w) * v1[2], bfhi(p.w) + bfhi(g.w) * v1[3]);
                    *(u32x4*)(mp + bj * HALF) = w;
                }
            }
    }
};
struct EpiResid {
    static constexpr bool PERM = false, AFTER_DRAIN = false;
    float* out; const float* xf; float alpha;
    __device__ __forceinline__ void operator()(const f32x4 (&acc)[2][2][4][2], const Unit& u, int wr, int wc, int fr, int fq) const {
        const int row0 = u.pm * BM + wr * 64 + fr, col0 = u.pn * BM + wc * 32 + 4 * fq;
#pragma unroll
        for (int ai = 0; ai < 2; ++ai)
#pragma unroll
            for (int m = 0; m < 4; ++m) {
                const size_t off = (size_t)(row0 + ai * HALF + m * 16) * 2048 + col0;
#pragma unroll
                for (int bj = 0; bj < 2; ++bj)
#pragma unroll
                    for (int n = 0; n < 2; ++n) { const f32x4 x = *(const f32x4*)(xf + off + bj * HALF + n * 16); *(f32x4*)(out + off + bj * HALF + n * 16) = x * alpha + acc[ai][bj][m][n]; }
            }
    }
};
struct EpiSwiGLU {
    static constexpr bool PERM = true, AFTER_DRAIN = false;
    bf16_t* H;
    __device__ __forceinline__ void operator()(const f32x4 (&acc)[2][2][4][2], const Unit& u, int wr, int wc, int fr, int fq) const {
        const int row0 = u.pm * BM + wr * 64 + fr, col0 = u.pn * HALF + wc * 32 + 8 * fq;
#pragma unroll
        for (int ai = 0; ai < 2; ++ai)
#pragma unroll
            for (int m = 0; m < 4; ++m) {
                bf16_t* hp = H + (size_t)(row0 + ai * HALF + m * 16) * 1024 + col0;
                f32x4 h0, h1;
#pragma unroll
                for (int j = 0; j < 4; ++j) { const float g0 = acc[ai][0][m][0][j], g1 = acc[ai][0][m][1][j];
                    h0[j] = g0 * sigmoidf_(g0) * acc[ai][1][m][0][j]; h1[j] = g1 * sigmoidf_(g1) * acc[ai][1][m][1][j]; }
                u32x4 w; w.x = cvt_pk_bf16(h0[0], h0[1]); w.y = cvt_pk_bf16(h0[2], h0[3]); w.z = cvt_pk_bf16(h1[0], h1[1]); w.w = cvt_pk_bf16(h1[2], h1[3]);
                *(u32x4*)hp = w;
            }
    }
};
struct EpiDown {
    static constexpr bool PERM = true, AFTER_DRAIN = false;
    bf16_t* Y; const float* gv;
    __device__ __forceinline__ void operator()(const f32x4 (&acc)[2][2][4][2], const Unit& u, int wr, int wc, int fr, int fq) const {
        const int row0 = u.pm * BM + wr * 64 + fr, col0 = u.pn * BM + wc * 32 + 8 * fq;
#pragma unroll
        for (int ai = 0; ai < 2; ++ai)
#pragma unroll
            for (int m = 0; m < 4; ++m) {
                const int row = row0 + ai * HALF + m * 16; const float s = gv[row];
                bf16_t* yp = Y + (size_t)row * 2048 + col0;
#pragma unroll
                for (int bj = 0; bj < 2; ++bj) { const f32x4 v0 = acc[ai][bj][m][0] * s, v1 = acc[ai][bj][m][1] * s;
                    u32x4 w; w.x = cvt_pk_bf16(v0[0], v0[1]); w.y = cvt_pk_bf16(v0[2], v0[3]); w.z = cvt_pk_bf16(v1[0], v1[1]); w.w = cvt_pk_bf16(v1[2], v1[3]);
                    *(u32x4*)(yp + bj * HALF) = w; }
            }
    }
};

template <class Epi, class Sched, bool ALIGN_EPI = false, bool SP2 = false>
__device__ __forceinline__ void gemm_phase(PG8_LAS unsigned char* lds, const Gemm g, const Sched& S, const Epi& E, const int tid) {
    const int wid = __builtin_amdgcn_readfirstlane(tid >> 6), lane = tid & 63, wr = wid >> 2, wc = wid & 3, fr = lane & 15, fq = lane >> 4;
    const int K = g.K, nt = K / BK;
    unsigned voffA[2], voffB[2];
#pragma unroll
    for (int i = 0; i < 2; ++i) { int R, C; stage_rc(tid * 16 + i * 8192, R, C); const int Rb = Epi::PERM ? ((R & ~31) + perm32(R & 31)) : R;
        voffA[i] = (unsigned)(R * K + C) * 2u; voffB[i] = (unsigned)(Rb * K + C) * 2u; }
    const size_t kstep = (size_t)(BK * 2);
    const size_t hstep = (size_t)HALF * K * 2;
    const size_t tstep = 2 * hstep;
    const unsigned ldsw = (unsigned)wid * 1024u;
    const int aoff = lds_byte(wr * 64 + fr, fq * 8), boff = lds_byte(wc * 32 + fr, fq * 8);
#define PG8_SA(b, h) (((b) * 2 + (h)) * HTB)
#define PG8_SB(b, h) ((4 + (b) * 2 + (h)) * HTB)
#define PG8_STAGE(bufoff, gbase, voff) do { _Pragma("unroll") for (int _i = 0; _i < 2; ++_i) \
        __builtin_amdgcn_global_load_lds((const unsigned*)((const char*)(gbase) + (voff)[_i]), (PG8_LAS unsigned*)(lds + (bufoff) + ldsw + _i * 8192), 16, 0, 0); } while (0)
#define PG8_LDA(dst, b, h) do { _Pragma("unroll") for (int m = 0; m < 4; ++m) _Pragma("unroll") for (int k = 0; k < 2; ++k) dst[m][k] = *(const PG8_LAS bf16x8*)(lds + PG8_SA(b, h) + aoff + m * 2048 + k * 1024); } while (0)
#define PG8_LDB(dst, b, h) do { _Pragma("unroll") for (int n = 0; n < 2; ++n) _Pragma("unroll") for (int k = 0; k < 2; ++k) dst[n][k] = *(const PG8_LAS bf16x8*)(lds + PG8_SB(b, h) + boff + n * 2048 + k * 1024); } while (0)
#define PG8_MMA(ai, bj, At, Bt) do { __builtin_amdgcn_s_setprio(1); _Pragma("unroll") for (int m = 0; m < 4; ++m) _Pragma("unroll") for (int n = 0; n < 2; ++n) _Pragma("unroll") for (int k = 0; k < 2; ++k) \
        acc[ai][bj][m][n] = __builtin_amdgcn_mfma_f32_16x16x32_bf16(Bt[n][k], At[m][k], acc[ai][bj][m][n], 0, 0, 0); __builtin_amdgcn_s_setprio(0); } while (0)
#define PG8_WAIT_V(n) asm volatile("s_waitcnt vmcnt(" #n ")" ::: "memory")
#define PG8_WAIT_L(n) asm volatile("s_waitcnt lgkmcnt(" #n ")" ::: "memory")
#define PG8_BAR __builtin_amdgcn_s_barrier()
#define PG8_SCHED __builtin_amdgcn_sched_barrier(0)
    Unit cur, nxt; int ui = 0;
    if (!S.next(0, cur)) return;
    f32x4 acc[2][2][4][2];
#pragma unroll
    for (int a = 0; a < 2; ++a)
#pragma unroll
        for (int b = 0; b < 2; ++b)
#pragma unroll
            for (int m = 0; m < 4; ++m)
#pragma unroll
                for (int n = 0; n < 2; ++n) acc[a][b][m][n] = (f32x4){0.f, 0.f, 0.f, 0.f};
    bf16x8 At[4][2], B0[2][2], B1[2][2];
    const char* cA = (const char*)g.A + (size_t)cur.pm * tstep; const char* cB = (const char*)g.Bt + (size_t)((cur.pm >> 1) & 15) * g.gstride + (size_t)cur.pn * tstep;
    S.a_ready(cur);
    if constexpr (SP2) {
        PG8_STAGE(PG8_SB(0, 0), cB, voffB); PG8_STAGE(PG8_SB(0, 1), cB + hstep, voffB); PG8_STAGE(PG8_SA(0, 0), cA, voffA); PG8_STAGE(PG8_SA(0, 1), cA + hstep, voffA);
        if (wr == 1) PG8_BAR;
        PG8_WAIT_V(2); PG8_BAR;
        PG8_STAGE(PG8_SB(1, 0), cB + kstep, voffB); PG8_STAGE(PG8_SA(1, 0), cA + kstep, voffA); PG8_STAGE(PG8_SB(1, 1), cB + hstep + kstep, voffB);
        PG8_WAIT_V(6); PG8_BAR;
    } else {
        PG8_STAGE(PG8_SB(0, 0), cB, voffB); PG8_STAGE(PG8_SA(0, 0), cA, voffA); PG8_STAGE(PG8_SB(0, 1), cB + hstep, voffB); PG8_STAGE(PG8_SA(0, 1), cA + hstep, voffA);
        if (wr == 1) PG8_BAR;
        PG8_WAIT_V(4); PG8_BAR;
        PG8_STAGE(PG8_SB(1, 0), cB + kstep, voffB); PG8_STAGE(PG8_SA(1, 0), cA + kstep, voffA); PG8_STAGE(PG8_SB(1, 1), cB + hstep + kstep, voffB);
        PG8_WAIT_V(6); PG8_BAR;
    }
    for (;;) {
        const bool has_next = S.next(ui + 1, nxt);
        const char* nA = has_next ? (const char*)g.A + (size_t)nxt.pm * tstep : cA; const char* nB = has_next ? (const char*)g.Bt + (size_t)((nxt.pm >> 1) & 15) * g.gstride + (size_t)nxt.pn * tstep : cB;
        for (int t = 0; t < nt; t += 2) {
            const bool last = (t == nt - 2);
            const char* a1 = cA + (size_t)(t + 1) * kstep;
            const char* a2 = last ? nA : cA + (size_t)(t + 2) * kstep; const char* b2 = last ? nB : cB + (size_t)(t + 2) * kstep;
            const char* a3 = a2 + kstep; const char* b3 = b2 + kstep;
            if (last && has_next) S.a_ready(nxt);
            if constexpr (SP2) {
            PG8_LDB(B0, 0, 0); PG8_LDB(B1, 0, 1); PG8_SCHED; PG8_LDA(At, 0, 0); PG8_STAGE(PG8_SA(1, 1), a1 + hstep, voffA);
            PG8_WAIT_V(8); PG8_WAIT_L(0); PG8_BAR; PG8_MMA(0, 0, At, B0); PG8_MMA(0, 1, At, B1); PG8_BAR; PG8_SCHED;
            PG8_LDA(At, 0, 1); PG8_STAGE(PG8_SB(0, 0), b2, voffB); PG8_STAGE(PG8_SB(0, 1), b2 + hstep, voffB); PG8_STAGE(PG8_SA(0, 0), a2, voffA);
            PG8_WAIT_V(8); PG8_WAIT_L(0); PG8_BAR; PG8_MMA(1, 0, At, B0); PG8_MMA(1, 1, At, B1); PG8_BAR; PG8_SCHED;
            PG8_LDB(B0, 1, 0); PG8_LDB(B1, 1, 1); PG8_SCHED; PG8_LDA(At, 1, 0); PG8_STAGE(PG8_SA(0, 1), a2 + hstep, voffA);
            PG8_WAIT_V(8); PG8_WAIT_L(0); PG8_BAR; PG8_MMA(0, 0, At, B0); PG8_MMA(0, 1, At, B1); PG8_BAR; PG8_SCHED;
            PG8_LDA(At, 1, 1); PG8_STAGE(PG8_SB(1, 0), b3, voffB); PG8_STAGE(PG8_SB(1, 1), b3 + hstep, voffB); PG8_STAGE(PG8_SA(1, 0), a3, voffA);
            PG8_WAIT_V(8); PG8_WAIT_L(0); PG8_BAR; PG8_MMA(1, 0, At, B0); PG8_MMA(1, 1, At, B1); PG8_BAR; PG8_SCHED;
            } else {
            PG8_LDB(B0, 0, 0); PG8_SCHED; PG8_LDA(At, 0, 0); PG8_STAGE(PG8_SA(1, 1), a1 + hstep, voffA);
            PG8_WAIT_L(8); PG8_BAR; PG8_WAIT_L(0); PG8_MMA(0, 0, At, B0); PG8_BAR; PG8_SCHED;
            PG8_LDB(B1, 0, 1); PG8_STAGE(PG8_SB(0, 0), b2, voffB);
            PG8_BAR; PG8_WAIT_L(0); PG8_MMA(0, 1, At, B1); PG8_BAR;
            PG8_LDA(At, 0, 1); PG8_STAGE(PG8_SA(0, 0), a2, voffA);
            PG8_BAR; PG8_WAIT_L(0); PG8_MMA(1, 0, At, B0); PG8_BAR; PG8_SCHED;
            PG8_STAGE(PG8_SB(0, 1), b2 + hstep, voffB);
            PG8_WAIT_V(6); PG8_BAR; PG8_MMA(1, 1, At, B1); PG8_BAR;
            PG8_LDB(B0, 1, 0); PG8_SCHED; PG8_LDA(At, 1, 0); PG8_STAGE(PG8_SA(0, 1), a2 + hstep, voffA);
            PG8_WAIT_L(8); PG8_BAR; PG8_WAIT_L(0); PG8_MMA(0, 0, At, B0); PG8_BAR; PG8_SCHED;
            PG8_LDB(B1, 1, 1); PG8_STAGE(PG8_SB(1, 0), b3, voffB);
            PG8_BAR; PG8_WAIT_L(0); PG8_MMA(0, 1, At, B1); PG8_BAR;
            PG8_LDA(At, 1, 1); PG8_STAGE(PG8_SA(1, 0), a3, voffA);
            PG8_BAR; PG8_WAIT_L(0); PG8_MMA(1, 0, At, B0); PG8_BAR; PG8_SCHED;
            PG8_STAGE(PG8_SB(1, 1), b3 + hstep, voffB);
            PG8_WAIT_V(6); PG8_BAR; PG8_MMA(1, 1, At, B1); PG8_BAR;
            }
        }
        if constexpr (ALIGN_EPI) { if (wr == 0) PG8_BAR; }
        if constexpr (!Epi::AFTER_DRAIN) { E(acc, cur, wr, wc, fr, fq); S.done(cur); }
        if (!has_next) break;
#pragma unroll
        for (int a = 0; a < 2; ++a)
#pragma unroll
            for (int b = 0; b < 2; ++b)
#pragma unroll
                for (int m = 0; m < 4; ++m)
#pragma unroll
                    for (int n = 0; n < 2; ++n) acc[a][b][m][n] = (f32x4){0.f, 0.f, 0.f, 0.f};
        cur = nxt; cA = nA; cB = nB; ++ui;
        if constexpr (ALIGN_EPI) { if (wr == 1) PG8_BAR; }
    }
    PG8_WAIT_V(0);
    if constexpr (!ALIGN_EPI) { if (wr == 0) PG8_BAR; }
    PG8_BAR;
    if constexpr (Epi::AFTER_DRAIN) { E.fused(acc, cur, wr, wc, fr, fq, lds, wid, lane); S.done(cur); }
#undef PG8_SA
#undef PG8_SB
#undef PG8_STAGE
#undef PG8_LDA
#undef PG8_LDB
#undef PG8_MMA
#undef PG8_WAIT_V
#undef PG8_WAIT_L
#undef PG8_BAR
#undef PG8_SCHED
}
}

constexpr int DM = 2048, NBATCH = 4, SEQ = 4096, DEPTH = 4, MTOK = NBATCH * SEQ;
constexpr int IN_TOTAL = 22784;
constexpr int OFF_QA = 0, OFF_KA = 2304, OFF_VA = 4608, OFF_QB = 6912, OFF_KB = 7936, OFF_VB = 8960, OFF_QC = 9984, OFF_KC = 11008, OFF_VC = 11264, OFF_QD = 11520, OFF_KD = 12544, OFF_VD = 13568, OFF_GATE = 14592;
constexpr int BR_TOTAL = 3840;
constexpr int NEXP = 16, CAP = 512, DEXP = 1024, NGRP = NBATCH * NEXP;
constexpr float LN_EPS = 1e-5f, SUBLN_EPS = 1e-5f;
constexpr float ALPHA = 1.6817928305074290f;
constexpr size_t MiB = 1u << 20;
constexpr size_t WS_CTL = 0, CTL_ZERO_BYTES = 1 * MiB;
constexpr size_t WS_ROPE128 = 1 * MiB, WS_ROPE64 = 3 * MiB, WS_AFF = 4 * MiB, WS_IDX = 5 * MiB, WS_GV = 5 * MiB + 131072, WS_SLOT = 6 * MiB, WS_LSE = 7 * MiB;
constexpr size_t WS_XF = 16 * MiB, WS_XB = 144 * MiB;
constexpr size_t WS_OA = 208 * MiB, WS_OB = 232 * MiB, WS_OC = 264 * MiB, WS_OD = 296 * MiB;
constexpr size_t WS_AG = 328 * MiB;
constexpr size_t WS_BSCR = 400 * MiB;
constexpr size_t WS_MIXED = 432 * MiB;
constexpr size_t WS_PRELN = 496 * MiB;
constexpr size_t WS_PROJ = 624 * MiB;
constexpr size_t WS_XG = WS_PROJ, WS_H = WS_PROJ + 128 * MiB, WS_Y = WS_PROJ + 192 * MiB;
constexpr size_t WS_WIN = 1336 * MiB;
constexpr size_t WS_WBR = 1692 * MiB;
constexpr size_t WS_WOUT = 1752 * MiB;
constexpr size_t WS_WGU = 1784 * MiB;
constexpr size_t WS_WDN = 2296 * MiB;
constexpr size_t WS_END = 2552 * MiB;
static_assert(WS_PROJ + (size_t)MTOK * IN_TOTAL * 2 == WS_WIN, "ws map");
constexpr int CW_BAR = 4096;
constexpr int LDS_BYTES = 147456, LDSCTL_OFF = 146944;
constexpr int NWAVES = 8;
constexpr int NPL = 11, NPHASES = 1 + DEPTH * NPL;

#define GAS __attribute__((address_space(1)))
#define LAS __attribute__((address_space(3)))
typedef unsigned short bf16_t;
typedef float f32x4 __attribute__((ext_vector_type(4)));
typedef float f32x2 __attribute__((ext_vector_type(2)));
typedef unsigned u32x4 __attribute__((ext_vector_type(4)));
typedef unsigned u32x2 __attribute__((ext_vector_type(2)));
using pg8::cvt_pk_bf16; using pg8::bflo; using pg8::bfhi;
__device__ __forceinline__ float bf2f(bf16_t h) { return __uint_as_float(((unsigned)h) << 16); }
__device__ __forceinline__ float wave_sum(float v) {
#pragma unroll
    for (int o = 1; o < 64; o <<= 1) v += __shfl_xor(v, o);
    return v;
}
__device__ __forceinline__ float wave_max(float v) {
#pragma unroll
    for (int o = 1; o < 64; o <<= 1) v = fmaxf(v, __shfl_xor(v, o));
    return v;
}
__device__ __forceinline__ int wave_sum_i(int v) {
#pragma unroll
    for (int o = 1; o < 64; o <<= 1) v += __shfl_xor(v, o);
    return v;
}

#define XB_TMO      128
#define XB_XCNT(j)  (256  + 64 * (j))
#define XB_XSUB(j)  (1280 + 64 * (j))
#define XB_XGEN(j)  (2304 + 64 * (j))
#define XB_TOP      3328
#define XB_TOPGEN   3392
#define XCD_BAR_WORDS 3456
#define XB_SPIN_CAP (1u << 23)

__device__ __forceinline__ unsigned xb_ld(unsigned* p)              { return __hip_atomic_load(p, __ATOMIC_RELAXED, __HIP_MEMORY_SCOPE_AGENT); }
__device__ __forceinline__ unsigned xb_add(unsigned* p, unsigned v) { return __hip_atomic_fetch_add(p, v, __ATOMIC_RELAXED, __HIP_MEMORY_SCOPE_AGENT); }
__device__ __forceinline__ unsigned xb_xcc_id() { return (unsigned)__builtin_amdgcn_s_getreg((3 << 11) | 20) & 0xFu; }
#define XB_SPIN(cond, bar) do { unsigned _sp = 0; while (cond) { __builtin_amdgcn_s_sleep(1); \
    if ((++_sp & 255u) == 0u) { if (xb_ld(&(bar)[XB_TMO])) break; if (_sp > XB_SPIN_CAP) { atomicAdd(&(bar)[XB_TMO], 1u); break; } } } } while (0)

struct XcdBarrier {
    unsigned* bar; unsigned x;
    volatile LAS unsigned* st;
};
__device__ __forceinline__ XcdBarrier xcd_barrier_post(unsigned* bar, volatile LAS unsigned* st) {
    XcdBarrier b; b.bar = bar; b.x = xb_xcc_id(); b.st = st;
    if (threadIdx.x == 0) (void)xb_add(&bar[XB_XCNT(b.x)], 1u);
    return b;
}
__device__ __forceinline__ void xcd_barrier_complete(unsigned* bar, unsigned x, unsigned& nloc, unsigned& nx) {
    const unsigned G = gridDim.x * gridDim.y * gridDim.z;
    unsigned sum, cnt, mine, sp = 0u;
    for (;;) {
        sum = 0u; cnt = 0u; mine = 0u;
#pragma unroll
        for (unsigned j = 0; j < 16; ++j) { const unsigned c = xb_ld(&bar[XB_XCNT(j)]); sum += c; cnt += (c > 0u) ? 1u : 0u; mine = (j == x) ? c : mine; }
        if (sum == G) break;
        __builtin_amdgcn_s_sleep(1);
        if ((++sp & 255u) == 0u) { if (xb_ld(&bar[XB_TMO])) break; if (sp > XB_SPIN_CAP) { atomicAdd(&bar[XB_TMO], 1u); break; } }
    }
    nloc = mine > 0u ? mine : 1u; nx = cnt > 0u ? cnt : 1u;
}
__device__ __forceinline__ void xcd_barrier(const XcdBarrier& b) {
    asm volatile("s_waitcnt vmcnt(0)" ::: "memory");
    __syncthreads();
    if (threadIdx.x == 0) {
        unsigned* bar = b.bar;
        __builtin_amdgcn_s_waitcnt(0);
        unsigned nloc = b.st[0], nx = b.st[1];
        if (nloc == 0u) { xcd_barrier_complete(bar, b.x, nloc, nx); b.st[0] = nloc; b.st[1] = nx; }
        const unsigned old = xb_add(&bar[XB_XSUB(b.x)], 1u);
        const unsigned gen = old / nloc;
        if (old + 1u == (gen + 1u) * nloc) {
            __builtin_amdgcn_fence(__ATOMIC_RELEASE, "agent");
            asm volatile("s_waitcnt vmcnt(0)" ::: "memory");
            const unsigned og = xb_add(&bar[XB_TOP], 1u);
            const unsigned tg = og / nx;
            if (og + 1u == (tg + 1u) * nx) xb_add(&bar[XB_TOPGEN], 1u);
            else XB_SPIN(xb_ld(&bar[XB_TOPGEN]) == tg, bar);
            __builtin_amdgcn_fence(__ATOMIC_ACQUIRE, "agent");
            xb_add(&bar[XB_XGEN(b.x)], 1u);
            asm volatile("s_waitcnt vmcnt(0)" ::: "memory");
        } else {
            XB_SPIN(xb_ld(&bar[XB_XGEN(b.x)]) == gen, bar);
            __builtin_amdgcn_fence(__ATOMIC_ACQUIRE, "agent");
            asm volatile("s_waitcnt vmcnt(0)" ::: "memory");
        }
    }
    __syncthreads();
}

__device__ __forceinline__ int win_src_col(int n) {
    if (n < OFF_VA || (n >= OFF_QC && n < OFF_VC)) { const int hb = n & ~127, j = n & 127; return hb + (j >> 1) + (j & 1) * 64; }
    if (n >= OFF_QB && n < OFF_VB) { const int hb = n & ~63, j = n & 63; return hb + (j >> 1) + (j & 1) * 32; }
    return n;
}
__device__ __forceinline__ void tr_item(const float* __restrict__ src, size_t ld, int srccol, int k0, bf16_t* __restrict__ dst) {
    const float* p = src + (size_t)k0 * ld + srccol;
#pragma unroll
    for (int kk = 0; kk < 8; ++kk) {
        float v[8];
#pragma unroll
        for (int j = 0; j < 8; ++j) v[j] = __builtin_nontemporal_load(p + (size_t)(kk * 8 + j) * ld);
        u32x4 w; w.x = cvt_pk_bf16(v[0], v[1]); w.y = cvt_pk_bf16(v[2], v[3]); w.z = cvt_pk_bf16(v[4], v[5]); w.w = cvt_pk_bf16(v[6], v[7]);
        *(u32x4*)(dst + k0 + kk * 8) = w;
    }
}

struct KeyA { int s, r;
    __device__ __forceinline__ int pos(int idx, float& bias) const { bias = 0.f; const int p = s + r * (idx - 64); return (p >= 0 && p < SEQ) ? p : -1; } };
struct KeyB {
    __device__ __forceinline__ int pos(int idx, float& bias) const { bias = 0.f; return idx; } };
struct KeyC { int s;
    __device__ __forceinline__ int pos(int idx, float& bias) const { bias = 0.f; const int p = s + idx - 128; return (p >= 0 && p < SEQ) ? p : -1; } };
struct KeyD { int r, c, rs, cs; const float* rpb;
    __device__ __forceinline__ int pos(int idx, float& bias) const { const int kr = rs + (idx >> 4), kc = cs + (idx & 15); int dc = kc - c; dc = dc < -15 ? -15 : (dc > 15 ? 15 : dc);
        bias = rpb[(kr - r + 7) * 31 + dc + 15]; return kr * 64 + kc; } };

template <int DK, class KF>
__device__ __forceinline__ void sattn(const bf16_t* q, const bf16_t* kb, const bf16_t* vb, const KF& kf, int nkeys, float scale, bool has_sink, float sink,
                                      LAS float* sq, LAS float* ss, int lane, float& o0, float& o1, float& m_out, float& l_out) {
    for (int d = lane; d < DK; d += 64) sq[d] = bf2f(q[d]);
    asm volatile("s_waitcnt lgkmcnt(0)" ::: "memory");
    float mx = -1e30f;
    for (int idx = lane; idx < nkeys; idx += 64) {
        float bias; const int p = kf.pos(idx, bias); float s = -1e30f;
        if (p >= 0) {
            const u32x4* kr = (const u32x4*)(kb + (size_t)p * IN_TOTAL); float acc = 0.f;
#pragma unroll
            for (int d8 = 0; d8 < DK / 8; ++d8) { const u32x4 w = kr[d8]; const LAS f32x4* qq = (const LAS f32x4*)(sq + d8 * 8); const f32x4 qa = qq[0], qb = qq[1];
                acc += qa[0] * bflo(w.x) + qa[1] * bfhi(w.x) + qa[2] * bflo(w.y) + qa[3] * bfhi(w.y) + qb[0] * bflo(w.z) + qb[1] * bfhi(w.z) + qb[2] * bflo(w.w) + qb[3] * bfhi(w.w); }
            s = acc * scale + bias;
        }
        ss[idx] = s; mx = fmaxf(mx, s);
    }
    mx = wave_max(mx); if (has_sink) mx = fmaxf(mx, sink);
    float sum = 0.f;
    for (int idx = lane; idx < nkeys; idx += 64) { const float s = ss[idx]; const float p = (s > -1e29f) ? __expf(s - mx) : 0.f; ss[idx] = p; sum += p; }
    sum = wave_sum(sum); if (has_sink) sum += __expf(sink - mx);
    asm volatile("s_waitcnt lgkmcnt(0)" ::: "memory");
    o0 = 0.f; o1 = 0.f;
    for (int idx = 0; idx < nkeys; ++idx) {
        const float p = ss[idx];
        if (p != 0.f) { float bias; const int pp = kf.pos(idx, bias); const unsigned w = *(const unsigned*)(vb + (size_t)pp * IN_TOTAL + 2 * lane); o0 += p * bflo(w); o1 += p * bfhi(w); }
    }
    const float inv = 1.0f / sum; o0 *= inv; o1 *= inv; m_out = mx; l_out = sum;
    asm volatile("s_waitcnt lgkmcnt(0)" ::: "memory");
}

struct AttnPtrs { const bf16_t* proj; bf16_t* ag; float* lse; bf16_t* ob; bf16_t* oc; bf16_t* od; const float* lam; const float* subln; const float* sink; const float* rpb; float lambda_init; };

template <int WHICH>
__device__ __forceinline__ void scalar_attn_phase(const AttnPtrs& P, LAS unsigned char* lds, int gw, int NGW, int wave, int lane) {
    LAS float* sq = (LAS float*)(lds + wave * 16896); LAS float* ss = sq + 128;
    constexpr int NH = WHICH == 0 ? 18 : 8;
    float lmbda = 0.f;
    if constexpr (WHICH == 1) { const float d01 = wave_sum(P.lam[lane] * P.lam[64 + lane]), d23 = wave_sum(P.lam[128 + lane] * P.lam[192 + lane]); lmbda = __expf(d01) - __expf(d23) + P.lambda_init; }
    for (int task = gw; task < NH * MTOK; task += NGW) {
        const int hs = task / MTOK, row = task % MTOK, b = row >> 12, s = row & 4095;
        const bf16_t* prow = P.proj + (size_t)row * IN_TOTAL; const bf16_t* pb = P.proj + (size_t)(b * SEQ) * IN_TOTAL;
        float o0, o1, mm, ll;
        if constexpr (WHICH == 0) {
            const int hh = hs, g = hh / 6, r = (g == 0) ? 1 : ((g == 1) ? 4 : 16); KeyA kf{s, r};
            sattn<128>(prow + OFF_QA + hh * 128, pb + OFF_KA + hh * 128, pb + OFF_VA + hh * 128, kf, 129, 0.08838834764831845f, false, 0.f, sq, ss, lane, o0, o1, mm, ll);
            *(unsigned*)(P.ag + ((size_t)g * MTOK + row) * 768 + (hh % 6) * 128 + 2 * lane) = cvt_pk_bf16(o0, o1);
            if (lane == 0) P.lse[((size_t)g * MTOK + row) * 6 + (hh % 6)] = mm + __logf(ll);
        } else if constexpr (WHICH == 1) {
            const int h = hs; KeyB kf; float a0, a1, b0, b1;
            sattn<64>(prow + OFF_QB + (2 * h) * 64, pb + OFF_KB + (2 * h) * 64, pb + OFF_VB + h * 128, kf, SEQ, 0.125f, false, 0.f, sq, ss, lane, a0, a1, mm, ll);
            sattn<64>(prow + OFF_QB + (2 * h + 1) * 64, pb + OFF_KB + (2 * h + 1) * 64, pb + OFF_VB + h * 128, kf, SEQ, 0.125f, false, 0.f, sq, ss, lane, b0, b1, mm, ll);
            const float v0 = a0 - lmbda * b0, v1 = a1 - lmbda * b1;
            const float rinv = rsqrtf(wave_sum(v0 * v0 + v1 * v1) * (1.0f / 128.0f) + SUBLN_EPS) * (1.0f - P.lambda_init);
            *(unsigned*)(P.ob + (size_t)row * 1024 + h * 128 + 2 * lane) = cvt_pk_bf16(v0 * rinv * P.subln[2 * lane], v1 * rinv * P.subln[2 * lane + 1]);
        } else if constexpr (WHICH == 2) {
            const int qh = hs, kvh = qh >> 2; KeyC kf{s};
            sattn<128>(prow + OFF_QC + qh * 128, pb + OFF_KC + kvh * 128, pb + OFF_VC + kvh * 128, kf, 257, 0.08838834764831845f, true, P.sink[qh], sq, ss, lane, o0, o1, mm, ll);
            *(unsigned*)(P.oc + (size_t)row * 1024 + qh * 128 + 2 * lane) = cvt_pk_bf16(o0, o1);
        } else {
            const int h = hs, r = s >> 6, c = s & 63; int rs = r - 4; rs = rs < 0 ? 0 : (rs > 56 ? 56 : rs); int cs = c - 8; cs = cs < 0 ? 0 : (cs > 48 ? 48 : cs);
            KeyD kf{r, c, rs, cs, P.rpb + h * 465};
            sattn<128>(prow + OFF_QD + h * 128, pb + OFF_KD + h * 128, pb + OFF_VD + h * 128, kf, 128, 0.08838834764831845f, false, 0.f, sq, ss, lane, o0, o1, mm, ll);
            *(unsigned*)(P.od + (size_t)row * 1024 + h * 128 + 2 * lane) = cvt_pk_bf16(o0, o1);
        }
    }
}

__device__ __forceinline__ void combine_a_phase(const bf16_t* ag, const float* lse, bf16_t* oa, int gw, int NGW, int lane) {
    for (int row = gw; row < MTOK; row += NGW) {
#pragma unroll
        for (int j = 0; j < 3; ++j) {
            const int e = 4 * lane + 256 * j, head = e >> 7;
            const float l0 = lse[((size_t)0 * MTOK + row) * 6 + head], l1 = lse[((size_t)1 * MTOK + row) * 6 + head], l2 = lse[((size_t)2 * MTOK + row) * 6 + head];
            const float mx = fmaxf(l0, fmaxf(l1, l2)); float w0 = __expf(l0 - mx), w1 = __expf(l1 - mx), w2 = __expf(l2 - mx); const float inv = 1.0f / (w0 + w1 + w2); w0 *= inv; w1 *= inv; w2 *= inv;
            const u32x2 a0 = *(const u32x2*)(ag + ((size_t)0 * MTOK + row) * 768 + e), a1 = *(const u32x2*)(ag + ((size_t)1 * MTOK + row) * 768 + e), a2 = *(const u32x2*)(ag + ((size_t)2 * MTOK + row) * 768 + e);
            u32x2 o;
            o.x = cvt_pk_bf16(w0 * bflo(a0.x) + w1 * bflo(a1.x) + w2 * bflo(a2.x), w0 * bfhi(a0.x) + w1 * bfhi(a1.x) + w2 * bfhi(a2.x));
            o.y = cvt_pk_bf16(w0 * bflo(a0.y) + w1 * bflo(a1.y) + w2 * bflo(a2.y), w0 * bfhi(a0.y) + w1 * bfhi(a1.y) + w2 * bfhi(a2.y));
            *(u32x2*)(oa + (size_t)row * 768 + e) = o;
        }
    }
}
__device__ __forceinline__ void ln1_router_phase(const float* preln, const float* gain, const float* bias, const float* wr, float* xf, bf16_t* xb, float* aff,
                                                 LAS unsigned char* lds, int tid, int gw, int NGW, int lane) {
    LAS float* W = (LAS float*)lds;
    for (int i = tid; i < DM * NEXP; i += NWAVES * 64) { const int k = i >> 4, e = i & 15; W[e * DM + k] = wr[i]; }
    __syncthreads();
    f32x4 g[8], bb[8];
#pragma unroll
    for (int j = 0; j < 8; ++j) { g[j] = *(const f32x4*)(gain + 256 * j + 4 * lane); bb[j] = *(const f32x4*)(bias + 256 * j + 4 * lane); }
    for (int row = gw; row < MTOK; row += NGW) {
        const float* pr = preln + (size_t)row * DM + 4 * lane;
        f32x4 v[8]; float s = 0.f;
#pragma unroll
        for (int j = 0; j < 8; ++j) { v[j] = *(const f32x4*)(pr + 256 * j); s += (v[j][0] + v[j][1]) + (v[j][2] + v[j][3]); }
        const float mean = wave_sum(s) * (1.0f / DM); float q = 0.f;
#pragma unroll
        for (int j = 0; j < 8; ++j) { v[j] = v[j] - mean; q += (v[j][0] * v[j][0] + v[j][1] * v[j][1]) + (v[j][2] * v[j][2] + v[j][3] * v[j][3]); }
        const float rstd = rsqrtf(wave_sum(q) * (1.0f / DM) + LN_EPS);
        float* xo = xf + (size_t)row * DM + 4 * lane; bf16_t* xbo = xb + (size_t)row * DM + 4 * lane;
#pragma unroll
        for (int j = 0; j < 8; ++j) { v[j] = v[j] * rstd * g[j] + bb[j]; *(f32x4*)(xo + 256 * j) = v[j];
            u32x2 w; w.x = cvt_pk_bf16(v[j][0], v[j][1]); w.y = cvt_pk_bf16(v[j][2], v[j][3]); *(u32x2*)(xbo + 256 * j) = w; }
        float lg[16];
#pragma unroll
        for (int e = 0; e < 16; ++e) { float a = 0.f;
#pragma unroll
            for (int j = 0; j < 8; ++j) { const f32x4 w = *(const LAS f32x4*)(W + e * DM + 256 * j + 4 * lane); a += (v[j][0] * w[0] + v[j][1] * w[1]) + (v[j][2] * w[2] + v[j][3] * w[3]); }
            lg[e] = wave_sum(a); }
        float mx = lg[0];
#pragma unroll
        for (int e = 1; e < 16; ++e) mx = fmaxf(mx, lg[e]);
        float den = 0.f;
#pragma unroll
        for (int e = 0; e < 16; ++e) { lg[e] = expf(lg[e] - mx); den += lg[e]; }
        float mine = 0.f;
#pragma unroll
        for (int e = 0; e < 16; ++e) mine = (lane == e) ? lg[e] : mine;
        if (lane < 16) aff[((size_t)(row >> 12) * NEXP + lane) * SEQ + (row & 4095)] = mine / den;
    }
    __syncthreads();
}
__device__ __forceinline__ void topk_phase(const float* aff, int* idxo, float* gvo, int* sloto, LAS unsigned char* lds, int tid, int wave, int lane, int wg, int G) {
    LAS int* cnt = (LAS int*)lds;
    for (int be = wg; be < NGRP; be += G) {
        const float* a = aff + (size_t)be * SEQ + tid * 8;
        const f32x4 a0 = *(const f32x4*)a, a1 = *(const f32x4*)(a + 4);
        unsigned v[8] = {__float_as_uint(a0[0]), __float_as_uint(a0[1]), __float_as_uint(a0[2]), __float_as_uint(a0[3]), __float_as_uint(a1[0]), __float_as_uint(a1[1]), __float_as_uint(a1[2]), __float_as_uint(a1[3])};
        unsigned T = 0u;
        for (int bit = 30; bit >= 0; --bit) {
            const unsigned cand = T | (1u << bit); int c = 0;
#pragma unroll
            for (int k = 0; k < 8; ++k) c += (v[k] >= cand) ? 1 : 0;
            c = wave_sum_i(c);
            if (lane == 0) cnt[(bit & 1) * 8 + wave] = c;
            __syncthreads();
            int tot = 0;
#pragma unroll
            for (int w = 0; w < 8; ++w) tot += cnt[(bit & 1) * 8 + w];
            if (tot >= CAP) T = cand;
        }
        int ngt = 0, neq = 0;
#pragma unroll
        for (int k = 0; k < 8; ++k) { ngt += (v[k] > T) ? 1 : 0; neq += (v[k] == T) ? 1 : 0; }
        int sgt = ngt, seq = neq;
#pragma unroll
        for (int o = 1; o < 64; o <<= 1) { const int tg = __shfl_up(sgt, o), te = __shfl_up(seq, o); if (lane >= o) { sgt += tg; seq += te; } }
        __syncthreads();
        if (lane == 63) { cnt[64 + wave] = sgt; cnt[64 + 8 + wave] = seq; }
        __syncthreads();
        int pgt = sgt - ngt, peq = seq - neq, totgt = 0;
#pragma unroll
        for (int w = 0; w < 8; ++w) { const int tg = cnt[64 + w], te = cnt[64 + 8 + w]; if (w < wave) { pgt += tg; peq += te; } totgt += tg; }
        const int need = CAP - totgt;
        const int b = be >> 4, e = be & 15;
#pragma unroll
        for (int k = 0; k < 8; ++k) {
            const bool gt = v[k] > T, eq = v[k] == T; const bool sel = gt || (eq && peq < need);
            const int slot = pgt + (peq < need ? peq : need);
            const int tok = tid * 8 + k;
            if (sel) { idxo[be * CAP + slot] = tok; gvo[be * CAP + slot] = __uint_as_float(v[k]); }
            sloto[((size_t)b * SEQ + tok) * NEXP + e] = sel ? slot : -1;
            pgt += gt ? 1 : 0; peq += eq ? 1 : 0;
        }
        __syncthreads();
    }
}
__device__ __forceinline__ void gather_phase(const bf16_t* xb, const int* idx, bf16_t* xg, int gw, int NGW, int lane) {
    for (int r = gw; r < NGRP * CAP; r += NGW) {
        const int be = r >> 9, b = be >> 4; const int tok = idx[r];
        const u32x4* src = (const u32x4*)(xb + ((size_t)b * SEQ + tok) * DM); u32x4* dst = (u32x4*)(xg + (size_t)r * DM);
#pragma unroll
        for (int j = 0; j < 4; ++j) dst[64 * j + lane] = src[64 * j + lane];
    }
}
__device__ __forceinline__ void ln2_phase(const float* x1, const bf16_t* y, const int* slot, const float* gain, const float* bias, float* xo_base, bf16_t* xb, int gw, int NGW, int lane) {
    f32x4 g[8], bb[8];
#pragma unroll
    for (int j = 0; j < 8; ++j) { g[j] = *(const f32x4*)(gain + 256 * j + 4 * lane); bb[j] = *(const f32x4*)(bias + 256 * j + 4 * lane); }
    for (int row = gw; row < MTOK; row += NGW) {
        const int b = row >> 12;
        const int myslot = slot[(size_t)row * NEXP + (lane & 15)];
        f32x4 acc[8];
#pragma unroll
        for (int j = 0; j < 8; ++j) acc[j] = (f32x4){0.f, 0.f, 0.f, 0.f};
        for (int e = 0; e < NEXP; ++e) {
            const int sl = __shfl(myslot, e);
            if (sl >= 0) {
                const bf16_t* yr = y + ((size_t)(b * NEXP + e) * CAP + sl) * DM + 4 * lane;
#pragma unroll
                for (int j = 0; j < 8; ++j) { const u32x2 w = *(const u32x2*)(yr + 256 * j); acc[j][0] += bflo(w.x); acc[j][1] += bfhi(w.x); acc[j][2] += bflo(w.y); acc[j][3] += bfhi(w.y); }
            }
        }
        const float* pr = x1 + (size_t)row * DM + 4 * lane; float s = 0.f;
#pragma unroll
        for (int j = 0; j < 8; ++j) { const f32x4 x = *(const f32x4*)(pr + 256 * j); acc[j] = x * ALPHA + acc[j]; s += (acc[j][0] + acc[j][1]) + (acc[j][2] + acc[j][3]); }
        const float mean = wave_sum(s) * (1.0f / DM); float q = 0.f;
#pragma unroll
        for (int j = 0; j < 8; ++j) { acc[j] = acc[j] - mean; q += (acc[j][0] * acc[j][0] + acc[j][1] * acc[j][1]) + (acc[j][2] * acc[j][2] + acc[j][3] * acc[j][3]); }
        const float rstd = rsqrtf(wave_sum(q) * (1.0f / DM) + LN_EPS);
        float* xo = xo_base + (size_t)row * DM + 4 * lane; bf16_t* xbo = xb + (size_t)row * DM + 4 * lane;
#pragma unroll
        for (int j = 0; j < 8; ++j) { const f32x4 o = acc[j] * rstd * g[j] + bb[j]; *(f32x4*)(xo + 256 * j) = o;
            u32x2 w; w.x = cvt_pk_bf16(o[0], o[1]); w.y = cvt_pk_bf16(o[2], o[3]); *(u32x2*)(xbo + 256 * j) = w; }
    }
}

namespace att {
typedef short bf16x8 __attribute__((ext_vector_type(8)));
typedef short s16x4 __attribute__((ext_vector_type(4)));
typedef float f32x16 __attribute__((ext_vector_type(16)));
constexpr int VBYTES = 16384, KOFF = 2 * VBYTES, WSOFF = 65536, TABOFF = WSOFF + 2048, ATTN_LDS = TABOFF + 2048;
constexpr float NEG = -1e30f, M0 = -1e29f;
#define ATT_SBAR() __builtin_amdgcn_sched_barrier(0)
__device__ __forceinline__ int crow(int r, int hi) { return (r & 3) + 8 * (r >> 2) + 4 * hi; }
__device__ __forceinline__ unsigned cvtpk(float lo, float hi) { unsigned r; asm volatile("v_cvt_pk_bf16_f32 %0, %1, %2" : "=v"(r) : "v"(lo), "v"(hi)); return r; }
__device__ __forceinline__ int kswz128(int row, int colB) { return row * 256 + (colB ^ ((row & 7) << 4)); }
__device__ __forceinline__ int kswz64(int row, int colB) { return row * 128 + (colB ^ (((row >> 1) & 7) << 4)); }

__device__ __forceinline__ void partialSM(f32x16& p0, f32x16& p1, float& m_reg, float& mn, float& alpha, const float C, const float thr_raw) {
    float pmax = p0[0];
#pragma unroll
    for (int r = 1; r < 16; ++r) pmax = fmaxf(pmax, p0[r]);
#pragma unroll
    for (int r = 0; r < 16; ++r) pmax = fmaxf(pmax, p1[r]);
    { auto rr = __builtin_amdgcn_permlane32_swap(__float_as_uint(pmax), __float_as_uint(pmax), false, false); pmax = fmaxf(__uint_as_float(rr[0]), __uint_as_float(rr[1])); }
    if (__all(pmax - m_reg <= thr_raw)) { mn = m_reg; alpha = 1.f; }
    else { mn = fmaxf(m_reg, pmax); alpha = __builtin_amdgcn_exp2f((m_reg - mn) * C); m_reg = mn; }
    const float mnC = -mn * C;
#pragma unroll
    for (int r = 0; r < 16; ++r) p0[r] = fmaf(p0[r], C, mnC);
#pragma unroll
    for (int r = 0; r < 16; ++r) p1[r] = fmaf(p1[r], C, mnC);
#pragma unroll
    for (int r = 0; r < 16; ++r) p0[r] = __builtin_amdgcn_exp2f(p0[r]);
}
__device__ __forceinline__ void finishSM(f32x16& p0, f32x16& p1, float alpha, float& l_reg, bf16x8& pa0, bf16x8& pa1, bf16x8& pa2, bf16x8& pa3) {
#pragma unroll
    for (int r = 0; r < 16; ++r) p1[r] = __builtin_amdgcn_exp2f(p1[r]);
    float ps = 0;
#pragma unroll
    for (int r = 0; r < 16; ++r) ps += p0[r];
#pragma unroll
    for (int r = 0; r < 16; ++r) ps += p1[r];
    { auto rr = __builtin_amdgcn_permlane32_swap(__float_as_uint(ps), __float_as_uint(ps), false, false); ps = __uint_as_float(rr[0]) + __uint_as_float(rr[1]); }
    l_reg = l_reg * alpha + ps;
#define ATT_PK4(P, BASE, OUT) do { unsigned a0 = cvtpk(P[BASE + 0], P[BASE + 1]), a1 = cvtpk(P[BASE + 2], P[BASE + 3]);   \
    unsigned b0 = cvtpk(P[BASE + 4], P[BASE + 5]), b1 = cvtpk(P[BASE + 6], P[BASE + 7]);                              \
    auto r0 = __builtin_amdgcn_permlane32_swap(a0, b0, false, false); auto r1 = __builtin_amdgcn_permlane32_swap(a1, b1, false, false); \
    u32x4 w = {r0[0], r1[0], r0[1], r1[1]}; OUT = __builtin_bit_cast(bf16x8, w); } while (0)
    ATT_PK4(p0, 0, pa0); ATT_PK4(p0, 8, pa1); ATT_PK4(p1, 0, pa2); ATT_PK4(p1, 8, pa3);
#undef ATT_PK4
}
template <int DK>
__device__ __forceinline__ void qkt(f32x16& p0, f32x16& p1, const LAS char* Ks, const bf16x8* qr, int r32, int hi) {
    p0 = f32x16{}; p1 = f32x16{};
#pragma unroll
    for (int d0 = 0; d0 < DK / 16; ++d0) { const int cb = (d0 * 16 + hi * 8) * 2;
        const bf16x8 b0 = *(const LAS bf16x8*)(Ks + (DK == 128 ? kswz128(r32, cb) : kswz64(r32, cb)));
        const bf16x8 b1 = *(const LAS bf16x8*)(Ks + (DK == 128 ? kswz128(32 + r32, cb) : kswz64(32 + r32, cb)));
        p0 = __builtin_amdgcn_mfma_f32_32x32x16_bf16(b0, qr[d0], p0, 0, 0, 0);
        p1 = __builtin_amdgcn_mfma_f32_32x32x16_bf16(b1, qr[d0], p1, 0, 0, 0); }
}
__device__ __forceinline__ int v_st(int k, int c) { const int kk = (k & ~0xC) | ((k & 4) << 1) | ((k & 8) >> 1); return ((kk >> 3) * 4 + (c >> 5)) * 512 + ((kk & 7) * 32 + (c & 31)) * 2; }
__device__ __forceinline__ int v_rd_base(int lane) { return ((lane & 3) << 3) | (((lane >> 2) & 3) << 6) | (((lane >> 4) & 1) << 5) | (((lane >> 5) & 1) << 8); }
constexpr int v_rd_off(int d0, int ks, int half) { return d0 * 512 + ks * 4096 + half * 2048; }
template <int OFF> __device__ __forceinline__ s16x4 tr_read(int vb) { s16x4 r; asm volatile("ds_read_b64_tr_b16 %0, %1 offset:%2" : "=&v"(r) : "v"(vb), "i"(OFF) : "memory"); return r; }
template <int D0> __device__ __forceinline__ void pv_one(f32x16& od, int vb, bf16x8 pa0, bf16x8 pa1, bf16x8 pa2, bf16x8 pa3) {
    const s16x4 l0 = tr_read<v_rd_off(D0, 0, 0)>(vb), h0 = tr_read<v_rd_off(D0, 0, 1)>(vb), l1 = tr_read<v_rd_off(D0, 1, 0)>(vb), h1 = tr_read<v_rd_off(D0, 1, 1)>(vb);
    const s16x4 l2 = tr_read<v_rd_off(D0, 2, 0)>(vb), h2 = tr_read<v_rd_off(D0, 2, 1)>(vb), l3 = tr_read<v_rd_off(D0, 3, 0)>(vb), h3 = tr_read<v_rd_off(D0, 3, 1)>(vb);
    asm volatile("s_waitcnt lgkmcnt(0)" ::: "memory"); ATT_SBAR();
#define ATT_PK(L, H) (bf16x8){L[0], L[1], L[2], L[3], H[0], H[1], H[2], H[3]}
    od = __builtin_amdgcn_mfma_f32_32x32x16_bf16(pa0, ATT_PK(l0, h0), od, 0, 0, 0);
    od = __builtin_amdgcn_mfma_f32_32x32x16_bf16(pa1, ATT_PK(l1, h1), od, 0, 0, 0);
    od = __builtin_amdgcn_mfma_f32_32x32x16_bf16(pa2, ATT_PK(l2, h2), od, 0, 0, 0);
    od = __builtin_amdgcn_mfma_f32_32x32x16_bf16(pa3, ATT_PK(l3, h3), od, 0, 0, 0);
#undef ATT_PK
}
__device__ __forceinline__ void pv_d0(f32x16* o, int vb, bf16x8 pa0, bf16x8 pa1, bf16x8 pa2, bf16x8 pa3) {
    pv_one<0>(o[0], vb, pa0, pa1, pa2, pa3); pv_one<1>(o[1], vb, pa0, pa1, pa2, pa3); pv_one<2>(o[2], vb, pa0, pa1, pa2, pa3); pv_one<3>(o[3], vb, pa0, pa1, pa2, pa3);
}

template <int DK, class Pol>
__device__ __forceinline__ void attn_unit(const Pol& P, LAS char* lds, const int tid) {
    const int wid = __builtin_amdgcn_readfirstlane(tid >> 6), lane = tid & 63, r32 = lane & 31, hi = lane >> 5;
    LAS char* V_lds = lds; LAS char* K_lds = lds + KOFF; constexpr int KBYTES = 64 * DK * 2;
    LAS float* wsx = (LAS float*)(lds + WSOFF) + wid * 64; LAS float* li_l = wsx; LAS float* al_l = wsx + 32;
    const float C = Pol::SCALE * 1.4426950408889634f, thr_raw = 8.0f / Pol::SCALE;
    float m_reg = P.m0(), l_reg = P.l0(); f32x16 o[4] = {}; bf16x8 qr[DK / 16];
    { const bf16_t* qp = P.q_row(wid * 32 + r32) + hi * 8;
#pragma unroll
      for (int d0 = 0; d0 < DK / 16; ++d0) qr[d0] = *(const bf16x8*)(qp + d0 * 16); }
    const int sr = tid >> 4, sc = (tid & 15) * 8, vst0 = v_st(sr, sc), vst1 = v_st(32 + sr, sc);
    const int k64r = tid >> 3, k64c = (tid & 7) * 8;
    const int vb0 = (int)(unsigned)(__UINTPTR_TYPE__)V_lds + v_rd_base(lane);
    bf16x8 vs0, vs1, ks0, ks1;
#define ATT_LOAD(t) do { vs0 = *(const bf16x8*)(P.v_row((t), sr) + sc); vs1 = *(const bf16x8*)(P.v_row((t), 32 + sr) + sc); \
        if constexpr (DK == 128) { ks0 = *(const bf16x8*)(P.k_row((t), sr) + sc); ks1 = *(const bf16x8*)(P.k_row((t), 32 + sr) + sc); } \
        else { ks0 = *(const bf16x8*)(P.k_row((t), k64r) + k64c); ks1 = ks0; } } while (0)
#define ATT_WRITE(b) do { *(LAS bf16x8*)(V_lds + (b) * VBYTES + vst0) = vs0; *(LAS bf16x8*)(V_lds + (b) * VBYTES + vst1) = vs1; \
        if constexpr (DK == 128) { *(LAS bf16x8*)(K_lds + (b) * KBYTES + kswz128(sr, sc * 2)) = ks0; *(LAS bf16x8*)(K_lds + (b) * KBYTES + kswz128(32 + sr, sc * 2)) = ks1; } \
        else { *(LAS bf16x8*)(K_lds + (b) * KBYTES + kswz64(k64r, k64c * 2)) = ks0; } } while (0)
    const int NT = P.ntiles();
    ATT_LOAD(0);
    for (int t = 0; t < NT; ++t) {
        const int b = t & 1;
        ATT_WRITE(b);
        __syncthreads();
        if (t + 1 < NT) ATT_LOAD(t + 1);
        if (P.wave_needs(t, wid)) {
            f32x16 p0, p1; float mn, alpha; bf16x8 pa0, pa1, pa2, pa3;
            qkt<DK>(p0, p1, K_lds + b * KBYTES, qr, r32, hi);
            P.mask(p0, p1, t, wid, r32, hi, lds);
            partialSM(p0, p1, m_reg, mn, alpha, C, thr_raw);
            if (__any(alpha < 1.f)) { if (hi == 0) al_l[r32] = alpha; asm volatile("s_waitcnt lgkmcnt(0)" ::: "memory");
#pragma unroll
                for (int d = 0; d < 4; ++d)
#pragma unroll
                    for (int r = 0; r < 16; ++r) o[d][r] *= al_l[crow(r, hi)]; }
            finishSM(p0, p1, alpha, l_reg, pa0, pa1, pa2, pa3); ATT_SBAR();
            pv_d0(o, vb0 + b * VBYTES, pa0, pa1, pa2, pa3);
        }
    }
#undef ATT_LOAD
#undef ATT_WRITE
    if (hi == 0) li_l[r32] = l_reg;
    asm volatile("s_waitcnt lgkmcnt(0)" ::: "memory");
    P.finish(o, m_reg, l_reg, li_l, wid, r32, hi);
    __syncthreads();
}

template <class RowFn>
__device__ __forceinline__ void store_o_bf16(const f32x16* o, const LAS float* li_l, int wid, int r32, int hi, const RowFn& orow) {
#pragma unroll
    for (int r = 0; r < 16; ++r) { const int i = crow(r, hi); const float inv = __builtin_amdgcn_rcpf(li_l[i]); bf16_t* p = orow(wid * 32 + i) + r32;
#pragma unroll
        for (int d0 = 0; d0 < 4; ++d0) p[d0 * 32] = (bf16_t)(cvtpk(o[d0][r] * inv, 0.f) & 0xffffu); }
}
struct PolA {
    static constexpr float SCALE = 0.08838834764831845f;
    const bf16_t* proj; bf16_t* ag; float* lse;
    int b, hh, j, r, L, qb;
    __device__ __forceinline__ const bf16_t* tok(int pos) const { return proj + (size_t)(b * SEQ + pos) * IN_TOTAL; }
    __device__ __forceinline__ const bf16_t* q_row(int i) const { return tok(j + r * (qb * 256 + i)) + OFF_QA + hh * 128; }
    __device__ __forceinline__ int ntiles() const { return 6; }
    __device__ __forceinline__ int kidx(int t, int kk) const { int ki = qb * 256 - 64 + 64 * t + kk; ki = ki < 0 ? 0 : (ki > L - 1 ? L - 1 : ki); return j + r * ki; }
    __device__ __forceinline__ const bf16_t* k_row(int t, int kk) const { return tok(kidx(t, kk)) + OFF_KA + hh * 128; }
    __device__ __forceinline__ const bf16_t* v_row(int t, int kk) const { return tok(kidx(t, kk)) + OFF_VA + hh * 128; }
    __device__ __forceinline__ bool wave_needs(int t, int wid) const { const int kbase = qb * 256 - 64 + 64 * t, q0 = qb * 256 + wid * 32; return kbase <= q0 + 95 && kbase + 63 >= q0 - 64 && kbase + 63 >= 0 && kbase < L; }
    __device__ __forceinline__ void mask(f32x16& p0, f32x16& p1, int t, int wid, int r32, int hi, LAS char*) const {
        const int qi = qb * 256 + wid * 32 + r32, kb = qb * 256 - 64 + 64 * t + 4 * hi;
#pragma unroll
        for (int r = 0; r < 16; ++r) { const int k0 = kb + (r & 3) + 8 * (r >> 2), k1 = k0 + 32; int d0 = k0 - qi, d1 = k1 - qi; d0 = d0 < 0 ? -d0 : d0; d1 = d1 < 0 ? -d1 : d1;
            p0[r] = ((unsigned)k0 < (unsigned)L && d0 <= 64) ? p0[r] : NEG; p1[r] = ((unsigned)k1 < (unsigned)L && d1 <= 64) ? p1[r] : NEG; }
    }
    __device__ __forceinline__ float m0() const { return M0; }
    __device__ __forceinline__ float l0() const { return 0.f; }
    __device__ __forceinline__ void finish(const f32x16* o, float m_reg, float l_reg, const LAS float* li_l, int wid, int r32, int hi) const {
        const int h6 = hh % 6;
        store_o_bf16(o, li_l, wid, r32, hi, [&](int i) { return ag + (size_t)(b * SEQ + j + r * (qb * 256 + i)) * 768 + h6 * 128; });
        if (hi == 0) lse[(size_t)(b * SEQ + j + r * (qb * 256 + wid * 32 + r32)) * 6 + h6] = m_reg * SCALE + __logf(l_reg);
    }
};
struct PolC {
    static constexpr float SCALE = 0.08838834764831845f;
    const bf16_t* proj; bf16_t* oc; float sink; int b, qh, qb;
    __device__ __forceinline__ const bf16_t* tok(int pos) const { return proj + (size_t)(b * SEQ + pos) * IN_TOTAL; }
    __device__ __forceinline__ const bf16_t* q_row(int i) const { return tok(qb * 256 + i) + OFF_QC + qh * 128; }
    __device__ __forceinline__ int ntiles() const { return 10; }
    __device__ __forceinline__ int kpos(int t, int kk) const { int k = qb * 256 - 128 + 64 * t + kk; return k < 0 ? 0 : (k > SEQ - 1 ? SEQ - 1 : k); }
    __device__ __forceinline__ const bf16_t* k_row(int t, int kk) const { return tok(kpos(t, kk)) + OFF_KC + (qh >> 2) * 128; }
    __device__ __forceinline__ const bf16_t* v_row(int t, int kk) const { return tok(kpos(t, kk)) + OFF_VC + (qh >> 2) * 128; }
    __device__ __forceinline__ bool wave_needs(int t, int wid) const { const int kbase = qb * 256 - 128 + 64 * t, q0 = qb * 256 + wid * 32; return kbase <= q0 + 159 && kbase + 63 >= q0 - 128 && kbase + 63 >= 0 && kbase < SEQ; }
    __device__ __forceinline__ void mask(f32x16& p0, f32x16& p1, int t, int wid, int r32, int hi, LAS char*) const {
        const int qi = qb * 256 + wid * 32 + r32, kb = qb * 256 - 128 + 64 * t + 4 * hi;
#pragma unroll
        for (int r = 0; r < 16; ++r) { const int k0 = kb + (r & 3) + 8 * (r >> 2), k1 = k0 + 32; int d0 = k0 - qi, d1 = k1 - qi; d0 = d0 < 0 ? -d0 : d0; d1 = d1 < 0 ? -d1 : d1;
            p0[r] = ((unsigned)k0 < (unsigned)SEQ && d0 <= 128) ? p0[r] : NEG; p1[r] = ((unsigned)k1 < (unsigned)SEQ && d1 <= 128) ? p1[r] : NEG; }
    }
    __device__ __forceinline__ float m0() const { return sink * (1.0f / SCALE); }
    __device__ __forceinline__ float l0() const { return 1.f; }
    __device__ __forceinline__ void finish(const f32x16* o, float, float, const LAS float* li_l, int wid, int r32, int hi) const {
        store_o_bf16(o, li_l, wid, r32, hi, [&](int i) { return oc + (size_t)(b * SEQ + qb * 256 + i) * 1024 + qh * 128; });
    }
};
struct PolD {
    static constexpr float SCALE = 0.08838834764831845f;
    const bf16_t* proj; bf16_t* od; int b, h, rb, lo, nt;
    __device__ __forceinline__ const bf16_t* tok(int pos) const { return proj + (size_t)(b * SEQ + pos) * IN_TOTAL; }
    __device__ __forceinline__ const bf16_t* q_row(int i) const { return tok(rb * 256 + i) + OFF_QD + h * 128; }
    __device__ __forceinline__ int ntiles() const { return nt; }
    __device__ __forceinline__ const bf16_t* k_row(int t, int kk) const { return tok((lo + t) * 64 + kk) + OFF_KD + h * 128; }
    __device__ __forceinline__ const bf16_t* v_row(int t, int kk) const { return tok((lo + t) * 64 + kk) + OFF_VD + h * 128; }
    __device__ __forceinline__ bool wave_needs(int t, int wid) const { const int qr_ = rb * 4 + (wid >> 1); int rs = qr_ - 4; rs = rs < 0 ? 0 : (rs > 56 ? 56 : rs); const int kr = lo + t; return kr >= rs && kr < rs + 8; }
    __device__ __forceinline__ void mask(f32x16& p0, f32x16& p1, int t, int wid, int r32, int hi, LAS char* lds) const {
        const int qr_ = rb * 4 + (wid >> 1), qc = 32 * (wid & 1) + r32, kr = lo + t; int cs = qc - 8; cs = cs < 0 ? 0 : (cs > 48 ? 48 : cs);
        const LAS float* T = (const LAS float*)(lds + TABOFF) + (kr - qr_ + 7) * 31 + 15 - qc + 4 * hi; const int kc0 = 4 * hi - cs;
#pragma unroll
        for (int r = 0; r < 16; ++r) { const int kk = (r & 3) + 8 * (r >> 2);
            const float b0 = T[kk], b1 = T[kk + 32];
            p0[r] = ((unsigned)(kc0 + kk) < 16u) ? p0[r] + b0 : NEG; p1[r] = ((unsigned)(kc0 + kk + 32) < 16u) ? p1[r] + b1 : NEG; }
    }
    __device__ __forceinline__ float m0() const { return M0; }
    __device__ __forceinline__ float l0() const { return 0.f; }
    __device__ __forceinline__ void finish(const f32x16* o, float, float, const LAS float* li_l, int wid, int r32, int hi) const {
        store_o_bf16(o, li_l, wid, r32, hi, [&](int i) { return od + (size_t)(b * SEQ + rb * 256 + i) * 1024 + h * 128; });
    }
};
struct PolB {
    static constexpr float SCALE = 0.125f;
    const bf16_t* proj; bf16_t* ob; float* scr; const float* subln; float lmbda, oscale; int b, h, qb, map;
    __device__ __forceinline__ const bf16_t* tok(int pos) const { return proj + (size_t)(b * SEQ + pos) * IN_TOTAL; }
    __device__ __forceinline__ const bf16_t* q_row(int i) const { return tok(qb * 256 + i) + OFF_QB + (2 * h + map) * 64; }
    __device__ __forceinline__ int ntiles() const { return SEQ / 64; }
    __device__ __forceinline__ const bf16_t* k_row(int t, int kk) const { return tok(64 * t + kk) + OFF_KB + (2 * h + map) * 64; }
    __device__ __forceinline__ const bf16_t* v_row(int t, int kk) const { return tok(64 * t + kk) + OFF_VB + h * 128; }
    __device__ __forceinline__ bool wave_needs(int, int) const { return true; }
    __device__ __forceinline__ void mask(f32x16&, f32x16&, int, int, int, int, LAS char*) const {}
    __device__ __forceinline__ float m0() const { return M0; }
    __device__ __forceinline__ float l0() const { return 0.f; }
    __device__ __forceinline__ void finish(const f32x16* o, float, float, const LAS float* li_l, int wid, int r32, int hi) const {
        if (map == 0) {
#pragma unroll
            for (int r = 0; r < 16; ++r) { const int i = crow(r, hi); const float inv = __builtin_amdgcn_rcpf(li_l[i]); float* p = scr + (size_t)(wid * 32 + i) * 128 + r32;
#pragma unroll
                for (int d0 = 0; d0 < 4; ++d0) p[d0 * 32] = o[d0][r] * inv; }
        } else {
            float sw[4];
#pragma unroll
            for (int d0 = 0; d0 < 4; ++d0) sw[d0] = subln[d0 * 32 + r32] * oscale;
#pragma unroll
            for (int r = 0; r < 16; ++r) { const int i = crow(r, hi); const float inv = __builtin_amdgcn_rcpf(li_l[i]); const float* p = scr + (size_t)(wid * 32 + i) * 128 + r32;
                float v[4]; float ss = 0.f;
#pragma unroll
                for (int d0 = 0; d0 < 4; ++d0) { v[d0] = p[d0 * 32] - lmbda * (o[d0][r] * inv); ss += v[d0] * v[d0]; }
#pragma unroll
                for (int s = 1; s < 32; s <<= 1) ss += __shfl_xor(ss, s);
                const float rinv = rsqrtf(ss * (1.0f / 128.0f) + SUBLN_EPS);
                bf16_t* q = ob + (size_t)(b * SEQ + qb * 256 + wid * 32 + i) * 1024 + h * 128 + r32;
#pragma unroll
                for (int d0 = 0; d0 < 4; ++d0) q[d0 * 32] = (bf16_t)(cvtpk(v[d0] * rinv * sw[d0], 0.f) & 0xffffu); }
        }
    }
};

#ifndef ATT_MASK
#define ATT_MASK 15
#endif
#define ATT_ON(k) ((ATT_MASK >> (k)) & 1)
struct Ptrs { const bf16_t* proj; bf16_t* ag; float* lse; bf16_t* ob; bf16_t* oc; bf16_t* od; float* bscr; const float* lam; const float* subln; const float* sink; const float* rpb; float lambda_init; };
__device__ __forceinline__ void attn_phase(const Ptrs& X, LAS char* lds, const int tid, const int vcu, const int G, const int wgid) {
    const int lane = tid & 63;
    if (ATT_ON(0)) {   const float d01 = wave_sum(X.lam[lane] * X.lam[64 + lane]), d23 = wave_sum(X.lam[128 + lane] * X.lam[192 + lane]);
        const float lmbda = __expf(d01) - __expf(d23) + X.lambda_init;
        for (int u = vcu; u < 512; u += G) {
            for (int map = 0; map < 2; ++map) {
                PolB P{X.proj, X.ob, X.bscr + (size_t)wgid * 32768, X.subln, lmbda, 1.0f - X.lambda_init, u >> 7, (u >> 4) & 7, u & 15, map};
                attn_unit<64, PolB>(P, lds, tid);
            }
        }
    }
    if (ATT_ON(1)) for (int u = vcu; u < 512; u += G) {
        const int rb = u & 15, h = (u >> 4) & 7, b = u >> 7; int lo = rb * 4 - 4; lo = lo < 0 ? 0 : (lo > 56 ? 56 : lo); int hi_ = rb * 4 + 3 - 4; hi_ = hi_ < 0 ? 0 : (hi_ > 56 ? 56 : hi_); hi_ += 7;
        { LAS float* T = (LAS float*)(lds + TABOFF); for (int i = tid; i < 465; i += 512) T[i] = X.rpb[h * 465 + i] * (1.0f / PolD::SCALE); }
        PolD P{X.proj, X.od, b, h, rb, lo, hi_ - lo + 1};
        attn_unit<128, PolD>(P, lds, tid);
    }
    if (ATT_ON(2)) for (int u = vcu; u < 512; u += G) {
        const int qb = u & 15, qh = (u >> 4) & 7, b = u >> 7;
        PolC P{X.proj, X.oc, X.sink[qh], b, qh, qb};
        attn_unit<128, PolC>(P, lds, tid);
    }
    if (ATT_ON(3)) for (int u = vcu; u < 1152; u += G) {
        const int g = u / 384, v = u % 384, w16 = v & 15, bh = v >> 4, h6 = bh % 6, b = bh / 6;
        const int r = g == 0 ? 1 : (g == 1 ? 4 : 16), L = SEQ / r;
        PolA P{X.proj, X.ag + (size_t)g * MTOK * 768, X.lse + (size_t)g * MTOK * 6, b, g * 6 + h6, w16 % r, r, L, w16 / r};
        attn_unit<128, PolA>(P, lds, tid);
    }
}
#undef ATT_SBAR
}

struct InPtrs { const float *x, *w_in, *b_gate, *w_branch, *w_out, *diff_lambda, *diff_subln, *sink_logit, *na_rpb, *w_router, *w_exp_gate, *w_exp_up, *w_exp_down, *ln_gain, *ln_bias; };

__device__ __forceinline__ void prologue_phase(const InPtrs& I, unsigned char* ws, int gw, int NGW, int lane) {
    { const f32x4* xs = (const f32x4*)I.x; f32x4* xf = (f32x4*)(ws + WS_XF); u32x4* xb = (u32x4*)(ws + WS_XB);
      for (size_t i = (size_t)gw * 64 + lane; i < (size_t)MTOK * DM / 8; i += (size_t)NGW * 64) {
          const f32x4 a = xs[2 * i], b = xs[2 * i + 1]; xf[2 * i] = a; xf[2 * i + 1] = b;
          u32x4 w; w.x = cvt_pk_bf16(a[0], a[1]); w.y = cvt_pk_bf16(a[2], a[3]); w.z = cvt_pk_bf16(b[0], b[1]); w.w = cvt_pk_bf16(b[2], b[3]); xb[i] = w; } }
    { float* r128 = (float*)(ws + WS_ROPE128); float* r64 = (float*)(ws + WS_ROPE64);
      for (int i = gw * 64 + lane; i < SEQ * 64 + SEQ * 32; i += NGW * 64) {
          int pos, ii, half; float* dst;
          if (i < SEQ * 64) { pos = i >> 6; ii = i & 63; half = 64; dst = r128 + 2 * (size_t)i; } else { const int k = i - SEQ * 64; pos = k >> 5; ii = k & 31; half = 32; dst = r64 + 2 * (size_t)k; }
          const float inv = (float)pow(10000.0, -(double)ii / (double)half); const float ang = (float)pos * inv;
          dst[0] = (float)cos((double)ang); dst[1] = (float)sin((double)ang); } }
    bf16_t* WIN = (bf16_t*)(ws + WS_WIN); bf16_t* WBR = (bf16_t*)(ws + WS_WBR); bf16_t* WOUT = (bf16_t*)(ws + WS_WOUT); bf16_t* WGU = (bf16_t*)(ws + WS_WGU); bf16_t* WDN = (bf16_t*)(ws + WS_WDN);
    constexpr int N1 = DEPTH * 32 * 356, N2 = DEPTH * 60 * 32, N3 = DEPTH * 32 * 32, N4 = DEPTH * NEXP * 32 * 32, N5 = DEPTH * NEXP * 16 * 32;
    for (int it = gw; it < N1 + N2 + N3 + N4 + N5; it += NGW) {
        int r = it;
        if (r < N1) { const int nb = r % 356, kb = (r / 356) % 32, l = r / (356 * 32); const int n = nb * 64 + lane;
            tr_item(I.w_in + (size_t)l * DM * IN_TOTAL, IN_TOTAL, win_src_col(n), kb * 64, WIN + ((size_t)l * IN_TOTAL + n) * DM); continue; }
        r -= N1;
        if (r < N2) { const int nb = r % 32, kbg = (r / 32) % 60, l = r / (32 * 60); const int n = nb * 64 + lane;
            int ro, Kb, kb; if (kbg < 12) { ro = 0; Kb = 768; kb = kbg; } else { const int q = (kbg - 12) >> 4; ro = 768 + 1024 * q; Kb = 1024; kb = (kbg - 12) & 15; }
            tr_item(I.w_branch + ((size_t)l * BR_TOTAL + ro) * DM, DM, n, kb * 64, WBR + ((size_t)l * BR_TOTAL + ro) * DM + (size_t)n * Kb); continue; }
        r -= N2;
        if (r < N3) { const int nb = r % 32, kb = (r / 32) % 32, l = r / (32 * 32); const int n = nb * 64 + lane;
            tr_item(I.w_out + (size_t)l * DM * DM, DM, n, kb * 64, WOUT + ((size_t)l * DM + n) * DM); continue; }
        r -= N3;
        if (r < N4) { const int nb = r % 32, kb = (r / 32) % 32, le = r / (32 * 32); const int n = nb * 64 + lane, pn = n >> 8, bj = (n >> 7) & 1, jj = n & 127;
            tr_item((bj ? I.w_exp_up : I.w_exp_gate) + (size_t)le * DM * DEXP, DEXP, pn * 128 + jj, kb * 64, WGU + ((size_t)le * 2048 + n) * DM); continue; }
        r -= N4;
        { const int nb = r % 32, kb = (r / 32) % 16, le = r / (32 * 16); const int n = nb * 64 + lane;
            tr_item(I.w_exp_down + (size_t)le * DEXP * DM, DM, n, kb * 64, WDN + ((size_t)le * DM + n) * DEXP); }
    }
}

struct Args { const float* in[15]; float* out; unsigned char* ws; int ph_lo, ph_hi; };
__global__ void __launch_bounds__(NWAVES * 64, 2) fwd(Args args) {
    extern __shared__ __attribute__((aligned(16))) unsigned char lds_raw[];
    LAS unsigned char* lds = (LAS unsigned char*)lds_raw;
    for (int u = threadIdx.x; u < (LDS_BYTES - LDSCTL_OFF) / 4; u += NWAVES * 64) ((LAS unsigned*)(lds + LDSCTL_OFF))[u] = 0u;
    __syncthreads();
    unsigned* ctl = (unsigned*)(args.ws + WS_CTL);
    XcdBarrier bar = xcd_barrier_post(ctl + CW_BAR, (volatile LAS unsigned*)(lds + LDSCTL_OFF));
    const int lo = args.ph_lo, hi = args.ph_hi;
#ifndef SCALAR_ATTN
#define SCALAR_ATTN 0
#endif
#ifndef PH_MASK
#define PH_MASK 0xFFFF
#endif
#define PHON(k) ((PH_MASK >> (k)) & 1)
#define IN(k) (lo <= (k) && (k) < hi)
#define PHASE_LOCALS long zz = 0; asm volatile("" : "+s"(zz)); unsigned char* const ws = args.ws + zz; int tid = threadIdx.x; asm volatile("" : "+v"(tid)); int bx = blockIdx.x, G = gridDim.x; asm volatile("" : "+s"(bx), "+s"(G)); \
    const int lane = tid & 63, wave = __builtin_amdgcn_readfirstlane(tid >> 6); const int vcu = (G % 8 == 0) ? (bx % 8) * (G / 8) + bx / 8 : bx; \
    const int gw = vcu * NWAVES + wave, NGW = G * NWAVES; (void)lane; (void)gw; (void)NGW
#define SEAM(k) do { if (IN(k) && IN((k) + 1)) xcd_barrier(bar); } while (0)

#define XF ((float*)(ws + WS_XF))
#define XB ((bf16_t*)(ws + WS_XB))
#define PROJ ((bf16_t*)(ws + WS_PROJ))
#define OA ((bf16_t*)(ws + WS_OA))
#define OB ((bf16_t*)(ws + WS_OB))
#define OC ((bf16_t*)(ws + WS_OC))
#define OD ((bf16_t*)(ws + WS_OD))
#define AG ((bf16_t*)(ws + WS_AG))
#define LSE ((float*)(ws + WS_LSE))
#define MIXED ((bf16_t*)(ws + WS_MIXED))
#define PRELN ((float*)(ws + WS_PRELN))
#define XG ((bf16_t*)(ws + WS_XG))
#define HB ((bf16_t*)(ws + WS_H))
#define YB ((bf16_t*)(ws + WS_Y))
#define AFF ((float*)(ws + WS_AFF))
#define IDX ((int*)(ws + WS_IDX))
#define GV ((float*)(ws + WS_GV))
#define SLOT ((int*)(ws + WS_SLOT))

    if (PHON(0) && IN(0)) { PHASE_LOCALS;
        InPtrs I; I.x = args.in[0 + zz]; I.w_in = args.in[1 + zz]; I.b_gate = args.in[2 + zz]; I.w_branch = args.in[3 + zz]; I.w_out = args.in[4 + zz]; I.diff_lambda = args.in[5 + zz]; I.diff_subln = args.in[6 + zz];
        I.sink_logit = args.in[7 + zz]; I.na_rpb = args.in[8 + zz]; I.w_router = args.in[9 + zz]; I.w_exp_gate = args.in[10 + zz]; I.w_exp_up = args.in[11 + zz]; I.w_exp_down = args.in[12 + zz]; I.ln_gain = args.in[13 + zz]; I.ln_bias = args.in[14 + zz];
        prologue_phase(I, ws, gw, NGW, lane); SEAM(0); }

    for (int l = 0; l < DEPTH; ++l) {
        const int pb = 1 + l * NPL;
        if (PHON(1) && IN(pb + 0)) { PHASE_LOCALS;
            pg8::Gemm g{XB, (const bf16_t*)(ws + WS_WIN) + (size_t)l * IN_TOTAL * DM, MTOK, IN_TOTAL, DM, 0}; pg8::StaticOrder S; S.init(MTOK, IN_TOTAL, G, bx);
            pg8::EpiProj E{PROJ, args.in[2 + zz] + (size_t)l * 8192, (const float*)(ws + WS_ROPE128), (const float*)(ws + WS_ROPE64)};
            pg8::gemm_phase<pg8::EpiProj, pg8::StaticOrder, true, true>(lds, g, S, E, tid);
            SEAM(pb + 0);
        }
        if (PHON(2) && IN(pb + 1)) { PHASE_LOCALS;
            const float li = l == 0 ? 0.2f : (l == 1 ? 0.35550906759096926f : (l == 2 ? 0.47071301834358416f : 0.5560582041556405f));
#if SCALAR_ATTN
            { AttnPtrs P{PROJ, AG, LSE, nullptr, nullptr, nullptr, nullptr, nullptr, nullptr, nullptr, li}; scalar_attn_phase<0>(P, lds, gw, NGW, wave, lane); }
            { AttnPtrs P{PROJ, nullptr, nullptr, OB, nullptr, nullptr, args.in[5 + zz] + l * 256, args.in[6 + zz] + l * 128, nullptr, nullptr, li}; scalar_attn_phase<1>(P, lds, gw, NGW, wave, lane); }
            { AttnPtrs P{PROJ, nullptr, nullptr, nullptr, OC, nullptr, nullptr, nullptr, args.in[7 + zz] + l * 8, nullptr, li}; scalar_attn_phase<2>(P, lds, gw, NGW, wave, lane); }
            { AttnPtrs P{PROJ, nullptr, nullptr, nullptr, nullptr, OD, nullptr, nullptr, nullptr, args.in[8 + zz] + (size_t)l * 8 * 465, li}; scalar_attn_phase<3>(P, lds, gw, NGW, wave, lane); }
#else
            att::Ptrs X{PROJ, AG, LSE, OB, OC, OD, (float*)(ws + WS_BSCR), args.in[5 + zz] + l * 256, args.in[6 + zz] + l * 128, args.in[7 + zz] + l * 8, args.in[8 + zz] + (size_t)l * 8 * 465, li};
            att::attn_phase(X, (LAS char*)lds, tid, vcu, G, bx);
#endif
            SEAM(pb + 1);
        }
        if (PHON(3) && IN(pb + 2)) { PHASE_LOCALS; combine_a_phase(AG, LSE, OA, gw, NGW, lane); SEAM(pb + 2); }
        if (PHON(4) && IN(pb + 3)) { PHASE_LOCALS;
            const bf16_t* wbr = (const bf16_t*)(ws + WS_WBR) + (size_t)l * BR_TOTAL * DM;
            for (int br = 0; br < 4; ++br) {
                const bf16_t* A = br == 0 ? OA : (br == 1 ? OB : (br == 2 ? OC : OD)); const int Kb = br == 0 ? 768 : 1024; const int ro = br == 0 ? 0 : 768 + 1024 * (br - 1);
                pg8::Gemm g{A, wbr + (size_t)ro * DM, MTOK, DM, Kb, 0}; pg8::StaticOrder S; S.init(MTOK, DM, G, bx);
                pg8::EpiGate E{MIXED, PROJ + OFF_GATE + br * DM, br == 0 ? 1 : 0};
                pg8::gemm_phase<pg8::EpiGate, pg8::StaticOrder, true, true>(lds, g, S, E, tid);
                asm volatile("s_waitcnt vmcnt(0)" ::: "memory");
            }
            SEAM(pb + 3);
        }
        if (PHON(5) && IN(pb + 4)) { PHASE_LOCALS;
            pg8::Gemm g{MIXED, (const bf16_t*)(ws + WS_WOUT) + (size_t)l * DM * DM, MTOK, DM, DM, 0}; pg8::StaticOrder S; S.init(MTOK, DM, G, bx);
            pg8::EpiResid E{PRELN, XF, ALPHA};
            pg8::gemm_phase<pg8::EpiResid, pg8::StaticOrder, true, true>(lds, g, S, E, tid);
            SEAM(pb + 4);
        }
        if (PHON(6) && IN(pb + 5)) { PHASE_LOCALS; ln1_router_phase(PRELN, args.in[13 + zz] + (size_t)(l * 2) * DM, args.in[14 + zz] + (size_t)(l * 2) * DM, args.in[9 + zz] + (size_t)l * DM * NEXP, XF, XB, AFF, lds, tid, gw, NGW, lane); SEAM(pb + 5); }
        if (PHON(7) && IN(pb + 6)) { PHASE_LOCALS; topk_phase(AFF, IDX, GV, SLOT, lds, tid, wave, lane, bx, G); SEAM(pb + 6); }
        if (PHON(8) && IN(pb + 7)) { PHASE_LOCALS; gather_phase(XB, IDX, XG, gw, NGW, lane); SEAM(pb + 7); }
        if (PHON(9) && IN(pb + 8)) { PHASE_LOCALS;
            pg8::Gemm g{XG, (const bf16_t*)(ws + WS_WGU) + (size_t)l * NEXP * 2048 * DM, NGRP * CAP, 2048, DM, (size_t)2048 * DM * 2}; pg8::StaticOrder S; S.init(NGRP * CAP, 2048, G, bx);
            pg8::EpiSwiGLU E{HB};
            pg8::gemm_phase<pg8::EpiSwiGLU, pg8::StaticOrder, true, true>(lds, g, S, E, tid);
            SEAM(pb + 8);
        }
        if (PHON(10) && IN(pb + 9)) { PHASE_LOCALS;
            pg8::Gemm g{HB, (const bf16_t*)(ws + WS_WDN) + (size_t)l * NEXP * DM * DEXP, NGRP * CAP, DM, DEXP, (size_t)DM * DEXP * 2}; pg8::StaticOrder S; S.init(NGRP * CAP, DM, G, bx);
            pg8::EpiDown E{YB, GV};
            pg8::gemm_phase<pg8::EpiDown, pg8::StaticOrder, true, true>(lds, g, S, E, tid);
            SEAM(pb + 9);
        }
        if (PHON(11) && IN(pb + 10)) { PHASE_LOCALS;
            ln2_phase(XF, YB, SLOT, args.in[13 + zz] + (size_t)(l * 2 + 1) * DM, args.in[14 + zz] + (size_t)(l * 2 + 1) * DM, (l == DEPTH - 1) ? args.out : XF, XB, gw, NGW, lane);
            SEAM(pb + 10);
        }
    }
#undef IN
#undef SEAM
}

#ifndef MK_ONE_LAUNCH
#define MK_ONE_LAUNCH 1
#endif
extern "C" void kernel_launch(void* const* d_in, const int* in_sizes, int n_in, void* d_out, int out_size, void* d_ws, size_t ws_size, hipStream_t stream) {
    static int grid = 0;
    if (grid == 0) {
        if (n_in != 15 || out_size != MTOK * DM || ws_size < WS_END) { fprintf(stderr, "kernel_launch: unexpected shapes (n_in %d out %d ws %zu, need ws >= %zu)\n", n_in, out_size, ws_size, (size_t)WS_END); grid = -1; return; }
        int dev = 0, cus = 0, per_cu = 0;
        if (hipGetDevice(&dev) != hipSuccess || hipDeviceGetAttribute(&cus, hipDeviceAttributeMultiprocessorCount, dev) != hipSuccess) { grid = -1; return; }
        if (hipFuncSetAttribute((const void*)fwd, hipFuncAttributeMaxDynamicSharedMemorySize, LDS_BYTES) != hipSuccess) { fprintf(stderr, "kernel_launch: hipFuncSetAttribute failed\n"); grid = -1; return; }
        if (hipOccupancyMaxActiveBlocksPerMultiprocessor(&per_cu, (const void*)fwd, NWAVES * 64, LDS_BYTES) != hipSuccess || per_cu < 1) { fprintf(stderr, "kernel_launch: occupancy query says %d\n", per_cu); }
        (void)hipGetLastError();
        grid = cus;
    }
    if (grid < 0) return;
    if (hipMemsetAsync((char*)d_ws + WS_CTL, 0, CTL_ZERO_BYTES, stream) != hipSuccess) return;
    Args a{};
    for (int i = 0; i < 15; ++i) a.in[i] = (const float*)d_in[i];
    a.out = (float*)d_out; a.ws = (unsigned char*)d_ws;
#if MK_ONE_LAUNCH
    a.ph_lo = 0; a.ph_hi = NPHASES;
    hipLaunchKernelGGL(fwd, dim3(grid), dim3(NWAVES * 64), LDS_BYTES, stream, a);
#else
    for (int p = 0; p < NPHASES; ++p) { a.ph_lo = p; a.ph_hi = p + 1; hipLaunchKernelGGL(fwd, dim3(grid), dim3(NWAVES * 64), LDS_BYTES, stream, a); }
#endif
}
```

```cpp
#include <hip/hip_runtime.h>
#include <cstdio>
#include <cstdint>
#include <cmath>
namespace pg8 {
#define PG8_LAS __attribute__((address_space(3)))
typedef unsigned short bf16_t;
typedef short bf16x8 __attribute__((ext_vector_type(8)));
typedef float f32x4 __attribute__((ext_vector_type(4)));
typedef unsigned u32x4 __attribute__((ext_vector_type(4)));
constexpr int BM = 256, BK = 64, HALF = 128, HTB = HALF * BK * 2  , STAGE_BYTES = 8 * HTB, NXCD = 8, WGM = 8;

__host__ __device__ __forceinline__ int lds_byte(int r, int c) { const int st = (r >> 4) * 2 + (c >> 5), rr = r & 15, cc = c & 31, ob = rr * 64 + cc * 2; return st * 1024 + (ob ^ (((ob >> 9) & 1) << 5)); }
__host__ __device__ __forceinline__ void stage_rc(int b, int& R, int& C) { const int st = b / 1024, sb = b % 1024, swz = sb ^ (((sb >> 9) & 1) << 5); R = (st >> 1) * 16 + swz / 64; C = (st & 1) * 32 + (swz % 64) / 2; }
__host__ __device__ __forceinline__ int perm32(int rho) { const int n = rho >> 4, i = rho & 15; return 8 * (i >> 2) + 4 * n + (i & 3); }

struct Unit { int pm, pn; };
struct Gemm { const bf16_t* A; const bf16_t* Bt; int M, N, K; size_t gstride; };

struct StaticOrder {
    int nM, nN, nwg, G, c;
    __host__ __device__ void init(int M, int N, int G_, int c_) { nM = M / BM; nN = N / BM; nwg = nM * nN; G = G_; c = c_; }
    __host__ __device__ bool next(int i, Unit& u) const {
        const long L = (long)i * G + c; if (L >= nwg) return false;
        int wgid = (int)L; { const int q = nwg / NXCD, r = nwg % NXCD, xcd = wgid % NXCD, off = wgid / NXCD; wgid = (xcd < r ? xcd * (q + 1) : r * (q + 1) + (xcd - r) * q) + off; }
        const int nig = WGM * nN, gid = wgid / nig, fm = gid * WGM, gsz = (nM - fm) < WGM ? (nM - fm) : WGM;
        u.pm = fm + ((wgid % nig) % gsz); u.pn = (wgid % nig) / gsz; return true;
    }
    __device__ __forceinline__ void a_ready(const Unit&) const {}
    __device__ __forceinline__ void done(const Unit&) const {}
};


__device__ __forceinline__ unsigned cvt_pk_bf16(float lo, float hi) { unsigned r; asm volatile("v_cvt_pk_bf16_f32 %0, %1, %2" : "=v"(r) : "v"(lo), "v"(hi)); return r; }
__device__ __forceinline__ float bflo(unsigned w) { return __uint_as_float(w << 16); }
__device__ __forceinline__ float bfhi(unsigned w) { return __uint_as_float(w & 0xffff0000u); }
__device__ __forceinline__ float sigmoidf_(float x) { return 1.0f / (1.0f + __expf(-x)); }

struct EpiProj {
    static constexpr bool PERM = true, AFTER_DRAIN = false;
    bf16_t* O; const float* bgate; const float* rope128; const float* rope64;
    __device__ __forceinline__ void operator()(const f32x4 (&acc)[2][2][4][2], const Unit& u, int wr, int wc, int fr, int fq) const {
        const int colt = u.pn * BM;
        int mode;
        if (colt < 4608) mode = 1; else if (colt < 6912) mode = 0; else if (colt < 8960) mode = 2; else if (colt < 9984) mode = 0; else if (colt < 11264) mode = 1; else if (colt < 14592) mode = 0; else mode = 3;
        const int row0 = u.pm * BM + wr * 64 + fr, col0 = colt + wc * 32 + 8 * fq;
        const int i128 = 16 * wc + 4 * fq, i64 = 16 * (wc & 1) + 4 * fq;
        f32x4 gb[2][2];
        if (mode == 3) {
#pragma unroll
            for (int bj = 0; bj < 2; ++bj)
#pragma unroll
                for (int n = 0; n < 2; ++n) gb[bj][n] = *(const f32x4*)(bgate + (col0 - 14592) + bj * HALF + 4 * n);
        }
#pragma unroll
        for (int ai = 0; ai < 2; ++ai)
#pragma unroll
            for (int m = 0; m < 4; ++m) {
                const int row = row0 + ai * HALF + m * 16; const int pos = row & 4095;
                bf16_t* rowp = O + (size_t)row * 22784 + col0;
                f32x4 cs0 = {1.f, 0.f, 1.f, 0.f}, cs1 = {1.f, 0.f, 1.f, 0.f};
                if (mode == 1) { const f32x4* t = (const f32x4*)(rope128 + ((size_t)pos * 64 + i128) * 2); cs0 = t[0]; cs1 = t[1]; }
                if (mode == 2) { const f32x4* t = (const f32x4*)(rope64 + ((size_t)pos * 32 + i64) * 2); cs0 = t[0]; cs1 = t[1]; }
#pragma unroll
                for (int bj = 0; bj < 2; ++bj) {
                    f32x4 v0 = acc[ai][bj][m][0], v1 = acc[ai][bj][m][1];
                    if (mode == 1 || mode == 2) {
                        f32x4 r0, r1;
                        r0[0] = v0[0] * cs0[0] - v0[1] * cs0[1]; r0[1] = v0[1] * cs0[0] + v0[0] * cs0[1];
                        r0[2] = v0[2] * cs0[2] - v0[3] * cs0[3]; r0[3] = v0[3] * cs0[2] + v0[2] * cs0[3];
                        r1[0] = v1[0] * cs1[0] - v1[1] * cs1[1]; r1[1] = v1[1] * cs1[0] + v1[0] * cs1[1];
                        r1[2] = v1[2] * cs1[2] - v1[3] * cs1[3]; r1[3] = v1[3] * cs1[2] + v1[2] * cs1[3];
                        v0 = r0; v1 = r1;
                    }
                    if (mode == 3) {
                        v0 = v0 + gb[bj][0]; v1 = v1 + gb[bj][1];
#pragma unroll
                        for (int j = 0; j < 4; ++j) { v0[j] = sigmoidf_(v0[j]); v1[j] = sigmoidf_(v1[j]); }
                    }
                    u32x4 w; w.x = cvt_pk_bf16(v0[0], v0[1]); w.y = cvt_pk_bf16(v0[2], v0[3]); w.z = cvt_pk_bf16(v1[0], v1[1]); w.w = cvt_pk_bf16(v1[2], v1[3]);
                    *(u32x4*)(rowp + bj * HALF) = w;
                }
            }
    }
};
struct EpiGate {
    static constexpr bool PERM = true, AFTER_DRAIN = false;
    bf16_t* mixed; const bf16_t* gate; int first;
    __device__ __forceinline__ void operator()(const f32x4 (&acc)[2][2][4][2], const Unit& u, int wr, int wc, int fr, int fq) const {
        const int row0 = u.pm * BM + wr * 64 + fr, col0 = u.pn * BM + wc * 32 + 8 * fq;
#pragma unroll
        for (int ai = 0; ai < 2; ++ai)
#pragma unroll
            for (int m = 0; m < 4; ++m) {
                const int row = row0 + ai * HALF + m * 16;
                const bf16_t* gp = gate + (size_t)row * 22784 + col0; bf16_t* mp = mixed + (size_t)row * 2048 + col0;
#pragma unroll
                for (int bj = 0; bj < 2; ++bj) {
                    const u32x4 g = *(const u32x4*)(gp + bj * HALF);
                    u32x4 p = {0u, 0u, 0u, 0u}; if (!first) p = *(const u32x4*)(mp + bj * HALF);
                    const f32x4 v0 = acc[ai][bj][m][0], v1 = acc[ai][bj][m][1];
                    u32x4 w;
                    w.x = cvt_pk_bf16(bflo(p.x) + bflo(g.x) * v0[0], bfhi(p.x) + bfhi(g.x) * v0[1]);
                    w.y = cvt_pk_bf16(bflo(p.y) + bflo(g.y) * v0[2], bfhi(p.y) + bfhi(g.y) * v0[3]);
                    w.z = cvt_pk_bf16(bflo(p.z) + bflo(g.z) * v1[0], bfhi(p.z) + bfhi(g.z) * v1[1]);
                    w.w = cvt_pk_bf16(bflo(p.w) + bflo(g.w) * v1[2], bfhi(p.w) + bfhi(g.w) * v1[3]);
                    *(u32x4*)(mp + bj * HALF) = w;
                }
            }
    }
};
struct EpiResid {
    static constexpr bool PERM = false, AFTER_DRAIN = false;
    float* out; const float* xf; float alpha;
    __device__ __forceinline__ void operator()(const f32x4 (&acc)[2][2][4][2], const Unit& u, int wr, int wc, int fr, int fq) const {
        const int row0 = u.pm * BM + wr * 64 + fr, col0 = u.pn * BM + wc * 32 + 4 * fq;
#pragma unroll
        for (int ai = 0; ai < 2; ++ai)
#pragma unroll
            for (int m = 0; m < 4; ++m) {
                const size_t off = (size_t)(row0 + ai * HALF + m * 16) * 2048 + col0;
#pragma unroll
                for (int bj = 0; bj < 2; ++bj)
#pragma unroll
                    for (int n = 0; n < 2; ++n) { const f32x4 x = *(const f32x4*)(xf + off + bj * HALF + n * 16); *(f32x4*)(out + off + bj * HALF + n * 16) = x * alpha + acc[ai][bj][m][n]; }
            }
    }
};
struct EpiSwiGLU {
    static constexpr bool PERM = true, AFTER_DRAIN = false;
    bf16_t* H;
    __device__ __forceinline__ void operator()(const f32x4 (&acc)[2][2][4][2], const Unit& u, int wr, int wc, int fr, int fq) const {
        const int row0 = u.pm * BM + wr * 64 + fr, col0 = u.pn * HALF + wc * 32 + 8 * fq;
#pragma unroll
        for (int ai = 0; ai < 2; ++ai)
#pragma unroll
            for (int m = 0; m < 4; ++m) {
                bf16_t* hp = H + (size_t)(row0 + ai * HALF + m * 16) * 1024 + col0;
                f32x4 h0, h1;
#pragma unroll
                for (int j = 0; j < 4; ++j) { const float g0 = acc[ai][0][m][0][j], g1 = acc[ai][0][m][1][j];
                    h0[j] = g0 * sigmoidf_(g0) * acc[ai][1][m][0][j]; h1[j] = g1 * sigmoidf_(g1) * acc[ai][1][m][1][j]; }
                u32x4 w; w.x = cvt_pk_bf16(h0[0], h0[1]); w.y = cvt_pk_bf16(h0[2], h0[3]); w.z = cvt_pk_bf16(h1[0], h1[1]); w.w = cvt_pk_bf16(h1[2], h1[3]);
                *(u32x4*)hp = w;
            }
    }
};
struct EpiDown {
    static constexpr bool PERM = true, AFTER_DRAIN = false;
    bf16_t* Y; const float* gv;
    __device__ __forceinline__ void operator()(const f32x4 (&acc)[2][2][4][2], const Unit& u, int wr, int wc, int fr, int fq) const {
        const int row0 = u.pm * BM + wr * 64 + fr, col0 = u.pn * BM + wc * 32 + 8 * fq;
#pragma unroll
        for (int ai = 0; ai < 2; ++ai)
#pragma unroll
            for (int m = 0; m < 4; ++m) {
                const int row = row0 + ai * HALF + m * 16; const float s = gv[row];
                bf16_t* yp = Y + (size_t)row * 2048 + col0;
#pragma unroll
                for (int bj = 0; bj < 2; ++bj) { const f32x4 v0 = acc[ai][bj][m][0] * s, v1 = acc[ai][bj][m][1] * s;
                    u32x4 w; w.x = cvt_pk_bf16(v0[0], v0[1]); w.y = cvt_pk_bf16(v0[2], v0[3]); w.z = cvt_pk_bf16(v1[0], v1[1]); w.w = cvt_pk_bf16(v1[2], v1[3]);
                    *(u32x4*)(yp + bj * HALF) = w; }
            }
    }
};

template <class Epi, class Sched, bool ALIGN_EPI = false, bool SP2 = false>
__device__ __forceinline__ void gemm_phase(PG8_LAS unsigned char* lds, const Gemm g, const Sched& S, const Epi& E, const int tid) {
    const int wid = __builtin_amdgcn_readfirstlane(tid >> 6), lane = tid & 63, wr = wid >> 2, wc = wid & 3, fr = lane & 15, fq = lane >> 4;
    const int K = g.K, nt = K / BK;
    unsigned voffA[2], voffB[2];
#pragma unroll
    for (int i = 0; i < 2; ++i) { int R, C; stage_rc(tid * 16 + i * 8192, R, C); const int Rb = Epi::PERM ? ((R & ~31) + perm32(R & 31)) : R;
        voffA[i] = (unsigned)(R * K + C) * 2u; voffB[i] = (unsigned)(Rb * K + C) * 2u; }
    const size_t kstep = (size_t)(BK * 2);
    const size_t hstep = (size_t)HALF * K * 2;
    const size_t tstep = 2 * hstep;
    const unsigned ldsw = (unsigned)wid * 1024u;
    const int aoff = lds_byte(wr * 64 + fr, fq * 8), boff = lds_byte(wc * 32 + fr, fq * 8);
#define PG8_SA(b, h) (((b) * 2 + (h)) * HTB)
#define PG8_SB(b, h) ((4 + (b) * 2 + (h)) * HTB)
#define PG8_STAGE(bufoff, gbase, voff) do { _Pragma("unroll") for (int _i = 0; _i < 2; ++_i) \
        __builtin_amdgcn_global_load_lds((const unsigned*)((const char*)(gbase) + (voff)[_i]), (PG8_LAS unsigned*)(lds + (bufoff) + ldsw + _i * 8192), 16, 0, 0); } while (0)
#define PG8_LDA(dst, b, h) do { _Pragma("unroll") for (int m = 0; m < 4; ++m) _Pragma("unroll") for (int k = 0; k < 2; ++k) dst[m][k] = *(const PG8_LAS bf16x8*)(lds + PG8_SA(b, h) + aoff + m * 2048 + k * 1024); } while (0)
#define PG8_LDB(dst, b, h) do { _Pragma("unroll") for (int n = 0; n < 2; ++n) _Pragma("unroll") for (int k = 0; k < 2; ++k) dst[n][k] = *(const PG8_LAS bf16x8*)(lds + PG8_SB(b, h) + boff + n * 2048 + k * 1024); } while (0)
#define PG8_MMA(ai, bj, At, Bt) do { __builtin_amdgcn_s_setprio(1); _Pragma("unroll") for (int m = 0; m < 4; ++m) _Pragma("unroll") for (int n = 0; n < 2; ++n) _Pragma("unroll") for (int k = 0; k < 2; ++k) \
        acc[ai][bj][m][n] = __builtin_amdgcn_mfma_f32_16x16x32_bf16(Bt[n][k], At[m][k], acc[ai][bj][m][n], 0, 0, 0); __builtin_amdgcn_s_setprio(0); } while (0)
#define PG8_WAIT_V(n) asm volatile("s_waitcnt vmcnt(" #n ")" ::: "memory")
#define PG8_WAIT_L(n) asm volatile("s_waitcnt lgkmcnt(" #n ")" ::: "memory")
#define PG8_BAR __builtin_amdgcn_s_barrier()
#define PG8_SCHED __builtin_amdgcn_sched_barrier(0)
    Unit cur, nxt; int ui = 0;
    if (!S.next(0, cur)) return;
    f32x4 acc[2][2][4][2];
#pragma unroll
    for (int a = 0; a < 2; ++a)
#pragma unroll
        for (int b = 0; b < 2; ++b)
#pragma unroll
            for (int m = 0; m < 4; ++m)
#pragma unroll
                for (int n = 0; n < 2; ++n) acc[a][b][m][n] = (f32x4){0.f, 0.f, 0.f, 0.f};
    bf16x8 At[4][2], B0[2][2], B1[2][2];
    const char* cA = (const char*)g.A + (size_t)cur.pm * tstep; const char* cB = (const char*)g.Bt + (size_t)((cur.pm >> 1) & 15) * g.gstride + (size_t)cur.pn * tstep;
    S.a_ready(cur);
    if constexpr (SP2) {
        PG8_STAGE(PG8_SB(0, 0), cB, voffB); PG8_STAGE(PG8_SB(0, 1), cB + hstep, voffB); PG8_STAGE(PG8_SA(0, 0), cA, voffA); PG8_STAGE(PG8_SA(0, 1), cA + hstep, voffA);
        if (wr == 1) PG8_BAR;
        PG8_WAIT_V(2); PG8_BAR;
        PG8_STAGE(PG8_SB(1, 0), cB + kstep, voffB); PG8_STAGE(PG8_SA(1, 0), cA + kstep, voffA); PG8_STAGE(PG8_SB(1, 1), cB + hstep + kstep, voffB);
        PG8_WAIT_V(6); PG8_BAR;
    } else {
        PG8_STAGE(PG8_SB(0, 0), cB, voffB); PG8_STAGE(PG8_SA(0, 0), cA, voffA); PG8_STAGE(PG8_SB(0, 1), cB + hstep, voffB); PG8_STAGE(PG8_SA(0, 1), cA + hstep, voffA);
        if (wr == 1) PG8_BAR;
        PG8_WAIT_V(4); PG8_BAR;
        PG8_STAGE(PG8_SB(1, 0), cB + kstep, voffB); PG8_STAGE(PG8_SA(1, 0), cA + kstep, voffA); PG8_STAGE(PG8_SB(1, 1), cB + hstep + kstep, voffB);
        PG8_WAIT_V(6); PG8_BAR;
    }
    for (;;) {
        const bool has_next = S.next(ui + 1, nxt);
        const char* nA = has_next ? (const char*)g.A + (size_t)nxt.pm * tstep : cA; const char* nB = has_next ? (const char*)g.Bt + (size_t)((nxt.pm >> 1) & 15) * g.gstride + (size_t)nxt.pn * tstep : cB;
        for (int t = 0; t < nt; t += 2) {
            const bool last = (t == nt - 2);
            const char* a1 = cA + (size_t)(t + 1) * kstep;
            const char* a2 = last ? nA : cA + (size_t)(t + 2) * kstep; const char* b2 = last ? nB : cB + (size_t)(t + 2) * kstep;
            const char* a3 = a2 + kstep; const char* b3 = b2 + kstep;
            if (last && has_next) S.a_ready(nxt);
            if constexpr (SP2) {
            PG8_LDB(B0, 0, 0); PG8_LDB(B1, 0, 1); PG8_SCHED; PG8_LDA(At, 0, 0); PG8_STAGE(PG8_SA(1, 1), a1 + hstep, voffA);
            PG8_WAIT_V(8); PG8_WAIT_L(0); PG8_BAR; PG8_MMA(0, 0, At, B0); PG8_MMA(0, 1, At, B1); PG8_BAR; PG8_SCHED;
            PG8_LDA(At, 0, 1); PG8_STAGE(PG8_SB(0, 0), b2, voffB); PG8_STAGE(PG8_SB(0, 1), b2 + hstep, voffB); PG8_STAGE(PG8_SA(0, 0), a2, voffA);
            PG8_WAIT_V(8); PG8_WAIT_L(0); PG8_BAR; PG8_MMA(1, 0, At, B0); PG8_MMA(1, 1, At, B1); PG8_BAR; PG8_SCHED;
            PG8_LDB(B0, 1, 0); PG8_LDB(B1, 1, 1); PG8_SCHED; PG8_LDA(At, 1, 0); PG8_STAGE(PG8_SA(0, 1), a2 + hstep, voffA);
            PG8_WAIT_V(8); PG8_WAIT_L(0); PG8_BAR; PG8_MMA(0, 0, At, B0); PG8_MMA(0, 1, At, B1); PG8_BAR; PG8_SCHED;
            PG8_LDA(At, 1, 1); PG8_STAGE(PG8_SB(1, 0), b3, voffB); PG8_STAGE(PG8_SB(1, 1), b3 + hstep, voffB); PG8_STAGE(PG8_SA(1, 0), a3, voffA);
            PG8_WAIT_V(8); PG8_WAIT_L(0); PG8_BAR; PG8_MMA(1, 0, At, B0); PG8_MMA(1, 1, At, B1); PG8_BAR; PG8_SCHED;
            } else {
            PG8_LDB(B0, 0, 0); PG8_SCHED; PG8_LDA(At, 0, 0); PG8_STAGE(PG8_SA(1, 1), a1 + hstep, voffA);
            PG8_WAIT_L(8); PG8_BAR; PG8_WAIT_L(0); PG8_MMA(0, 0, At, B0); PG8_BAR; PG8_SCHED;
            PG8_LDB(B1, 0, 1); PG8_STAGE(PG8_SB(0, 0), b2, voffB);
            PG8_BAR; PG8_WAIT_L(0); PG8_MMA(0, 1, At, B1); PG8_BAR;
            PG8_LDA(At, 0, 1); PG8_STAGE(PG8_SA(0, 0), a2, voffA);
            PG8_BAR; PG8_WAIT_L(0); PG8_MMA(1, 0, At, B0); PG8_BAR; PG8_SCHED;
            PG8_STAGE(PG8_SB(0, 1), b2 + hstep, voffB);
            PG8_WAIT_V(6); PG8_BAR; PG8_MMA(1, 1, At, B1); PG8_BAR;
            PG8_LDB(B0, 1, 0); PG8_SCHED; PG8_LDA(At, 1, 0); PG8_STAGE(PG8_SA(0, 1), a2 + hstep, voffA);
            PG8_WAIT_L(8); PG8_BAR; PG8_WAIT_L(0); PG8_MMA(0, 0, At, B0); PG8_BAR; PG8_SCHED;
            PG8_LDB(B1, 1, 1); PG8_STAGE(PG8_SB(1, 0), b3, voffB);
            PG8_BAR; PG8_WAIT_L(0); PG8_MMA(0, 1, At, B1); PG8_BAR;
            PG8_LDA(At, 1, 1); PG8_STAGE(PG8_SA(1, 0), a3, voffA);
            PG8_BAR; PG8_WAIT_L(0); PG8_MMA(1, 0, At, B0); PG8_BAR; PG8_SCHED;
            PG8_STAGE(PG8_SB(1, 1), b3 + hstep, voffB);
            PG8_WAIT_V(6); PG8_BAR; PG8_MMA(1, 1, At, B1); PG8_BAR;
            }
        }
        if constexpr (ALIGN_EPI) { if (wr == 0) PG8_BAR; }
        if constexpr (!Epi::AFTER_DRAIN) { E(acc, cur, wr, wc, fr, fq); S.done(cur); }
        if (!has_next) break;
#pragma unroll
        for (int a = 0; a < 2; ++a)
#pragma unroll
            for (int b = 0; b < 2; ++b)
#pragma unroll
                for (int m = 0; m < 4; ++m)
#pragma unroll
                    for (int n = 0; n < 2; ++n) acc[a][b][m][n] = (f32x4){0.f, 0.f, 0.f, 0.f};
        cur = nxt; cA = nA; cB = nB; ++ui;
        if constexpr (ALIGN_EPI) { if (wr == 1) PG8_BAR; }
    }
    PG8_WAIT_V(0);
    if constexpr (!ALIGN_EPI) { if (wr == 0) PG8_BAR; }
    PG8_BAR;
    if constexpr (Epi::AFTER_DRAIN) { E.fused(acc, cur, wr, wc, fr, fq, lds, wid, lane); S.done(cur); }
#undef PG8_SA
#undef PG8_SB
#undef PG8_STAGE
#undef PG8_LDA
#undef PG8_LDB
#undef PG8_MMA
#undef PG8_WAIT_V
#undef PG8_WAIT_L
#undef PG8_BAR
#undef PG8_SCHED
}
}

constexpr int DM = 2048, NBATCH = 4, SEQ = 4096, DEPTH = 4, MTOK = NBATCH * SEQ;
constexpr int IN_TOTAL = 22784;
constexpr int OFF_QA = 0, OFF_KA = 2304, OFF_VA = 4608, OFF_QB = 6912, OFF_KB = 7936, OFF_VB = 8960, OFF_QC = 9984, OFF_KC = 11008, OFF_VC = 11264, OFF_QD = 11520, OFF_KD = 12544, OFF_VD = 13568, OFF_GATE = 14592;
constexpr int BR_TOTAL = 3840;
constexpr int NEXP = 16, CAP = 512, DEXP = 1024, NGRP = NBATCH * NEXP;
constexpr float LN_EPS = 1e-5f, SUBLN_EPS = 1e-5f;
constexpr float ALPHA = 1.6817928305074290f;
constexpr size_t MiB = 1u << 20;
constexpr size_t WS_CTL = 0, CTL_ZERO_BYTES = 1 * MiB;
constexpr size_t WS_ROPE128 = 1 * MiB, WS_ROPE64 = 3 * MiB, WS_AFF = 4 * MiB, WS_IDX = 5 * MiB, WS_GV = 5 * MiB + 131072, WS_SLOT = 6 * MiB, WS_LSE = 7 * MiB;
constexpr size_t WS_XF = 16 * MiB, WS_XB = 144 * MiB;
constexpr size_t WS_OA = 208 * MiB, WS_OB = 232 * MiB, WS_OC = 264 * MiB, WS_OD = 296 * MiB;
constexpr size_t WS_AG = 328 * MiB;
constexpr size_t WS_BSCR = 400 * MiB;
constexpr size_t WS_MIXED = 432 * MiB;
constexpr size_t WS_PRELN = 496 * MiB;
constexpr size_t WS_PROJ = 624 * MiB;
constexpr size_t WS_XG = WS_PROJ, WS_H = WS_PROJ + 128 * MiB, WS_Y = WS_PROJ + 192 * MiB;
constexpr size_t WS_WIN = 1336 * MiB;
constexpr size_t WS_WBR = 1692 * MiB;
constexpr size_t WS_WOUT = 1752 * MiB;
constexpr size_t WS_WGU = 1784 * MiB;
constexpr size_t WS_WDN = 2296 * MiB;
constexpr size_t WS_END = 2552 * MiB;
static_assert(WS_PROJ + (size_t)MTOK * IN_TOTAL * 2 == WS_WIN, "ws map");
constexpr int CW_BAR = 4096;
constexpr int LDS_BYTES = 147456, LDSCTL_OFF = 146944;
constexpr int NWAVES = 8;
constexpr int NPL = 11, NPHASES = 1 + DEPTH * NPL;

#define GAS __attribute__((address_space(1)))
#define LAS __attribute__((address_space(3)))
typedef unsigned short bf16_t;
typedef float f32x4 __attribute__((ext_vector_type(4)));
typedef float f32x2 __attribute__((ext_vector_type(2)));
typedef unsigned u32x4 __attribute__((ext_vector_type(4)));
typedef unsigned u32x2 __attribute__((ext_vector_type(2)));
using pg8::cvt_pk_bf16; using pg8::bflo; using pg8::bfhi;
__device__ __forceinline__ float bf2f(bf16_t h) { return __uint_as_float(((unsigned)h) << 16); }
__device__ __forceinline__ float wave_sum(float v) {
#pragma unroll
    for (int o = 1; o < 64; o <<= 1) v += __shfl_xor(v, o);
    return v;
}
__device__ __forceinline__ float wave_max(float v) {
#pragma unroll
    for (int o = 1; o < 64; o <<= 1) v = fmaxf(v, __shfl_xor(v, o));
    return v;
}
__device__ __forceinline__ int wave_sum_i(int v) {
#pragma unroll
    for (int o = 1; o < 64; o <<= 1) v += __shfl_xor(v, o);
    return v;
}

#define XB_TMO      128
#define XB_XCNT(j)  (256  + 64 * (j))
#define XB_XSUB(j)  (1280 + 64 * (j))
#define XB_XGEN(j)  (2304 + 64 * (j))
#define XB_TOP      3328
#define XB_TOPGEN   3392
#define XCD_BAR_WORDS 3456
#define XB_SPIN_CAP (1u << 23)

__device__ __forceinline__ unsigned xb_ld(unsigned* p)              { return __hip_atomic_load(p, __ATOMIC_RELAXED, __HIP_MEMORY_SCOPE_AGENT); }
__device__ __forceinline__ unsigned xb_add(unsigned* p, unsigned v) { return __hip_atomic_fetch_add(p, v, __ATOMIC_RELAXED, __HIP_MEMORY_SCOPE_AGENT); }
__device__ __forceinline__ unsigned xb_xcc_id() { return (unsigned)__builtin_amdgcn_s_getreg((3 << 11) | 20) & 0xFu; }
#define XB_SPIN(cond, bar) do { unsigned _sp = 0; while (cond) { __builtin_amdgcn_s_sleep(1); \
    if ((++_sp & 255u) == 0u) { if (xb_ld(&(bar)[XB_TMO])) break; if (_sp > XB_SPIN_CAP) { atomicAdd(&(bar)[XB_TMO], 1u); break; } } } } while (0)

struct XcdBarrier {
    unsigned* bar; unsigned x;
    volatile LAS unsigned* st;
};
__device__ __forceinline__ XcdBarrier xcd_barrier_post(unsigned* bar, volatile LAS unsigned* st) {
    XcdBarrier b; b.bar = bar; b.x = xb_xcc_id(); b.st = st;
    if (threadIdx.x == 0) (void)xb_add(&bar[XB_XCNT(b.x)], 1u);
    return b;
}
__device__ __forceinline__ void xcd_barrier_complete(unsigned* bar, unsigned x, unsigned& nloc, unsigned& nx) {
    const unsigned G = gridDim.x * gridDim.y * gridDim.z;
    unsigned sum, cnt, mine, sp = 0u;
    for (;;) {
        sum = 0u; cnt = 0u; mine = 0u;
#pragma unroll
        for (unsigned j = 0; j < 16; ++j) { const unsigned c = xb_ld(&bar[XB_XCNT(j)]); sum += c; cnt += (c > 0u) ? 1u : 0u; mine = (j == x) ? c : mine; }
        if (sum == G) break;
        __builtin_amdgcn_s_sleep(1);
        if ((++sp & 255u) == 0u) { if (xb_ld(&bar[XB_TMO])) break; if (sp > XB_SPIN_CAP) { atomicAdd(&bar[XB_TMO], 1u); break; } }
    }
    nloc = mine > 0u ? mine : 1u; nx = cnt > 0u ? cnt : 1u;
}
__device__ __forceinline__ void xcd_barrier(const XcdBarrier& b) {
    asm volatile("s_waitcnt vmcnt(0)" ::: "memory");
    __syncthreads();
    if (threadIdx.x == 0) {
        unsigned* bar = b.bar;
        __builtin_amdgcn_s_waitcnt(0);
        unsigned nloc = b.st[0], nx = b.st[1];
        if (nloc == 0u) { xcd_barrier_complete(bar, b.x, nloc, nx); b.st[0] = nloc; b.st[1] = nx; }
        const unsigned old = xb_add(&bar[XB_XSUB(b.x)], 1u);
        const unsigned gen = old / nloc;
        if (old + 1u == (gen + 1u) * nloc) {
            __builtin_amdgcn_fence(__ATOMIC_RELEASE, "agent");
            asm volatile("s_waitcnt vmcnt(0)" ::: "memory");
            const unsigned og = xb_add(&bar[XB_TOP], 1u);
            const unsigned tg = og / nx;
            if (og + 1u == (tg + 1u) * nx) xb_add(&bar[XB_TOPGEN], 1u);
            else XB_SPIN(xb_ld(&bar[XB_TOPGEN]) == tg, bar);
            __builtin_amdgcn_fence(__ATOMIC_ACQUIRE, "agent");
            xb_add(&bar[XB_XGEN(b.x)], 1u);
            asm volatile("s_waitcnt vmcnt(0)" ::: "memory");
        } else {
            XB_SPIN(xb_ld(&bar[XB_XGEN(b.x)]) == gen, bar);
            __builtin_amdgcn_fence(__ATOMIC_ACQUIRE, "agent");
            asm volatile("s_waitcnt vmcnt(0)" ::: "memory");
        }
    }
    __syncthreads();
}

__device__ __forceinline__ int win_src_col(int n) {
    if (n < OFF_VA || (n >= OFF_QC && n < OFF_VC)) { const int hb = n & ~127, j = n & 127; return hb + (j >> 1) + (j & 1) * 64; }
    if (n >= OFF_QB && n < OFF_VB) { const int hb = n & ~63, j = n & 63; return hb + (j >> 1) + (j & 1) * 32; }
    return n;
}
__device__ __forceinline__ void tr_item(const float* __restrict__ src, size_t ld, int srccol, int k0, bf16_t* __restrict__ dst_tile, size_t dld, LAS unsigned char* scr, int lane) {
    const float* p = src + (size_t)k0 * ld + srccol;
#pragma unroll
    for (int kk = 0; kk < 8; ++kk) {
        float v[8];
#pragma unroll
        for (int j = 0; j < 8; ++j) v[j] = __builtin_nontemporal_load(p + (size_t)(kk * 8 + j) * ld);
        u32x4 w; w.x = cvt_pk_bf16(v[0], v[1]); w.y = cvt_pk_bf16(v[2], v[3]); w.z = cvt_pk_bf16(v[4], v[5]); w.w = cvt_pk_bf16(v[6], v[7]);
        *(LAS u32x4*)(scr + lane * 144 + kk * 16) = w;
    }
    bf16_t* d = dst_tile + (size_t)(lane >> 3) * dld + (lane & 7) * 8;
#pragma unroll
    for (int i = 0; i < 8; ++i) { const u32x4 w = *(const LAS u32x4*)(scr + (8 * i + (lane >> 3)) * 144 + (lane & 7) * 16); *(u32x4*)(d + (size_t)(8 * i) * dld) = w; }
}

struct KeyA { int s, r;
    __device__ __forceinline__ int pos(int idx, float& bias) const { bias = 0.f; const int p = s + r * (idx - 64); return (p >= 0 && p < SEQ) ? p : -1; } };
struct KeyB {
    __device__ __forceinline__ int pos(int idx, float& bias) const { bias = 0.f; return idx; } };
struct KeyC { int s;
    __device__ __forceinline__ int pos(int idx, float& bias) const { bias = 0.f; const int p = s + idx - 128; return (p >= 0 && p < SEQ) ? p : -1; } };
struct KeyD { int r, c, rs, cs; const float* rpb;
    __device__ __forceinline__ int pos(int idx, float& bias) const { const int kr = rs + (idx >> 4), kc = cs + (idx & 15); int dc = kc - c; dc = dc < -15 ? -15 : (dc > 15 ? 15 : dc);
        bias = rpb[(kr - r + 7) * 31 + dc + 15]; return kr * 64 + kc; } };

template <int DK, class KF>
__device__ __forceinline__ void sattn(const bf16_t* q, const bf16_t* kb, const bf16_t* vb, const KF& kf, int nkeys, float scale, bool has_sink, float sink,
                                      LAS float* sq, LAS float* ss, int lane, float& o0, float& o1, float& m_out, float& l_out) {
    for (int d = lane; d < DK; d += 64) sq[d] = bf2f(q[d]);
    asm volatile("s_waitcnt lgkmcnt(0)" ::: "memory");
    float mx = -1e30f;
    for (int idx = lane; idx < nkeys; idx += 64) {
        float bias; const int p = kf.pos(idx, bias); float s = -1e30f;
        if (p >= 0) {
            const u32x4* kr = (const u32x4*)(kb + (size_t)p * IN_TOTAL); float acc = 0.f;
#pragma unroll
            for (int d8 = 0; d8 < DK / 8; ++d8) { const u32x4 w = kr[d8]; const LAS f32x4* qq = (const LAS f32x4*)(sq + d8 * 8); const f32x4 qa = qq[0], qb = qq[1];
                acc += qa[0] * bflo(w.x) + qa[1] * bfhi(w.x) + qa[2] * bflo(w.y) + qa[3] * bfhi(w.y) + qb[0] * bflo(w.z) + qb[1] * bfhi(w.z) + qb[2] * bflo(w.w) + qb[3] * bfhi(w.w); }
            s = acc * scale + bias;
        }
        ss[idx] = s; mx = fmaxf(mx, s);
    }
    mx = wave_max(mx); if (has_sink) mx = fmaxf(mx, sink);
    float sum = 0.f;
    for (int idx = lane; idx < nkeys; idx += 64) { const float s = ss[idx]; const float p = (s > -1e29f) ? __expf(s - mx) : 0.f; ss[idx] = p; sum += p; }
    sum = wave_sum(sum); if (has_sink) sum += __expf(sink - mx);
    asm volatile("s_waitcnt lgkmcnt(0)" ::: "memory");
    o0 = 0.f; o1 = 0.f;
    for (int idx = 0; idx < nkeys; ++idx) {
        const float p = ss[idx];
        if (p != 0.f) { float bias; const int pp = kf.pos(idx, bias); const unsigned w = *(const unsigned*)(vb + (size_t)pp * IN_TOTAL + 2 * lane); o0 += p * bflo(w); o1 += p * bfhi(w); }
    }
    const float inv = 1.0f / sum; o0 *= inv; o1 *= inv; m_out = mx; l_out = sum;
    asm volatile("s_waitcnt lgkmcnt(0)" ::: "memory");
}

struct AttnPtrs { const bf16_t* proj; bf16_t* ag; float* lse; bf16_t* ob; bf16_t* oc; bf16_t* od; const float* lam; const float* subln; const float* sink; const float* rpb; float lambda_init; };

template <int WHICH>
__device__ __forceinline__ void scalar_attn_phase(const AttnPtrs& P, LAS unsigned char* lds, int gw, int NGW, int wave, int lane) {
    LAS float* sq = (LAS float*)(lds + wave * 16896); LAS float* ss = sq + 128;
    constexpr int NH = WHICH == 0 ? 18 : 8;
    float lmbda = 0.f;
    if constexpr (WHICH == 1) { const float d01 = wave_sum(P.lam[lane] * P.lam[64 + lane]), d23 = wave_sum(P.lam[128 + lane] * P.lam[192 + lane]); lmbda = __expf(d01) - __expf(d23) + P.lambda_init; }
    for (int task = gw; task < NH * MTOK; task += NGW) {
        const int hs = task / MTOK, row = task % MTOK, b = row >> 12, s = row & 4095;
        const bf16_t* prow = P.proj + (size_t)row * IN_TOTAL; const bf16_t* pb = P.proj + (size_t)(b * SEQ) * IN_TOTAL;
        float o0, o1, mm, ll;
        if constexpr (WHICH == 0) {
            const int hh = hs, g = hh / 6, r = (g == 0) ? 1 : ((g == 1) ? 4 : 16); KeyA kf{s, r};
            sattn<128>(prow + OFF_QA + hh * 128, pb + OFF_KA + hh * 128, pb + OFF_VA + hh * 128, kf, 129, 0.08838834764831845f, false, 0.f, sq, ss, lane, o0, o1, mm, ll);
            *(unsigned*)(P.ag + ((size_t)g * MTOK + row) * 768 + (hh % 6) * 128 + 2 * lane) = cvt_pk_bf16(o0, o1);
            if (lane == 0) P.lse[((size_t)g * MTOK + row) * 6 + (hh % 6)] = mm + __logf(ll);
        } else if constexpr (WHICH == 1) {
            const int h = hs; KeyB kf; float a0, a1, b0, b1;
            sattn<64>(prow + OFF_QB + (2 * h) * 64, pb + OFF_KB + (2 * h) * 64, pb + OFF_VB + h * 128, kf, SEQ, 0.125f, false, 0.f, sq, ss, lane, a0, a1, mm, ll);
            sattn<64>(prow + OFF_QB + (2 * h + 1) * 64, pb + OFF_KB + (2 * h + 1) * 64, pb + OFF_VB + h * 128, kf, SEQ, 0.125f, false, 0.f, sq, ss, lane, b0, b1, mm, ll);
            const float v0 = a0 - lmbda * b0, v1 = a1 - lmbda * b1;
            const float rinv = rsqrtf(wave_sum(v0 * v0 + v1 * v1) * (1.0f / 128.0f) + SUBLN_EPS) * (1.0f - P.lambda_init);
            *(unsigned*)(P.ob + (size_t)row * 1024 + h * 128 + 2 * lane) = cvt_pk_bf16(v0 * rinv * P.subln[2 * lane], v1 * rinv * P.subln[2 * lane + 1]);
        } else if constexpr (WHICH == 2) {
            const int qh = hs, kvh = qh >> 2; KeyC kf{s};
            sattn<128>(prow + OFF_QC + qh * 128, pb + OFF_KC + kvh * 128, pb + OFF_VC + kvh * 128, kf, 257, 0.08838834764831845f, true, P.sink[qh], sq, ss, lane, o0, o1, mm, ll);
            *(unsigned*)(P.oc + (size_t)row * 1024 + qh * 128 + 2 * lane) = cvt_pk_bf16(o0, o1);
        } else {
            const int h = hs, r = s >> 6, c = s & 63; int rs = r - 4; rs = rs < 0 ? 0 : (rs > 56 ? 56 : rs); int cs = c - 8; cs = cs < 0 ? 0 : (cs > 48 ? 48 : cs);
            KeyD kf{r, c, rs, cs, P.rpb + h * 465};
            sattn<128>(prow + OFF_QD + h * 128, pb + OFF_KD + h * 128, pb + OFF_VD + h * 128, kf, 128, 0.08838834764831845f, false, 0.f, sq, ss, lane, o0, o1, mm, ll);
            *(unsigned*)(P.od + (size_t)row * 1024 + h * 128 + 2 * lane) = cvt_pk_bf16(o0, o1);
        }
    }
}

__device__ __forceinline__ void combine_a_phase(const bf16_t* ag, const float* lse, bf16_t* oa, int gw, int NGW, int lane) {
    for (int row = gw; row < MTOK; row += NGW) {
#pragma unroll
        for (int j = 0; j < 3; ++j) {
            const int e = 4 * lane + 256 * j, head = e >> 7;
            const float l0 = lse[((size_t)0 * MTOK + row) * 6 + head], l1 = lse[((size_t)1 * MTOK + row) * 6 + head], l2 = lse[((size_t)2 * MTOK + row) * 6 + head];
            const float mx = fmaxf(l0, fmaxf(l1, l2)); float w0 = __expf(l0 - mx), w1 = __expf(l1 - mx), w2 = __expf(l2 - mx); const float inv = 1.0f / (w0 + w1 + w2); w0 *= inv; w1 *= inv; w2 *= inv;
            const u32x2 a0 = *(const u32x2*)(ag + ((size_t)0 * MTOK + row) * 768 + e), a1 = *(const u32x2*)(ag + ((size_t)1 * MTOK + row) * 768 + e), a2 = *(const u32x2*)(ag + ((size_t)2 * MTOK + row) * 768 + e);
            u32x2 o;
            o.x = cvt_pk_bf16(w0 * bflo(a0.x) + w1 * bflo(a1.x) + w2 * bflo(a2.x), w0 * bfhi(a0.x) + w1 * bfhi(a1.x) + w2 * bfhi(a2.x));
            o.y = cvt_pk_bf16(w0 * bflo(a0.y) + w1 * bflo(a1.y) + w2 * bflo(a2.y), w0 * bfhi(a0.y) + w1 * bfhi(a1.y) + w2 * bfhi(a2.y));
            *(u32x2*)(oa + (size_t)row * 768 + e) = o;
        }
    }
}
__device__ __forceinline__ void ln1_router_phase(const float* preln, const float* gain, const float* bias, const float* wr, float* xf, bf16_t* xb, float* aff,
                                                 LAS unsigned char* lds, int tid, int gw, int NGW, int lane) {
    LAS float* W = (LAS float*)lds;
    for (int i = tid; i < DM * NEXP; i += NWAVES * 64) { const int k = i >> 4, e = i & 15; W[e * DM + k] = wr[i]; }
    __syncthreads();
    f32x4 g[8], bb[8];
#pragma unroll
    for (int j = 0; j < 8; ++j) { g[j] = *(const f32x4*)(gain + 256 * j + 4 * lane); bb[j] = *(const f32x4*)(bias + 256 * j + 4 * lane); }
    f32x4 vn[8];
    if (gw < MTOK) {
#pragma unroll
        for (int j = 0; j < 8; ++j) vn[j] = *(const f32x4*)(preln + (size_t)gw * DM + 4 * lane + 256 * j);
    }
    for (int row = gw; row < MTOK; row += NGW) {
        f32x4 v[8]; float s = 0.f;
#pragma unroll
        for (int j = 0; j < 8; ++j) { v[j] = vn[j]; s += (v[j][0] + v[j][1]) + (v[j][2] + v[j][3]); }
        if (row + NGW < MTOK) {
#pragma unroll
            for (int j = 0; j < 8; ++j) vn[j] = *(const f32x4*)(preln + (size_t)(row + NGW) * DM + 4 * lane + 256 * j);
        }
        const float mean = wave_sum(s) * (1.0f / DM); float q = 0.f;
#pragma unroll
        for (int j = 0; j < 8; ++j) { v[j] = v[j] - mean; q += (v[j][0] * v[j][0] + v[j][1] * v[j][1]) + (v[j][2] * v[j][2] + v[j][3] * v[j][3]); }
        const float rstd = rsqrtf(wave_sum(q) * (1.0f / DM) + LN_EPS);
        float* xo = xf + (size_t)row * DM + 4 * lane; bf16_t* xbo = xb + (size_t)row * DM + 4 * lane;
#pragma unroll
        for (int j = 0; j < 8; ++j) { v[j] = v[j] * rstd * g[j] + bb[j]; *(f32x4*)(xo + 256 * j) = v[j];
            u32x2 w; w.x = cvt_pk_bf16(v[j][0], v[j][1]); w.y = cvt_pk_bf16(v[j][2], v[j][3]); *(u32x2*)(xbo + 256 * j) = w; }
        float a[16];
#pragma unroll
        for (int e = 0; e < 16; ++e) { float t = 0.f;
#pragma unroll
            for (int j = 0; j < 8; ++j) { const f32x4 w = *(const LAS f32x4*)(W + e * DM + 256 * j + 4 * lane); t += (v[j][0] * w[0] + v[j][1] * w[1]) + (v[j][2] * w[2] + v[j][3] * w[3]); }
            a[e] = t; }
        float r8[8], r4[4], r2[2], r1;
        { const bool up = (lane & 32) != 0;
#pragma unroll
          for (int i = 0; i < 8; ++i) { const float keep = up ? a[i + 8] : a[i], send = up ? a[i] : a[i + 8]; r8[i] = keep + __shfl_xor(send, 32); } }
        { const bool up = (lane & 16) != 0;
#pragma unroll
          for (int i = 0; i < 4; ++i) { const float keep = up ? r8[i + 4] : r8[i], send = up ? r8[i] : r8[i + 4]; r4[i] = keep + __shfl_xor(send, 16); } }
        { const bool up = (lane & 8) != 0;
#pragma unroll
          for (int i = 0; i < 2; ++i) { const float keep = up ? r4[i + 2] : r4[i], send = up ? r4[i] : r4[i + 2]; r2[i] = keep + __shfl_xor(send, 8); } }
        { const bool up = (lane & 4) != 0; const float keep = up ? r2[1] : r2[0], send = up ? r2[0] : r2[1]; r1 = keep + __shfl_xor(send, 4); }
        r1 += __shfl_xor(r1, 1); r1 += __shfl_xor(r1, 2);
        float mx = r1;
#pragma unroll
        for (int o = 4; o < 64; o <<= 1) mx = fmaxf(mx, __shfl_xor(mx, o));
        const float ex = expf(r1 - mx); float den = ex;
#pragma unroll
        for (int o = 4; o < 64; o <<= 1) den += __shfl_xor(den, o);
        const int eidx = ((lane >> 5) & 1) * 8 + ((lane >> 4) & 1) * 4 + ((lane >> 3) & 1) * 2 + ((lane >> 2) & 1);
        if ((lane & 3) == 0) aff[((size_t)(row >> 12) * NEXP + eidx) * SEQ + (row & 4095)] = ex / den;
    }
    __syncthreads();
}
__device__ __forceinline__ void topk_phase(const float* aff, int* idxo, float* gvo, int* sloto, LAS unsigned char* lds, int tid, int wave, int lane, int wg, int G) {
    LAS int* cnt = (LAS int*)lds;
    for (int be = wg; be < NGRP; be += G) {
        const float* a = aff + (size_t)be * SEQ + tid * 8;
        const f32x4 a0 = *(const f32x4*)a, a1 = *(const f32x4*)(a + 4);
        unsigned v[8] = {__float_as_uint(a0[0]), __float_as_uint(a0[1]), __float_as_uint(a0[2]), __float_as_uint(a0[3]), __float_as_uint(a1[0]), __float_as_uint(a1[1]), __float_as_uint(a1[2]), __float_as_uint(a1[3])};
        unsigned T = 0u;
        for (int bit = 30; bit >= 0; --bit) {
            const unsigned cand = T | (1u << bit); int c = 0;
#pragma unroll
            for (int k = 0; k < 8; ++k) c += (v[k] >= cand) ? 1 : 0;
            c = wave_sum_i(c);
            if (lane == 0) cnt[(bit & 1) * 8 + wave] = c;
            __syncthreads();
            int tot = 0;
#pragma unroll
            for (int w = 0; w < 8; ++w) tot += cnt[(bit & 1) * 8 + w];
            if (tot >= CAP) T = cand;
        }
        int ngt = 0, neq = 0;
#pragma unroll
        for (int k = 0; k < 8; ++k) { ngt += (v[k] > T) ? 1 : 0; neq += (v[k] == T) ? 1 : 0; }
        int sgt = ngt, seq = neq;
#pragma unroll
        for (int o = 1; o < 64; o <<= 1) { const int tg = __shfl_up(sgt, o), te = __shfl_up(seq, o); if (lane >= o) { sgt += tg; seq += te; } }
        __syncthreads();
        if (lane == 63) { cnt[64 + wave] = sgt; cnt[64 + 8 + wave] = seq; }
        __syncthreads();
        int pgt = sgt - ngt, peq = seq - neq, totgt = 0;
#pragma unroll
        for (int w = 0; w < 8; ++w) { const int tg = cnt[64 + w], te = cnt[64 + 8 + w]; if (w < wave) { pgt += tg; peq += te; } totgt += tg; }
        const int need = CAP - totgt;
        const int b = be >> 4, e = be & 15;
#pragma unroll
        for (int k = 0; k < 8; ++k) {
            const bool gt = v[k] > T, eq = v[k] == T; const bool sel = gt || (eq && peq < need);
            const int slot = pgt + (peq < need ? peq : need);
            const int tok = tid * 8 + k;
            if (sel) { idxo[be * CAP + slot] = tok; gvo[be * CAP + slot] = __uint_as_float(v[k]); }
            sloto[((size_t)b * SEQ + tok) * NEXP + e] = sel ? slot : -1;
            pgt += gt ? 1 : 0; peq += eq ? 1 : 0;
        }
        __syncthreads();
    }
}
__device__ __forceinline__ void gather_phase(const bf16_t* xb, const int* idx, bf16_t* xg, int gw, int NGW, int lane) {
    for (int r = gw; r < NGRP * CAP; r += NGW) {
        const int be = r >> 9, b = be >> 4; const int tok = idx[r];
        const u32x4* src = (const u32x4*)(xb + ((size_t)b * SEQ + tok) * DM); u32x4* dst = (u32x4*)(xg + (size_t)r * DM);
#pragma unroll
        for (int j = 0; j < 4; ++j) dst[64 * j + lane] = src[64 * j + lane];
    }
}
__device__ __forceinline__ void ln2_phase(const float* x1, const bf16_t* y, const int* slot, const float* gain, const float* bias, float* xo_base, bf16_t* xb, int gw, int NGW, int lane) {
    f32x4 g[8], bb[8];
#pragma unroll
    for (int j = 0; j < 4; ++j) { g[2 * j] = *(const f32x4*)(gain + 512 * j + 8 * lane); g[2 * j + 1] = *(const f32x4*)(gain + 512 * j + 8 * lane + 4);
        bb[2 * j] = *(const f32x4*)(bias + 512 * j + 8 * lane); bb[2 * j + 1] = *(const f32x4*)(bias + 512 * j + 8 * lane + 4); }
    f32x4 xn[8]; int slot_n = -1;
    if (gw < MTOK) { slot_n = slot[(size_t)gw * NEXP + (lane & 15)];
#pragma unroll
        for (int j = 0; j < 4; ++j) { xn[2 * j] = *(const f32x4*)(x1 + (size_t)gw * DM + 512 * j + 8 * lane); xn[2 * j + 1] = *(const f32x4*)(x1 + (size_t)gw * DM + 512 * j + 8 * lane + 4); } }
    for (int row = gw; row < MTOK; row += NGW) {
        const int b = row >> 12; const int myslot = slot_n;
        f32x4 xc[8];
#pragma unroll
        for (int j = 0; j < 8; ++j) xc[j] = xn[j];
        f32x4 acc[8];
#pragma unroll
        for (int j = 0; j < 8; ++j) acc[j] = (f32x4){0.f, 0.f, 0.f, 0.f};
        unsigned hits = (unsigned)(__ballot(myslot >= 0) & 0xffffull);
        while (hits) {
            const int e = __builtin_ctz(hits); hits &= hits - 1;
            const int sl = __shfl(myslot, e);
            const bf16_t* yr = y + ((size_t)(b * NEXP + e) * CAP + sl) * DM + 8 * lane;
#pragma unroll
            for (int j = 0; j < 4; ++j) { const u32x4 w = *(const u32x4*)(yr + 512 * j);
                acc[2 * j][0] += bflo(w.x); acc[2 * j][1] += bfhi(w.x); acc[2 * j][2] += bflo(w.y); acc[2 * j][3] += bfhi(w.y);
                acc[2 * j + 1][0] += bflo(w.z); acc[2 * j + 1][1] += bfhi(w.z); acc[2 * j + 1][2] += bflo(w.w); acc[2 * j + 1][3] += bfhi(w.w); }
        }
        if (row + NGW < MTOK) { slot_n = slot[(size_t)(row + NGW) * NEXP + (lane & 15)];
#pragma unroll
            for (int j = 0; j < 4; ++j) { xn[2 * j] = *(const f32x4*)(x1 + (size_t)(row + NGW) * DM + 512 * j + 8 * lane); xn[2 * j + 1] = *(const f32x4*)(x1 + (size_t)(row + NGW) * DM + 512 * j + 8 * lane + 4); } }
        float s = 0.f;
#pragma unroll
        for (int j = 0; j < 8; ++j) { acc[j] = xc[j] * ALPHA + acc[j]; s += (acc[j][0] + acc[j][1]) + (acc[j][2] + acc[j][3]); }
        const float mean = wave_sum(s) * (1.0f / DM); float q = 0.f;
#pragma unroll
        for (int j = 0; j < 8; ++j) { acc[j] = acc[j] - mean; q += (acc[j][0] * acc[j][0] + acc[j][1] * acc[j][1]) + (acc[j][2] * acc[j][2] + acc[j][3] * acc[j][3]); }
        const float rstd = rsqrtf(wave_sum(q) * (1.0f / DM) + LN_EPS);
        float* xo = xo_base + (size_t)row * DM + 8 * lane; bf16_t* xbo = xb + (size_t)row * DM + 8 * lane;
#pragma unroll
        for (int j = 0; j < 4; ++j) { const f32x4 o0 = acc[2 * j] * rstd * g[2 * j] + bb[2 * j], o1 = acc[2 * j + 1] * rstd * g[2 * j + 1] + bb[2 * j + 1];
            *(f32x4*)(xo + 512 * j) = o0; *(f32x4*)(xo + 512 * j + 4) = o1;
            u32x4 w; w.x = cvt_pk_bf16(o0[0], o0[1]); w.y = cvt_pk_bf16(o0[2], o0[3]); w.z = cvt_pk_bf16(o1[0], o1[1]); w.w = cvt_pk_bf16(o1[2], o1[3]); *(u32x4*)(xbo + 512 * j) = w; }
    }
}

namespace att {
typedef short bf16x8 __attribute__((ext_vector_type(8)));
typedef short s16x4 __attribute__((ext_vector_type(4)));
typedef float f32x16 __attribute__((ext_vector_type(16)));
constexpr int VBYTES = 16384, KOFF = 2 * VBYTES, WSOFF = 65536, TABOFF = WSOFF + 2048, ATTN_LDS = TABOFF + 2048;
constexpr float NEG = -1e30f, M0 = -1e29f;
#define ATT_SBAR() __builtin_amdgcn_sched_barrier(0)
__device__ __forceinline__ int crow(int r, int hi) { return (r & 3) + 8 * (r >> 2) + 4 * hi; }
__device__ __forceinline__ unsigned cvtpk(float lo, float hi) { unsigned r; asm volatile("v_cvt_pk_bf16_f32 %0, %1, %2" : "=v"(r) : "v"(lo), "v"(hi)); return r; }
__device__ __forceinline__ int kswz128(int row, int colB) { return row * 256 + (colB ^ ((row & 7) << 4)); }
__device__ __forceinline__ int kswz64(int row, int colB) { return row * 128 + (colB ^ (((row >> 1) & 7) << 4)); }

__device__ __forceinline__ void partialSM(f32x16& p0, f32x16& p1, float& m_reg, float& mn, float& alpha, const float C, const float thr_raw) {
    float pmax = p0[0];
#pragma unroll
    for (int r = 1; r < 16; ++r) pmax = fmaxf(pmax, p0[r]);
#pragma unroll
    for (int r = 0; r < 16; ++r) pmax = fmaxf(pmax, p1[r]);
    { auto rr = __builtin_amdgcn_permlane32_swap(__float_as_uint(pmax), __float_as_uint(pmax), false, false); pmax = fmaxf(__uint_as_float(rr[0]), __uint_as_float(rr[1])); }
    if (__all(pmax - m_reg <= thr_raw)) { mn = m_reg; alpha = 1.f; }
    else { mn = fmaxf(m_reg, pmax); alpha = __builtin_amdgcn_exp2f((m_reg - mn) * C); m_reg = mn; }
    const float mnC = -mn * C;
#pragma unroll
    for (int r = 0; r < 16; ++r) p0[r] = fmaf(p0[r], C, mnC);
#pragma unroll
    for (int r = 0; r < 16; ++r) p1[r] = fmaf(p1[r], C, mnC);
#pragma unroll
    for (int r = 0; r < 16; ++r) p0[r] = __builtin_amdgcn_exp2f(p0[r]);
}
__device__ __forceinline__ void finishSM(f32x16& p0, f32x16& p1, float alpha, float& l_reg, bf16x8& pa0, bf16x8& pa1, bf16x8& pa2, bf16x8& pa3) {
#pragma unroll
    for (int r = 0; r < 16; ++r) p1[r] = __builtin_amdgcn_exp2f(p1[r]);
    float ps = 0;
#pragma unroll
    for (int r = 0; r < 16; ++r) ps += p0[r];
#pragma unroll
    for (int r = 0; r < 16; ++r) ps += p1[r];
    { auto rr = __builtin_amdgcn_permlane32_swap(__float_as_uint(ps), __float_as_uint(ps), false, false); ps = __uint_as_float(rr[0]) + __uint_as_float(rr[1]); }
    l_reg = l_reg * alpha + ps;
#define ATT_PK4(P, BASE, OUT) do { unsigned a0 = cvtpk(P[BASE + 0], P[BASE + 1]), a1 = cvtpk(P[BASE + 2], P[BASE + 3]);   \
    unsigned b0 = cvtpk(P[BASE + 4], P[BASE + 5]), b1 = cvtpk(P[BASE + 6], P[BASE + 7]);                              \
    auto r0 = __builtin_amdgcn_permlane32_swap(a0, b0, false, false); auto r1 = __builtin_amdgcn_permlane32_swap(a1, b1, false, false); \
    u32x4 w = {r0[0], r1[0], r0[1], r1[1]}; OUT = __builtin_bit_cast(bf16x8, w); } while (0)
    ATT_PK4(p0, 0, pa0); ATT_PK4(p0, 8, pa1); ATT_PK4(p1, 0, pa2); ATT_PK4(p1, 8, pa3);
#undef ATT_PK4
}
template <int DK>
__device__ __forceinline__ void qkt(f32x16& p0, f32x16& p1, const LAS char* Ks, const bf16x8* qr, int r32, int hi) {
    p0 = f32x16{}; p1 = f32x16{};
#pragma unroll
    for (int d0 = 0; d0 < DK / 16; ++d0) { const int cb = (d0 * 16 + hi * 8) * 2;
        const bf16x8 b0 = *(const LAS bf16x8*)(Ks + (DK == 128 ? kswz128(r32, cb) : kswz64(r32, cb)));
        const bf16x8 b1 = *(const LAS bf16x8*)(Ks + (DK == 128 ? kswz128(32 + r32, cb) : kswz64(32 + r32, cb)));
        p0 = __builtin_amdgcn_mfma_f32_32x32x16_bf16(b0, qr[d0], p0, 0, 0, 0);
        p1 = __builtin_amdgcn_mfma_f32_32x32x16_bf16(b1, qr[d0], p1, 0, 0, 0); }
}
__device__ __forceinline__ int v_st(int k, int c) { const int kk = (k & ~0xC) | ((k & 4) << 1) | ((k & 8) >> 1); return ((kk >> 3) * 4 + (c >> 5)) * 512 + ((kk & 7) * 32 + (c & 31)) * 2; }
__device__ __forceinline__ int v_rd_base(int lane) { return ((lane & 3) << 3) | (((lane >> 2) & 3) << 6) | (((lane >> 4) & 1) << 5) | (((lane >> 5) & 1) << 8); }
constexpr int v_rd_off(int d0, int ks, int half) { return d0 * 512 + ks * 4096 + half * 2048; }
template <int OFF> __device__ __forceinline__ s16x4 tr_read(int vb) { s16x4 r; asm volatile("ds_read_b64_tr_b16 %0, %1 offset:%2" : "=&v"(r) : "v"(vb), "i"(OFF) : "memory"); return r; }
template <int D0> __device__ __forceinline__ void pv_one(f32x16& od, int vb, bf16x8 pa0, bf16x8 pa1, bf16x8 pa2, bf16x8 pa3) {
    const s16x4 l0 = tr_read<v_rd_off(D0, 0, 0)>(vb), h0 = tr_read<v_rd_off(D0, 0, 1)>(vb), l1 = tr_read<v_rd_off(D0, 1, 0)>(vb), h1 = tr_read<v_rd_off(D0, 1, 1)>(vb);
    const s16x4 l2 = tr_read<v_rd_off(D0, 2, 0)>(vb), h2 = tr_read<v_rd_off(D0, 2, 1)>(vb), l3 = tr_read<v_rd_off(D0, 3, 0)>(vb), h3 = tr_read<v_rd_off(D0, 3, 1)>(vb);
    asm volatile("s_waitcnt lgkmcnt(0)" ::: "memory"); ATT_SBAR();
#define ATT_PK(L, H) (bf16x8){L[0], L[1], L[2], L[3], H[0], H[1], H[2], H[3]}
    od = __builtin_amdgcn_mfma_f32_32x32x16_bf16(pa0, ATT_PK(l0, h0), od, 0, 0, 0);
    od = __builtin_amdgcn_mfma_f32_32x32x16_bf16(pa1, ATT_PK(l1, h1), od, 0, 0, 0);
    od = __builtin_amdgcn_mfma_f32_32x32x16_bf16(pa2, ATT_PK(l2, h2), od, 0, 0, 0);
    od = __builtin_amdgcn_mfma_f32_32x32x16_bf16(pa3, ATT_PK(l3, h3), od, 0, 0, 0);
#undef ATT_PK
}
__device__ __forceinline__ void pv_d0(f32x16* o, int vb, bf16x8 pa0, bf16x8 pa1, bf16x8 pa2, bf16x8 pa3) {
    pv_one<0>(o[0], vb, pa0, pa1, pa2, pa3); pv_one<1>(o[1], vb, pa0, pa1, pa2, pa3); pv_one<2>(o[2], vb, pa0, pa1, pa2, pa3); pv_one<3>(o[3], vb, pa0, pa1, pa2, pa3);
}

template <int DK, class Pol>
__device__ __forceinline__ void attn_unit(const Pol& P, LAS char* lds, const int tid) {
    const int wid = __builtin_amdgcn_readfirstlane(tid >> 6), lane = tid & 63, r32 = lane & 31, hi = lane >> 5;
    LAS char* V_lds = lds; LAS char* K_lds = lds + KOFF; constexpr int KBYTES = 64 * DK * 2;
    LAS float* wsx = (LAS float*)(lds + WSOFF) + wid * 64; LAS float* li_l = wsx; LAS float* al_l = wsx + 32;
    const float C = Pol::SCALE * 1.4426950408889634f, thr_raw = 8.0f / Pol::SCALE;
    float m_reg = P.m0(), l_reg = P.l0(); f32x16 o[4] = {}; bf16x8 qr[DK / 16];
    { const bf16_t* qp = P.q_row(wid * 32 + r32) + hi * 8;
#pragma unroll
      for (int d0 = 0; d0 < DK / 16; ++d0) qr[d0] = *(const bf16x8*)(qp + d0 * 16); }
    const int sr = tid >> 4, sc = (tid & 15) * 8, vst0 = v_st(sr, sc), vst1 = v_st(32 + sr, sc);
    const int k64r = tid >> 3, k64c = (tid & 7) * 8;
    const int vb0 = (int)(unsigned)(__UINTPTR_TYPE__)V_lds + v_rd_base(lane);
    bf16x8 vs0, vs1, ks0, ks1;
#define ATT_LOAD(t) do { vs0 = *(const bf16x8*)(P.v_row((t), sr) + sc); vs1 = *(const bf16x8*)(P.v_row((t), 32 + sr) + sc); \
        if constexpr (DK == 128) { ks0 = *(const bf16x8*)(P.k_row((t), sr) + sc); ks1 = *(const bf16x8*)(P.k_row((t), 32 + sr) + sc); } \
        else { ks0 = *(const bf16x8*)(P.k_row((t), k64r) + k64c); ks1 = ks0; } } while (0)
#define ATT_WRITE(b) do { *(LAS bf16x8*)(V_lds + (b) * VBYTES + vst0) = vs0; *(LAS bf16x8*)(V_lds + (b) * VBYTES + vst1) = vs1; \
        if constexpr (DK == 128) { *(LAS bf16x8*)(K_lds + (b) * KBYTES + kswz128(sr, sc * 2)) = ks0; *(LAS bf16x8*)(K_lds + (b) * KBYTES + kswz128(32 + sr, sc * 2)) = ks1; } \
        else { *(LAS bf16x8*)(K_lds + (b) * KBYTES + kswz64(k64r, k64c * 2)) = ks0; } } while (0)
    const int NT = P.ntiles();
    ATT_LOAD(0);
    for (int t = 0; t < NT; ++t) {
        const int b = t & 1;
        ATT_WRITE(b);
        __syncthreads();
        if (t + 1 < NT) ATT_LOAD(t + 1);
        if (P.wave_needs(t, wid)) {
            f32x16 p0, p1; float mn, alpha; bf16x8 pa0, pa1, pa2, pa3;
            qkt<DK>(p0, p1, K_lds + b * KBYTES, qr, r32, hi);
            P.mask(p0, p1, t, wid, r32, hi, lds);
            partialSM(p0, p1, m_reg, mn, alpha, C, thr_raw);
            if (__any(alpha < 1.f)) { if (hi == 0) al_l[r32] = alpha; asm volatile("s_waitcnt lgkmcnt(0)" ::: "memory");
#pragma unroll
                for (int d = 0; d < 4; ++d)
#pragma unroll
                    for (int r = 0; r < 16; ++r) o[d][r] *= al_l[crow(r, hi)]; }
            finishSM(p0, p1, alpha, l_reg, pa0, pa1, pa2, pa3); ATT_SBAR();
            pv_d0(o, vb0 + b * VBYTES, pa0, pa1, pa2, pa3);
        }
    }
#undef ATT_LOAD
#undef ATT_WRITE
    if (hi == 0) li_l[r32] = l_reg;
    asm volatile("s_waitcnt lgkmcnt(0)" ::: "memory");
    P.finish(o, m_reg, l_reg, li_l, wid, r32, hi);
    __syncthreads();
}

template <class RowFn>
__device__ __forceinline__ void store_o_bf16(const f32x16* o, const LAS float* li_l, int wid, int r32, int hi, const RowFn& orow) {
#pragma unroll
    for (int r = 0; r < 16; ++r) { const int i = crow(r, hi); const float inv = __builtin_amdgcn_rcpf(li_l[i]); bf16_t* p = orow(wid * 32 + i) + r32;
#pragma unroll
        for (int d0 = 0; d0 < 4; ++d0) p[d0 * 32] = (bf16_t)(cvtpk(o[d0][r] * inv, 0.f) & 0xffffu); }
}
struct PolA {
    static constexpr float SCALE = 0.08838834764831845f;
    const bf16_t* proj; bf16_t* ag; float* lse;
    int b, hh, j, r, L, qb;
    __device__ __forceinline__ const bf16_t* tok(int pos) const { return proj + (size_t)(b * SEQ + pos) * IN_TOTAL; }
    __device__ __forceinline__ const bf16_t* q_row(int i) const { return tok(j + r * (qb * 256 + i)) + OFF_QA + hh * 128; }
    __device__ __forceinline__ int ntiles() const { return 6; }
    __device__ __forceinline__ int kidx(int t, int kk) const { int ki = qb * 256 - 64 + 64 * t + kk; ki = ki < 0 ? 0 : (ki > L - 1 ? L - 1 : ki); return j + r * ki; }
    __device__ __forceinline__ const bf16_t* k_row(int t, int kk) const { return tok(kidx(t, kk)) + OFF_KA + hh * 128; }
    __device__ __forceinline__ const bf16_t* v_row(int t, int kk) const { return tok(kidx(t, kk)) + OFF_VA + hh * 128; }
    __device__ __forceinline__ bool wave_needs(int t, int wid) const { const int kbase = qb * 256 - 64 + 64 * t, q0 = qb * 256 + wid * 32; return kbase <= q0 + 95 && kbase + 63 >= q0 - 64 && kbase + 63 >= 0 && kbase < L; }
    __device__ __forceinline__ void mask(f32x16& p0, f32x16& p1, int t, int wid, int r32, int hi, LAS char*) const {
        const int qi = qb * 256 + wid * 32 + r32, kb = qb * 256 - 64 + 64 * t + 4 * hi;
#pragma unroll
        for (int r = 0; r < 16; ++r) { const int k0 = kb + (r & 3) + 8 * (r >> 2), k1 = k0 + 32; int d0 = k0 - qi, d1 = k1 - qi; d0 = d0 < 0 ? -d0 : d0; d1 = d1 < 0 ? -d1 : d1;
            p0[r] = ((unsigned)k0 < (unsigned)L && d0 <= 64) ? p0[r] : NEG; p1[r] = ((unsigned)k1 < (unsigned)L && d1 <= 64) ? p1[r] : NEG; }
    }
    __device__ __forceinline__ float m0() const { return M0; }
    __device__ __forceinline__ float l0() const { return 0.f; }
    __device__ __forceinline__ void finish(const f32x16* o, float m_reg, float l_reg, const LAS float* li_l, int wid, int r32, int hi) const {
        const int h6 = hh % 6;
        store_o_bf16(o, li_l, wid, r32, hi, [&](int i) { return ag + (size_t)(b * SEQ + j + r * (qb * 256 + i)) * 768 + h6 * 128; });
        if (hi == 0) lse[(size_t)(b * SEQ + j + r * (qb * 256 + wid * 32 + r32)) * 6 + h6] = m_reg * SCALE + __logf(l_reg);
    }
};
struct PolC {
    static constexpr float SCALE = 0.08838834764831845f;
    const bf16_t* proj; bf16_t* oc; float sink; int b, qh, qb;
    __device__ __forceinline__ const bf16_t* tok(int pos) const { return proj + (size_t)(b * SEQ + pos) * IN_TOTAL; }
    __device__ __forceinline__ const bf16_t* q_row(int i) const { return tok(qb * 256 + i) + OFF_QC + qh * 128; }
    __device__ __forceinline__ int ntiles() const { return 10; }
    __device__ __forceinline__ int kpos(int t, int kk) const { int k = qb * 256 - 128 + 64 * t + kk; return k < 0 ? 0 : (k > SEQ - 1 ? SEQ - 1 : k); }
    __device__ __forceinline__ const bf16_t* k_row(int t, int kk) const { return tok(kpos(t, kk)) + OFF_KC + (qh >> 2) * 128; }
    __device__ __forceinline__ const bf16_t* v_row(int t, int kk) const { return tok(kpos(t, kk)) + OFF_VC + (qh >> 2) * 128; }
    __device__ __forceinline__ bool wave_needs(int t, int wid) const { const int kbase = qb * 256 - 128 + 64 * t, q0 = qb * 256 + wid * 32; return kbase <= q0 + 159 && kbase + 63 >= q0 - 128 && kbase + 63 >= 0 && kbase < SEQ; }
    __device__ __forceinline__ void mask(f32x16& p0, f32x16& p1, int t, int wid, int r32, int hi, LAS char*) const {
        const int qi = qb * 256 + wid * 32 + r32, kb = qb * 256 - 128 + 64 * t + 4 * hi;
#pragma unroll
        for (int r = 0; r < 16; ++r) { const int k0 = kb + (r & 3) + 8 * (r >> 2), k1 = k0 + 32; int d0 = k0 - qi, d1 = k1 - qi; d0 = d0 < 0 ? -d0 : d0; d1 = d1 < 0 ? -d1 : d1;
            p0[r] = ((unsigned)k0 < (unsigned)SEQ && d0 <= 128) ? p0[r] : NEG; p1[r] = ((unsigned)k1 < (unsigned)SEQ && d1 <= 128) ? p1[r] : NEG; }
    }
    __device__ __forceinline__ float m0() const { return sink * (1.0f / SCALE); }
    __device__ __forceinline__ float l0() const { return 1.f; }
    __device__ __forceinline__ void finish(const f32x16* o, float, float, const LAS float* li_l, int wid, int r32, int hi) const {
        store_o_bf16(o, li_l, wid, r32, hi, [&](int i) { return oc + (size_t)(b * SEQ + qb * 256 + i) * 1024 + qh * 128; });
    }
};
struct PolD {
    static constexpr float SCALE = 0.08838834764831845f;
    const bf16_t* proj; bf16_t* od; int b, h, rb, lo, nt;
    __device__ __forceinline__ const bf16_t* tok(int pos) const { return proj + (size_t)(b * SEQ + pos) * IN_TOTAL; }
    __device__ __forceinline__ const bf16_t* q_row(int i) const { return tok(rb * 256 + i) + OFF_QD + h * 128; }
    __device__ __forceinline__ int ntiles() const { return nt; }
    __device__ __forceinline__ const bf16_t* k_row(int t, int kk) const { return tok((lo + t) * 64 + kk) + OFF_KD + h * 128; }
    __device__ __forceinline__ const bf16_t* v_row(int t, int kk) const { return tok((lo + t) * 64 + kk) + OFF_VD + h * 128; }
    __device__ __forceinline__ bool wave_needs(int t, int wid) const { const int qr_ = rb * 4 + (wid >> 1); int rs = qr_ - 4; rs = rs < 0 ? 0 : (rs > 56 ? 56 : rs); const int kr = lo + t; return kr >= rs && kr < rs + 8; }
    __device__ __forceinline__ void mask(f32x16& p0, f32x16& p1, int t, int wid, int r32, int hi, LAS char* lds) const {
        const int qr_ = rb * 4 + (wid >> 1), qc = 32 * (wid & 1) + r32, kr = lo + t; int cs = qc - 8; cs = cs < 0 ? 0 : (cs > 48 ? 48 : cs);
        const LAS float* T = (const LAS float*)(lds + TABOFF) + (kr - qr_ + 7) * 31 + 15 - qc + 4 * hi; const int kc0 = 4 * hi - cs;
#pragma unroll
        for (int r = 0; r < 16; ++r) { const int kk = (r & 3) + 8 * (r >> 2);
            const float b0 = T[kk], b1 = T[kk + 32];
            p0[r] = ((unsigned)(kc0 + kk) < 16u) ? p0[r] + b0 : NEG; p1[r] = ((unsigned)(kc0 + kk + 32) < 16u) ? p1[r] + b1 : NEG; }
    }
    __device__ __forceinline__ float m0() const { return M0; }
    __device__ __forceinline__ float l0() const { return 0.f; }
    __device__ __forceinline__ void finish(const f32x16* o, float, float, const LAS float* li_l, int wid, int r32, int hi) const {
        store_o_bf16(o, li_l, wid, r32, hi, [&](int i) { return od + (size_t)(b * SEQ + rb * 256 + i) * 1024 + h * 128; });
    }
};
struct PolB {
    static constexpr float SCALE = 0.125f;
    const bf16_t* proj; bf16_t* ob; float* scr; const float* subln; float lmbda, oscale; int b, h, qb, map;
    __device__ __forceinline__ const bf16_t* tok(int pos) const { return proj + (size_t)(b * SEQ + pos) * IN_TOTAL; }
    __device__ __forceinline__ const bf16_t* q_row(int i) const { return tok(qb * 256 + i) + OFF_QB + (2 * h + map) * 64; }
    __device__ __forceinline__ int ntiles() const { return SEQ / 64; }
    __device__ __forceinline__ const bf16_t* k_row(int t, int kk) const { return tok(64 * t + kk) + OFF_KB + (2 * h + map) * 64; }
    __device__ __forceinline__ const bf16_t* v_row(int t, int kk) const { return tok(64 * t + kk) + OFF_VB + h * 128; }
    __device__ __forceinline__ bool wave_needs(int, int) const { return true; }
    __device__ __forceinline__ void mask(f32x16&, f32x16&, int, int, int, int, LAS char*) const {}
    __device__ __forceinline__ float m0() const { return M0; }
    __device__ __forceinline__ float l0() const { return 0.f; }
    __device__ __forceinline__ void finish(const f32x16* o, float, float, const LAS float* li_l, int wid, int r32, int hi) const {
        if (map == 0) {
#pragma unroll
            for (int r = 0; r < 16; ++r) { const int i = crow(r, hi); const float inv = __builtin_amdgcn_rcpf(li_l[i]); float* p = scr + (size_t)(wid * 32 + i) * 128 + r32;
#pragma unroll
                for (int d0 = 0; d0 < 4; ++d0) p[d0 * 32] = o[d0][r] * inv; }
        } else {
            float sw[4];
#pragma unroll
            for (int d0 = 0; d0 < 4; ++d0) sw[d0] = subln[d0 * 32 + r32] * oscale;
#pragma unroll
            for (int r = 0; r < 16; ++r) { const int i = crow(r, hi); const float inv = __builtin_amdgcn_rcpf(li_l[i]); const float* p = scr + (size_t)(wid * 32 + i) * 128 + r32;
                float v[4]; float ss = 0.f;
#pragma unroll
                for (int d0 = 0; d0 < 4; ++d0) { v[d0] = p[d0 * 32] - lmbda * (o[d0][r] * inv); ss += v[d0] * v[d0]; }
#pragma unroll
                for (int s = 1; s < 32; s <<= 1) ss += __shfl_xor(ss, s);
                const float rinv = rsqrtf(ss * (1.0f / 128.0f) + SUBLN_EPS);
                bf16_t* q = ob + (size_t)(b * SEQ + qb * 256 + wid * 32 + i) * 1024 + h * 128 + r32;
#pragma unroll
                for (int d0 = 0; d0 < 4; ++d0) q[d0 * 32] = (bf16_t)(cvtpk(v[d0] * rinv * sw[d0], 0.f) & 0xffffu); }
        }
    }
};

#ifndef ATT_MASK
#define ATT_MASK 15
#endif
#define ATT_ON(k) ((ATT_MASK >> (k)) & 1)
struct Ptrs { const bf16_t* proj; bf16_t* ag; float* lse; bf16_t* ob; bf16_t* oc; bf16_t* od; float* bscr; const float* lam; const float* subln; const float* sink; const float* rpb; float lambda_init; };
__device__ __forceinline__ void attn_phase(const Ptrs& X, LAS char* lds, const int tid, const int vcu, const int G, const int wgid) {
    const int lane = tid & 63;
    if (ATT_ON(0)) {   const float d01 = wave_sum(X.lam[lane] * X.lam[64 + lane]), d23 = wave_sum(X.lam[128 + lane] * X.lam[192 + lane]);
        const float lmbda = __expf(d01) - __expf(d23) + X.lambda_init;
        for (int u = vcu; u < 512; u += G) {
            for (int map = 0; map < 2; ++map) {
                PolB P{X.proj, X.ob, X.bscr + (size_t)wgid * 32768, X.subln, lmbda, 1.0f - X.lambda_init, u >> 7, (u >> 4) & 7, u & 15, map};
                attn_unit<64, PolB>(P, lds, tid);
            }
        }
    }
    if (ATT_ON(1)) for (int u = vcu; u < 512; u += G) {
        const int rb = u & 15, h = (u >> 4) & 7, b = u >> 7; int lo = rb * 4 - 4; lo = lo < 0 ? 0 : (lo > 56 ? 56 : lo); int hi_ = rb * 4 + 3 - 4; hi_ = hi_ < 0 ? 0 : (hi_ > 56 ? 56 : hi_); hi_ += 7;
        { LAS float* T = (LAS float*)(lds + TABOFF); for (int i = tid; i < 465; i += 512) T[i] = X.rpb[h * 465 + i] * (1.0f / PolD::SCALE); }
        PolD P{X.proj, X.od, b, h, rb, lo, hi_ - lo + 1};
        attn_unit<128, PolD>(P, lds, tid);
    }
    if (ATT_ON(2)) for (int u = vcu; u < 512; u += G) {
        const int qb = u & 15, qh = (u >> 4) & 7, b = u >> 7;
        PolC P{X.proj, X.oc, X.sink[qh], b, qh, qb};
        attn_unit<128, PolC>(P, lds, tid);
    }
    if (ATT_ON(3)) for (int u = vcu; u < 1152; u += G) {
        const int g = u / 384, v = u % 384, w16 = v & 15, bh = v >> 4, h6 = bh % 6, b = bh / 6;
        const int r = g == 0 ? 1 : (g == 1 ? 4 : 16), L = SEQ / r;
        PolA P{X.proj, X.ag + (size_t)g * MTOK * 768, X.lse + (size_t)g * MTOK * 6, b, g * 6 + h6, w16 % r, r, L, w16 / r};
        attn_unit<128, PolA>(P, lds, tid);
    }
}
#undef ATT_SBAR
}

struct InPtrs { const float *x, *w_in, *b_gate, *w_branch, *w_out, *diff_lambda, *diff_subln, *sink_logit, *na_rpb, *w_router, *w_exp_gate, *w_exp_up, *w_exp_down, *ln_gain, *ln_bias; };

__device__ __forceinline__ void prologue_phase(const InPtrs& I, unsigned char* ws, LAS unsigned char* lds, int gw, int NGW, int wave, int lane) {
    LAS unsigned char* scr = lds + wave * 9216;
    { const f32x4* xs = (const f32x4*)I.x; u32x4* xb = (u32x4*)(ws + WS_XB);
      for (size_t i = (size_t)gw * 64 + lane; i < (size_t)MTOK * DM / 8; i += (size_t)NGW * 64) {
          const f32x4 a = xs[2 * i], b = xs[2 * i + 1];
          u32x4 w; w.x = cvt_pk_bf16(a[0], a[1]); w.y = cvt_pk_bf16(a[2], a[3]); w.z = cvt_pk_bf16(b[0], b[1]); w.w = cvt_pk_bf16(b[2], b[3]); xb[i] = w; } }
    { float* r128 = (float*)(ws + WS_ROPE128); float* r64 = (float*)(ws + WS_ROPE64);
      for (int i = gw * 64 + lane; i < SEQ * 64 + SEQ * 32; i += NGW * 64) {
          int pos, ii, half; float* dst;
          if (i < SEQ * 64) { pos = i >> 6; ii = i & 63; half = 64; dst = r128 + 2 * (size_t)i; } else { const int k = i - SEQ * 64; pos = k >> 5; ii = k & 31; half = 32; dst = r64 + 2 * (size_t)k; }
          const float inv = (float)pow(10000.0, -(double)ii / (double)half); const float ang = (float)pos * inv;
          dst[0] = (float)cos((double)ang); dst[1] = (float)sin((double)ang); } }
    bf16_t* WIN = (bf16_t*)(ws + WS_WIN); bf16_t* WBR = (bf16_t*)(ws + WS_WBR); bf16_t* WOUT = (bf16_t*)(ws + WS_WOUT); bf16_t* WGU = (bf16_t*)(ws + WS_WGU); bf16_t* WDN = (bf16_t*)(ws + WS_WDN);
    constexpr int N1 = DEPTH * 32 * 356, N2 = DEPTH * 60 * 32, N3 = DEPTH * 32 * 32, N4 = DEPTH * NEXP * 32 * 32, N5 = DEPTH * NEXP * 16 * 32;
    for (int it = gw; it < N1 + N2 + N3 + N4 + N5; it += NGW) {
        int r = it;
        if (r < N1) { const int nb = r % 356, kb = (r / 356) % 32, l = r / (356 * 32); const int n = nb * 64 + lane;
            tr_item(I.w_in + (size_t)l * DM * IN_TOTAL, IN_TOTAL, win_src_col(n), kb * 64, WIN + ((size_t)l * IN_TOTAL + nb * 64) * DM + kb * 64, DM, scr, lane); continue; }
        r -= N1;
        if (r < N2) { const int nb = r % 32, kbg = (r / 32) % 60, l = r / (32 * 60); const int n = nb * 64 + lane;
            int ro, Kb, kb; if (kbg < 12) { ro = 0; Kb = 768; kb = kbg; } else { const int q = (kbg - 12) >> 4; ro = 768 + 1024 * q; Kb = 1024; kb = (kbg - 12) & 15; }
            tr_item(I.w_branch + ((size_t)l * BR_TOTAL + ro) * DM, DM, n, kb * 64, WBR + ((size_t)l * BR_TOTAL + ro) * DM + (size_t)(nb * 64) * Kb + kb * 64, Kb, scr, lane); continue; }
        r -= N2;
        if (r < N3) { const int nb = r % 32, kb = (r / 32) % 32, l = r / (32 * 32); const int n = nb * 64 + lane;
            tr_item(I.w_out + (size_t)l * DM * DM, DM, n, kb * 64, WOUT + ((size_t)l * DM + nb * 64) * DM + kb * 64, DM, scr, lane); continue; }
        r -= N3;
        if (r < N4) { const int nb = r % 32, kb = (r / 32) % 32, le = r / (32 * 32); const int n = nb * 64 + lane, pn = n >> 8, bj = (n >> 7) & 1, jj = n & 127;
            tr_item((bj ? I.w_exp_up : I.w_exp_gate) + (size_t)le * DM * DEXP, DEXP, pn * 128 + jj, kb * 64, WGU + ((size_t)le * 2048 + nb * 64) * DM + kb * 64, DM, scr, lane); continue; }
        r -= N4;
        { const int nb = r % 32, kb = (r / 32) % 16, le = r / (32 * 16); const int n = nb * 64 + lane;
            tr_item(I.w_exp_down + (size_t)le * DEXP * DM, DM, n, kb * 64, WDN + ((size_t)le * DM + nb * 64) * DEXP + kb * 64, DEXP, scr, lane); }
    }
}

struct Args { const float* in[15]; float* out; unsigned char* ws; int ph_lo, ph_hi; };
__global__ void __launch_bounds__(NWAVES * 64, 2) fwd(Args args) {
    extern __shared__ __attribute__((aligned(16))) unsigned char lds_raw[];
    LAS unsigned char* lds = (LAS unsigned char*)lds_raw;
    for (int u = threadIdx.x; u < (LDS_BYTES - LDSCTL_OFF) / 4; u += NWAVES * 64) ((LAS unsigned*)(lds + LDSCTL_OFF))[u] = 0u;
    __syncthreads();
    unsigned* ctl = (unsigned*)(args.ws + WS_CTL);
    XcdBarrier bar = xcd_barrier_post(ctl + CW_BAR, (volatile LAS unsigned*)(lds + LDSCTL_OFF));
    const int lo = args.ph_lo, hi = args.ph_hi;
#ifndef SCALAR_ATTN
#define SCALAR_ATTN 0
#endif
#ifndef REP_MASK
#define REP_MASK 0
#endif
#define NREP(k) (((REP_MASK >> (k)) & 1) ? 2 : 1)
#ifndef PH_MASK
#define PH_MASK 0xFFFF
#endif
#define PHON(k) ((PH_MASK >> (k)) & 1)
#define IN(k) (lo <= (k) && (k) < hi)
#define PHASE_LOCALS long zz = 0; asm volatile("" : "+s"(zz)); unsigned char* const ws = args.ws + zz; int tid = threadIdx.x; asm volatile("" : "+v"(tid)); int bx = blockIdx.x, G = gridDim.x; asm volatile("" : "+s"(bx), "+s"(G)); \
    const int lane = tid & 63, wave = __builtin_amdgcn_readfirstlane(tid >> 6); const int vcu = (G % 8 == 0) ? (bx % 8) * (G / 8) + bx / 8 : bx; \
    const int gw = vcu * NWAVES + wave, NGW = G * NWAVES; (void)lane; (void)gw; (void)NGW
#define SEAM(k) do { if (IN(k) && IN((k) + 1)) xcd_barrier(bar); } while (0)

#define XF ((float*)(ws + WS_XF))
#define XB ((bf16_t*)(ws + WS_XB))
#define PROJ ((bf16_t*)(ws + WS_PROJ))
#define OA ((bf16_t*)(ws + WS_OA))
#define OB ((bf16_t*)(ws + WS_OB))
#define OC ((bf16_t*)(ws + WS_OC))
#define OD ((bf16_t*)(ws + WS_OD))
#define AG ((bf16_t*)(ws + WS_AG))
#define LSE ((float*)(ws + WS_LSE))
#define MIXED ((bf16_t*)(ws + WS_MIXED))
#define PRELN ((float*)(ws + WS_PRELN))
#define XG ((bf16_t*)(ws + WS_XG))
#define HB ((bf16_t*)(ws + WS_H))
#define YB ((bf16_t*)(ws + WS_Y))
#define AFF ((float*)(ws + WS_AFF))
#define IDX ((int*)(ws + WS_IDX))
#define GV ((float*)(ws + WS_GV))
#define SLOT ((int*)(ws + WS_SLOT))

    if (PHON(0) && IN(0)) for (int rep = 0; rep < NREP(0); ++rep) { PHASE_LOCALS;
        InPtrs I; I.x = args.in[0 + zz]; I.w_in = args.in[1 + zz]; I.b_gate = args.in[2 + zz]; I.w_branch = args.in[3 + zz]; I.w_out = args.in[4 + zz]; I.diff_lambda = args.in[5 + zz]; I.diff_subln = args.in[6 + zz];
        I.sink_logit = args.in[7 + zz]; I.na_rpb = args.in[8 + zz]; I.w_router = args.in[9 + zz]; I.w_exp_gate = args.in[10 + zz]; I.w_exp_up = args.in[11 + zz]; I.w_exp_down = args.in[12 + zz]; I.ln_gain = args.in[13 + zz]; I.ln_bias = args.in[14 + zz];
        prologue_phase(I, ws, lds, gw, NGW, wave, lane); if (rep == NREP(0) - 1) SEAM(0); else xcd_barrier(bar); }

    for (int l = 0; l < DEPTH; ++l) {
        const int pb = 1 + l * NPL;
        if (PHON(1) && IN(pb + 0)) for (int rep = 0; rep < NREP(1); ++rep) { PHASE_LOCALS;
            pg8::Gemm g{XB, (const bf16_t*)(ws + WS_WIN) + (size_t)l * IN_TOTAL * DM, MTOK, IN_TOTAL, DM, 0}; pg8::StaticOrder S; S.init(MTOK, IN_TOTAL, G, bx);
            pg8::EpiProj E{PROJ, args.in[2 + zz] + (size_t)l * 8192, (const float*)(ws + WS_ROPE128), (const float*)(ws + WS_ROPE64)};
            pg8::gemm_phase<pg8::EpiProj, pg8::StaticOrder, true, true>(lds, g, S, E, tid);
            if (rep == NREP(1) - 1) SEAM(pb + 0); else xcd_barrier(bar);
        }
        if (PHON(2) && IN(pb + 1)) for (int rep = 0; rep < NREP(2); ++rep) { PHASE_LOCALS;
            const float li = l == 0 ? 0.2f : (l == 1 ? 0.35550906759096926f : (l == 2 ? 0.47071301834358416f : 0.5560582041556405f));
#if SCALAR_ATTN
            { AttnPtrs P{PROJ, AG, LSE, nullptr, nullptr, nullptr, nullptr, nullptr, nullptr, nullptr, li}; scalar_attn_phase<0>(P, lds, gw, NGW, wave, lane); }
            { AttnPtrs P{PROJ, nullptr, nullptr, OB, nullptr, nullptr, args.in[5 + zz] + l * 256, args.in[6 + zz] + l * 128, nullptr, nullptr, li}; scalar_attn_phase<1>(P, lds, gw, NGW, wave, lane); }
            { AttnPtrs P{PROJ, nullptr, nullptr, nullptr, OC, nullptr, nullptr, nullptr, args.in[7 + zz] + l * 8, nullptr, li}; scalar_attn_phase<2>(P, lds, gw, NGW, wave, lane); }
            { AttnPtrs P{PROJ, nullptr, nullptr, nullptr, nullptr, OD, nullptr, nullptr, nullptr, args.in[8 + zz] + (size_t)l * 8 * 465, li}; scalar_attn_phase<3>(P, lds, gw, NGW, wave, lane); }
#else
            att::Ptrs X{PROJ, AG, LSE, OB, OC, OD, (float*)(ws + WS_BSCR), args.in[5 + zz] + l * 256, args.in[6 + zz] + l * 128, args.in[7 + zz] + l * 8, args.in[8 + zz] + (size_t)l * 8 * 465, li};
            att::attn_phase(X, (LAS char*)lds, tid, vcu, G, bx);
#endif
            if (rep == NREP(2) - 1) SEAM(pb + 1); else xcd_barrier(bar);
        }
        if (PHON(3) && IN(pb + 2)) for (int rep = 0; rep < NREP(3); ++rep) { PHASE_LOCALS; combine_a_phase(AG, LSE, OA, gw, NGW, lane); if (rep == NREP(3) - 1) SEAM(pb + 2); else xcd_barrier(bar); }
        if (PHON(4) && IN(pb + 3)) for (int rep = 0; rep < NREP(4); ++rep) { PHASE_LOCALS;
            const bf16_t* wbr = (const bf16_t*)(ws + WS_WBR) + (size_t)l * BR_TOTAL * DM;
            for (int br = 0; br < 4; ++br) {
                const bf16_t* A = br == 0 ? OA : (br == 1 ? OB : (br == 2 ? OC : OD)); const int Kb = br == 0 ? 768 : 1024; const int ro = br == 0 ? 0 : 768 + 1024 * (br - 1);
                pg8::Gemm g{A, wbr + (size_t)ro * DM, MTOK, DM, Kb, 0}; pg8::StaticOrder S; S.init(MTOK, DM, G, bx);
                pg8::EpiGate E{MIXED, PROJ + OFF_GATE + br * DM, br == 0 ? 1 : 0};
                pg8::gemm_phase<pg8::EpiGate, pg8::StaticOrder, true, true>(lds, g, S, E, tid);
                asm volatile("s_waitcnt vmcnt(0)" ::: "memory");
            }
            if (rep == NREP(4) - 1) SEAM(pb + 3); else xcd_barrier(bar);
        }
        if (PHON(5) && IN(pb + 4)) for (int rep = 0; rep < NREP(5); ++rep) { PHASE_LOCALS;
            pg8::Gemm g{MIXED, (const bf16_t*)(ws + WS_WOUT) + (size_t)l * DM * DM, MTOK, DM, DM, 0}; pg8::StaticOrder S; S.init(MTOK, DM, G, bx);
            pg8::EpiResid E{PRELN, l == 0 ? args.in[0 + zz] : (const float*)XF, ALPHA};
            pg8::gemm_phase<pg8::EpiResid, pg8::StaticOrder, true, true>(lds, g, S, E, tid);
            if (rep == NREP(5) - 1) SEAM(pb + 4); else xcd_barrier(bar);
        }
        if (PHON(6) && IN(pb + 5)) for (int rep = 0; rep < NREP(6); ++rep) { PHASE_LOCALS; ln1_router_phase(PRELN, args.in[13 + zz] + (size_t)(l * 2) * DM, args.in[14 + zz] + (size_t)(l * 2) * DM, args.in[9 + zz] + (size_t)l * DM * NEXP, XF, XB, AFF, lds, tid, gw, NGW, lane); if (rep == NREP(6) - 1) SEAM(pb + 5); else xcd_barrier(bar); }
        if (PHON(7) && IN(pb + 6)) for (int rep = 0; rep < NREP(7); ++rep) { PHASE_LOCALS; topk_phase(AFF, IDX, GV, SLOT, lds, tid, wave, lane, bx, G); if (rep == NREP(7) - 1) SEAM(pb + 6); else xcd_barrier(bar); }
        if (PHON(8) && IN(pb + 7)) for (int rep = 0; rep < NREP(8); ++rep) { PHASE_LOCALS; gather_phase(XB, IDX, XG, gw, NGW, lane); if (rep == NREP(8) - 1) SEAM(pb + 7); else xcd_barrier(bar); }
        if (PHON(9) && IN(pb + 8)) for (int rep = 0; rep < NREP(9); ++rep) { PHASE_LOCALS;
            pg8::Gemm g{XG, (const bf16_t*)(ws + WS_WGU) + (size_t)l * NEXP * 2048 * DM, NGRP * CAP, 2048, DM, (size_t)2048 * DM * 2}; pg8::StaticOrder S; S.init(NGRP * CAP, 2048, G, bx);
            pg8::EpiSwiGLU E{HB};
            pg8::gemm_phase<pg8::EpiSwiGLU, pg8::StaticOrder, true, true>(lds, g, S, E, tid);
            if (rep == NREP(9) - 1) SEAM(pb + 8); else xcd_barrier(bar);
        }
        if (PHON(10) && IN(pb + 9)) for (int rep = 0; rep < NREP(10); ++rep) { PHASE_LOCALS;
            pg8::Gemm g{HB, (const bf16_t*)(ws + WS_WDN) + (size_t)l * NEXP * DM * DEXP, NGRP * CAP, DM, DEXP, (size_t)DM * DEXP * 2}; pg8::StaticOrder S; S.init(NGRP * CAP, DM, G, bx);
            pg8::EpiDown E{YB, GV};
            pg8::gemm_phase<pg8::EpiDown, pg8::StaticOrder, true, true>(lds, g, S, E, tid);
            if (rep == NREP(10) - 1) SEAM(pb + 9); else xcd_barrier(bar);
        }
        if (PHON(11) && IN(pb + 10)) for (int rep = 0; rep < NREP(11); ++rep) { PHASE_LOCALS;
            if (NREP(11) == 2 && rep == 0) ln2_phase(XF, YB, SLOT, args.in[13 + zz] + (size_t)(l * 2 + 1) * DM, args.in[14 + zz] + (size_t)(l * 2 + 1) * DM, PRELN, MIXED, gw, NGW, lane); else
            ln2_phase(XF, YB, SLOT, args.in[13 + zz] + (size_t)(l * 2 + 1) * DM, args.in[14 + zz] + (size_t)(l * 2 + 1) * DM, (l == DEPTH - 1) ? args.out : XF, XB, gw, NGW, lane);
            if (rep == NREP(11) - 1) SEAM(pb + 10); else xcd_barrier(bar);
        }
    }
#undef IN
#undef SEAM
}

#ifndef MK_ONE_LAUNCH
#define MK_ONE_LAUNCH 1
#endif
extern "C" void kernel_launch(void* const* d_in, const int* in_sizes, int n_in, void* d_out, int out_size, void* d_ws, size_t ws_size, hipStream_t stream) {
    static int grid = 0;
    if (grid == 0) {
        if (n_in != 15 || out_size != MTOK * DM || ws_size < WS_END) { fprintf(stderr, "kernel_launch: unexpected shapes (n_in %d out %d ws %zu, need ws >= %zu)\n", n_in, out_size, ws_size, (size_t)WS_END); grid = -1; return; }
        int dev = 0, cus = 0, per_cu = 0;
        if (hipGetDevice(&dev) != hipSuccess || hipDeviceGetAttribute(&cus, hipDeviceAttributeMultiprocessorCount, dev) != hipSuccess) { grid = -1; return; }
        if (hipFuncSetAttribute((const void*)fwd, hipFuncAttributeMaxDynamicSharedMemorySize, LDS_BYTES) != hipSuccess) { fprintf(stderr, "kernel_launch: hipFuncSetAttribute failed\n"); grid = -1; return; }
        if (hipOccupancyMaxActiveBlocksPerMultiprocessor(&per_cu, (const void*)fwd, NWAVES * 64, LDS_BYTES) != hipSuccess || per_cu < 1) { fprintf(stderr, "kernel_launch: occupancy query says %d\n", per_cu); }
        (void)hipGetLastError();
        grid = cus;
    }
    if (grid < 0) return;
    if (hipMemsetAsync((char*)d_ws + WS_CTL, 0, CTL_ZERO_BYTES, stream) != hipSuccess) return;
    Args a{};
    for (int i = 0; i < 15; ++i) a.in[i] = (const float*)d_in[i];
    a.out = (float*)d_out; a.ws = (unsigned char*)d_ws;
#if MK_ONE_LAUNCH
    a.ph_lo = 0; a.ph_hi = NPHASES;
    hipLaunchKernelGGL(fwd, dim3(grid), dim3(NWAVES * 64), LDS_BYTES, stream, a);
#else
    for (int p = 0; p < NPHASES; ++p) { a.ph_lo = p; a.ph_hi = p + 1; hipLaunchKernelGGL(fwd, dim3(grid), dim3(NWAVES * 64), LDS_BYTES, stream, a); }
#endif
}
```

```cpp
#include <hip/hip_runtime.h>
#include <cstdio>
#include <cstdint>
#include <cmath>
#define B3_PRIO 1
namespace pg8 {
#define PG8_LAS __attribute__((address_space(3)))
typedef unsigned short bf16_t;
typedef short bf16x8 __attribute__((ext_vector_type(8)));
typedef float f32x4 __attribute__((ext_vector_type(4)));
typedef unsigned u32x4 __attribute__((ext_vector_type(4)));
typedef unsigned u32x2 __attribute__((ext_vector_type(2)));
typedef _Float16 f16x8 __attribute__((ext_vector_type(8)));
typedef int i32x4 __attribute__((ext_vector_type(4)));
constexpr int BM = 256, BK = 64, HALF = 128, HTB = HALF * BK * 2  , STAGE_BYTES = 8 * HTB, NXCD = 8, WGM = 8;

__host__ __device__ __forceinline__ int lds_byte(int r, int c) { const int st = (r >> 4) * 2 + (c >> 5), rr = r & 15, cc = c & 31, ob = rr * 64 + cc * 2; return st * 1024 + (ob ^ (((ob >> 9) & 1) << 5)); }
__host__ __device__ __forceinline__ void stage_rc(int b, int& R, int& C) { const int st = b / 1024, sb = b % 1024, swz = sb ^ (((sb >> 9) & 1) << 5); R = (st >> 1) * 16 + swz / 64; C = (st & 1) * 32 + (swz % 64) / 2; }
__host__ __device__ __forceinline__ int perm32(int rho) { const int n = rho >> 4, i = rho & 15; return 8 * (i >> 2) + 4 * n + (i & 3); }

struct Unit { int pm, pn, br; };
struct Gemm { const bf16_t* A; const bf16_t* Bt; int M, N, K; size_t gstride; size_t a_brstride, b_brstride; const int* gidx;
#if defined(STAMP_SEL)
    unsigned long long* stamp;
#endif
};

struct StaticOrder {
    int nM, nN, nwg, G, c;
    __host__ __device__ void init(int M, int N, int G_, int c_) { nM = M / BM; nN = N / BM; nwg = nM * nN; G = G_; c = c_; }
    __host__ __device__ bool next(int i, Unit& u) const {
        const long L = (long)i * G + c; if (L >= nwg) return false;
        int wgid = (int)L; { const int q = nwg / NXCD, r = nwg % NXCD, xcd = wgid % NXCD, off = wgid / NXCD; wgid = (xcd < r ? xcd * (q + 1) : r * (q + 1) + (xcd - r) * q) + off; }
        const int nig = WGM * nN, gid = wgid / nig, fm = gid * WGM, gsz = (nM - fm) < WGM ? (nM - fm) : WGM;
        u.pm = fm + ((wgid % nig) % gsz); u.pn = (wgid % nig) / gsz; u.br = 0; return true;
    }
    __device__ __forceinline__ int ntiles(const Unit&, int nt_full) const { return nt_full; }
    __device__ __forceinline__ void a_ready(const Unit&) const {}
    __device__ __forceinline__ void done(const Unit&) const {}
};
struct BranchOrder4 : StaticOrder {
    __device__ bool next(int i, Unit& u) const { if (!StaticOrder::next(i >> 2, u)) return false; u.br = i & 3; return true; }
    __device__ __forceinline__ int ntiles(const Unit& u, int) const { return u.br == 0 ? 6 : 8; }
};

__device__ __forceinline__ unsigned cvt_pk_bf16(float lo, float hi) { unsigned r; asm volatile("v_cvt_pk_bf16_f32 %0, %1, %2" : "=v"(r) : "v"(lo), "v"(hi)); return r; }
__device__ __forceinline__ float bflo(unsigned w) { return __uint_as_float(w << 16); }
__device__ __forceinline__ float bfhi(unsigned w) { return __uint_as_float(w & 0xffff0000u); }
typedef _Float16 h16x2 __attribute__((ext_vector_type(2)));
__device__ __forceinline__ unsigned pk_f16(float a, float b) { const h16x2 h = {(_Float16)a, (_Float16)b}; return __builtin_bit_cast(unsigned, h); }
__device__ __forceinline__ float f16lo(unsigned w) { return (float)__builtin_bit_cast(h16x2, w)[0]; }
__device__ __forceinline__ float f16hi(unsigned w) { return (float)__builtin_bit_cast(h16x2, w)[1]; }
__device__ __forceinline__ float sigmoidf_(float x) { return 1.0f / (1.0f + __expf(-x)); }
__device__ __forceinline__ unsigned q8x4e(float a, float b, float c, float d, float s) {
    const float ca = fminf(fmaxf(a * s, -127.0f), 127.0f) + 12582912.0f, cb = fminf(fmaxf(b * s, -127.0f), 127.0f) + 12582912.0f;
    const float cc = fminf(fmaxf(c * s, -127.0f), 127.0f) + 12582912.0f, cd = fminf(fmaxf(d * s, -127.0f), 127.0f) + 12582912.0f;
    const unsigned lo = __builtin_amdgcn_perm(__float_as_uint(cb), __float_as_uint(ca), 0x0c0c0400u), hi = __builtin_amdgcn_perm(__float_as_uint(cd), __float_as_uint(cc), 0x0c0c0400u);
    return __builtin_amdgcn_perm(hi, lo, 0x05040100u);
}

template <bool I8> struct EpiProjT {
    static constexpr bool PERM = true, AFTER_DRAIN = false, RMW = false;
    bf16_t* O; const float* rope128; const float* rope64; int cbase, csplit, cskip; float inv_qk, inv_v;
    __device__ __forceinline__ void operator()(const f32x4 (&acc)[2][2][4][2], const Unit& u, int wr, int wc, int fr, int fq) const {
        const int ct = u.pn * BM; const int colt = cbase + ct + (ct >= csplit ? cskip : 0);
        int mode;
        if (colt < 4608) mode = 1; else if (colt < 6912) mode = 0; else if (colt < 8960) mode = 2; else if (colt < 9984) mode = 0; else if (colt < 11264) mode = 1; else mode = 0;
        const bool isv = (colt >= 4608 && colt < 6912) || (colt >= 8960 && colt < 9984) || (colt >= 11264 && colt < 11520) || (colt >= 13568);
        const float inv = isv ? inv_v : inv_qk;
        const int row0 = u.pm * BM + wr * 64 + fr, col0 = colt + wc * 32 + 8 * fq;
        const int i128 = 16 * wc + 4 * fq, i64 = 16 * (wc & 1) + 4 * fq;
        f32x4 cs0[2][4], cs1[2][4];
        if (mode == 1 || mode == 2) {
#pragma unroll
            for (int ai = 0; ai < 2; ++ai)
#pragma unroll
                for (int m = 0; m < 4; ++m) { const int pos = (row0 + ai * HALF + m * 16) & 4095;
                    const f32x4* t = (mode == 1) ? (const f32x4*)(rope128 + ((size_t)pos * 64 + i128) * 2) : (const f32x4*)(rope64 + ((size_t)pos * 32 + i64) * 2);
                    cs0[ai][m] = t[0]; cs1[ai][m] = t[1]; }
        }
#pragma unroll
        for (int ai = 0; ai < 2; ++ai)
#pragma unroll
            for (int m = 0; m < 4; ++m) {
                const int row = row0 + ai * HALF + m * 16;
                bf16_t* rowp = O + (size_t)row * 14592 + col0;
#pragma unroll
                for (int bj = 0; bj < 2; ++bj) {
                    f32x4 v0 = acc[ai][bj][m][0], v1 = acc[ai][bj][m][1];
                    if constexpr (I8) { const i32x4 i0 = __builtin_bit_cast(i32x4, v0), i1 = __builtin_bit_cast(i32x4, v1);
                        v0 = (f32x4){(float)i0[0], (float)i0[1], (float)i0[2], (float)i0[3]} * inv; v1 = (f32x4){(float)i1[0], (float)i1[1], (float)i1[2], (float)i1[3]} * inv; }
                    if (mode == 1 || mode == 2) {
                        const f32x4 c0 = cs0[ai][m], c1 = cs1[ai][m];
                        f32x4 r0, r1;
                        r0[0] = v0[0] * c0[0] - v0[1] * c0[1]; r0[1] = v0[1] * c0[0] + v0[0] * c0[1];
                        r0[2] = v0[2] * c0[2] - v0[3] * c0[3]; r0[3] = v0[3] * c0[2] + v0[2] * c0[3];
                        r1[0] = v1[0] * c1[0] - v1[1] * c1[1]; r1[1] = v1[1] * c1[0] + v1[0] * c1[1];
                        r1[2] = v1[2] * c1[2] - v1[3] * c1[3]; r1[3] = v1[3] * c1[2] + v1[2] * c1[3];
                        v0 = r0; v1 = r1;
                    }
                    {
                        u32x4 w; w.x = cvt_pk_bf16(v0[0], v0[1]); w.y = cvt_pk_bf16(v0[2], v0[3]); w.z = cvt_pk_bf16(v1[0], v1[1]); w.w = cvt_pk_bf16(v1[2], v1[3]);
                        *(u32x4*)(rowp + bj * HALF) = w;
                    }
                }
            }
    }
};
struct EpiGate8 {
    static constexpr bool PERM = true, AFTER_DRAIN = false, RMW = false;
    unsigned char* G8; const float* bgate; float inv;
    __device__ __forceinline__ void operator()(const f32x4 (&acc)[2][2][4][2], const Unit& u, int wr, int wc, int fr, int fq) const {
        const int row0 = u.pm * BM + wr * 64 + fr, col0 = u.pn * BM + wc * 32 + 8 * fq;
        const float ninv = -inv * 1.4426950408889634f;
        f32x4 gb[2][2];
#pragma unroll
        for (int bj = 0; bj < 2; ++bj)
#pragma unroll
            for (int n = 0; n < 2; ++n) gb[bj][n] = *(const f32x4*)(bgate + col0 + bj * HALF + 4 * n) * (-1.4426950408889634f);
#pragma unroll
        for (int ai = 0; ai < 2; ++ai)
#pragma unroll
            for (int m = 0; m < 4; ++m) { unsigned char* growp = G8 + (size_t)(row0 + ai * HALF + m * 16) * 8192 + col0;
#pragma unroll
                for (int bj = 0; bj < 2; ++bj) { const i32x4 a0 = __builtin_bit_cast(i32x4, acc[ai][bj][m][0]), a1 = __builtin_bit_cast(i32x4, acc[ai][bj][m][1]);
                    unsigned q[8];
#pragma unroll
                    for (int j = 0; j < 4; ++j) {
                        const float e0 = __builtin_amdgcn_exp2f(fmaf((float)a0[j], ninv, gb[bj][0][j])), e1 = __builtin_amdgcn_exp2f(fmaf((float)a1[j], ninv, gb[bj][1][j]));
                        q[j] = __float_as_uint(__builtin_amdgcn_rcpf(fmaf(e0, 1.0f / 255.0f, 1.0f / 255.0f)) + 12582912.0f);
                        q[4 + j] = __float_as_uint(__builtin_amdgcn_rcpf(fmaf(e1, 1.0f / 255.0f, 1.0f / 255.0f)) + 12582912.0f); }
                    u32x2 wq;
                    wq.x = __builtin_amdgcn_perm(__builtin_amdgcn_perm(q[3], q[2], 0x0c0c0400u), __builtin_amdgcn_perm(q[1], q[0], 0x0c0c0400u), 0x05040100u);
                    wq.y = __builtin_amdgcn_perm(__builtin_amdgcn_perm(q[7], q[6], 0x0c0c0400u), __builtin_amdgcn_perm(q[5], q[4], 0x0c0c0400u), 0x05040100u);
                    *(u32x2*)(growp + bj * HALF) = wq; } }
    }
};
struct EpiGate4 {
    static constexpr bool PERM = true, AFTER_DRAIN = false, RMW = true;
    bf16_t* mixed; const unsigned char* gate; float inv_a, inv_b, inv_cd; unsigned char* mixed8; float qm;
    __device__ __forceinline__ void operator()(const f32x4 (&acc)[2][2][4][2], const Unit& u, int wr, int wc, int fr, int fq) const {
        const int row0 = u.pm * BM + wr * 64 + fr, col0 = u.pn * BM + wc * 32 + 8 * fq;
        const unsigned char* gate_b = gate + u.br * 2048; const bool first = u.br == 0, last = u.br == 3;
        const float sc = (inv_cd + (u.br == 0 ? 1.0f : 0.0f) * (inv_a - inv_cd) + (u.br == 1 ? 1.0f : 0.0f) * (inv_b - inv_cd)) * (1.0f / 255.0f);
#pragma unroll
        for (int ai = 0; ai < 2; ++ai) {
            u32x2 g[4][2]; u32x4 p[4][2];
#pragma unroll
            for (int m = 0; m < 4; ++m) { const int row = row0 + ai * HALF + m * 16;
#pragma unroll
                for (int bj = 0; bj < 2; ++bj) { g[m][bj] = *(const u32x2*)(gate_b + (size_t)row * 8192 + col0 + bj * HALF);
                    p[m][bj] = (u32x4){0u, 0u, 0u, 0u}; if (!first) p[m][bj] = *(const u32x4*)(mixed + (size_t)row * 2048 + col0 + bj * HALF); } }
#pragma unroll
            for (int m = 0; m < 4; ++m) { const int row = row0 + ai * HALF + m * 16; bf16_t* mp = mixed + (size_t)row * 2048 + col0;
#pragma unroll
                for (int bj = 0; bj < 2; ++bj) {
                    const u32x2 gg = g[m][bj]; const u32x4 pp = p[m][bj]; const i32x4 i0 = __builtin_bit_cast(i32x4, acc[ai][bj][m][0]), i1 = __builtin_bit_cast(i32x4, acc[ai][bj][m][1]);
                    const f32x4 v0 = (f32x4){(float)i0[0], (float)i0[1], (float)i0[2], (float)i0[3]} * sc, v1 = (f32x4){(float)i1[0], (float)i1[1], (float)i1[2], (float)i1[3]} * sc;
                    const float s0 = bflo(pp.x) + (float)(gg.x & 0xffu) * v0[0], s1 = bfhi(pp.x) + (float)((gg.x >> 8) & 0xffu) * v0[1], s2 = bflo(pp.y) + (float)((gg.x >> 16) & 0xffu) * v0[2], s3 = bfhi(pp.y) + (float)(gg.x >> 24) * v0[3];
                    const float s4 = bflo(pp.z) + (float)(gg.y & 0xffu) * v1[0], s5 = bfhi(pp.z) + (float)((gg.y >> 8) & 0xffu) * v1[1], s6 = bflo(pp.w) + (float)((gg.y >> 16) & 0xffu) * v1[2], s7 = bfhi(pp.w) + (float)(gg.y >> 24) * v1[3];
                    if (last) { u32x2 q8; q8.x = q8x4e(s0, s1, s2, s3, qm); q8.y = q8x4e(s4, s5, s6, s7, qm); *(u32x2*)(mixed8 + (size_t)row * 2048 + col0 + bj * HALF) = q8; }
                    else { u32x4 w; w.x = cvt_pk_bf16(s0, s1); w.y = cvt_pk_bf16(s2, s3); w.z = cvt_pk_bf16(s4, s5); w.w = cvt_pk_bf16(s6, s7); *(u32x4*)(mp + bj * HALF) = w; }
                } }
        }
    }
};
struct EpiResid {
    static constexpr bool PERM = false, AFTER_DRAIN = false, RMW = false;
    bf16_t* out; const float* xf; const bf16_t* xh; float alpha, inv;
    __device__ __forceinline__ void operator()(const f32x4 (&acc)[2][2][4][2], const Unit& u, int wr, int wc, int fr, int fq) const {
        const int row0 = u.pm * BM + wr * 64 + fr, col0 = u.pn * BM + wc * 32 + 4 * fq;
#pragma unroll
        for (int ai = 0; ai < 2; ++ai) {
            f32x4 x[4][2][2];
#pragma unroll
            for (int m = 0; m < 4; ++m) { const size_t off = (size_t)(row0 + ai * HALF + m * 16) * 2048 + col0;
#pragma unroll
                for (int bj = 0; bj < 2; ++bj)
#pragma unroll
                    for (int n = 0; n < 2; ++n) { if (xf) x[m][bj][n] = *(const f32x4*)(xf + off + bj * HALF + n * 16);
                        else { const u32x2 w = *(const u32x2*)(xh + off + bj * HALF + n * 16); x[m][bj][n] = (f32x4){f16lo(w.x), f16hi(w.x), f16lo(w.y), f16hi(w.y)}; } } }
#pragma unroll
            for (int m = 0; m < 4; ++m) { const size_t off = (size_t)(row0 + ai * HALF + m * 16) * 2048 + col0;
#pragma unroll
                for (int bj = 0; bj < 2; ++bj)
#pragma unroll
                    for (int n = 0; n < 2; ++n) { const i32x4 ia = __builtin_bit_cast(i32x4, acc[ai][bj][m][n]); const f32x4 r = x[m][bj][n] * alpha + (f32x4){(float)ia[0], (float)ia[1], (float)ia[2], (float)ia[3]} * inv;
                        u32x2 w; w.x = pk_f16(r[0], r[1]); w.y = pk_f16(r[2], r[3]); *(u32x2*)(out + off + bj * HALF + n * 16) = w; } }
        }
    }
};
struct EpiSwiGLU {
    static constexpr bool PERM = true, AFTER_DRAIN = false, RMW = false;
    unsigned char* H; float inv_g, inv_u, qh;
    __device__ __forceinline__ void operator()(const f32x4 (&acc)[2][2][4][2], const Unit& u, int wr, int wc, int fr, int fq) const {
        const int row0 = u.pm * BM + wr * 64 + fr, col0 = u.pn * HALF + wc * 32 + 8 * fq;
        const float ksc = qh * inv_g * inv_u, kexp = -inv_g * 1.4426950408889634f;
#pragma unroll
        for (int ai = 0; ai < 2; ++ai)
#pragma unroll
            for (int m = 0; m < 4; ++m) {
                unsigned char* hp = H + (size_t)(row0 + ai * HALF + m * 16) * 1024 + col0;
                f32x4 h0, h1;
                const i32x4 ig0 = __builtin_bit_cast(i32x4, acc[ai][0][m][0]), ig1 = __builtin_bit_cast(i32x4, acc[ai][0][m][1]), iu0 = __builtin_bit_cast(i32x4, acc[ai][1][m][0]), iu1 = __builtin_bit_cast(i32x4, acc[ai][1][m][1]);
#pragma unroll
                for (int j = 0; j < 4; ++j) { const float fg0 = (float)ig0[j], fg1 = (float)ig1[j];
                    h0[j] = fg0 * (float)iu0[j] * ksc * __builtin_amdgcn_rcpf(1.0f + __builtin_amdgcn_exp2f(fg0 * kexp));
                    h1[j] = fg1 * (float)iu1[j] * ksc * __builtin_amdgcn_rcpf(1.0f + __builtin_amdgcn_exp2f(fg1 * kexp)); }
                u32x2 w; w.x = q8x4e(h0[0], h0[1], h0[2], h0[3], 1.0f); w.y = q8x4e(h1[0], h1[1], h1[2], h1[3], 1.0f);
                *(u32x2*)hp = w;
            }
    }
};
struct EpiDown {
    static constexpr bool PERM = true, AFTER_DRAIN = false, RMW = false;
    bf16_t* Y; const float* gv; float inv;
    __device__ __forceinline__ void operator()(const f32x4 (&acc)[2][2][4][2], const Unit& u, int wr, int wc, int fr, int fq) const {
        const int row0 = u.pm * BM + wr * 64 + fr, col0 = u.pn * BM + wc * 32 + 8 * fq;
        float sv[2][4];
#pragma unroll
        for (int ai = 0; ai < 2; ++ai)
#pragma unroll
            for (int m = 0; m < 4; ++m) sv[ai][m] = gv[row0 + ai * HALF + m * 16] * inv;
#pragma unroll
        for (int ai = 0; ai < 2; ++ai)
#pragma unroll
            for (int m = 0; m < 4; ++m) {
                const int row = row0 + ai * HALF + m * 16; const float s = sv[ai][m];
                bf16_t* yp = Y + (size_t)row * 2048 + col0;
#pragma unroll
                for (int bj = 0; bj < 2; ++bj) { const i32x4 i0 = __builtin_bit_cast(i32x4, acc[ai][bj][m][0]), i1 = __builtin_bit_cast(i32x4, acc[ai][bj][m][1]);
                    const f32x4 v0 = (f32x4){(float)i0[0], (float)i0[1], (float)i0[2], (float)i0[3]} * s, v1 = (f32x4){(float)i1[0], (float)i1[1], (float)i1[2], (float)i1[3]} * s;
                    u32x4 w; w.x = cvt_pk_bf16(v0[0], v0[1]); w.y = cvt_pk_bf16(v0[2], v0[3]); w.z = cvt_pk_bf16(v1[0], v1[1]); w.w = cvt_pk_bf16(v1[2], v1[3]);
                    *(u32x4*)(yp + bj * HALF) = w; }
            }
    }
};

template <class Epi, class Sched, bool ALIGN_EPI = false, bool SP2 = false, bool GATHER = false, bool I8 = false, bool F16 = false>
__device__ __forceinline__ void gemm_phase(PG8_LAS unsigned char* lds, const Gemm g, const Sched& S, const Epi& E, const int tid) {
    const int wid = __builtin_amdgcn_readfirstlane(tid >> 6), lane = tid & 63, wr = wid >> 2, wc = wid & 3, fr = lane & 15, fq = lane >> 4;
    const int K = g.K, nt = K / BK;
    unsigned voffA[2], voffB[2];
#pragma unroll
    for (int i = 0; i < 2; ++i) { int R, C; stage_rc(tid * 16 + i * 8192, R, C); const int Rb = Epi::PERM ? ((R & ~31) + perm32(R & 31)) : R;
        voffA[i] = (unsigned)(R * K + C) * 2u; voffB[i] = (unsigned)(Rb * K + C) * 2u; }
    unsigned gcur[2][2] = {{0u, 0u}, {0u, 0u}}, gnx[2][2] = {{0u, 0u}, {0u, 0u}};
#define PG8_GOFF(dst, U) do { _Pragma("unroll") for (int _h = 0; _h < 2; ++_h) _Pragma("unroll") for (int _i = 0; _i < 2; ++_i) { int R_, C_; stage_rc(tid * 16 + _i * 8192, R_, C_); \
        const int r_ = (U).pm * BM + _h * HALF + R_; const int tok_ = g.gidx[r_]; dst[_h][_i] = (unsigned)(((r_ >> 13) * 4096 + tok_) * K + C_) * 2u; } } while (0)
    const size_t kstep = (size_t)(BK * 2);
    const size_t hstep = (size_t)HALF * K * 2;
    const size_t tstep = 2 * hstep;
    const unsigned ldsw = (unsigned)wid * 1024u;
    const int aoff = lds_byte(wr * 64 + fr, fq * 8), boff = lds_byte(wc * 32 + fr, fq * 8);
#define PG8_SA(b, h) (((b) * 2 + (h)) * HTB)
#define PG8_SB(b, h) ((4 + (b) * 2 + (h)) * HTB)
#define PG8_STAGE(bufoff, gbase, voff) do { _Pragma("unroll") for (int _i = 0; _i < 2; ++_i) \
        __builtin_amdgcn_global_load_lds((const unsigned*)((const char*)(gbase) + (voff)[_i]), (PG8_LAS unsigned*)(lds + (bufoff) + ldsw + _i * 8192), 16, 0, 0); } while (0)
#define PG8_LDA(dst, b, h) do { _Pragma("unroll") for (int m = 0; m < 4; ++m) _Pragma("unroll") for (int k = 0; k < 2; ++k) dst[m][k] = *(const PG8_LAS bf16x8*)(lds + PG8_SA(b, h) + aoff + m * 2048 + k * 1024); } while (0)
#define PG8_LDB(dst, b, h) do { _Pragma("unroll") for (int n = 0; n < 2; ++n) _Pragma("unroll") for (int k = 0; k < 2; ++k) dst[n][k] = *(const PG8_LAS bf16x8*)(lds + PG8_SB(b, h) + boff + n * 2048 + k * 1024); } while (0)
#define PG8_MMA(ai, bj, At, Bt) do { __builtin_amdgcn_s_setprio(1); _Pragma("unroll") for (int m = 0; m < 4; ++m) _Pragma("unroll") for (int n = 0; n < 2; ++n) _Pragma("unroll") for (int k = 0; k < 2; ++k) { \
        if constexpr (I8) acc[ai][bj][m][n] = __builtin_bit_cast(f32x4, __builtin_amdgcn_mfma_i32_16x16x64_i8(__builtin_bit_cast(i32x4, Bt[n][k]), __builtin_bit_cast(i32x4, At[m][k]), __builtin_bit_cast(i32x4, acc[ai][bj][m][n]), 0, 0, 0)); \
        else if constexpr (F16) acc[ai][bj][m][n] = __builtin_amdgcn_mfma_f32_16x16x32_f16(__builtin_bit_cast(f16x8, Bt[n][k]), __builtin_bit_cast(f16x8, At[m][k]), acc[ai][bj][m][n], 0, 0, 0); \
        else acc[ai][bj][m][n] = __builtin_amdgcn_mfma_f32_16x16x32_bf16(Bt[n][k], At[m][k], acc[ai][bj][m][n], 0, 0, 0); } \
        __builtin_amdgcn_s_setprio(0); } while (0)
#define PG8_STA(bufoff, gbase, h, nx) do { if constexpr (GATHER) { unsigned vo_[2]; vo_[0] = (nx) ? gnx[h][0] : gcur[h][0]; vo_[1] = (nx) ? gnx[h][1] : gcur[h][1]; PG8_STAGE(bufoff, gbase, vo_); } \
        else { PG8_STAGE(bufoff, (gbase) + (h) * hstep, voffA); } } while (0)
#define PG8_WAIT_V(n) asm volatile("s_waitcnt vmcnt(" #n ")" ::: "memory")
#define PG8_WAIT_L(n) asm volatile("s_waitcnt lgkmcnt(" #n ")" ::: "memory")
#define PG8_BAR __builtin_amdgcn_s_barrier()
#define PG8_SCHED __builtin_amdgcn_sched_barrier(0)
    Unit cur, nxt; int ui = 0;
    if (!S.next(0, cur)) return;
    f32x4 acc[2][2][4][2];
#pragma unroll
    for (int a = 0; a < 2; ++a)
#pragma unroll
        for (int b = 0; b < 2; ++b)
#pragma unroll
            for (int m = 0; m < 4; ++m)
#pragma unroll
                for (int n = 0; n < 2; ++n) acc[a][b][m][n] = (f32x4){0.f, 0.f, 0.f, 0.f};
    bf16x8 At[4][2], B0[2][2], B1[2][2];
    const char* cA = (const char*)g.A + (size_t)cur.br * g.a_brstride + (GATHER ? (size_t)0 : (size_t)cur.pm * tstep); const char* cB = (const char*)g.Bt + (size_t)cur.br * g.b_brstride + (size_t)((cur.pm >> 1) & 15) * g.gstride + (size_t)cur.pn * tstep;
    S.a_ready(cur);
    if constexpr (GATHER) PG8_GOFF(gcur, cur);
    if constexpr (SP2) {
        PG8_STAGE(PG8_SB(0, 0), cB, voffB); PG8_STAGE(PG8_SB(0, 1), cB + hstep, voffB); PG8_STA(PG8_SA(0, 0), cA, 0, false); PG8_STA(PG8_SA(0, 1), cA, 1, false);
        if (wr == 1) PG8_BAR;
        PG8_WAIT_V(2); PG8_BAR;
        PG8_STAGE(PG8_SB(1, 0), cB + kstep, voffB); PG8_STA(PG8_SA(1, 0), cA + kstep, 0, false); PG8_STAGE(PG8_SB(1, 1), cB + hstep + kstep, voffB);
        PG8_WAIT_V(6); PG8_BAR;
    } else {
        PG8_STAGE(PG8_SB(0, 0), cB, voffB); PG8_STAGE(PG8_SA(0, 0), cA, voffA); PG8_STAGE(PG8_SB(0, 1), cB + hstep, voffB); PG8_STAGE(PG8_SA(0, 1), cA + hstep, voffA);
        if (wr == 1) PG8_BAR;
        PG8_WAIT_V(4); PG8_BAR;
        PG8_STAGE(PG8_SB(1, 0), cB + kstep, voffB); PG8_STAGE(PG8_SA(1, 0), cA + kstep, voffA); PG8_STAGE(PG8_SB(1, 1), cB + hstep + kstep, voffB);
        PG8_WAIT_V(6); PG8_BAR;
    }
#if defined(STAMP_SEL)
    unsigned long long st_t0 = 0, st_t1 = 0, st_t2 = 0, st_r0 = 0, st_r1 = 0;
#endif
    for (;;) {
        const bool has_next = S.next(ui + 1, nxt);
#if defined(STAMP_SEL)
        if (g.stamp && ui == 5) { st_t0 = __builtin_amdgcn_s_memtime(); st_r0 = __builtin_amdgcn_s_memrealtime(); }
#endif
        const char* nA = has_next ? (const char*)g.A + (size_t)nxt.br * g.a_brstride + (GATHER ? (size_t)0 : (size_t)nxt.pm * tstep) : cA; const char* nB = has_next ? (const char*)g.Bt + (size_t)nxt.br * g.b_brstride + (size_t)((nxt.pm >> 1) & 15) * g.gstride + (size_t)nxt.pn * tstep : cB;
        const int ntu = S.ntiles(cur, nt);
        if constexpr (GATHER) { if (has_next) PG8_GOFF(gnx, nxt); else { gnx[0][0] = gcur[0][0]; gnx[0][1] = gcur[0][1]; gnx[1][0] = gcur[1][0]; gnx[1][1] = gcur[1][1]; } }
        for (int t = 0; t < ntu; t += 2) {
            const bool last = (t == ntu - 2);
            const char* a1 = cA + (size_t)(t + 1) * kstep;
            const char* a2 = last ? nA : cA + (size_t)(t + 2) * kstep; const char* b2 = last ? nB : cB + (size_t)(t + 2) * kstep;
            const char* a3 = a2 + kstep; const char* b3 = b2 + kstep;
            if (last && has_next) S.a_ready(nxt);
            if constexpr (SP2) {
            PG8_LDB(B0, 0, 0); PG8_LDB(B1, 0, 1); PG8_SCHED; PG8_LDA(At, 0, 0); PG8_STA(PG8_SA(1, 1), a1, 1, false);
            PG8_WAIT_V(8); PG8_WAIT_L(0); PG8_BAR; PG8_MMA(0, 0, At, B0); PG8_MMA(0, 1, At, B1); PG8_BAR; PG8_SCHED;
            PG8_LDA(At, 0, 1); PG8_STAGE(PG8_SB(0, 0), b2, voffB); PG8_STAGE(PG8_SB(0, 1), b2 + hstep, voffB); PG8_STA(PG8_SA(0, 0), a2, 0, last);
            PG8_WAIT_V(8); PG8_WAIT_L(0); PG8_BAR; PG8_MMA(1, 0, At, B0); PG8_MMA(1, 1, At, B1); PG8_BAR; PG8_SCHED;
            PG8_LDB(B0, 1, 0); PG8_LDB(B1, 1, 1); PG8_SCHED; PG8_LDA(At, 1, 0); PG8_STA(PG8_SA(0, 1), a2, 1, last);
            PG8_WAIT_V(8); PG8_WAIT_L(0); PG8_BAR; PG8_MMA(0, 0, At, B0); PG8_MMA(0, 1, At, B1); PG8_BAR; PG8_SCHED;
            PG8_LDA(At, 1, 1); PG8_STAGE(PG8_SB(1, 0), b3, voffB); PG8_STAGE(PG8_SB(1, 1), b3 + hstep, voffB); PG8_STA(PG8_SA(1, 0), a3, 0, last);
            PG8_WAIT_V(8); PG8_WAIT_L(0); PG8_BAR; PG8_MMA(1, 0, At, B0); PG8_MMA(1, 1, At, B1); PG8_BAR; PG8_SCHED;
            } else {
            PG8_LDB(B0, 0, 0); PG8_SCHED; PG8_LDA(At, 0, 0); PG8_STAGE(PG8_SA(1, 1), a1 + hstep, voffA);
            PG8_WAIT_L(8); PG8_BAR; PG8_WAIT_L(0); PG8_MMA(0, 0, At, B0); PG8_BAR; PG8_SCHED;
            PG8_LDB(B1, 0, 1); PG8_STAGE(PG8_SB(0, 0), b2, voffB);
            PG8_BAR; PG8_WAIT_L(0); PG8_MMA(0, 1, At, B1); PG8_BAR;
            PG8_LDA(At, 0, 1); PG8_STAGE(PG8_SA(0, 0), a2, voffA);
            PG8_BAR; PG8_WAIT_L(0); PG8_MMA(1, 0, At, B0); PG8_BAR; PG8_SCHED;
            PG8_STAGE(PG8_SB(0, 1), b2 + hstep, voffB);
            PG8_WAIT_V(6); PG8_BAR; PG8_MMA(1, 1, At, B1); PG8_BAR;
            PG8_LDB(B0, 1, 0); PG8_SCHED; PG8_LDA(At, 1, 0); PG8_STAGE(PG8_SA(0, 1), a2 + hstep, voffA);
            PG8_WAIT_L(8); PG8_BAR; PG8_WAIT_L(0); PG8_MMA(0, 0, At, B0); PG8_BAR; PG8_SCHED;
            PG8_LDB(B1, 1, 1); PG8_STAGE(PG8_SB(1, 0), b3, voffB);
            PG8_BAR; PG8_WAIT_L(0); PG8_MMA(0, 1, At, B1); PG8_BAR;
            PG8_LDA(At, 1, 1); PG8_STAGE(PG8_SA(1, 0), a3, voffA);
            PG8_BAR; PG8_WAIT_L(0); PG8_MMA(1, 0, At, B0); PG8_BAR; PG8_SCHED;
            PG8_STAGE(PG8_SB(1, 1), b3 + hstep, voffB);
            PG8_WAIT_V(6); PG8_BAR; PG8_MMA(1, 1, At, B1); PG8_BAR;
            }
        }
#if defined(STAMP_SEL)
        if (g.stamp && ui == 5) st_t1 = __builtin_amdgcn_s_memtime();
#endif
        if constexpr (ALIGN_EPI) { if (wr == 0) PG8_BAR; }
        if constexpr (!Epi::AFTER_DRAIN) { E(acc, cur, wr, wc, fr, fq);
#if defined(PROBE_EPI2)
            if constexpr (!Epi::RMW) { asm volatile("" ::: "memory"); E(acc, cur, wr, wc, fr, fq); }
#endif
            S.done(cur); }
#if defined(STAMP_SEL)
        if (g.stamp && ui == 5) { st_t2 = __builtin_amdgcn_s_memtime(); st_r1 = __builtin_amdgcn_s_memrealtime(); }
#endif
        if (!has_next) break;
#pragma unroll
        for (int a = 0; a < 2; ++a)
#pragma unroll
            for (int b = 0; b < 2; ++b)
#pragma unroll
                for (int m = 0; m < 4; ++m)
#pragma unroll
                    for (int n = 0; n < 2; ++n) acc[a][b][m][n] = (f32x4){0.f, 0.f, 0.f, 0.f};
        cur = nxt; cA = nA; cB = nB; ++ui;
        if constexpr (GATHER) { gcur[0][0] = gnx[0][0]; gcur[0][1] = gnx[0][1]; gcur[1][0] = gnx[1][0]; gcur[1][1] = gnx[1][1]; }
        if constexpr (ALIGN_EPI) { if (wr == 1) PG8_BAR; }
    }
    PG8_WAIT_V(0);
    if constexpr (!ALIGN_EPI) { if (wr == 0) PG8_BAR; }
    PG8_BAR;
    if constexpr (Epi::AFTER_DRAIN) { E.fused(acc, cur, wr, wc, fr, fq, lds, wid, lane); S.done(cur); }
#if defined(STAMP_SEL)
    if (g.stamp && tid == 0) { g.stamp[0] = st_t0; g.stamp[1] = st_t1; g.stamp[2] = st_t2; g.stamp[3] = st_r0; g.stamp[4] = st_r1; }
#endif
#undef PG8_SA
#undef PG8_SB
#undef PG8_STAGE
#undef PG8_LDA
#undef PG8_LDB
#undef PG8_MMA
#undef PG8_STA
#undef PG8_GOFF
#undef PG8_WAIT_V
#undef PG8_WAIT_L
#undef PG8_BAR
#undef PG8_SCHED
}
}

#if defined(STAMP_SEL)
#define STAMP_ARG(x) , x
#else
#define STAMP_ARG(x)
#endif

constexpr int DM = 2048, NBATCH = 4, SEQ = 4096, DEPTH = 4, MTOK = NBATCH * SEQ;
constexpr int IN_TOTAL = 22784, PROJ_PITCH = 14592;
constexpr int OFF_QA = 0, OFF_KA = 2304, OFF_VA = 4608, OFF_QB = 6912, OFF_KB = 7936, OFF_VB = 8960, OFF_QC = 9984, OFF_KC = 11008, OFF_VC = 11264, OFF_QD = 11520, OFF_KD = 12544, OFF_VD = 13568, OFF_GATE = 14592;
constexpr int BR_TOTAL = 3840;
constexpr int NEXP = 16, CAP = 512, DEXP = 1024, NGRP = NBATCH * NEXP;
constexpr float LN_EPS = 1e-5f, SUBLN_EPS = 1e-5f;
constexpr float ALPHA = 1.6817928305074290f;
constexpr size_t MiB = 1u << 20;
constexpr size_t WS_CTL = 0, CTL_ZERO_BYTES = 1 * MiB;
constexpr size_t WS_ROPE128 = 1 * MiB, WS_ROPE64 = 3 * MiB, WS_AFF = 4 * MiB, WS_IDX = 5 * MiB, WS_GV = 5 * MiB + 131072, WS_SLOT = 6 * MiB, WS_LSE = 7 * MiB, WS_STATS = 9 * MiB;
constexpr size_t WS_XF = 16 * MiB, WS_XB = 144 * MiB;
constexpr size_t WS_X8 = 208 * MiB;
constexpr size_t WS_W8G = 240 * MiB;
constexpr float QSIG = 4.0f;
constexpr float QX = 127.0f / QSIG, QWG = 127.0f / (QSIG * 0.022097086912079608f), QWU = 127.0f / (QSIG * 0.022097086912079608f * 0.42044820762685725f),
                QO = 127.0f / 0.5f, QWBA = 127.0f / (QSIG * 0.42044820762685725f * 0.036084391824351615f), QWBC = 127.0f / (QSIG * 0.42044820762685725f * 0.03125f),
                QH = 127.0f / 4.0f, QWD = 127.0f / (QSIG * 0.03125f * 0.42044820762685725f);
constexpr size_t WS_O4 = 2552 * MiB, WS_OA = WS_O4, WS_OB = WS_O4 + 32 * MiB, WS_OC = WS_O4 + 64 * MiB, WS_OD = WS_O4 + 96 * MiB;
constexpr size_t WS_AG = 328 * MiB;
constexpr size_t WS_MIXED8 = 400 * MiB;
constexpr size_t WS_MIXED = 432 * MiB;
constexpr size_t WS_PRELN = 496 * MiB;
constexpr size_t WS_PROJ = 624 * MiB;
constexpr size_t WS_GATE = WS_PROJ + 456 * MiB;
constexpr size_t WS_XG = WS_PROJ, WS_H = WS_PROJ + 128 * MiB, WS_Y = WS_PROJ + 192 * MiB;
constexpr size_t WS_W8Q = 1336 * MiB;
constexpr size_t WS_WIN = 1432 * MiB;
constexpr size_t WS_W8BR = 1692 * MiB;
constexpr size_t WS_O8 = 2616 * MiB;
constexpr size_t WS_WOUT = 1752 * MiB;
constexpr size_t WS_WGU = 1784 * MiB;
constexpr size_t WS_WDN = 2296 * MiB;
constexpr size_t WS_END = 2744 * MiB;
static_assert(WS_PROJ + (size_t)MTOK * IN_TOTAL * 2 == WS_W8Q && WS_W8Q + (size_t)DEPTH * 11520 * DM <= WS_WIN && WS_WIN + (size_t)DEPTH * 3072 * DM * 2 <= 1692 * MiB, "ws map");
constexpr int CW_BAR = 4096;
constexpr int LDS_BYTES = 155648, LDSCTL_OFF = 155136;
constexpr int NWAVES = 8;
#ifndef LB_WAVES
#define LB_WAVES 2
#endif
constexpr int NPL = 10, NPHASES = 1 + DEPTH * NPL;

#define GAS __attribute__((address_space(1)))
#define LAS __attribute__((address_space(3)))
typedef unsigned short bf16_t;
typedef float f32x4 __attribute__((ext_vector_type(4)));
typedef float f32x2 __attribute__((ext_vector_type(2)));
typedef unsigned u32x4 __attribute__((ext_vector_type(4)));
typedef unsigned u32x2 __attribute__((ext_vector_type(2)));
using pg8::cvt_pk_bf16; using pg8::bflo; using pg8::bfhi; using pg8::pk_f16; using pg8::f16lo; using pg8::f16hi;
__device__ __forceinline__ float bf2f(bf16_t h) { return __uint_as_float(((unsigned)h) << 16); }
__device__ __forceinline__ float wave_sum(float v) {
#pragma unroll
    for (int o = 1; o < 64; o <<= 1) v += __shfl_xor(v, o);
    return v;
}
__device__ __forceinline__ float wave_max(float v) {
#pragma unroll
    for (int o = 1; o < 64; o <<= 1) v = fmaxf(v, __shfl_xor(v, o));
    return v;
}
__device__ __forceinline__ int wave_sum_i(int v) {
#pragma unroll
    for (int o = 1; o < 64; o <<= 1) v += __shfl_xor(v, o);
    return v;
}

#define XB_TMO      128
#define XB_XCNT(j)  (256  + 64 * (j))
#define XB_XSUB(j)  (1280 + 64 * (j))
#define XB_XGEN(j)  (2304 + 64 * (j))
#define XB_TOP      3328
#define XB_TOPGEN   3392
#define XCD_BAR_WORDS 3456
#define XB_SPIN_CAP (1u << 23)

__device__ __forceinline__ unsigned xb_ld(unsigned* p)              { return __hip_atomic_load(p, __ATOMIC_RELAXED, __HIP_MEMORY_SCOPE_AGENT); }
__device__ __forceinline__ unsigned xb_add(unsigned* p, unsigned v) { return __hip_atomic_fetch_add(p, v, __ATOMIC_RELAXED, __HIP_MEMORY_SCOPE_AGENT); }
__device__ __forceinline__ unsigned xb_xcc_id() { return (unsigned)__builtin_amdgcn_s_getreg((3 << 11) | 20) & 0xFu; }
#define XB_SPIN(cond, bar) do { unsigned _sp = 0; while (cond) { __builtin_amdgcn_s_sleep(1); \
    if ((++_sp & 255u) == 0u) { if (xb_ld(&(bar)[XB_TMO])) break; if (_sp > XB_SPIN_CAP) { atomicAdd(&(bar)[XB_TMO], 1u); break; } } } } while (0)

struct XcdBarrier {
    unsigned* bar; unsigned x;
    volatile LAS unsigned* st;
};
__device__ __forceinline__ XcdBarrier xcd_barrier_post(unsigned* bar, volatile LAS unsigned* st) {
    XcdBarrier b; b.bar = bar; b.x = xb_xcc_id(); b.st = st;
    if (threadIdx.x == 0) (void)xb_add(&bar[XB_XCNT(b.x)], 1u);
    return b;
}
__device__ __forceinline__ void xcd_barrier_complete(unsigned* bar, unsigned x, unsigned& nloc, unsigned& nx) {
    const unsigned G = gridDim.x * gridDim.y * gridDim.z;
    unsigned sum, cnt, mine, sp = 0u;
    for (;;) {
        sum = 0u; cnt = 0u; mine = 0u;
#pragma unroll
        for (unsigned j = 0; j < 16; ++j) { const unsigned c = xb_ld(&bar[XB_XCNT(j)]); sum += c; cnt += (c > 0u) ? 1u : 0u; mine = (j == x) ? c : mine; }
        if (sum == G) break;
        __builtin_amdgcn_s_sleep(1);
        if ((++sp & 255u) == 0u) { if (xb_ld(&bar[XB_TMO])) break; if (sp > XB_SPIN_CAP) { atomicAdd(&bar[XB_TMO], 1u); break; } }
    }
    nloc = mine > 0u ? mine : 1u; nx = cnt > 0u ? cnt : 1u;
}
__device__ __forceinline__ void xcd_barrier(const XcdBarrier& b) {
    asm volatile("s_waitcnt vmcnt(0)" ::: "memory");
    __syncthreads();
    if (threadIdx.x == 0) {
        unsigned* bar = b.bar;
        __builtin_amdgcn_s_waitcnt(0);
        unsigned nloc = b.st[0], nx = b.st[1];
        if (nloc == 0u) { xcd_barrier_complete(bar, b.x, nloc, nx); b.st[0] = nloc; b.st[1] = nx; }
        const unsigned old = xb_add(&bar[XB_XSUB(b.x)], 1u);
        const unsigned gen = old / nloc;
        if (old + 1u == (gen + 1u) * nloc) {
            __builtin_amdgcn_fence(__ATOMIC_RELEASE, "agent");
            asm volatile("s_waitcnt vmcnt(0)" ::: "memory");
            const unsigned og = xb_add(&bar[XB_TOP], 1u);
            const unsigned tg = og / nx;
            if (og + 1u == (tg + 1u) * nx) xb_add(&bar[XB_TOPGEN], 1u);
            else XB_SPIN(xb_ld(&bar[XB_TOPGEN]) == tg, bar);
            __builtin_amdgcn_fence(__ATOMIC_ACQUIRE, "agent");
            xb_add(&bar[XB_XGEN(b.x)], 1u);
            asm volatile("s_waitcnt vmcnt(0)" ::: "memory");
        } else {
            XB_SPIN(xb_ld(&bar[XB_XGEN(b.x)]) == gen, bar);
            __builtin_amdgcn_fence(__ATOMIC_ACQUIRE, "agent");
            asm volatile("s_waitcnt vmcnt(0)" ::: "memory");
        }
    }
    __syncthreads();
}

__device__ __forceinline__ int win_src_col(int n) {
    if (n < OFF_VA || (n >= OFF_QC && n < OFF_VC)) { const int hb = n & ~127, j = n & 127; return hb + (j >> 1) + (j & 1) * 64; }
    if (n >= OFF_QB && n < OFF_VB) { const int hb = n & ~63, j = n & 63; return hb + (j >> 1) + (j & 1) * 32; }
    return n;
}
__device__ __forceinline__ void tr_item(const float* __restrict__ src, size_t ld, int srccol, int k0, bf16_t* __restrict__ dst_tile, size_t dld, LAS unsigned char* scr, int lane) {
    const float* p = src + (size_t)k0 * ld + srccol;
    float v[64];
#pragma unroll
    for (int j = 0; j < 64; ++j) v[j] = __builtin_nontemporal_load(p + (size_t)j * ld);
    __builtin_amdgcn_sched_barrier(0);
#pragma unroll
    for (int kk = 0; kk < 8; ++kk) { const int o = kk * 8;
        u32x4 w; w.x = pk_f16(v[o + 0], v[o + 1]); w.y = pk_f16(v[o + 2], v[o + 3]); w.z = pk_f16(v[o + 4], v[o + 5]); w.w = pk_f16(v[o + 6], v[o + 7]);
        *(LAS u32x4*)(scr + lane * 144 + kk * 16) = w;
    }
    bf16_t* d = dst_tile + (size_t)(lane >> 3) * dld + (lane & 7) * 8;
#pragma unroll
    for (int i = 0; i < 8; ++i) { const u32x4 w = *(const LAS u32x4*)(scr + (8 * i + (lane >> 3)) * 144 + (lane & 7) * 16); *(u32x4*)(d + (size_t)(8 * i) * dld) = w; }
}
__device__ __forceinline__ unsigned q8x4(float a, float b, float c, float d, float s) {
    const float ca = fminf(fmaxf(a * s, -127.0f), 127.0f) + 12582912.0f, cb = fminf(fmaxf(b * s, -127.0f), 127.0f) + 12582912.0f;
    const float cc = fminf(fmaxf(c * s, -127.0f), 127.0f) + 12582912.0f, cd = fminf(fmaxf(d * s, -127.0f), 127.0f) + 12582912.0f;
    const unsigned lo = __builtin_amdgcn_perm(__float_as_uint(cb), __float_as_uint(ca), 0x0c0c0400u), hi = __builtin_amdgcn_perm(__float_as_uint(cd), __float_as_uint(cc), 0x0c0c0400u);
    return __builtin_amdgcn_perm(hi, lo, 0x05040100u);
}
__device__ __forceinline__ void tr_item8(const float* __restrict__ src, size_t ld, int srccol, int k0, unsigned char* __restrict__ dst_tile, size_t dld, float scale, LAS unsigned char* scr, int lane) {
    const float* p = src + (size_t)k0 * ld + srccol;
    float v[64];
#pragma unroll
    for (int j = 0; j < 64; ++j) v[j] = __builtin_nontemporal_load(p + (size_t)j * ld);
    __builtin_amdgcn_sched_barrier(0);
#pragma unroll
    for (int kk = 0; kk < 4; ++kk) { const int o = kk * 16;
        u32x4 w; w.x = q8x4(v[o + 0], v[o + 1], v[o + 2], v[o + 3], scale); w.y = q8x4(v[o + 4], v[o + 5], v[o + 6], v[o + 7], scale); w.z = q8x4(v[o + 8], v[o + 9], v[o + 10], v[o + 11], scale); w.w = q8x4(v[o + 12], v[o + 13], v[o + 14], v[o + 15], scale);
        *(LAS u32x4*)(scr + lane * 80 + kk * 16) = w;
    }
    unsigned char* d = dst_tile + (size_t)(lane >> 2) * dld + (lane & 3) * 16;
#pragma unroll
    for (int i = 0; i < 4; ++i) { const u32x4 w = *(const LAS u32x4*)(scr + (16 * i + (lane >> 2)) * 80 + (lane & 3) * 16); *(u32x4*)(d + (size_t)(16 * i) * dld) = w; }
}

struct KeyA { int s, r;
    __device__ __forceinline__ int pos(int idx, float& bias) const { bias = 0.f; const int p = s + r * (idx - 64); return (p >= 0 && p < SEQ) ? p : -1; } };
struct KeyB {
    __device__ __forceinline__ int pos(int idx, float& bias) const { bias = 0.f; return idx; } };
struct KeyC { int s;
    __device__ __forceinline__ int pos(int idx, float& bias) const { bias = 0.f; const int p = s + idx - 128; return (p >= 0 && p < SEQ) ? p : -1; } };
struct KeyD { int r, c, rs, cs; const float* rpb;
    __device__ __forceinline__ int pos(int idx, float& bias) const { const int kr = rs + (idx >> 4), kc = cs + (idx & 15); int dc = kc - c; dc = dc < -15 ? -15 : (dc > 15 ? 15 : dc);
        bias = rpb[(kr - r + 7) * 31 + dc + 15]; return kr * 64 + kc; } };

template <int DK, class KF>
__device__ __forceinline__ void sattn(const bf16_t* q, const bf16_t* kb, const bf16_t* vb, const KF& kf, int nkeys, float scale, bool has_sink, float sink,
                                      LAS float* sq, LAS float* ss, int lane, float& o0, float& o1, float& m_out, float& l_out) {
    for (int d = lane; d < DK; d += 64) sq[d] = bf2f(q[d]);
    asm volatile("s_waitcnt lgkmcnt(0)" ::: "memory");
    float mx = -1e30f;
    for (int idx = lane; idx < nkeys; idx += 64) {
        float bias; const int p = kf.pos(idx, bias); float s = -1e30f;
        if (p >= 0) {
            const u32x4* kr = (const u32x4*)(kb + (size_t)p * PROJ_PITCH); float acc = 0.f;
#pragma unroll
            for (int d8 = 0; d8 < DK / 8; ++d8) { const u32x4 w = kr[d8]; const LAS f32x4* qq = (const LAS f32x4*)(sq + d8 * 8); const f32x4 qa = qq[0], qb = qq[1];
                acc += qa[0] * bflo(w.x) + qa[1] * bfhi(w.x) + qa[2] * bflo(w.y) + qa[3] * bfhi(w.y) + qb[0] * bflo(w.z) + qb[1] * bfhi(w.z) + qb[2] * bflo(w.w) + qb[3] * bfhi(w.w); }
            s = acc * scale + bias;
        }
        ss[idx] = s; mx = fmaxf(mx, s);
    }
    mx = wave_max(mx); if (has_sink) mx = fmaxf(mx, sink);
    float sum = 0.f;
    for (int idx = lane; idx < nkeys; idx += 64) { const float s = ss[idx]; const float p = (s > -1e29f) ? __expf(s - mx) : 0.f; ss[idx] = p; sum += p; }
    sum = wave_sum(sum); if (has_sink) sum += __expf(sink - mx);
    asm volatile("s_waitcnt lgkmcnt(0)" ::: "memory");
    o0 = 0.f; o1 = 0.f;
    for (int idx = 0; idx < nkeys; ++idx) {
        const float p = ss[idx];
        if (p != 0.f) { float bias; const int pp = kf.pos(idx, bias); const unsigned w = *(const unsigned*)(vb + (size_t)pp * PROJ_PITCH + 2 * lane); o0 += p * bflo(w); o1 += p * bfhi(w); }
    }
    const float inv = 1.0f / sum; o0 *= inv; o1 *= inv; m_out = mx; l_out = sum;
    asm volatile("s_waitcnt lgkmcnt(0)" ::: "memory");
}

struct AttnPtrs { const bf16_t* proj; bf16_t* ag; float* lse; bf16_t* ob; bf16_t* oc; bf16_t* od; const float* lam; const float* subln; const float* sink; const float* rpb; float lambda_init; };

template <int WHICH>
__device__ __forceinline__ void scalar_attn_phase(const AttnPtrs& P, LAS unsigned char* lds, int gw, int NGW, int wave, int lane) {
    LAS float* sq = (LAS float*)(lds + wave * 16896); LAS float* ss = sq + 128;
    constexpr int NH = WHICH == 0 ? 18 : 8;
    float lmbda = 0.f;
    if constexpr (WHICH == 1) { const float d01 = wave_sum(P.lam[lane] * P.lam[64 + lane]), d23 = wave_sum(P.lam[128 + lane] * P.lam[192 + lane]); lmbda = __expf(d01) - __expf(d23) + P.lambda_init; }
    for (int task = gw; task < NH * MTOK; task += NGW) {
        const int hs = task / MTOK, row = task % MTOK, b = row >> 12, s = row & 4095;
        const bf16_t* prow = P.proj + (size_t)row * PROJ_PITCH; const bf16_t* pb = P.proj + (size_t)(b * SEQ) * PROJ_PITCH;
        float o0, o1, mm, ll;
        if constexpr (WHICH == 0) {
            const int hh = hs, g = hh / 6, r = (g == 0) ? 1 : ((g == 1) ? 4 : 16); KeyA kf{s, r};
            sattn<128>(prow + OFF_QA + hh * 128, pb + OFF_KA + hh * 128, pb + OFF_VA + hh * 128, kf, 129, 0.08838834764831845f, false, 0.f, sq, ss, lane, o0, o1, mm, ll);
            *(unsigned*)(P.ag + ((size_t)g * MTOK + row) * 768 + (hh % 6) * 128 + 2 * lane) = cvt_pk_bf16(o0, o1);
            if (lane == 0) P.lse[((size_t)g * MTOK + row) * 6 + (hh % 6)] = mm + __logf(ll);
        } else if constexpr (WHICH == 1) {
            const int h = hs; KeyB kf; float a0, a1, b0, b1;
            sattn<64>(prow + OFF_QB + (2 * h) * 64, pb + OFF_KB + (2 * h) * 64, pb + OFF_VB + h * 128, kf, SEQ, 0.125f, false, 0.f, sq, ss, lane, a0, a1, mm, ll);
            sattn<64>(prow + OFF_QB + (2 * h + 1) * 64, pb + OFF_KB + (2 * h + 1) * 64, pb + OFF_VB + h * 128, kf, SEQ, 0.125f, false, 0.f, sq, ss, lane, b0, b1, mm, ll);
            const float v0 = a0 - lmbda * b0, v1 = a1 - lmbda * b1;
            const float rinv = rsqrtf(wave_sum(v0 * v0 + v1 * v1) * (1.0f / 128.0f) + SUBLN_EPS) * (1.0f - P.lambda_init);
            *(unsigned*)(P.ob + (size_t)row * 1024 + h * 128 + 2 * lane) = cvt_pk_bf16(v0 * rinv * P.subln[2 * lane], v1 * rinv * P.subln[2 * lane + 1]);
        } else if constexpr (WHICH == 2) {
            const int qh = hs, kvh = qh >> 2; KeyC kf{s};
            sattn<128>(prow + OFF_QC + qh * 128, pb + OFF_KC + kvh * 128, pb + OFF_VC + kvh * 128, kf, 257, 0.08838834764831845f, true, P.sink[qh], sq, ss, lane, o0, o1, mm, ll);
            *(unsigned*)(P.oc + (size_t)row * 1024 + qh * 128 + 2 * lane) = cvt_pk_bf16(o0, o1);
        } else {
            const int h = hs, r = s >> 6, c = s & 63; int rs = r - 4; rs = rs < 0 ? 0 : (rs > 56 ? 56 : rs); int cs = c - 8; cs = cs < 0 ? 0 : (cs > 48 ? 48 : cs);
            KeyD kf{r, c, rs, cs, P.rpb + h * 465};
            sattn<128>(prow + OFF_QD + h * 128, pb + OFF_KD + h * 128, pb + OFF_VD + h * 128, kf, 128, 0.08838834764831845f, false, 0.f, sq, ss, lane, o0, o1, mm, ll);
            *(unsigned*)(P.od + (size_t)row * 1024 + h * 128 + 2 * lane) = cvt_pk_bf16(o0, o1);
        }
    }
}

__device__ __forceinline__ void combine_a_phase(const bf16_t* ag, const float* lse, unsigned* oa8, int gw, int NGW, int lane) {
    for (int row0 = gw; row0 < MTOK; row0 += 4 * NGW) {
        float lc[4][3][3]; u32x2 ac[4][3][3];
#pragma unroll
        for (int u = 0; u < 4; ++u) { const int row = row0 + u * NGW; if (row < MTOK) {
#pragma unroll
            for (int j = 0; j < 3; ++j) { const int e = 4 * lane + 256 * j, head = e >> 7;
#pragma unroll
                for (int g = 0; g < 3; ++g) { lc[u][j][g] = lse[((size_t)g * MTOK + row) * 6 + head]; ac[u][j][g] = *(const u32x2*)(ag + ((size_t)g * MTOK + row) * 768 + e); } } } }
#pragma unroll
        for (int u = 0; u < 4; ++u) { const int row = row0 + u * NGW; if (row >= MTOK) break;
#pragma unroll
            for (int j = 0; j < 3; ++j) {
                const int e = 4 * lane + 256 * j;
                const float l0 = lc[u][j][0], l1 = lc[u][j][1], l2 = lc[u][j][2];
                const float mx = fmaxf(l0, fmaxf(l1, l2)); float w0 = __expf(l0 - mx), w1 = __expf(l1 - mx), w2 = __expf(l2 - mx); const float inv = 1.0f / (w0 + w1 + w2); w0 *= inv; w1 *= inv; w2 *= inv;
                const u32x2 a0 = ac[u][j][0], a1 = ac[u][j][1], a2 = ac[u][j][2];
                oa8[(size_t)row * 256 + (e >> 2)] = q8x4(w0 * bflo(a0.x) + w1 * bflo(a1.x) + w2 * bflo(a2.x), w0 * bfhi(a0.x) + w1 * bfhi(a1.x) + w2 * bfhi(a2.x),
                                                      w0 * bflo(a0.y) + w1 * bflo(a1.y) + w2 * bflo(a2.y), w0 * bfhi(a0.y) + w1 * bfhi(a1.y) + w2 * bfhi(a2.y), QO);
            } }
    }
}
__device__ __forceinline__ void ln1_router_phase(const bf16_t* preln, const float* gain, const float* bias, const float* wr, float* stats, unsigned* x8, float* aff,
                                                 LAS unsigned char* lds, int tid, int gw, int NGW, int lane) {
    LAS float* W = (LAS float*)lds;
    u32x2 vn[8];
    if (gw < MTOK) {
#pragma unroll
        for (int j = 0; j < 8; ++j) vn[j] = *(const u32x2*)(preln + (size_t)gw * DM + 4 * lane + 256 * j);
    }
    f32x4 g[8], bb[8];
#pragma unroll
    for (int j = 0; j < 8; ++j) { g[j] = *(const f32x4*)(gain + 256 * j + 4 * lane); bb[j] = *(const f32x4*)(bias + 256 * j + 4 * lane); }
    { f32x4 w4[16];
#pragma unroll
      for (int it = 0; it < 16; ++it) w4[it] = *(const f32x4*)(wr + 4 * (size_t)(tid + it * (NWAVES * 64)));
#pragma unroll
      for (int it = 0; it < 16; ++it) { const int i4 = tid + it * (NWAVES * 64), k = i4 >> 2, e0 = (i4 & 3) * 4;
          W[(e0 + 0) * DM + k] = w4[it][0]; W[(e0 + 1) * DM + k] = w4[it][1]; W[(e0 + 2) * DM + k] = w4[it][2]; W[(e0 + 3) * DM + k] = w4[it][3]; } }
    __syncthreads();
    for (int row = gw; row < MTOK; row += NGW) {
        f32x4 v[8]; float s = 0.f;
#pragma unroll
        for (int j = 0; j < 8; ++j) { v[j] = (f32x4){f16lo(vn[j].x), f16hi(vn[j].x), f16lo(vn[j].y), f16hi(vn[j].y)}; s += (v[j][0] + v[j][1]) + (v[j][2] + v[j][3]); }
        if (row + NGW < MTOK) {
#pragma unroll
            for (int j = 0; j < 8; ++j) vn[j] = *(const u32x2*)(preln + (size_t)(row + NGW) * DM + 4 * lane + 256 * j);
        }
        const float mean = wave_sum(s) * (1.0f / DM); float q = 0.f;
#pragma unroll
        for (int j = 0; j < 8; ++j) { v[j] = v[j] - mean; q += (v[j][0] * v[j][0] + v[j][1] * v[j][1]) + (v[j][2] * v[j][2] + v[j][3] * v[j][3]); }
        const float rstd = rsqrtf(wave_sum(q) * (1.0f / DM) + LN_EPS);
        if (lane == 0) *(f32x2*)(stats + 2 * (size_t)row) = (f32x2){mean, rstd};
        unsigned* x8o = x8 + (size_t)row * (DM / 4) + lane;
#pragma unroll
        for (int j = 0; j < 8; ++j) { v[j] = v[j] * rstd * g[j] + bb[j]; x8o[64 * j] = q8x4(v[j][0], v[j][1], v[j][2], v[j][3], QX); }
        float a[16];
        f32x4 wa[8], wb[8];
#define LN1_LDW(dst, e) do { _Pragma("unroll") for (int j = 0; j < 8; ++j) dst[j] = *(const LAS f32x4*)(W + (e) * DM + 256 * j + 4 * lane); } while (0)
#define LN1_DOT(src, e) do { f32x2 t2 = {0.f, 0.f}; _Pragma("unroll") for (int j = 0; j < 8; ++j) { \
            t2 = __builtin_elementwise_fma((f32x2){v[j][0], v[j][1]}, (f32x2){src[j][0], src[j][1]}, t2); t2 = __builtin_elementwise_fma((f32x2){v[j][2], v[j][3]}, (f32x2){src[j][2], src[j][3]}, t2); } \
            a[e] = t2[0] + t2[1]; } while (0)
        LN1_LDW(wa, 0);
#pragma unroll
        for (int e = 0; e < 16; e += 2) {
            LN1_LDW(wb, e + 1); asm volatile("" ::: "memory"); LN1_DOT(wa, e); asm volatile("" ::: "memory");
            if (e + 2 < 16) LN1_LDW(wa, e + 2);
            asm volatile("" ::: "memory"); LN1_DOT(wb, e + 1); asm volatile("" ::: "memory"); }
#undef LN1_LDW
#undef LN1_DOT
        float r8[8], r4[4], r2[2], r1;
        { const bool up = (lane & 32) != 0;
#pragma unroll
          for (int i = 0; i < 8; ++i) { const float keep = up ? a[i + 8] : a[i], send = up ? a[i] : a[i + 8]; r8[i] = keep + __shfl_xor(send, 32); } }
        { const bool up = (lane & 16) != 0;
#pragma unroll
          for (int i = 0; i < 4; ++i) { const float keep = up ? r8[i + 4] : r8[i], send = up ? r8[i] : r8[i + 4]; r4[i] = keep + __shfl_xor(send, 16); } }
        { const bool up = (lane & 8) != 0;
#pragma unroll
          for (int i = 0; i < 2; ++i) { const float keep = up ? r4[i + 2] : r4[i], send = up ? r4[i] : r4[i + 2]; r2[i] = keep + __shfl_xor(send, 8); } }
        { const bool up = (lane & 4) != 0; const float keep = up ? r2[1] : r2[0], send = up ? r2[0] : r2[1]; r1 = keep + __shfl_xor(send, 4); }
        r1 += __shfl_xor(r1, 1); r1 += __shfl_xor(r1, 2);
        float mx = r1;
#pragma unroll
        for (int o = 4; o < 64; o <<= 1) mx = fmaxf(mx, __shfl_xor(mx, o));
        const float ex = expf(r1 - mx); float den = ex;
#pragma unroll
        for (int o = 4; o < 64; o <<= 1) den += __shfl_xor(den, o);
        const int eidx = ((lane >> 5) & 1) * 8 + ((lane >> 4) & 1) * 4 + ((lane >> 3) & 1) * 2 + ((lane >> 2) & 1);
        if ((lane & 3) == 0) aff[((size_t)(row >> 12) * NEXP + eidx) * SEQ + (row & 4095)] = ex / den;
    }
    __syncthreads();
}
__device__ __forceinline__ void topk_phase(const float* aff, int* idxo, float* gvo, int* sloto, LAS unsigned char* lds, int tid, int wave, int lane, int wg, int G) {
    LAS int* cnt = (LAS int*)lds;
    for (int be = wg; be < NGRP; be += G) {
        const float* a = aff + (size_t)be * SEQ + tid * 8;
        const f32x4 a0 = *(const f32x4*)a, a1 = *(const f32x4*)(a + 4);
        unsigned v[8] = {__float_as_uint(a0[0]), __float_as_uint(a0[1]), __float_as_uint(a0[2]), __float_as_uint(a0[3]), __float_as_uint(a1[0]), __float_as_uint(a1[1]), __float_as_uint(a1[2]), __float_as_uint(a1[3])};
        unsigned T = 0u;
        for (int bit = 30; bit >= 0; --bit) {
            const unsigned cand = T | (1u << bit); int c = 0;
#pragma unroll
            for (int k = 0; k < 8; ++k) c += (v[k] >= cand) ? 1 : 0;
            c = wave_sum_i(c);
            if (lane == 0) cnt[(bit & 1) * 8 + wave] = c;
            __syncthreads();
            int tot = 0;
#pragma unroll
            for (int w = 0; w < 8; ++w) tot += cnt[(bit & 1) * 8 + w];
            if (tot >= CAP) T = cand;
        }
        int ngt = 0, neq = 0;
#pragma unroll
        for (int k = 0; k < 8; ++k) { ngt += (v[k] > T) ? 1 : 0; neq += (v[k] == T) ? 1 : 0; }
        int sgt = ngt, seq = neq;
#pragma unroll
        for (int o = 1; o < 64; o <<= 1) { const int tg = __shfl_up(sgt, o), te = __shfl_up(seq, o); if (lane >= o) { sgt += tg; seq += te; } }
        __syncthreads();
        if (lane == 63) { cnt[64 + wave] = sgt; cnt[64 + 8 + wave] = seq; }
        __syncthreads();
        int pgt = sgt - ngt, peq = seq - neq, totgt = 0;
#pragma unroll
        for (int w = 0; w < 8; ++w) { const int tg = cnt[64 + w], te = cnt[64 + 8 + w]; if (w < wave) { pgt += tg; peq += te; } totgt += tg; }
        const int need = CAP - totgt;
        const int b = be >> 4, e = be & 15;
#pragma unroll
        for (int k = 0; k < 8; ++k) {
            const bool gt = v[k] > T, eq = v[k] == T; const bool sel = gt || (eq && peq < need);
            const int slot = pgt + (peq < need ? peq : need);
            const int tok = tid * 8 + k;
            if (sel) { idxo[be * CAP + slot] = tok; gvo[be * CAP + slot] = __uint_as_float(v[k]); }
            sloto[((size_t)b * SEQ + tok) * NEXP + e] = sel ? slot : -1;
            pgt += gt ? 1 : 0; peq += eq ? 1 : 0;
        }
        __syncthreads();
    }
}
__device__ __forceinline__ void gather_phase(const bf16_t* xb, const int* idx, bf16_t* xg, int gw, int NGW, int lane) {
    for (int r = gw; r < NGRP * CAP; r += NGW) {
        const int be = r >> 9, b = be >> 4; const int tok = idx[r];
        const u32x4* src = (const u32x4*)(xb + ((size_t)b * SEQ + tok) * DM); u32x4* dst = (u32x4*)(xg + (size_t)r * DM);
#pragma unroll
        for (int j = 0; j < 4; ++j) dst[64 * j + lane] = src[64 * j + lane];
    }
}
__device__ __forceinline__ void ln2_phase(const bf16_t* x1, const float* stats, const float* gain1, const float* bias1, const bf16_t* y, const int* slot, const float* gain, const float* bias, float* xo_base, bf16_t* xh, bf16_t* xb, unsigned char* x8, int gw, int NGW, int lane) {
    u32x4 xn[4]; int slot_n = -1;
    if (gw < MTOK) { slot_n = slot[(size_t)gw * NEXP + (lane & 15)];
#pragma unroll
        for (int j = 0; j < 4; ++j) xn[j] = *(const u32x4*)(x1 + (size_t)gw * DM + 512 * j + 8 * lane); }
    for (int row = gw; row < MTOK; row += NGW) {
        const int b = row >> 12; const int myslot = slot_n;
        f32x4 xc[8];
#pragma unroll
        for (int j = 0; j < 4; ++j) { xc[2 * j] = (f32x4){f16lo(xn[j].x), f16hi(xn[j].x), f16lo(xn[j].y), f16hi(xn[j].y)}; xc[2 * j + 1] = (f32x4){f16lo(xn[j].z), f16hi(xn[j].z), f16lo(xn[j].w), f16hi(xn[j].w)}; }
        unsigned hits = (unsigned)(__ballot(myslot >= 0) & 0xffffull);
        const bool h0 = hits != 0u; const int e0 = h0 ? __builtin_ctz(hits) : 0; if (h0) hits &= hits - 1;
        const bool h1 = hits != 0u; const int e1 = h1 ? __builtin_ctz(hits) : e0; if (h1) hits &= hits - 1;
        int sl0 = __shfl(myslot, e0), sl1 = __shfl(myslot, e1); sl0 = sl0 < 0 ? 0 : sl0; sl1 = sl1 < 0 ? 0 : sl1;
        const f32x2 st = *(const f32x2*)(stats + 2 * (size_t)row);
        f32x4 ga[4], gb[4], ba[4], bv[4];
#pragma unroll
        for (int j = 0; j < 4; ++j) { ga[j] = *(const f32x4*)(gain1 + 512 * j + 8 * lane); gb[j] = *(const f32x4*)(gain1 + 512 * j + 8 * lane + 4);
            ba[j] = *(const f32x4*)(bias1 + 512 * j + 8 * lane); bv[j] = *(const f32x4*)(bias1 + 512 * j + 8 * lane + 4); }
        u32x4 ya[4], yb[4];
        { const bf16_t* yr0 = y + ((size_t)(b * NEXP + e0) * CAP + sl0) * DM + 8 * lane; const bf16_t* yr1 = y + ((size_t)(b * NEXP + e1) * CAP + sl1) * DM + 8 * lane;
#pragma unroll
          for (int j = 0; j < 4; ++j) ya[j] = *(const u32x4*)(yr0 + 512 * j);
#pragma unroll
          for (int j = 0; j < 4; ++j) yb[j] = *(const u32x4*)(yr1 + 512 * j); }
        if (row + NGW < MTOK) { slot_n = slot[(size_t)(row + NGW) * NEXP + (lane & 15)];
#pragma unroll
            for (int j = 0; j < 4; ++j) xn[j] = *(const u32x4*)(x1 + (size_t)(row + NGW) * DM + 512 * j + 8 * lane); }
#pragma unroll
        for (int j = 0; j < 4; ++j) { xc[2 * j] = (xc[2 * j] - st[0]) * st[1] * ga[j] + ba[j]; xc[2 * j + 1] = (xc[2 * j + 1] - st[0]) * st[1] * gb[j] + bv[j]; }
        f32x4 acc[8];
#pragma unroll
        for (int j = 0; j < 8; ++j) acc[j] = (f32x4){0.f, 0.f, 0.f, 0.f};
#define LN2_ACC(Y_, j) do { acc[2 * j][0] += bflo((Y_).x); acc[2 * j][1] += bfhi((Y_).x); acc[2 * j][2] += bflo((Y_).y); acc[2 * j][3] += bfhi((Y_).y); \
            acc[2 * j + 1][0] += bflo((Y_).z); acc[2 * j + 1][1] += bfhi((Y_).z); acc[2 * j + 1][2] += bflo((Y_).w); acc[2 * j + 1][3] += bfhi((Y_).w); } while (0)
        if (h0) {
#pragma unroll
            for (int j = 0; j < 4; ++j) LN2_ACC(ya[j], j); }
        if (h1) {
#pragma unroll
            for (int j = 0; j < 4; ++j) LN2_ACC(yb[j], j); }
        while (hits) {
            const int e = __builtin_ctz(hits); hits &= hits - 1;
            const int sl = __shfl(myslot, e);
            const bf16_t* yr = y + ((size_t)(b * NEXP + e) * CAP + sl) * DM + 8 * lane;
#pragma unroll
            for (int j = 0; j < 4; ++j) { const u32x4 w = *(const u32x4*)(yr + 512 * j); LN2_ACC(w, j); }
        }
#undef LN2_ACC
        float s = 0.f;
#pragma unroll
        for (int j = 0; j < 8; ++j) { acc[j] = xc[j] * ALPHA + acc[j]; s += (acc[j][0] + acc[j][1]) + (acc[j][2] + acc[j][3]); }
        const float mean = wave_sum(s) * (1.0f / DM); float q = 0.f;
#pragma unroll
        for (int j = 0; j < 8; ++j) { acc[j] = acc[j] - mean; q += (acc[j][0] * acc[j][0] + acc[j][1] * acc[j][1]) + (acc[j][2] * acc[j][2] + acc[j][3] * acc[j][3]); }
        const float rstd = rsqrtf(wave_sum(q) * (1.0f / DM) + LN_EPS);
        float* xo = xo_base + (size_t)row * DM + 8 * lane; (void)xb; bf16_t* xho = xh + (size_t)row * DM + 8 * lane;
#pragma unroll
        for (int j = 0; j < 4; ++j) { const f32x4 g0 = *(const f32x4*)(gain + 512 * j + 8 * lane), g1 = *(const f32x4*)(gain + 512 * j + 8 * lane + 4), b0 = *(const f32x4*)(bias + 512 * j + 8 * lane), b1 = *(const f32x4*)(bias + 512 * j + 8 * lane + 4);
            const f32x4 o0 = acc[2 * j] * rstd * g0 + b0, o1 = acc[2 * j + 1] * rstd * g1 + b1;
            if (!x8) { *(f32x4*)(xo + 512 * j) = o0; *(f32x4*)(xo + 512 * j + 4) = o1; }
            else { u32x4 hw; hw.x = pk_f16(o0[0], o0[1]); hw.y = pk_f16(o0[2], o0[3]); hw.z = pk_f16(o1[0], o1[1]); hw.w = pk_f16(o1[2], o1[3]); *(u32x4*)(xho + 512 * j) = hw; }
            if (x8) {
                u32x2 q; q.x = q8x4(o0[0], o0[1], o0[2], o0[3], QX); q.y = q8x4(o1[0], o1[1], o1[2], o1[3], QX); *(u32x2*)(x8 + (size_t)row * DM + 8 * lane + 512 * j) = q; } }
    }
}

namespace att {
typedef short bf16x8 __attribute__((ext_vector_type(8)));
typedef short s16x4 __attribute__((ext_vector_type(4)));
typedef float f32x16 __attribute__((ext_vector_type(16)));
constexpr int VBYTES = 16384, KOFF = 2 * VBYTES, WSOFF = 65536, TABOFF = WSOFF + 2048, QOFF = TABOFF + 2048, ATTN_LDS = QOFF + 32768;
constexpr float NEG = -1e30f, M0 = -1e29f;
#define ATT_SBAR() __builtin_amdgcn_sched_barrier(0)
__device__ __forceinline__ int crow(int r, int hi) { return (r & 3) + 8 * (r >> 2) + 4 * hi; }
__device__ __forceinline__ unsigned cvtpk(float lo, float hi) { unsigned r; asm volatile("v_cvt_pk_bf16_f32 %0, %1, %2" : "=v"(r) : "v"(lo), "v"(hi)); return r; }
__device__ __forceinline__ int kswz128(int row, int colB) { return row * 256 + (colB ^ ((row & 7) << 4)); }
__device__ __forceinline__ int kswz64(int row, int colB) { return row * 128 + (colB ^ (((row >> 1) & 7) << 4)); }

__device__ __forceinline__ void partialSM(f32x16& p0, f32x16& p1, float& m_reg, float& mn, float& alpha, const float C, const float thr_raw) {
    float pmax = p0[0];
#pragma unroll
    for (int r = 1; r < 16; ++r) pmax = fmaxf(pmax, p0[r]);
#pragma unroll
    for (int r = 0; r < 16; ++r) pmax = fmaxf(pmax, p1[r]);
    { auto rr = __builtin_amdgcn_permlane32_swap(__float_as_uint(pmax), __float_as_uint(pmax), false, false); pmax = fmaxf(__uint_as_float(rr[0]), __uint_as_float(rr[1])); }
    if (__all(pmax - m_reg <= thr_raw)) { mn = m_reg; alpha = 1.f; }
    else { mn = fmaxf(m_reg, pmax); alpha = __builtin_amdgcn_exp2f((m_reg - mn) * C); m_reg = mn; }
    const float mnC = -mn * C;
#pragma unroll
    for (int r = 0; r < 16; ++r) p0[r] = fmaf(p0[r], C, mnC);
#pragma unroll
    for (int r = 0; r < 16; ++r) p1[r] = fmaf(p1[r], C, mnC);
#pragma unroll
    for (int r = 0; r < 16; ++r) p0[r] = __builtin_amdgcn_exp2f(p0[r]);
}
__device__ __forceinline__ void finishSM(f32x16& p0, f32x16& p1, float alpha, float& l_reg, bf16x8& pa0, bf16x8& pa1, bf16x8& pa2, bf16x8& pa3) {
#pragma unroll
    for (int r = 0; r < 16; ++r) p1[r] = __builtin_amdgcn_exp2f(p1[r]);
    float ps = 0;
#pragma unroll
    for (int r = 0; r < 16; ++r) ps += p0[r];
#pragma unroll
    for (int r = 0; r < 16; ++r) ps += p1[r];
    { auto rr = __builtin_amdgcn_permlane32_swap(__float_as_uint(ps), __float_as_uint(ps), false, false); ps = __uint_as_float(rr[0]) + __uint_as_float(rr[1]); }
    l_reg = l_reg * alpha + ps;
#define ATT_PK4(P, BASE, OUT) do { unsigned a0 = cvtpk(P[BASE + 0], P[BASE + 1]), a1 = cvtpk(P[BASE + 2], P[BASE + 3]);   \
    unsigned b0 = cvtpk(P[BASE + 4], P[BASE + 5]), b1 = cvtpk(P[BASE + 6], P[BASE + 7]);                              \
    auto r0 = __builtin_amdgcn_permlane32_swap(a0, b0, false, false); auto r1 = __builtin_amdgcn_permlane32_swap(a1, b1, false, false); \
    u32x4 w = {r0[0], r1[0], r0[1], r1[1]}; OUT = __builtin_bit_cast(bf16x8, w); } while (0)
    ATT_PK4(p0, 0, pa0); ATT_PK4(p0, 8, pa1); ATT_PK4(p1, 0, pa2); ATT_PK4(p1, 8, pa3);
#undef ATT_PK4
}
template <int DK>
__device__ __forceinline__ void qkt(f32x16& p0, f32x16& p1, const LAS char* Ks, const bf16x8* qr, int r32, int hi) {
    p0 = f32x16{}; p1 = f32x16{};
#pragma unroll
    for (int d0 = 0; d0 < DK / 16; ++d0) { const int cb = (d0 * 16 + hi * 8) * 2;
        const bf16x8 b0 = *(const LAS bf16x8*)(Ks + (DK == 128 ? kswz128(r32, cb) : kswz64(r32, cb)));
        const bf16x8 b1 = *(const LAS bf16x8*)(Ks + (DK == 128 ? kswz128(32 + r32, cb) : kswz64(32 + r32, cb)));
        p0 = __builtin_amdgcn_mfma_f32_32x32x16_bf16(b0, qr[d0], p0, 0, 0, 0);
        p1 = __builtin_amdgcn_mfma_f32_32x32x16_bf16(b1, qr[d0], p1, 0, 0, 0); }
}
__device__ __forceinline__ void qkt64_ldsq(f32x16& p0, f32x16& p1, const LAS char* Ks, const LAS char* qb_l, int r32, int hi) {
    unsigned qa = (unsigned)(__UINTPTR_TYPE__)qb_l; asm volatile("" : "+v"(qa)); const LAS char* qp = (const LAS char*)(__UINTPTR_TYPE__)qa;
    p0 = f32x16{}; p1 = f32x16{};
#pragma unroll
    for (int d0 = 0; d0 < 4; ++d0) { const int cb = (d0 * 16 + hi * 8) * 2;
        const bf16x8 q = *(const LAS bf16x8*)(qp + d0 * 1024);
        const bf16x8 b0 = *(const LAS bf16x8*)(Ks + kswz64(r32, cb));
        const bf16x8 b1 = *(const LAS bf16x8*)(Ks + kswz64(32 + r32, cb));
        p0 = __builtin_amdgcn_mfma_f32_32x32x16_bf16(b0, q, p0, 0, 0, 0);
        p1 = __builtin_amdgcn_mfma_f32_32x32x16_bf16(b1, q, p1, 0, 0, 0); }
}
__device__ __forceinline__ int v_st(int k, int c) { const int kk = (k & ~0xC) | ((k & 4) << 1) | ((k & 8) >> 1); return ((kk >> 3) * 4 + (c >> 5)) * 512 + ((kk & 7) * 32 + (c & 31)) * 2; }
__device__ __forceinline__ int v_rd_base(int lane) { return ((lane & 3) << 3) | (((lane >> 2) & 3) << 6) | (((lane >> 4) & 1) << 5) | (((lane >> 5) & 1) << 8); }
constexpr int v_rd_off(int d0, int ks, int half) { return d0 * 512 + ks * 4096 + half * 2048; }
template <int OFF> __device__ __forceinline__ s16x4 tr_read(int vb) { s16x4 r; asm volatile("ds_read_b64_tr_b16 %0, %1 offset:%2" : "=&v"(r) : "v"(vb), "i"(OFF) : "memory"); return r; }
template <int D0> __device__ __forceinline__ void pv_one(f32x16& od, int vb, bf16x8 pa0, bf16x8 pa1, bf16x8 pa2, bf16x8 pa3) {
    const s16x4 l0 = tr_read<v_rd_off(D0, 0, 0)>(vb), h0 = tr_read<v_rd_off(D0, 0, 1)>(vb), l1 = tr_read<v_rd_off(D0, 1, 0)>(vb), h1 = tr_read<v_rd_off(D0, 1, 1)>(vb);
    const s16x4 l2 = tr_read<v_rd_off(D0, 2, 0)>(vb), h2 = tr_read<v_rd_off(D0, 2, 1)>(vb), l3 = tr_read<v_rd_off(D0, 3, 0)>(vb), h3 = tr_read<v_rd_off(D0, 3, 1)>(vb);
    asm volatile("s_waitcnt lgkmcnt(0)" ::: "memory"); ATT_SBAR();
#define ATT_PK(L, H) (bf16x8){L[0], L[1], L[2], L[3], H[0], H[1], H[2], H[3]}
    od = __builtin_amdgcn_mfma_f32_32x32x16_bf16(pa0, ATT_PK(l0, h0), od, 0, 0, 0);
    od = __builtin_amdgcn_mfma_f32_32x32x16_bf16(pa1, ATT_PK(l1, h1), od, 0, 0, 0);
    od = __builtin_amdgcn_mfma_f32_32x32x16_bf16(pa2, ATT_PK(l2, h2), od, 0, 0, 0);
    od = __builtin_amdgcn_mfma_f32_32x32x16_bf16(pa3, ATT_PK(l3, h3), od, 0, 0, 0);
#undef ATT_PK
}
__device__ __forceinline__ void pv_d0(f32x16* o, int vb, bf16x8 pa0, bf16x8 pa1, bf16x8 pa2, bf16x8 pa3) {
    pv_one<0>(o[0], vb, pa0, pa1, pa2, pa3); pv_one<1>(o[1], vb, pa0, pa1, pa2, pa3); pv_one<2>(o[2], vb, pa0, pa1, pa2, pa3); pv_one<3>(o[3], vb, pa0, pa1, pa2, pa3);
}

template <int DK, class Pol>
__device__ __forceinline__ void attn_unit(const Pol& P, LAS char* lds, const int tid_in) {
    int tid = tid_in; asm volatile("" : "+v"(tid));
    const int wid = __builtin_amdgcn_readfirstlane(tid >> 6), lane = tid & 63, r32 = lane & 31, hi = lane >> 5;
    LAS char* V_lds = lds; LAS char* K_lds = lds + KOFF; constexpr int KBYTES = 64 * DK * 2;
    LAS float* wsx = (LAS float*)(lds + WSOFF) + wid * 64; LAS float* li_l = wsx; LAS float* al_l = wsx + 32;
    const float C = Pol::SCALE * 1.4426950408889634f, thr_raw = 8.0f / Pol::SCALE;
    float m_reg = P.m0w(wid), l_reg = P.l0(); f32x16 o[4] = {}; bf16x8 qr[DK / 16];
    { const bf16_t* qp = P.q_row(wid * 32 + r32) + hi * 8;
#pragma unroll
      for (int d0 = 0; d0 < DK / 16; ++d0) qr[d0] = *(const bf16x8*)(qp + d0 * 16); }
    const int sr = tid >> 4, sc = (tid & 15) * 8, vst0 = v_st(sr, sc), vst1 = v_st(32 + sr, sc);
    const int k64r = tid >> 3, k64c = (tid & 7) * 8;
    const int vb0 = (int)(unsigned)(__UINTPTR_TYPE__)V_lds + v_rd_base(lane);
    bf16x8 aV0, aV1, aK0, aK1, bV0, bV1, bK0, bK1;
#define ATT_LOADX(V0, V1, K0, K1, t) do { V0 = *(const bf16x8*)(P.v_row((t), sr) + sc); V1 = *(const bf16x8*)(P.v_row((t), 32 + sr) + sc); \
        if constexpr (DK == 128) { K0 = *(const bf16x8*)(P.k_row((t), sr) + sc); K1 = *(const bf16x8*)(P.k_row((t), 32 + sr) + sc); } \
        else { K0 = *(const bf16x8*)(P.k_row((t), k64r) + k64c); K1 = K0; } } while (0)
#define ATT_WRITEX(V0, V1, K0, K1, b) do { *(LAS bf16x8*)(V_lds + (b) * VBYTES + vst0) = V0; *(LAS bf16x8*)(V_lds + (b) * VBYTES + vst1) = V1; \
        if constexpr (DK == 128) { *(LAS bf16x8*)(K_lds + (b) * KBYTES + kswz128(sr, sc * 2)) = K0; *(LAS bf16x8*)(K_lds + (b) * KBYTES + kswz128(32 + sr, sc * 2)) = K1; } \
        else { *(LAS bf16x8*)(K_lds + (b) * KBYTES + kswz64(k64r, k64c * 2)) = K0; } } while (0)
#define ATT_COMPUTE(t, b) do { if (P.wave_needs((t), wid)) { \
            f32x16 p0, p1; float mn, alpha; bf16x8 pa0, pa1, pa2, pa3; \
            qkt<DK>(p0, p1, K_lds + (b) * KBYTES, qr, r32, hi); \
            P.mask(p0, p1, (t), wid, r32, hi, lds); \
            partialSM(p0, p1, m_reg, mn, alpha, C, thr_raw); \
            if (__any(alpha < 1.f)) { if (hi == 0) al_l[r32] = alpha; asm volatile("s_waitcnt lgkmcnt(0)" ::: "memory"); \
                _Pragma("unroll") for (int d = 0; d < 4; ++d) _Pragma("unroll") for (int r = 0; r < 16; ++r) o[d][r] *= al_l[crow(r, hi)]; } \
            finishSM(p0, p1, alpha, l_reg, pa0, pa1, pa2, pa3); ATT_SBAR(); \
            pv_d0(o, vb0 + (b) * VBYTES, pa0, pa1, pa2, pa3); } } while (0)
    const int NT = P.ntiles();
    ATT_LOADX(aV0, aV1, aK0, aK1, 0);
    if (NT > 1) ATT_LOADX(bV0, bV1, bK0, bK1, 1);
    for (int t = 0; t < NT; t += 2) {
        ATT_WRITEX(aV0, aV1, aK0, aK1, 0);
        __syncthreads();
        if (t + 2 < NT) ATT_LOADX(aV0, aV1, aK0, aK1, t + 2);
        ATT_COMPUTE(t, 0);
        if (t + 1 < NT) {
            ATT_WRITEX(bV0, bV1, bK0, bK1, 1);
            __syncthreads();
            if (t + 3 < NT) ATT_LOADX(bV0, bV1, bK0, bK1, t + 3);
            ATT_COMPUTE(t + 1, 1);
        }
    }
#undef ATT_LOADX
#undef ATT_WRITEX
#undef ATT_COMPUTE
    if (hi == 0) li_l[r32] = l_reg;
    asm volatile("s_waitcnt lgkmcnt(0)" ::: "memory");
    P.finish(o, m_reg, l_reg, li_l, wid, r32, hi);
    __syncthreads();
}

template <class Pol>
__device__ __forceinline__ void attn_unit_dense64(const Pol& P, LAS char* lds, const int tid_in) {
    int tid = tid_in; asm volatile("" : "+v"(tid));
    const int wid = __builtin_amdgcn_readfirstlane(tid >> 6), lane = tid & 63, r32 = lane & 31, hi = lane >> 5;
    LAS char* V_lds = lds; LAS char* K_lds = lds + KOFF; constexpr int KBYTES = 64 * 64 * 2;
    LAS float* wsx = (LAS float*)(lds + WSOFF) + wid * 64; LAS float* li_l = wsx; LAS float* al_l = wsx + 32;
    const float C = Pol::SCALE * 1.4426950408889634f, thr_raw = 8.0f / Pol::SCALE;
    float m_reg = M0, l_reg = 0.f; f32x16 o[4] = {};
    LAS char* qb_l = lds + QOFF + wid * 4096 + lane * 16;
    { const bf16_t* qp = P.q_row(wid * 32 + r32) + hi * 8;
#pragma unroll
      for (int d0 = 0; d0 < 4; ++d0) *(LAS bf16x8*)(qb_l + d0 * 1024) = *(const bf16x8*)(qp + d0 * 16); }
    const int sr = tid >> 4, sc = (tid & 15) * 8, vst0 = v_st(sr, sc), vst1 = v_st(32 + sr, sc);
    const int k64r = tid >> 3, k64c = (tid & 7) * 8, kst = kswz64(k64r, k64c * 2);
    const int vb0 = (int)(unsigned)(__UINTPTR_TYPE__)V_lds + v_rd_base(lane);
    bf16x8 sAv0, sAv1, sAk, sBv0, sBv1, sBk;
#define D64_LOADA(t) do { sAv0 = *(const bf16x8*)(P.v_row((t), sr) + sc); sAv1 = *(const bf16x8*)(P.v_row((t), 32 + sr) + sc); sAk = *(const bf16x8*)(P.k_row((t), k64r) + k64c); } while (0)
#define D64_LOADB(t) do { sBv0 = *(const bf16x8*)(P.v_row((t), sr) + sc); sBv1 = *(const bf16x8*)(P.v_row((t), 32 + sr) + sc); sBk = *(const bf16x8*)(P.k_row((t), k64r) + k64c); } while (0)
#define D64_WRITEA() do { *(LAS bf16x8*)(V_lds + vst0) = sAv0; *(LAS bf16x8*)(V_lds + vst1) = sAv1; *(LAS bf16x8*)(K_lds + kst) = sAk; } while (0)
#define D64_WRITEB() do { *(LAS bf16x8*)(V_lds + VBYTES + vst0) = sBv0; *(LAS bf16x8*)(V_lds + VBYTES + vst1) = sBv1; *(LAS bf16x8*)(K_lds + KBYTES + kst) = sBk; } while (0)
#define D64_WAIT() asm volatile("s_waitcnt vmcnt(3)" ::: "memory")
#define D64_RESC(a) do { if (__any((a) < 1.f)) { if (hi == 0) al_l[r32] = (a); asm volatile("s_waitcnt lgkmcnt(0)" ::: "memory"); \
    _Pragma("unroll") for (int d = 0; d < 4; ++d) _Pragma("unroll") for (int r = 0; r < 16; ++r) o[d][r] *= al_l[crow(r, hi)]; } } while (0)
    f32x16 pA0, pA1, pB0, pB1; float mnA, mnB, alA, alB; bf16x8 pa0, pa1, pa2, pa3; const int NT = P.ntiles();
    D64_LOADA(0); asm volatile("s_waitcnt vmcnt(0)" ::: "memory"); D64_WRITEA(); __syncthreads();
    qkt64_ldsq(pA0, pA1, K_lds, qb_l, r32, hi); partialSM(pA0, pA1, m_reg, mnA, alA, C, thr_raw);
    D64_LOADB(1); D64_LOADA(2);
    D64_WAIT(); D64_WRITEB(); __syncthreads();
#if defined(STAMP_SEL)
    unsigned long long sa0 = 0, sa1 = 0, sa2 = 0, sr0 = 0, sr1 = 0; if (P.stamp) { sa0 = __builtin_amdgcn_s_memtime(); sr0 = __builtin_amdgcn_s_memrealtime(); }
#endif
    for (int j = 1; j + 1 < NT; j += 2) {
        ATT_SBAR(); qkt64_ldsq(pB0, pB1, K_lds + KBYTES, qb_l, r32, hi);
        finishSM(pA0, pA1, alA, l_reg, pa0, pa1, pa2, pa3); ATT_SBAR();
        D64_LOADB(j + 2); ATT_SBAR();
        pv_d0(o, vb0, pa0, pa1, pa2, pa3); partialSM(pB0, pB1, m_reg, mnB, alB, C, thr_raw);
        __syncthreads(); D64_WAIT(); D64_WRITEA();
        D64_RESC(alB); __syncthreads();
        ATT_SBAR(); qkt64_ldsq(pA0, pA1, K_lds, qb_l, r32, hi);
        finishSM(pB0, pB1, alB, l_reg, pa0, pa1, pa2, pa3); ATT_SBAR();
        if (j + 3 < NT) D64_LOADA(j + 3); ATT_SBAR();
        pv_d0(o, vb0 + VBYTES, pa0, pa1, pa2, pa3); partialSM(pA0, pA1, m_reg, mnA, alA, C, thr_raw);
        __syncthreads(); D64_WAIT(); D64_WRITEB();
        D64_RESC(alA); __syncthreads();
    }
    ATT_SBAR(); qkt64_ldsq(pB0, pB1, K_lds + KBYTES, qb_l, r32, hi);
    finishSM(pA0, pA1, alA, l_reg, pa0, pa1, pa2, pa3); ATT_SBAR();
    pv_d0(o, vb0, pa0, pa1, pa2, pa3); partialSM(pB0, pB1, m_reg, mnB, alB, C, thr_raw);
    __syncthreads(); D64_RESC(alB);
    finishSM(pB0, pB1, alB, l_reg, pa0, pa1, pa2, pa3); ATT_SBAR();
    pv_d0(o, vb0 + VBYTES, pa0, pa1, pa2, pa3);
#undef D64_LOADA
#undef D64_LOADB
#undef D64_WRITEA
#undef D64_WRITEB
#undef D64_WAIT
#undef D64_RESC
#if defined(STAMP_SEL)
    if (P.stamp) { sa1 = __builtin_amdgcn_s_memtime(); sr1 = __builtin_amdgcn_s_memrealtime(); }
#endif
    if (hi == 0) li_l[r32] = l_reg;
    asm volatile("s_waitcnt lgkmcnt(0)" ::: "memory");
    P.finish(o, m_reg, l_reg, li_l, wid, r32, hi);
    __syncthreads();
#if defined(STAMP_SEL)
    if (P.stamp && tid == 0) { sa2 = __builtin_amdgcn_s_memtime(); P.stamp[10] = sa0; P.stamp[12] = sa1; P.stamp[13] = sa2; P.stamp[14] = sr0; P.stamp[15] = sr1; }
#endif
}

typedef short v4i16_t __attribute__((ext_vector_type(4)));
__device__ __forceinline__ s16x4 vtr(const LAS char* p) { return __builtin_bit_cast(s16x4, __builtin_amdgcn_ds_read_tr16_b64_v4i16((LAS v4i16_t*)p)); }
template <class Pol>
__device__ __forceinline__ void attn_unit_b2(const Pol& P, LAS char* lds, const int tid_in) {
    int tid = tid_in; asm volatile("" : "+v"(tid));
    const int wid = __builtin_amdgcn_readfirstlane(tid >> 6), lane = tid & 63, r32 = lane & 31, hi = lane >> 5;
    const bool trail = wid >= 4;
    constexpr int KB = 8192, VB = 16384, KR = 3 * VB, WSB = KR + 3 * KB;
    LAS char* V_lds = lds; LAS char* K_lds = lds + KR;
    LAS float* wsx = (LAS float*)(lds + WSB) + wid * 64; LAS float* li_l = wsx; LAS float* al_l = wsx + 32;
    const float C = Pol::SCALE * 1.4426950408889634f, thr_raw = 8.0f / Pol::SCALE;
    float m_reg = M0, l_reg = 0.f; f32x16 o[4] = {}; bf16x8 qr[4];
    { const bf16_t* qp = P.q_row(wid * 32 + r32) + hi * 8;
#pragma unroll
      for (int d0 = 0; d0 < 4; ++d0) qr[d0] = *(const bf16x8*)(qp + d0 * 16); }
    const int sr = tid >> 4, sc = (tid & 15) * 8, vst0 = v_st(sr, sc), vst1 = v_st(32 + sr, sc);
    const int k64r = tid >> 3, k64c = (tid & 7) * 8, kst = kswz64(k64r, k64c * 2);
    const LAS char* vrd = V_lds + v_rd_base(lane);
    bf16x8 sAv0, sAv1, sAk, sBv0, sBv1, sBk;
#define B2_LOADA(t) do { sAv0 = *(const bf16x8*)(P.v_row((t), sr) + sc); sAv1 = *(const bf16x8*)(P.v_row((t), 32 + sr) + sc); sAk = *(const bf16x8*)(P.k_row((t), k64r) + k64c); } while (0)
#define B2_LOADB(t) do { sBv0 = *(const bf16x8*)(P.v_row((t), sr) + sc); sBv1 = *(const bf16x8*)(P.v_row((t), 32 + sr) + sc); sBk = *(const bf16x8*)(P.k_row((t), k64r) + k64c); } while (0)
#define B2_WRITEA(r) do { *(LAS bf16x8*)(V_lds + (r) * VB + vst0) = sAv0; *(LAS bf16x8*)(V_lds + (r) * VB + vst1) = sAv1; *(LAS bf16x8*)(K_lds + (r) * KB + kst) = sAk; } while (0)
#define B2_WRITEB(r) do { *(LAS bf16x8*)(V_lds + (r) * VB + vst0) = sBv0; *(LAS bf16x8*)(V_lds + (r) * VB + vst1) = sBv1; *(LAS bf16x8*)(K_lds + (r) * KB + kst) = sBk; } while (0)
#define B2_BAR() do { asm volatile("s_waitcnt lgkmcnt(0)" ::: "memory"); __builtin_amdgcn_sched_barrier(0); __builtin_amdgcn_s_barrier(); __builtin_amdgcn_sched_barrier(0); } while (0)
#define B2_QK(r) do { const LAS char* Ks_ = K_lds + (r) * KB; p0 = f32x16{}; p1 = f32x16{}; \
    _Pragma("unroll") for (int d0 = 0; d0 < 4; ++d0) { const int cb = (d0 * 16 + hi * 8) * 2; \
        const bf16x8 b0 = *(const LAS bf16x8*)(Ks_ + kswz64(r32, cb)); const bf16x8 b1 = *(const LAS bf16x8*)(Ks_ + kswz64(32 + r32, cb)); \
        p0 = __builtin_amdgcn_mfma_f32_32x32x16_bf16(b0, qr[d0], p0, 0, 0, 0); p1 = __builtin_amdgcn_mfma_f32_32x32x16_bf16(b1, qr[d0], p1, 0, 0, 0); } } while (0)
#define B2_PKV(L, H) (bf16x8){L[0], L[1], L[2], L[3], H[0], H[1], H[2], H[3]}
#define B2_PV(r) do { const LAS char* vb_ = vrd + (r) * VB; \
    _Pragma("unroll") for (int d0 = 0; d0 < 4; ++d0) { \
        const s16x4 l0 = vtr(vb_ + v_rd_off(d0, 0, 0)), h0 = vtr(vb_ + v_rd_off(d0, 0, 1)), l1 = vtr(vb_ + v_rd_off(d0, 1, 0)), h1 = vtr(vb_ + v_rd_off(d0, 1, 1)); \
        const s16x4 l2 = vtr(vb_ + v_rd_off(d0, 2, 0)), h2 = vtr(vb_ + v_rd_off(d0, 2, 1)), l3 = vtr(vb_ + v_rd_off(d0, 3, 0)), h3 = vtr(vb_ + v_rd_off(d0, 3, 1)); \
        o[d0] = __builtin_amdgcn_mfma_f32_32x32x16_bf16(pa0, B2_PKV(l0, h0), o[d0], 0, 0, 0); o[d0] = __builtin_amdgcn_mfma_f32_32x32x16_bf16(pa1, B2_PKV(l1, h1), o[d0], 0, 0, 0); \
        o[d0] = __builtin_amdgcn_mfma_f32_32x32x16_bf16(pa2, B2_PKV(l2, h2), o[d0], 0, 0, 0); o[d0] = __builtin_amdgcn_mfma_f32_32x32x16_bf16(pa3, B2_PKV(l3, h3), o[d0], 0, 0, 0); } } while (0)
#define B2_SM() do { float mn_, alpha_; partialSM(p0, p1, m_reg, mn_, alpha_, C, thr_raw); \
    if (__any(alpha_ < 1.f)) { if (hi == 0) al_l[r32] = alpha_; asm volatile("s_waitcnt lgkmcnt(0)" ::: "memory"); \
        _Pragma("unroll") for (int d = 0; d < 4; ++d) _Pragma("unroll") for (int r = 0; r < 16; ++r) o[d][r] *= al_l[crow(r, hi)]; } \
    finishSM(p0, p1, alpha_, l_reg, pa0, pa1, pa2, pa3); } while (0)
    f32x16 p0, p1; bf16x8 pa0, pa1, pa2, pa3; const int NT = P.ntiles();
    B2_LOADA(0); B2_LOADB(1);
    B2_WRITEA(0);
    B2_LOADA(2);
    B2_BAR();
    if (trail) B2_BAR();
    B2_QK(0); B2_WRITEB(1); B2_LOADB(3);
    B2_BAR();
    B2_SM();
    B2_BAR();
    int rk = 1, rv = 0, rw = 2;
    for (int j = 1; j < NT - 1; j += 2) {
        B2_QK(rk); B2_PV(rv); B2_WRITEA(rw); if (j + 3 < NT) B2_LOADA(j + 3);
        B2_BAR();
        B2_SM();
        B2_BAR();
        rv = rk; rk = rw; rw = (rw == 2) ? 0 : rw + 1;
        B2_QK(rk); B2_PV(rv); B2_WRITEB(rw); if (j + 4 < NT) B2_LOADB(j + 4);
        B2_BAR();
        B2_SM();
        B2_BAR();
        rv = rk; rk = rw; rw = (rw == 2) ? 0 : rw + 1;
    }
    B2_QK(rk); B2_PV(rv);
    B2_BAR();
    B2_SM();
    B2_BAR();
    rv = rk;
    B2_PV(rv);
    if (!trail) B2_BAR();
#undef B2_LOADA
#undef B2_LOADB
#undef B2_WRITEA
#undef B2_WRITEB
#undef B2_QK
#undef B2_PKV
#undef B2_PV
#undef B2_SM
    if (hi == 0) li_l[r32] = l_reg;
    asm volatile("s_waitcnt lgkmcnt(0)" ::: "memory");
    P.finish(o, m_reg, l_reg, li_l, wid, r32, hi);
    __syncthreads();
#undef B2_BAR
}

template <class Pol>
__device__ __forceinline__ void attn_unit_b3(const Pol& P, LAS char* lds, const int tid_in, unsigned long long* stamp_ = nullptr) {
    int tid = tid_in; asm volatile("" : "+v"(tid));
    const int wid = __builtin_amdgcn_readfirstlane(tid >> 6), lane = tid & 63, r32 = lane & 31, hi = lane >> 5;
    constexpr int KB = 8192, VB = 16384, K0OFF = 3 * VB, K1OFF = K0OFF + 2 * KB, WS3 = K1OFF + 2 * KB, Q3OFF = WS3 + 2048;
    static_assert(Q3OFF + 65536 <= LDSCTL_OFF, "mixer B LDS image overlaps the control words");
    LAS char* V_lds = lds;
    LAS float* wsx = (LAS float*)(lds + WS3) + wid * 64; LAS float* li_l = wsx; LAS float* al_l = wsx + 32;
    const float C = Pol::SCALE * 1.4426950408889634f, thr_raw = 8.0f / Pol::SCALE;
    float m0 = M0, l0 = 0.f, m1 = M0, l1 = 0.f; f32x16 o0[4] = {}, o1[4] = {};
    LAS char* qb_l = lds + Q3OFF + wid * 8192 + lane * 16;
#pragma unroll
    for (int mp = 0; mp < 2; ++mp) { const bf16_t* qp = P.q_row(mp, wid * 32 + r32) + hi * 8;
#pragma unroll
        for (int d0 = 0; d0 < 4; ++d0) *(LAS bf16x8*)(qb_l + mp * 4096 + d0 * 1024) = *(const bf16x8*)(qp + d0 * 16); }
    const int sr = tid >> 4, sc = (tid & 15) * 8, vst0 = v_st(sr, sc), vst1 = v_st(32 + sr, sc);
    const int k64r = tid >> 3, k64c = (tid & 7) * 8, kst = kswz64(k64r, k64c * 2);
    const int vb0 = (int)(unsigned)(__UINTPTR_TYPE__)V_lds + v_rd_base(lane);
    bf16x8 aV0, aV1, aK0, aK1;
#define B3_LOAD(V0, V1, K0, K1, t) do { V0 = *(const bf16x8*)(P.v_row((t), sr) + sc); V1 = *(const bf16x8*)(P.v_row((t), 32 + sr) + sc); \
        K0 = *(const bf16x8*)(P.k_row(0, (t), k64r) + k64c); K1 = *(const bf16x8*)(P.k_row(1, (t), k64r) + k64c); } while (0)
#define B3_WRITE(V0, V1, K0, K1, b, vs_) do { *(LAS bf16x8*)(V_lds + (vs_) * VB + vst0) = V0; *(LAS bf16x8*)(V_lds + (vs_) * VB + vst1) = V1; \
        *(LAS bf16x8*)(lds + K0OFF + (b) * KB + kst) = K0; *(LAS bf16x8*)(lds + K1OFF + (b) * KB + kst) = K1; } while (0)
#if defined(B3_PRIO) && B3_PRIO == 1
#define B3_P1() do { __builtin_amdgcn_s_setprio(1); ATT_SBAR(); } while (0)
#define B3_P0() do { ATT_SBAR(); __builtin_amdgcn_s_setprio(0); } while (0)
#else
#define B3_P1() do { } while (0)
#define B3_P0() do { } while (0)
#endif
#define B3_QS(KOFF_, QO_, m_, l_, o_, b, A0, A1, A2, A3) do { f32x16 p0, p1; float mn, alpha; \
        B3_P1(); qkt64_ldsq(p0, p1, lds + (KOFF_) + (b) * KB, qb_l + (QO_), r32, hi); B3_P0(); \
        partialSM(p0, p1, m_, mn, alpha, C, thr_raw); \
        if (__any(alpha < 1.f)) { if (hi == 0) al_l[r32] = alpha; asm volatile("s_waitcnt lgkmcnt(0)" ::: "memory"); \
            _Pragma("unroll") for (int d = 0; d < 4; ++d) _Pragma("unroll") for (int r = 0; r < 16; ++r) o_[d][r] *= al_l[crow(r, hi)]; } \
        finishSM(p0, p1, alpha, l_, A0, A1, A2, A3); ATT_SBAR(); } while (0)
#define B3_PV(o_, vs_, A0, A1, A2, A3) do { B3_P1(); pv_d0(o_, vb0 + (vs_) * VB, A0, A1, A2, A3); B3_P0(); } while (0)
#define B3_MAP(KOFF_, QO_, m_, l_, o_, b, vs_) do { bf16x8 pa0, pa1, pa2, pa3; B3_QS(KOFF_, QO_, m_, l_, o_, b, pa0, pa1, pa2, pa3); B3_PV(o_, vs_, pa0, pa1, pa2, pa3); } while (0)
    const int NT = P.ntiles();
    const bool young = wid >= 4;
    bf16x8 c0 = {}, c1 = {}, c2 = {}, c3 = {};
    int vs = 0, vprev = 0;
#if defined(STAMP_SEL)
    unsigned long long sa0 = 0, sa1 = 0, sr0 = 0, sr1 = 0; if (stamp_) { sa0 = __builtin_amdgcn_s_memtime(); sr0 = __builtin_amdgcn_s_memrealtime(); }
#endif
    B3_LOAD(aV0, aV1, aK0, aK1, 0);
    for (int t = 0; t < NT; ++t) {
        const int b = t & 1;
        B3_WRITE(aV0, aV1, aK0, aK1, b, vs);
        __syncthreads();
        if (t + 1 < NT) B3_LOAD(aV0, aV1, aK0, aK1, t + 1);
        if (young && t > 0) B3_PV(o1, vprev, c0, c1, c2, c3);
        B3_MAP(K0OFF, 0, m0, l0, o0, b, vs);
        B3_QS(K1OFF, 4096, m1, l1, o1, b, c0, c1, c2, c3);
        if (!young) B3_PV(o1, vs, c0, c1, c2, c3);
        vprev = vs; vs = (vs == 2) ? 0 : vs + 1;
    }
    if (young) B3_PV(o1, vprev, c0, c1, c2, c3);
#if defined(STAMP_SEL)
    if (stamp_ && wid == STAMP_WAVE) { sa1 = __builtin_amdgcn_s_memtime(); sr1 = __builtin_amdgcn_s_memrealtime(); if (lane == 0) { stamp_[10] = sa0; stamp_[12] = sa1; stamp_[13] = sa1; stamp_[14] = sr0; stamp_[15] = sr1; } }
#endif
#undef B3_LOAD
#undef B3_WRITE
#undef B3_MAP
#undef B3_QS
#undef B3_PV
#undef B3_P1
#undef B3_P0
    if (hi == 0) { li_l[r32] = l0; al_l[r32] = l1; }
    asm volatile("s_waitcnt lgkmcnt(0)" ::: "memory");
    P.finish2(o0, o1, li_l, al_l, wid, r32, hi);
    __syncthreads();
}

template <class RowFn>
__device__ __forceinline__ void store_o_i8(const f32x16* o, const LAS float* li_l, int wid, int r32, int hi, float qo, const RowFn& orow) {
#pragma unroll
    for (int r = 0; r < 16; ++r) { const int i = crow(r, hi); const float inv = __builtin_amdgcn_rcpf(li_l[i]) * qo; unsigned char* p = orow(wid * 32 + i) + r32;
#pragma unroll
        for (int d0 = 0; d0 < 4; ++d0) { int q = (int)__builtin_rintf(o[d0][r] * inv); q = q < -127 ? -127 : (q > 127 ? 127 : q); p[d0 * 32] = (unsigned char)q; } }
}
template <class RowFn>
__device__ __forceinline__ void store_o_bf16(const f32x16* o, const LAS float* li_l, int wid, int r32, int hi, const RowFn& orow) {
#pragma unroll
    for (int r = 0; r < 16; ++r) { const int i = crow(r, hi); const float inv = __builtin_amdgcn_rcpf(li_l[i]); bf16_t* p = orow(wid * 32 + i) + r32;
#pragma unroll
        for (int d0 = 0; d0 < 4; ++d0) p[d0 * 32] = (bf16_t)(cvtpk(o[d0][r] * inv, 0.f) & 0xffffu); }
}
struct PolA {
    static constexpr float SCALE = 0.08838834764831845f;
    const bf16_t* proj; bf16_t* ag; float* lse;
    int b, hh, j, r, L, qb, tlo, nt;
    __device__ __forceinline__ const bf16_t* tok(int pos) const { return proj + (size_t)(b * SEQ + pos) * PROJ_PITCH; }
    __device__ __forceinline__ const bf16_t* q_row(int i) const { return tok(j + r * (qb * 256 + i)) + OFF_QA + hh * 128; }
    __device__ __forceinline__ int ntiles() const { return nt; }
    __device__ __forceinline__ int kidx(int t, int kk) const { int ki = qb * 256 - 64 + 64 * (t + tlo) + kk; ki = ki < 0 ? 0 : (ki > L - 1 ? L - 1 : ki); return j + r * ki; }
    __device__ __forceinline__ const bf16_t* k_row(int t, int kk) const { return tok(kidx(t, kk)) + OFF_KA + hh * 128; }
    __device__ __forceinline__ const bf16_t* v_row(int t, int kk) const { return tok(kidx(t, kk)) + OFF_VA + hh * 128; }
    __device__ __forceinline__ bool wave_needs(int t, int wid) const { const int kbase = qb * 256 - 64 + 64 * (t + tlo), q0 = qb * 256 + wid * 32; return kbase <= q0 + 95 && kbase + 63 >= q0 - 64; }
    __device__ __forceinline__ void mask(f32x16& p0, f32x16& p1, int t, int wid, int r32, int hi, LAS char*) const {
        const int qi = qb * 256 + wid * 32 + r32; const int lo = qi - 64 < 0 ? 0 : qi - 64, hi_ = qi + 64 > L - 1 ? L - 1 : qi + 64;
        const unsigned span = (unsigned)(hi_ - lo); const int t0 = qb * 256 - 64 + 64 * (t + tlo) + 4 * hi - lo;
#pragma unroll
        for (int r = 0; r < 16; ++r) { const int kk = (r & 3) + 8 * (r >> 2);
            p0[r] = ((unsigned)(t0 + kk) <= span) ? p0[r] : NEG; p1[r] = ((unsigned)(t0 + kk + 32) <= span) ? p1[r] : NEG; }
    }
    __device__ __forceinline__ float m0w(int) const { return M0; }
    __device__ __forceinline__ float l0() const { return 0.f; }
    __device__ __forceinline__ void finish(const f32x16* o, float m_reg, float l_reg, const LAS float* li_l, int wid, int r32, int hi) const {
        const int h6 = hh % 6;
        store_o_bf16(o, li_l, wid, r32, hi, [&](int i) { return ag + (size_t)(b * SEQ + j + r * (qb * 256 + i)) * 768 + h6 * 128; });
        if (hi == 0) lse[(size_t)(b * SEQ + j + r * (qb * 256 + wid * 32 + r32)) * 6 + h6] = m_reg * SCALE + __logf(l_reg);
    }
};
struct PolC2 {
    static constexpr float SCALE = 0.08838834764831845f;
    const bf16_t* proj; unsigned char* oc; const float* sinkp; int b, kvh, qb;
    __device__ __forceinline__ const bf16_t* tok(int pos) const { return proj + (size_t)(b * SEQ + pos) * PROJ_PITCH; }
    __device__ __forceinline__ const bf16_t* q_row(int i) const { return tok(qb * 64 + (i & 63)) + OFF_QC + (kvh * 4 + (i >> 6)) * 128; }
    __device__ __forceinline__ int ntiles() const { return 5; }
    __device__ __forceinline__ int kpos(int t, int kk) const { int k = qb * 64 - 128 + 64 * t + kk; return k < 0 ? 0 : (k > SEQ - 1 ? SEQ - 1 : k); }
    __device__ __forceinline__ const bf16_t* k_row(int t, int kk) const { return tok(kpos(t, kk)) + OFF_KC + kvh * 128; }
    __device__ __forceinline__ const bf16_t* v_row(int t, int kk) const { return tok(kpos(t, kk)) + OFF_VC + kvh * 128; }
    __device__ __forceinline__ bool wave_needs(int t, int) const { const int kbase = qb * 64 - 128 + 64 * t; return kbase + 63 >= 0 && kbase < SEQ; }
    __device__ __forceinline__ void mask(f32x16& p0, f32x16& p1, int t, int wid, int r32, int hi, LAS char*) const {
        const int qi = qb * 64 + (wid & 1) * 32 + r32; const int lo = qi - 128 < 0 ? 0 : qi - 128, hi_ = qi + 128 > SEQ - 1 ? SEQ - 1 : qi + 128;
        const unsigned span = (unsigned)(hi_ - lo); const int t0 = qb * 64 - 128 + 64 * t + 4 * hi - lo;
#pragma unroll
        for (int r = 0; r < 16; ++r) { const int kk = (r & 3) + 8 * (r >> 2);
            p0[r] = ((unsigned)(t0 + kk) <= span) ? p0[r] : NEG; p1[r] = ((unsigned)(t0 + kk + 32) <= span) ? p1[r] : NEG; }
    }
    __device__ __forceinline__ float m0w(int wid) const { return sinkp[kvh * 4 + (wid >> 1)] * (1.0f / SCALE); }
    __device__ __forceinline__ float l0() const { return 1.f; }
    __device__ __forceinline__ void finish(const f32x16* o, float, float, const LAS float* li_l, int wid, int r32, int hi) const {
        store_o_i8(o, li_l, wid, r32, hi, QO, [&](int i) { return oc + (size_t)(b * SEQ + qb * 64 + (i & 63)) * 1024 + (kvh * 4 + (i >> 6)) * 128; });
    }
};
struct PolD {
    static constexpr float SCALE = 0.08838834764831845f;
    const bf16_t* proj; unsigned char* od; int b, h, rb, lo, nt;
    __device__ __forceinline__ const bf16_t* tok(int pos) const { return proj + (size_t)(b * SEQ + pos) * PROJ_PITCH; }
    __device__ __forceinline__ const bf16_t* q_row(int i) const { return tok(rb * 256 + i) + OFF_QD + h * 128; }
    __device__ __forceinline__ int ntiles() const { return nt; }
    __device__ __forceinline__ const bf16_t* k_row(int t, int kk) const { return tok((lo + t) * 64 + kk) + OFF_KD + h * 128; }
    __device__ __forceinline__ const bf16_t* v_row(int t, int kk) const { return tok((lo + t) * 64 + kk) + OFF_VD + h * 128; }
    __device__ __forceinline__ bool wave_needs(int t, int wid) const { const int qr_ = rb * 4 + (wid >> 1); int rs = qr_ - 4; rs = rs < 0 ? 0 : (rs > 56 ? 56 : rs); const int kr = lo + t; return kr >= rs && kr < rs + 8; }
    __device__ __forceinline__ void mask(f32x16& p0, f32x16& p1, int t, int wid, int r32, int hi, LAS char* lds) const {
        const int qr_ = rb * 4 + (wid >> 1), qc = 32 * (wid & 1) + r32, kr = lo + t; int cs = qc - 8; cs = cs < 0 ? 0 : (cs > 48 ? 48 : cs);
        const LAS float* T = (const LAS float*)(lds + TABOFF) + (kr - qr_ + 7) * 31 + 15 - qc + 4 * hi; const int kc0 = 4 * hi - cs;
#pragma unroll
        for (int r = 0; r < 16; ++r) { const int kk = (r & 3) + 8 * (r >> 2);
            const float b0 = T[kk], b1 = T[kk + 32];
            p0[r] = ((unsigned)(kc0 + kk) < 16u) ? p0[r] + b0 : NEG; p1[r] = ((unsigned)(kc0 + kk + 32) < 16u) ? p1[r] + b1 : NEG; }
    }
    __device__ __forceinline__ float m0w(int) const { return M0; }
    __device__ __forceinline__ float l0() const { return 0.f; }
    __device__ __forceinline__ void finish(const f32x16* o, float, float, const LAS float* li_l, int wid, int r32, int hi) const {
        store_o_i8(o, li_l, wid, r32, hi, QO, [&](int i) { return od + (size_t)(b * SEQ + rb * 256 + i) * 1024 + h * 128; });
    }
};
struct PolB {
    static constexpr float SCALE = 0.125f;
    const bf16_t* proj; bf16_t* ob; float* scr; const float* subln; const float* lam; float lambda_init; int b, h, qb, map;
#if defined(STAMP_SEL)
    unsigned long long* stamp;
#endif
    __device__ __forceinline__ const bf16_t* tok(int pos) const { return proj + (size_t)(b * SEQ + pos) * PROJ_PITCH; }
    __device__ __forceinline__ const bf16_t* q_row(int i) const { return tok(qb * 256 + i) + OFF_QB + (2 * h + map) * 64; }
    __device__ __forceinline__ int ntiles() const { return SEQ / 64; }
    __device__ __forceinline__ const bf16_t* k_row(int t, int kk) const { return tok(64 * t + kk) + OFF_KB + (2 * h + map) * 64; }
    __device__ __forceinline__ const bf16_t* v_row(int t, int kk) const { return tok(64 * t + kk) + OFF_VB + h * 128; }
    __device__ __forceinline__ bool wave_needs(int, int) const { return true; }
    __device__ __forceinline__ void mask(f32x16&, f32x16&, int, int, int, int, LAS char*) const {}
    __device__ __forceinline__ float m0w(int) const { return M0; }
    __device__ __forceinline__ float l0() const { return 0.f; }
    __device__ __forceinline__ void finish(const f32x16* o, float, float, const LAS float* li_l, int wid, int r32, int hi) const {
        if (map == 0) {
#pragma unroll
            for (int r = 0; r < 16; ++r) { const int i = crow(r, hi); const float inv = __builtin_amdgcn_rcpf(li_l[i]); float* p = scr + (size_t)(wid * 32 + i) * 128 + r32;
#pragma unroll
                for (int d0 = 0; d0 < 4; ++d0) p[d0 * 32] = o[d0][r] * inv; }
        } else {
            const int ln_ = r32 + 32 * hi; const float d01 = wave_sum(lam[ln_] * lam[64 + ln_]), d23 = wave_sum(lam[128 + ln_] * lam[192 + ln_]);
            const float lmbda = __expf(d01) - __expf(d23) + lambda_init, oscale = 1.0f - lambda_init;
            float sw[4];
#pragma unroll
            for (int d0 = 0; d0 < 4; ++d0) sw[d0] = subln[d0 * 32 + r32] * oscale;
#pragma unroll
            for (int r = 0; r < 16; ++r) { const int i = crow(r, hi); const float inv = __builtin_amdgcn_rcpf(li_l[i]); const float* p = scr + (size_t)(wid * 32 + i) * 128 + r32;
                float v[4]; float ss = 0.f;
#pragma unroll
                for (int d0 = 0; d0 < 4; ++d0) { v[d0] = p[d0 * 32] - lmbda * (o[d0][r] * inv); ss += v[d0] * v[d0]; }
#pragma unroll
                for (int s = 1; s < 32; s <<= 1) ss += __shfl_xor(ss, s);
                const float rinv = rsqrtf(ss * (1.0f / 128.0f) + SUBLN_EPS);
                bf16_t* q = ob + (size_t)(b * SEQ + qb * 256 + wid * 32 + i) * 1024 + h * 128 + r32;
#pragma unroll
                for (int d0 = 0; d0 < 4; ++d0) q[d0 * 32] = (bf16_t)(cvtpk(v[d0] * rinv * sw[d0], 0.f) & 0xffffu); }
        }
    }
};

struct PolB2 {
    static constexpr float SCALE = 0.125f;
    const bf16_t* proj; unsigned char* ob; const float* subln; const float* lam; float lambda_init; int b, h, qb;
    __device__ __forceinline__ const bf16_t* tok(int pos) const { return proj + (size_t)(b * SEQ + pos) * PROJ_PITCH; }
    __device__ __forceinline__ const bf16_t* q_row(int mp, int i) const { return tok(qb * 256 + i) + OFF_QB + (2 * h + mp) * 64; }
    __device__ __forceinline__ int ntiles() const { return SEQ / 64; }
    __device__ __forceinline__ const bf16_t* k_row(int mp, int t, int kk) const { return tok(64 * t + kk) + OFF_KB + (2 * h + mp) * 64; }
    __device__ __forceinline__ const bf16_t* v_row(int t, int kk) const { return tok(64 * t + kk) + OFF_VB + h * 128; }
    __device__ __forceinline__ void finish2(const f32x16* o0, const f32x16* o1, const LAS float* l0_l, const LAS float* l1_l, int wid, int r32, int hi) const {
        const int ln_ = r32 + 32 * hi; const float d01 = wave_sum(lam[ln_] * lam[64 + ln_]), d23 = wave_sum(lam[128 + ln_] * lam[192 + ln_]);
        const float lmbda = __expf(d01) - __expf(d23) + lambda_init;
        float sw[4];
#pragma unroll
        for (int d0 = 0; d0 < 4; ++d0) sw[d0] = subln[d0 * 32 + r32] * QX;
#pragma unroll
        for (int r = 0; r < 16; ++r) { const int i = crow(r, hi); const float inv0 = __builtin_amdgcn_rcpf(l0_l[i]), inv1 = lmbda * __builtin_amdgcn_rcpf(l1_l[i]);
            float v[4]; float ss = 0.f;
#pragma unroll
            for (int d0 = 0; d0 < 4; ++d0) { v[d0] = o0[d0][r] * inv0 - o1[d0][r] * inv1; ss += v[d0] * v[d0]; }
#pragma unroll
            for (int s = 1; s < 32; s <<= 1) ss += __shfl_xor(ss, s);
            const float rinv = rsqrtf(ss * (1.0f / 128.0f) + SUBLN_EPS);
            unsigned char* q = ob + (size_t)(b * SEQ + qb * 256 + wid * 32 + i) * 1024 + h * 128 + r32;
#pragma unroll
            for (int d0 = 0; d0 < 4; ++d0) { int t = (int)__builtin_rintf(v[d0] * rinv * sw[d0]); t = t < -127 ? -127 : (t > 127 ? 127 : t); q[d0 * 32] = (unsigned char)t; } }
    }
};

#ifndef ATT_MASK
#define ATT_MASK 15
#endif
#define ATT_ON(k) ((ATT_MASK >> (k)) & 1)
#ifndef ATT_REP
#define ATT_REP 0
#endif
#define ATT_NREP(k) (((ATT_REP >> (k)) & 1) ? 2 : 1)
struct Ptrs { const bf16_t* proj; bf16_t* ag; float* lse; unsigned char* ob; unsigned char* oc; unsigned char* od; const float* lam; const float* subln; const float* sink; const float* rpb; float lambda_init;
#if defined(STAMP_SEL)
    unsigned long long* stamp;
#endif
};
__device__ __forceinline__ void attn_phase(const Ptrs& X, LAS char* lds, const int tid, const int vcu, const int G, const int wgid) {
    const int lane = tid & 63;
    if (ATT_ON(0)) for (int rep = 0; rep < ATT_NREP(0); ++rep) {
        for (int u = vcu; u < 512; u += G) {
            PolB2 P{X.proj, X.ob, X.subln, X.lam, X.lambda_init, u >> 7, (u >> 4) & 7, u & 15};
#if defined(STAMP_SEL)
            attn_unit_b3<PolB2>(P, lds, tid, (wgid == STAMP_WG && u == vcu && rep == 0) ? X.stamp : nullptr);
#else
            attn_unit_b3<PolB2>(P, lds, tid);
#endif
        }
    }
    if (ATT_ON(1)) for (int rep = 0; rep < ATT_NREP(1); ++rep) for (int u = vcu; u < 512; u += G) {
        const int rb = u & 15, h = (u >> 4) & 7, b = u >> 7; int lo = rb * 4 - 4; lo = lo < 0 ? 0 : (lo > 56 ? 56 : lo); int hi_ = rb * 4 + 3 - 4; hi_ = hi_ < 0 ? 0 : (hi_ > 56 ? 56 : hi_); hi_ += 7;
        { LAS float* T = (LAS float*)(lds + TABOFF); for (int i = tid; i < 465; i += 512) T[i] = X.rpb[h * 465 + i] * (1.0f / PolD::SCALE); }
        PolD P{X.proj, X.od, b, h, rb, lo, hi_ - lo + 1};
        attn_unit<128, PolD>(P, lds, tid);
    }
    if (ATT_ON(2)) for (int rep = 0; rep < ATT_NREP(2); ++rep) for (int u = vcu; u < 512; u += G) {
        const int qb = u & 63, kvh = (u >> 6) & 1, b = u >> 7;
        PolC2 P{X.proj, X.oc, X.sink, b, kvh, qb};
        attn_unit<128, PolC2>(P, lds, tid);
    }
    if (ATT_ON(3)) for (int rep = 0; rep < ATT_NREP(3); ++rep) for (int u = vcu; u < 1152; u += G) {
        const int g = u / 384, v = u % 384, w16 = v & 15, bh = v >> 4, h6 = bh % 6, b = bh / 6;
        const int r = g == 0 ? 1 : (g == 1 ? 4 : 16), L = SEQ / r;
        const int qb = w16 / r, tlo = qb == 0 ? 1 : 0; int thi = (L - qb * 256 + 64 + 63) / 64; thi = thi > 6 ? 6 : thi;
        PolA P{X.proj, X.ag + (size_t)g * MTOK * 768, X.lse + (size_t)g * MTOK * 6, b, g * 6 + h6, w16 % r, r, L, qb, tlo, thi - tlo};
        attn_unit<128, PolA>(P, lds, tid);
    }
}
#undef ATT_SBAR
}

struct InPtrs { const float *x, *w_in, *b_gate, *w_branch, *w_out, *diff_lambda, *diff_subln, *sink_logit, *na_rpb, *w_router, *w_exp_gate, *w_exp_up, *w_exp_down, *ln_gain, *ln_bias; };

__device__ __forceinline__ void prologue_phase(const InPtrs& I, unsigned char* ws, LAS unsigned char* lds, int gw, int NGW, int wave, int lane) {
    LAS unsigned char* scr = lds + wave * 9216;
    { const f32x4* xs = (const f32x4*)I.x;
      for (size_t i = (size_t)gw * 64 + lane; i < (size_t)MTOK * DM / 8; i += (size_t)NGW * 64) {
          const f32x4 a = xs[2 * i], b = xs[2 * i + 1];
          u32x2 q; q.x = q8x4(a[0], a[1], a[2], a[3], QX); q.y = q8x4(b[0], b[1], b[2], b[3], QX); ((u32x2*)(ws + WS_X8))[i] = q; } }
    { float* r128 = (float*)(ws + WS_ROPE128); float* r64 = (float*)(ws + WS_ROPE64);
      for (int i = gw * 64 + lane; i < SEQ * 64 + SEQ * 32; i += NGW * 64) {
          int pos, ii, half; float* dst;
          if (i < SEQ * 64) { pos = i >> 6; ii = i & 63; half = 64; dst = r128 + 2 * (size_t)i; } else { const int k = i - SEQ * 64; pos = k >> 5; ii = k & 31; half = 32; dst = r64 + 2 * (size_t)k; }
          const float inv = (float)pow(10000.0, -(double)ii / (double)half); const float ang = (float)pos * inv;
          dst[0] = (float)cos((double)ang); dst[1] = (float)sin((double)ang); } }
    bf16_t* WIN = (bf16_t*)(ws + WS_WIN); bf16_t* WOUT = (bf16_t*)(ws + WS_WOUT); bf16_t* WGU = (bf16_t*)(ws + WS_WGU); bf16_t* WDN = (bf16_t*)(ws + WS_WDN);
    constexpr int N1 = DEPTH * 32 * 356, N2 = DEPTH * 60 * 32, N3 = DEPTH * 32 * 32, N4 = DEPTH * NEXP * 32 * 32, N5 = DEPTH * NEXP * 16 * 32;
    for (int it = gw; it < N1 + N2 + N3 + N4 + N5; it += NGW) {
        int r = it;
        if (r < N1) { const int sub = r & 15, grp = r >> 4; const int nb = (grp % 89) * 4 + (sub & 3), kb = ((grp / 89) & 7) * 4 + (sub >> 2), l = grp / (89 * 8); const int n = nb * 64 + lane;
            const int c0 = nb * 64;
            if (c0 >= 14592) tr_item8(I.w_in + (size_t)l * DM * IN_TOTAL, IN_TOTAL, n, kb * 64, (unsigned char*)(ws + WS_W8G) + ((size_t)l * 8192 + (c0 - 14592)) * DM + kb * 64, DM, QWG, scr, lane);
            else { const bool isv = (c0 >= 4608 && c0 < 6912) || (c0 >= 8960 && c0 < 9984) || (c0 >= 11264 && c0 < 11520) || (c0 >= 13568);
                tr_item8(I.w_in + (size_t)l * DM * IN_TOTAL, IN_TOTAL, win_src_col(n), kb * 64, (unsigned char*)(ws + WS_W8Q) + ((size_t)l * 14592 + c0) * DM + kb * 64, DM, isv ? QWU : QWG, scr, lane); }
            continue; }
        r -= N1;
        if (r < N2) { const int nb = r % 32, kbg = (r / 32) % 60, l = r / (32 * 60); const int n = nb * 64 + lane;
            int ro, Kb, kb; if (kbg < 12) { ro = 0; Kb = 768; kb = kbg; } else { const int q = (kbg - 12) >> 4; ro = 768 + 1024 * q; Kb = 1024; kb = (kbg - 12) & 15; }
            const int brn = kbg < 12 ? 0 : 1 + ((kbg - 12) >> 4); (void)Kb;
            tr_item8(I.w_branch + ((size_t)l * BR_TOTAL + ro) * DM, DM, n, kb * 64, (unsigned char*)(ws + WS_W8BR) + ((size_t)(l * 4 + brn) * DM + nb * 64) * 1024 + kb * 64, 1024, brn == 0 ? QWBA : QWBC, scr, lane);
            continue; }
        r -= N2;
        if (r < N3) { const int nb = r % 32, kb = (r / 32) % 32, l = r / (32 * 32); const int n = nb * 64 + lane;
            tr_item8(I.w_out + (size_t)l * DM * DM, DM, n, kb * 64, (unsigned char*)WOUT + ((size_t)l * DM + nb * 64) * DM + kb * 64, DM, QWU, scr, lane); continue; }
        r -= N3;
        if (r < N4) { const int sub = r & 15, grp = r >> 4; const int nb = (grp & 3) * 8 + (sub & 7), kb = ((grp >> 2) & 15) * 2 + (sub >> 3), le = grp >> 6; const int n = nb * 64 + lane, pn = n >> 8, bj = (n >> 7) & 1, jj = n & 127;
            tr_item8((bj ? I.w_exp_up : I.w_exp_gate) + (size_t)le * DM * DEXP, DEXP, pn * 128 + jj, kb * 64, (unsigned char*)WGU + ((size_t)le * 2048 + nb * 64) * DM + kb * 64, DM, bj ? QWU : QWG, scr, lane); continue; }
        r -= N4;
        { const int sub = r & 15, grp = r >> 4; const int nb = (grp & 3) * 8 + (sub & 7), kb = ((grp >> 2) & 7) * 2 + (sub >> 3), le = grp >> 5; const int n = nb * 64 + lane;
            tr_item8(I.w_exp_down + (size_t)le * DEXP * DM, DM, n, kb * 64, (unsigned char*)WDN + ((size_t)le * DM + nb * 64) * DEXP + kb * 64, DEXP, QWD, scr, lane); }
    }
}

struct Args { const float* in[15]; float* out; unsigned char* ws; int ph_lo, ph_hi; };
__global__ void __launch_bounds__(NWAVES * 64, LB_WAVES) fwd(Args args) {
    extern __shared__ __attribute__((aligned(16))) unsigned char lds_raw[];
    LAS unsigned char* lds = (LAS unsigned char*)lds_raw;
    for (int u = threadIdx.x; u < (LDS_BYTES - LDSCTL_OFF) / 4; u += NWAVES * 64) ((LAS unsigned*)(lds + LDSCTL_OFF))[u] = 0u;
    __syncthreads();
    unsigned* ctl = (unsigned*)(args.ws + WS_CTL);
    XcdBarrier bar = xcd_barrier_post(ctl + CW_BAR, (volatile LAS unsigned*)(lds + LDSCTL_OFF));
    const int lo = args.ph_lo, hi = args.ph_hi;
#ifndef SCALAR_ATTN
#define SCALAR_ATTN 0
#endif
#ifndef REP_MASK
#define REP_MASK 0
#endif
#define NREP(k) (((REP_MASK >> (k)) & 1) ? 2 : 1)
#ifndef PH_MASK
#define PH_MASK 0xFFFF
#endif
#define PHON(k) ((PH_MASK >> (k)) & 1)
#define IN(k) (lo <= (k) && (k) < hi)
#define PHASE_LOCALS long zz = 0; asm volatile("" : "+s"(zz)); unsigned char* const ws = args.ws + zz; int tid = threadIdx.x; asm volatile("" : "+v"(tid)); int bx = blockIdx.x, G = gridDim.x; asm volatile("" : "+s"(bx), "+s"(G)); \
    const int lane = tid & 63, wave = __builtin_amdgcn_readfirstlane(tid >> 6); const int vcu = (G % 8 == 0) ? (bx % 8) * (G / 8) + bx / 8 : bx; \
    const int gw = vcu * NWAVES + wave, NGW = G * NWAVES; (void)lane; (void)gw; (void)NGW
#if defined(STAMP_SEL)
#define SEAM(k) do { if (IN(k) && IN((k) + 1)) { const unsigned long long b0_ = __builtin_amdgcn_s_memrealtime(); xcd_barrier(bar); \
    if (__builtin_amdgcn_readfirstlane((int)blockIdx.x) == STAMP_WG && threadIdx.x == 0) { unsigned long long* st_ = (unsigned long long*)(args.ws + WS_CTL + 65536); st_[20] += __builtin_amdgcn_s_memrealtime() - b0_; } } } while (0)
#else
#define SEAM(k) do { if (IN(k) && IN((k) + 1)) xcd_barrier(bar); } while (0)
#endif

#define XF ((float*)(ws + WS_XF))
#define XB ((bf16_t*)(ws + WS_XB))
#define PROJ ((bf16_t*)(ws + WS_PROJ))
#define OA ((bf16_t*)(ws + WS_OA))
#define OB ((bf16_t*)(ws + WS_OB))
#define OC ((bf16_t*)(ws + WS_OC))
#define OD ((bf16_t*)(ws + WS_OD))
#define AG ((bf16_t*)(ws + WS_AG))
#define LSE ((float*)(ws + WS_LSE))
#define MIXED ((bf16_t*)(ws + WS_MIXED))
#define PRELN ((float*)(ws + WS_PRELN))
#define XG ((bf16_t*)(ws + WS_XG))
#define HB ((bf16_t*)(ws + WS_H))
#define YB ((bf16_t*)(ws + WS_Y))
#define AFF ((float*)(ws + WS_AFF))
#define IDX ((int*)(ws + WS_IDX))
#define GV ((float*)(ws + WS_GV))
#define SLOT ((int*)(ws + WS_SLOT))

    if (PHON(0) && IN(0)) for (int rep = 0; rep < NREP(0); ++rep) { PHASE_LOCALS;
        InPtrs I; I.x = args.in[0 + zz]; I.w_in = args.in[1 + zz]; I.b_gate = args.in[2 + zz]; I.w_branch = args.in[3 + zz]; I.w_out = args.in[4 + zz]; I.diff_lambda = args.in[5 + zz]; I.diff_subln = args.in[6 + zz];
        I.sink_logit = args.in[7 + zz]; I.na_rpb = args.in[8 + zz]; I.w_router = args.in[9 + zz]; I.w_exp_gate = args.in[10 + zz]; I.w_exp_up = args.in[11 + zz]; I.w_exp_down = args.in[12 + zz]; I.ln_gain = args.in[13 + zz]; I.ln_bias = args.in[14 + zz];
        prologue_phase(I, ws, lds, gw, NGW, wave, lane); if (rep == NREP(0) - 1) SEAM(0); else xcd_barrier(bar); }

    for (int l = 0; l < DEPTH; ++l) {
        const int pb = 1 + l * NPL;
        if (PHON(1) && IN(pb + 0)) for (int rep = 0; rep < NREP(1); ++rep) { PHASE_LOCALS;
            { pg8::Gemm g{(const bf16_t*)(ws + WS_X8), (const bf16_t*)(ws + WS_W8Q + (size_t)l * 14592 * DM), MTOK, 14592, DM / 2, 0, 0, 0, nullptr STAMP_ARG(nullptr)}; pg8::StaticOrder S; S.init(MTOK, 14592, G, bx);
              pg8::EpiProjT<true> E{PROJ, (const float*)(ws + WS_ROPE128), (const float*)(ws + WS_ROPE64), 0, 1 << 30, 0, 1.0f / (QX * QWG), 1.0f / (QX * QWU)};
              pg8::gemm_phase<pg8::EpiProjT<true>, pg8::StaticOrder, true, true, false, true>(lds, g, S, E, tid); }
            { pg8::Gemm g{(const bf16_t*)(ws + WS_X8), (const bf16_t*)(ws + WS_W8G + (size_t)l * 8192 * DM), MTOK, 8192, DM / 2, 0, 0, 0, nullptr STAMP_ARG(nullptr)}; pg8::StaticOrder S; S.init(MTOK, 8192, G, bx);
              pg8::EpiGate8 E{(unsigned char*)(ws + WS_GATE), args.in[2 + zz] + (size_t)l * 8192, 1.0f / (QX * QWG)};
              int tid2 = tid; asm volatile("" : "+v"(tid2));
              pg8::gemm_phase<pg8::EpiGate8, pg8::StaticOrder, true, true, false, true>(lds, g, S, E, tid2); }
            if (rep == NREP(1) - 1) SEAM(pb + 0); else xcd_barrier(bar);
        }
        if (PHON(2) && IN(pb + 1)) for (int rep = 0; rep < NREP(2); ++rep) { PHASE_LOCALS;
            const float li = l == 0 ? 0.2f : (l == 1 ? 0.35550906759096926f : (l == 2 ? 0.47071301834358416f : 0.5560582041556405f));
#if SCALAR_ATTN
            { AttnPtrs P{PROJ, AG, LSE, nullptr, nullptr, nullptr, nullptr, nullptr, nullptr, nullptr, li}; scalar_attn_phase<0>(P, lds, gw, NGW, wave, lane); }
            { AttnPtrs P{PROJ, nullptr, nullptr, OB, nullptr, nullptr, args.in[5 + zz] + l * 256, args.in[6 + zz] + l * 128, nullptr, nullptr, li}; scalar_attn_phase<1>(P, lds, gw, NGW, wave, lane); }
            { AttnPtrs P{PROJ, nullptr, nullptr, nullptr, OC, nullptr, nullptr, nullptr, args.in[7 + zz] + l * 8, nullptr, li}; scalar_attn_phase<2>(P, lds, gw, NGW, wave, lane); }
            { AttnPtrs P{PROJ, nullptr, nullptr, nullptr, nullptr, OD, nullptr, nullptr, nullptr, args.in[8 + zz] + (size_t)l * 8 * 465, li}; scalar_attn_phase<3>(P, lds, gw, NGW, wave, lane); }
#else
            att::Ptrs X{PROJ, AG, LSE, (unsigned char*)(ws + WS_O8 + (size_t)1 * MTOK * 1024), (unsigned char*)(ws + WS_O8 + (size_t)2 * MTOK * 1024), (unsigned char*)(ws + WS_O8 + (size_t)3 * MTOK * 1024), args.in[5 + zz] + l * 256, args.in[6 + zz] + l * 128, args.in[7 + zz] + l * 8, args.in[8 + zz] + (size_t)l * 8 * 465, li STAMP_ARG((unsigned long long*)(ws + WS_CTL + 65536))};
            att::attn_phase(X, (LAS char*)lds, tid, vcu, G, bx);
#endif
            if (rep == NREP(2) - 1) SEAM(pb + 1); else xcd_barrier(bar);
        }
        if (PHON(3) && IN(pb + 2)) for (int rep = 0; rep < NREP(3); ++rep) { PHASE_LOCALS; combine_a_phase(AG, LSE, (unsigned*)(ws + WS_O8), gw, NGW, lane); if (rep == NREP(3) - 1) SEAM(pb + 2); else xcd_barrier(bar); }
        if (PHON(4) && IN(pb + 3)) for (int rep = 0; rep < NREP(4); ++rep) { PHASE_LOCALS;
            { const float one_m_li = 1.0f - (l == 0 ? 0.2f : (l == 1 ? 0.35550906759096926f : (l == 2 ? 0.47071301834358416f : 0.5560582041556405f)));
              const float qm = 127.0f / (6.0f * 0.2275f * one_m_li);
              pg8::Gemm g{(const bf16_t*)(ws + WS_O8), (const bf16_t*)(ws + WS_W8BR + (size_t)l * 4 * DM * 1024), MTOK, DM, 512, 0, (size_t)MTOK * 1024, (size_t)DM * 1024, nullptr STAMP_ARG(nullptr)}; pg8::BranchOrder4 S; S.init(MTOK, DM, G, bx);
              pg8::EpiGate4 E{MIXED, (const unsigned char*)(ws + WS_GATE), 1.0f / (QO * QWBA), one_m_li / (QX * QWBC), 1.0f / (QO * QWBC), (unsigned char*)(ws + WS_MIXED8), qm};
              pg8::gemm_phase<pg8::EpiGate4, pg8::BranchOrder4, true, true, false, true>(lds, g, S, E, tid); }
            if (rep == NREP(4) - 1) SEAM(pb + 3); else xcd_barrier(bar);
        }
        if (PHON(5) && IN(pb + 4)) for (int rep = 0; rep < NREP(5); ++rep) { PHASE_LOCALS;
            const float one_m_li = 1.0f - (l == 0 ? 0.2f : (l == 1 ? 0.35550906759096926f : (l == 2 ? 0.47071301834358416f : 0.5560582041556405f)));
            const float qm = 127.0f / (6.0f * 0.2275f * one_m_li);
            pg8::Gemm g{(const bf16_t*)(ws + WS_MIXED8), (const bf16_t*)(ws + WS_WOUT + (size_t)l * DM * DM), MTOK, DM, DM / 2, 0, 0, 0, nullptr STAMP_ARG(nullptr)}; pg8::StaticOrder S; S.init(MTOK, DM, G, bx);
            pg8::EpiResid E{(bf16_t*)PRELN, l == 0 ? args.in[0 + zz] : (const float*)nullptr, (const bf16_t*)XF, ALPHA, 1.0f / (qm * QWU)};
            pg8::gemm_phase<pg8::EpiResid, pg8::StaticOrder, true, true, false, true>(lds, g, S, E, tid);
            if (rep == NREP(5) - 1) SEAM(pb + 4); else xcd_barrier(bar);
        }
        if (PHON(6) && IN(pb + 5)) for (int rep = 0; rep < NREP(6); ++rep) { PHASE_LOCALS; ln1_router_phase((const bf16_t*)PRELN, args.in[13 + zz] + (size_t)(l * 2) * DM, args.in[14 + zz] + (size_t)(l * 2) * DM, args.in[9 + zz] + (size_t)l * DM * NEXP, (float*)(ws + WS_STATS), (unsigned*)(ws + WS_X8), AFF, lds, tid, gw, NGW, lane); if (rep == NREP(6) - 1) SEAM(pb + 5); else xcd_barrier(bar); }
        if (PHON(7) && IN(pb + 6)) for (int rep = 0; rep < NREP(7); ++rep) { PHASE_LOCALS; topk_phase(AFF, IDX, GV, SLOT, lds, tid, wave, lane, bx, G); if (rep == NREP(7) - 1) SEAM(pb + 6); else xcd_barrier(bar); }
        if (PHON(9) && IN(pb + 7)) for (int rep = 0; rep < NREP(9); ++rep) { PHASE_LOCALS;
            pg8::Gemm g{(const bf16_t*)(ws + WS_X8), (const bf16_t*)(ws + WS_WGU + (size_t)l * NEXP * 2048 * DM), NGRP * CAP, 2048, DM / 2, (size_t)2048 * DM, 0, 0, IDX STAMP_ARG(nullptr)};
            pg8::StaticOrder S; S.init(NGRP * CAP, 2048, G, bx);
            pg8::EpiSwiGLU E{(unsigned char*)(ws + WS_H), 1.0f / (QX * QWG), 1.0f / (QX * QWU), QH};
            pg8::gemm_phase<pg8::EpiSwiGLU, pg8::StaticOrder, true, true, true, true>(lds, g, S, E, tid);
            if (rep == NREP(9) - 1) SEAM(pb + 7); else xcd_barrier(bar);
        }
        if (PHON(10) && IN(pb + 8)) for (int rep = 0; rep < NREP(10); ++rep) { PHASE_LOCALS;
            pg8::Gemm g{(const bf16_t*)(ws + WS_H), (const bf16_t*)(ws + WS_WDN + (size_t)l * NEXP * DM * DEXP), NGRP * CAP, DM, DEXP / 2, (size_t)DM * DEXP, 0, 0, nullptr STAMP_ARG(nullptr)};
            pg8::StaticOrder S; S.init(NGRP * CAP, DM, G, bx);
            pg8::EpiDown E{YB, GV, 1.0f / (QH * QWD)};
            pg8::gemm_phase<pg8::EpiDown, pg8::StaticOrder, true, true, false, true>(lds, g, S, E, tid);
            if (rep == NREP(10) - 1) SEAM(pb + 8); else xcd_barrier(bar);
        }
        if (PHON(11) && IN(pb + 9)) for (int rep = 0; rep < NREP(11); ++rep) { PHASE_LOCALS;
            if (NREP(11) == 2 && rep == 0) ln2_phase((const bf16_t*)PRELN, (const float*)(ws + WS_STATS), args.in[13 + zz] + (size_t)(l * 2) * DM, args.in[14 + zz] + (size_t)(l * 2) * DM, YB, SLOT, args.in[13 + zz] + (size_t)(l * 2 + 1) * DM, args.in[14 + zz] + (size_t)(l * 2 + 1) * DM, (float*)(ws + WS_O8), (bf16_t*)(ws + WS_O8), MIXED, (unsigned char*)(ws + WS_AG), gw, NGW, lane); else
            ln2_phase((const bf16_t*)PRELN, (const float*)(ws + WS_STATS), args.in[13 + zz] + (size_t)(l * 2) * DM, args.in[14 + zz] + (size_t)(l * 2) * DM, YB, SLOT, args.in[13 + zz] + (size_t)(l * 2 + 1) * DM, args.in[14 + zz] + (size_t)(l * 2 + 1) * DM, (l == DEPTH - 1) ? args.out : XF, (bf16_t*)XF, XB, (l == DEPTH - 1) ? (unsigned char*)nullptr : (unsigned char*)(ws + WS_X8), gw, NGW, lane);
            if (rep == NREP(11) - 1) SEAM(pb + 9); else xcd_barrier(bar);
#if defined(PROBE_XBAR)
            for (int xb_ = 0; xb_ < PROBE_XBAR; ++xb_) xcd_barrier(bar);
#endif
#if defined(STAMP_SEL)
            if (l == DEPTH - 1 && bx == STAMP_WG && tid == 0) { asm volatile("s_waitcnt vmcnt(0)" ::: "memory");
                const unsigned long long* st = (const unsigned long long*)(ws + WS_CTL + 65536);
                float val = 0.f;
                if (STAMP_SEL == 1) val = (float)(st[1] - st[0]) * (1.0f / 32.0f);
                if (STAMP_SEL == 2) val = (float)(st[2] - st[1]);
                if (STAMP_SEL == 3) val = (float)(st[2] - st[0]) / ((float)(st[4] - st[3]) * 0.01f);
                if (STAMP_SEL == 4) val = (float)(st[12] - st[10]) * (1.0f / 63.0f);
                if (STAMP_SEL == 5) val = (float)(st[13] - st[12]);
                if (STAMP_SEL == 7) val = (float)st[20] * 0.01f;
                if (STAMP_SEL == 6) val = (float)(st[12] - st[10]) / ((float)(st[15] - st[14]) * 0.01f);
                const unsigned long long w0 = __builtin_amdgcn_s_memrealtime(), wt = (unsigned long long)(val * (float)STAMP_SCALE);
                while (__builtin_amdgcn_s_memrealtime() - w0 < wt) __builtin_amdgcn_s_sleep(16); }
#endif
        }
    }
#undef IN
#undef SEAM
}

#ifndef MK_ONE_LAUNCH
#define MK_ONE_LAUNCH 1
#endif
extern "C" void kernel_launch(void* const* d_in, const int* in_sizes, int n_in, void* d_out, int out_size, void* d_ws, size_t ws_size, hipStream_t stream) {
    static int grid = 0;
    if (grid == 0) {
        if (n_in != 15 || out_size != MTOK * DM || ws_size < WS_END) { fprintf(stderr, "kernel_launch: unexpected shapes (n_in %d out %d ws %zu, need ws >= %zu)\n", n_in, out_size, ws_size, (size_t)WS_END); grid = -1; return; }
        int dev = 0, cus = 0, per_cu = 0;
        if (hipGetDevice(&dev) != hipSuccess || hipDeviceGetAttribute(&cus, hipDeviceAttributeMultiprocessorCount, dev) != hipSuccess) { grid = -1; return; }
        if (hipFuncSetAttribute((const void*)fwd, hipFuncAttributeMaxDynamicSharedMemorySize, LDS_BYTES) != hipSuccess) { fprintf(stderr, "kernel_launch: hipFuncSetAttribute failed\n"); grid = -1; return; }
        if (hipOccupancyMaxActiveBlocksPerMultiprocessor(&per_cu, (const void*)fwd, NWAVES * 64, LDS_BYTES) != hipSuccess || per_cu < 1) { fprintf(stderr, "kernel_launch: occupancy query says %d\n", per_cu); }
        (void)hipGetLastError();
        grid = cus;
    }
    if (grid < 0) return;
    if (hipMemsetAsync((char*)d_ws + WS_CTL, 0, CTL_ZERO_BYTES, stream) != hipSuccess) return;
    Args a{};
    for (int i = 0; i < 15; ++i) a.in[i] = (const float*)d_in[i];
    a.out = (float*)d_out; a.ws = (unsigned char*)d_ws;
#if MK_ONE_LAUNCH
    a.ph_lo = 0; a.ph_hi = NPHASES;
    hipLaunchKernelGGL(fwd, dim3(grid), dim3(NWAVES * 64), LDS_BYTES, stream, a);
#else
    for (int p = 0; p < NPHASES; ++p) { a.ph_lo = p; a.ph_hi = p + 1; hipLaunchKernelGGL(fwd, dim3(grid), dim3(NWAVES * 64), LDS_BYTES, stream, a); }
#endif
}
```

```cpp
#include <hip/hip_runtime.h>
#include <cstdio>
#include <cstdint>
#include <cmath>
#define B3_PRIO 1
namespace pg8 {
#define PG8_LAS __attribute__((address_space(3)))
typedef unsigned short bf16_t;
typedef short bf16x8 __attribute__((ext_vector_type(8)));
typedef float f32x4 __attribute__((ext_vector_type(4)));
typedef unsigned u32x4 __attribute__((ext_vector_type(4)));
typedef unsigned u32x2 __attribute__((ext_vector_type(2)));
typedef _Float16 f16x8 __attribute__((ext_vector_type(8)));
typedef int i32x4 __attribute__((ext_vector_type(4)));
constexpr int BM = 256, BK = 64, HALF = 128, HTB = HALF * BK * 2  , STAGE_BYTES = 8 * HTB, NXCD = 8, WGM = 8;

__host__ __device__ __forceinline__ int lds_byte(int r, int c) { const int st = (r >> 4) * 2 + (c >> 5), rr = r & 15, cc = c & 31, ob = rr * 64 + cc * 2; return st * 1024 + (ob ^ (((ob >> 9) & 1) << 5)); }
__host__ __device__ __forceinline__ void stage_rc(int b, int& R, int& C) { const int st = b / 1024, sb = b % 1024, swz = sb ^ (((sb >> 9) & 1) << 5); R = (st >> 1) * 16 + swz / 64; C = (st & 1) * 32 + (swz % 64) / 2; }
__host__ __device__ __forceinline__ int perm32(int rho) { const int n = rho >> 4, i = rho & 15; return 8 * (i >> 2) + 4 * n + (i & 3); }

struct Unit { int pm, pn, br; };
struct Gemm { const bf16_t* A; const bf16_t* Bt; int M, N, K; size_t gstride; size_t a_brstride, b_brstride; const int* gidx;
#if defined(STAMP_SEL)
    unsigned long long* stamp;
#endif
};

struct StaticOrder {
    int nM, nN, nwg, G, c;
    __host__ __device__ void init(int M, int N, int G_, int c_) { nM = M / BM; nN = N / BM; nwg = nM * nN; G = G_; c = c_; }
    __host__ __device__ bool next(int i, Unit& u) const {
        const long L = (long)i * G + c; if (L >= nwg) return false;
        int wgid = (int)L; { const int q = nwg / NXCD, r = nwg % NXCD, xcd = wgid % NXCD, off = wgid / NXCD; wgid = (xcd < r ? xcd * (q + 1) : r * (q + 1) + (xcd - r) * q) + off; }
        const int nig = WGM * nN, gid = wgid / nig, fm = gid * WGM, gsz = (nM - fm) < WGM ? (nM - fm) : WGM;
        u.pm = fm + ((wgid % nig) % gsz); u.pn = (wgid % nig) / gsz; u.br = 0; return true;
    }
    __device__ __forceinline__ int ntiles(const Unit&, int nt_full) const { return nt_full; }
    __device__ __forceinline__ void a_ready(const Unit&) const {}
    __device__ __forceinline__ void done(const Unit&) const {}
};
struct BranchOrder4 : StaticOrder {
    __device__ bool next(int i, Unit& u) const { if (!StaticOrder::next(i >> 2, u)) return false; u.br = i & 3; return true; }
    __device__ __forceinline__ int ntiles(const Unit& u, int) const { return u.br == 0 ? 6 : 8; }
};

__device__ __forceinline__ unsigned cvt_pk_bf16(float lo, float hi) { unsigned r; asm volatile("v_cvt_pk_bf16_f32 %0, %1, %2" : "=v"(r) : "v"(lo), "v"(hi)); return r; }
__device__ __forceinline__ float bflo(unsigned w) { return __uint_as_float(w << 16); }
__device__ __forceinline__ float bfhi(unsigned w) { return __uint_as_float(w & 0xffff0000u); }
typedef _Float16 h16x2 __attribute__((ext_vector_type(2)));
__device__ __forceinline__ unsigned pk_f16(float a, float b) { const h16x2 h = {(_Float16)a, (_Float16)b}; return __builtin_bit_cast(unsigned, h); }
__device__ __forceinline__ float f16lo(unsigned w) { return (float)__builtin_bit_cast(h16x2, w)[0]; }
__device__ __forceinline__ float f16hi(unsigned w) { return (float)__builtin_bit_cast(h16x2, w)[1]; }
__device__ __forceinline__ float sigmoidf_(float x) { return 1.0f / (1.0f + __expf(-x)); }
__device__ __forceinline__ unsigned q8x4e(float a, float b, float c, float d, float s) {
    const float ca = fminf(fmaxf(a * s, -127.0f), 127.0f) + 12582912.0f, cb = fminf(fmaxf(b * s, -127.0f), 127.0f) + 12582912.0f;
    const float cc = fminf(fmaxf(c * s, -127.0f), 127.0f) + 12582912.0f, cd = fminf(fmaxf(d * s, -127.0f), 127.0f) + 12582912.0f;
    const unsigned lo = __builtin_amdgcn_perm(__float_as_uint(cb), __float_as_uint(ca), 0x0c0c0400u), hi = __builtin_amdgcn_perm(__float_as_uint(cd), __float_as_uint(cc), 0x0c0c0400u);
    return __builtin_amdgcn_perm(hi, lo, 0x05040100u);
}

template <bool I8> struct EpiProjT {
    static constexpr bool PERM = true, AFTER_DRAIN = false, RMW = false;
    bf16_t* O; const float* rope128; const float* rope64; int cbase, csplit, cskip; float inv_qk, inv_v;
    __device__ __forceinline__ void operator()(const f32x4 (&acc)[2][2][4][2], const Unit& u, int wr, int wc, int fr, int fq) const {
        const int ct = u.pn * BM; const int colt = cbase + ct + (ct >= csplit ? cskip : 0);
        int mode;
        if (colt < 4608) mode = 1; else if (colt < 6912) mode = 0; else if (colt < 8960) mode = 2; else if (colt < 9984) mode = 0; else if (colt < 11264) mode = 1; else mode = 0;
        const bool isv = (colt >= 4608 && colt < 6912) || (colt >= 8960 && colt < 9984) || (colt >= 11264 && colt < 11520) || (colt >= 13568);
        const float inv = isv ? inv_v : inv_qk;
        const int row0 = u.pm * BM + wr * 64 + fr, col0 = colt + wc * 32 + 8 * fq;
        const int i128 = 16 * wc + 4 * fq, i64 = 16 * (wc & 1) + 4 * fq;
        f32x4 cs0[2][4], cs1[2][4];
        if (mode == 1 || mode == 2) {
#pragma unroll
            for (int ai = 0; ai < 2; ++ai)
#pragma unroll
                for (int m = 0; m < 4; ++m) { const int pos = (row0 + ai * HALF + m * 16) & 4095;
                    const f32x4* t = (mode == 1) ? (const f32x4*)(rope128 + ((size_t)pos * 64 + i128) * 2) : (const f32x4*)(rope64 + ((size_t)pos * 32 + i64) * 2);
                    cs0[ai][m] = t[0]; cs1[ai][m] = t[1]; }
        }
#pragma unroll
        for (int ai = 0; ai < 2; ++ai)
#pragma unroll
            for (int m = 0; m < 4; ++m) {
                const int row = row0 + ai * HALF + m * 16;
                bf16_t* rowp = O + (size_t)row * 14592 + col0;
#pragma unroll
                for (int bj = 0; bj < 2; ++bj) {
                    f32x4 v0 = acc[ai][bj][m][0], v1 = acc[ai][bj][m][1];
                    if constexpr (I8) { const i32x4 i0 = __builtin_bit_cast(i32x4, v0), i1 = __builtin_bit_cast(i32x4, v1);
                        v0 = (f32x4){(float)i0[0], (float)i0[1], (float)i0[2], (float)i0[3]} * inv; v1 = (f32x4){(float)i1[0], (float)i1[1], (float)i1[2], (float)i1[3]} * inv; }
                    if (mode == 1 || mode == 2) {
                        const f32x4 c0 = cs0[ai][m], c1 = cs1[ai][m];
                        f32x4 r0, r1;
                        r0[0] = v0[0] * c0[0] - v0[1] * c0[1]; r0[1] = v0[1] * c0[0] + v0[0] * c0[1];
                        r0[2] = v0[2] * c0[2] - v0[3] * c0[3]; r0[3] = v0[3] * c0[2] + v0[2] * c0[3];
                        r1[0] = v1[0] * c1[0] - v1[1] * c1[1]; r1[1] = v1[1] * c1[0] + v1[0] * c1[1];
                        r1[2] = v1[2] * c1[2] - v1[3] * c1[3]; r1[3] = v1[3] * c1[2] + v1[2] * c1[3];
                        v0 = r0; v1 = r1;
                    }
                    {
                        u32x4 w; w.x = cvt_pk_bf16(v0[0], v0[1]); w.y = cvt_pk_bf16(v0[2], v0[3]); w.z = cvt_pk_bf16(v1[0], v1[1]); w.w = cvt_pk_bf16(v1[2], v1[3]);
                        *(u32x4*)(rowp + bj * HALF) = w;
                    }
                }
            }
    }
};
struct EpiGate8 {
    static constexpr bool PERM = true, AFTER_DRAIN = false, RMW = false;
    unsigned char* G8; const float* bgate; float inv;
    __device__ __forceinline__ void operator()(const f32x4 (&acc)[2][2][4][2], const Unit& u, int wr, int wc, int fr, int fq) const {
        const int row0 = u.pm * BM + wr * 64 + fr, col0 = u.pn * BM + wc * 32 + 8 * fq;
        const float ninv = -inv * 1.4426950408889634f;
        f32x4 gb[2][2];
#pragma unroll
        for (int bj = 0; bj < 2; ++bj)
#pragma unroll
            for (int n = 0; n < 2; ++n) gb[bj][n] = *(const f32x4*)(bgate + col0 + bj * HALF + 4 * n) * (-1.4426950408889634f);
#pragma unroll
        for (int ai = 0; ai < 2; ++ai)
#pragma unroll
            for (int m = 0; m < 4; ++m) { unsigned char* growp = G8 + (size_t)(row0 + ai * HALF + m * 16) * 8192 + col0;
#pragma unroll
                for (int bj = 0; bj < 2; ++bj) { const i32x4 a0 = __builtin_bit_cast(i32x4, acc[ai][bj][m][0]), a1 = __builtin_bit_cast(i32x4, acc[ai][bj][m][1]);
                    unsigned q[8];
#pragma unroll
                    for (int j = 0; j < 4; ++j) {
                        const float e0 = __builtin_amdgcn_exp2f(fmaf((float)a0[j], ninv, gb[bj][0][j])), e1 = __builtin_amdgcn_exp2f(fmaf((float)a1[j], ninv, gb[bj][1][j]));
                        q[j] = __float_as_uint(__builtin_amdgcn_rcpf(fmaf(e0, 1.0f / 255.0f, 1.0f / 255.0f)) + 12582912.0f);
                        q[4 + j] = __float_as_uint(__builtin_amdgcn_rcpf(fmaf(e1, 1.0f / 255.0f, 1.0f / 255.0f)) + 12582912.0f); }
                    u32x2 wq;
                    wq.x = __builtin_amdgcn_perm(__builtin_amdgcn_perm(q[3], q[2], 0x0c0c0400u), __builtin_amdgcn_perm(q[1], q[0], 0x0c0c0400u), 0x05040100u);
                    wq.y = __builtin_amdgcn_perm(__builtin_amdgcn_perm(q[7], q[6], 0x0c0c0400u), __builtin_amdgcn_perm(q[5], q[4], 0x0c0c0400u), 0x05040100u);
                    *(u32x2*)(growp + bj * HALF) = wq; } }
    }
};
struct EpiGate4 {
    static constexpr bool PERM = true, AFTER_DRAIN = false, RMW = true;
    bf16_t* mixed; const unsigned char* gate; float inv_a, inv_b, inv_cd; unsigned char* mixed8; float qm;
    __device__ __forceinline__ void operator()(const f32x4 (&acc)[2][2][4][2], const Unit& u, int wr, int wc, int fr, int fq) const {
        const int row0 = u.pm * BM + wr * 64 + fr, col0 = u.pn * BM + wc * 32 + 8 * fq;
        const unsigned char* gate_b = gate + u.br * 2048; const bool first = u.br == 0, last = u.br == 3;
        const float sc = (inv_cd + (u.br == 0 ? 1.0f : 0.0f) * (inv_a - inv_cd) + (u.br == 1 ? 1.0f : 0.0f) * (inv_b - inv_cd)) * (1.0f / 255.0f);
#pragma unroll
        for (int ai = 0; ai < 2; ++ai) {
            u32x2 g[4][2]; u32x4 p[4][2];
#pragma unroll
            for (int m = 0; m < 4; ++m) { const int row = row0 + ai * HALF + m * 16;
#pragma unroll
                for (int bj = 0; bj < 2; ++bj) { g[m][bj] = *(const u32x2*)(gate_b + (size_t)row * 8192 + col0 + bj * HALF);
                    p[m][bj] = (u32x4){0u, 0u, 0u, 0u}; if (!first) p[m][bj] = *(const u32x4*)(mixed + (size_t)row * 2048 + col0 + bj * HALF); } }
#pragma unroll
            for (int m = 0; m < 4; ++m) { const int row = row0 + ai * HALF + m * 16; bf16_t* mp = mixed + (size_t)row * 2048 + col0;
#pragma unroll
                for (int bj = 0; bj < 2; ++bj) {
                    const u32x2 gg = g[m][bj]; const u32x4 pp = p[m][bj]; const i32x4 i0 = __builtin_bit_cast(i32x4, acc[ai][bj][m][0]), i1 = __builtin_bit_cast(i32x4, acc[ai][bj][m][1]);
                    const f32x4 v0 = (f32x4){(float)i0[0], (float)i0[1], (float)i0[2], (float)i0[3]} * sc, v1 = (f32x4){(float)i1[0], (float)i1[1], (float)i1[2], (float)i1[3]} * sc;
                    const float s0 = bflo(pp.x) + (float)(gg.x & 0xffu) * v0[0], s1 = bfhi(pp.x) + (float)((gg.x >> 8) & 0xffu) * v0[1], s2 = bflo(pp.y) + (float)((gg.x >> 16) & 0xffu) * v0[2], s3 = bfhi(pp.y) + (float)(gg.x >> 24) * v0[3];
                    const float s4 = bflo(pp.z) + (float)(gg.y & 0xffu) * v1[0], s5 = bfhi(pp.z) + (float)((gg.y >> 8) & 0xffu) * v1[1], s6 = bflo(pp.w) + (float)((gg.y >> 16) & 0xffu) * v1[2], s7 = bfhi(pp.w) + (float)(gg.y >> 24) * v1[3];
                    if (last) { u32x2 q8; q8.x = q8x4e(s0, s1, s2, s3, qm); q8.y = q8x4e(s4, s5, s6, s7, qm); *(u32x2*)(mixed8 + (size_t)row * 2048 + col0 + bj * HALF) = q8; }
                    else { u32x4 w; w.x = cvt_pk_bf16(s0, s1); w.y = cvt_pk_bf16(s2, s3); w.z = cvt_pk_bf16(s4, s5); w.w = cvt_pk_bf16(s6, s7); *(u32x4*)(mp + bj * HALF) = w; }
                } }
        }
    }
};
struct EpiResid {
    static constexpr bool PERM = false, AFTER_DRAIN = false, RMW = false;
    bf16_t* out; const float* xf; const bf16_t* xh; float alpha, inv;
    __device__ __forceinline__ void operator()(const f32x4 (&acc)[2][2][4][2], const Unit& u, int wr, int wc, int fr, int fq) const {
        const int row0 = u.pm * BM + wr * 64 + fr, col0 = u.pn * BM + wc * 32 + 4 * fq;
#pragma unroll
        for (int ai = 0; ai < 2; ++ai) {
            f32x4 x[4][2][2];
#pragma unroll
            for (int m = 0; m < 4; ++m) { const size_t off = (size_t)(row0 + ai * HALF + m * 16) * 2048 + col0;
#pragma unroll
                for (int bj = 0; bj < 2; ++bj)
#pragma unroll
                    for (int n = 0; n < 2; ++n) { if (xf) x[m][bj][n] = *(const f32x4*)(xf + off + bj * HALF + n * 16);
                        else { const u32x2 w = *(const u32x2*)(xh + off + bj * HALF + n * 16); x[m][bj][n] = (f32x4){f16lo(w.x), f16hi(w.x), f16lo(w.y), f16hi(w.y)}; } } }
#pragma unroll
            for (int m = 0; m < 4; ++m) { const size_t off = (size_t)(row0 + ai * HALF + m * 16) * 2048 + col0;
#pragma unroll
                for (int bj = 0; bj < 2; ++bj)
#pragma unroll
                    for (int n = 0; n < 2; ++n) { const i32x4 ia = __builtin_bit_cast(i32x4, acc[ai][bj][m][n]); const f32x4 r = x[m][bj][n] * alpha + (f32x4){(float)ia[0], (float)ia[1], (float)ia[2], (float)ia[3]} * inv;
                        u32x2 w; w.x = pk_f16(r[0], r[1]); w.y = pk_f16(r[2], r[3]); *(u32x2*)(out + off + bj * HALF + n * 16) = w; } }
        }
    }
};
struct EpiSwiGLU {
    static constexpr bool PERM = true, AFTER_DRAIN = false, RMW = false;
    unsigned char* H; float inv_g, inv_u, qh;
    __device__ __forceinline__ void operator()(const f32x4 (&acc)[2][2][4][2], const Unit& u, int wr, int wc, int fr, int fq) const {
        const int row0 = u.pm * BM + wr * 64 + fr, col0 = u.pn * HALF + wc * 32 + 8 * fq;
        const float ksc = qh * inv_g * inv_u, kexp = -inv_g * 1.4426950408889634f;
#pragma unroll
        for (int ai = 0; ai < 2; ++ai)
#pragma unroll
            for (int m = 0; m < 4; ++m) {
                unsigned char* hp = H + (size_t)(row0 + ai * HALF + m * 16) * 1024 + col0;
                f32x4 h0, h1;
                const i32x4 ig0 = __builtin_bit_cast(i32x4, acc[ai][0][m][0]), ig1 = __builtin_bit_cast(i32x4, acc[ai][0][m][1]), iu0 = __builtin_bit_cast(i32x4, acc[ai][1][m][0]), iu1 = __builtin_bit_cast(i32x4, acc[ai][1][m][1]);
#pragma unroll
                for (int j = 0; j < 4; ++j) { const float fg0 = (float)ig0[j], fg1 = (float)ig1[j];
                    h0[j] = fg0 * (float)iu0[j] * ksc * __builtin_amdgcn_rcpf(1.0f + __builtin_amdgcn_exp2f(fg0 * kexp));
                    h1[j] = fg1 * (float)iu1[j] * ksc * __builtin_amdgcn_rcpf(1.0f + __builtin_amdgcn_exp2f(fg1 * kexp)); }
                u32x2 w; w.x = q8x4e(h0[0], h0[1], h0[2], h0[3], 1.0f); w.y = q8x4e(h1[0], h1[1], h1[2], h1[3], 1.0f);
                *(u32x2*)hp = w;
            }
    }
};
struct EpiDown {
    static constexpr bool PERM = true, AFTER_DRAIN = false, RMW = false;
    unsigned char* Y; float sc;
    __device__ __forceinline__ void operator()(const f32x4 (&acc)[2][2][4][2], const Unit& u, int wr, int wc, int fr, int fq) const {
        const int row0 = u.pm * BM + wr * 64 + fr, col0 = u.pn * BM + wc * 32 + 8 * fq;
#pragma unroll
        for (int ai = 0; ai < 2; ++ai)
#pragma unroll
            for (int m = 0; m < 4; ++m) {
                const int row = row0 + ai * HALF + m * 16;
                unsigned char* yp = Y + (size_t)row * 2048 + col0;
#pragma unroll
                for (int bj = 0; bj < 2; ++bj) { const i32x4 i0 = __builtin_bit_cast(i32x4, acc[ai][bj][m][0]), i1 = __builtin_bit_cast(i32x4, acc[ai][bj][m][1]);
                    u32x2 w; w.x = q8x4e((float)i0[0], (float)i0[1], (float)i0[2], (float)i0[3], sc) ^ 0x80808080u; w.y = q8x4e((float)i1[0], (float)i1[1], (float)i1[2], (float)i1[3], sc) ^ 0x80808080u;
                    *(u32x2*)(yp + bj * HALF) = w; }
            }
    }
};

template <class Epi, class Sched, bool ALIGN_EPI = false, bool SP2 = false, bool GATHER = false, bool I8 = false, bool F16 = false>
__device__ __forceinline__ void gemm_phase(PG8_LAS unsigned char* lds, const Gemm g, const Sched& S, const Epi& E, const int tid) {
    const int wid = __builtin_amdgcn_readfirstlane(tid >> 6), lane = tid & 63, wr = wid >> 2, wc = wid & 3, fr = lane & 15, fq = lane >> 4;
    const int K = g.K, nt = K / BK;
    unsigned voffA[2], voffB[2];
#pragma unroll
    for (int i = 0; i < 2; ++i) { int R, C; stage_rc(tid * 16 + i * 8192, R, C); const int Rb = Epi::PERM ? ((R & ~31) + perm32(R & 31)) : R;
        voffA[i] = (unsigned)(R * K + C) * 2u; voffB[i] = (unsigned)(Rb * K + C) * 2u; }
    unsigned gcur[2][2] = {{0u, 0u}, {0u, 0u}}, gnx[2][2] = {{0u, 0u}, {0u, 0u}};
#define PG8_GOFF(dst, U) do { _Pragma("unroll") for (int _h = 0; _h < 2; ++_h) _Pragma("unroll") for (int _i = 0; _i < 2; ++_i) { int R_, C_; stage_rc(tid * 16 + _i * 8192, R_, C_); \
        const int r_ = (U).pm * BM + _h * HALF + R_; const int tok_ = g.gidx[r_]; dst[_h][_i] = (unsigned)(((r_ >> 13) * 4096 + tok_) * K + C_) * 2u; } } while (0)
    const size_t kstep = (size_t)(BK * 2);
    const size_t hstep = (size_t)HALF * K * 2;
    const size_t tstep = 2 * hstep;
    const unsigned ldsw = (unsigned)wid * 1024u;
    const int aoff = lds_byte(wr * 64 + fr, fq * 8), boff = lds_byte(wc * 32 + fr, fq * 8);
#define PG8_SA(b, h) (((b) * 2 + (h)) * HTB)
#define PG8_SB(b, h) ((4 + (b) * 2 + (h)) * HTB)
#define PG8_STAGE(bufoff, gbase, voff) do { _Pragma("unroll") for (int _i = 0; _i < 2; ++_i) \
        __builtin_amdgcn_global_load_lds((const unsigned*)((const char*)(gbase) + (voff)[_i]), (PG8_LAS unsigned*)(lds + (bufoff) + ldsw + _i * 8192), 16, 0, 0); } while (0)
#define PG8_LDA(dst, b, h) do { _Pragma("unroll") for (int m = 0; m < 4; ++m) _Pragma("unroll") for (int k = 0; k < 2; ++k) dst[m][k] = *(const PG8_LAS bf16x8*)(lds + PG8_SA(b, h) + aoff + m * 2048 + k * 1024); } while (0)
#define PG8_LDB(dst, b, h) do { _Pragma("unroll") for (int n = 0; n < 2; ++n) _Pragma("unroll") for (int k = 0; k < 2; ++k) dst[n][k] = *(const PG8_LAS bf16x8*)(lds + PG8_SB(b, h) + boff + n * 2048 + k * 1024); } while (0)
#define PG8_MMA(ai, bj, At, Bt) do { __builtin_amdgcn_s_setprio(1); _Pragma("unroll") for (int m = 0; m < 4; ++m) _Pragma("unroll") for (int n = 0; n < 2; ++n) _Pragma("unroll") for (int k = 0; k < 2; ++k) { \
        if constexpr (I8) acc[ai][bj][m][n] = __builtin_bit_cast(f32x4, __builtin_amdgcn_mfma_i32_16x16x64_i8(__builtin_bit_cast(i32x4, Bt[n][k]), __builtin_bit_cast(i32x4, At[m][k]), __builtin_bit_cast(i32x4, acc[ai][bj][m][n]), 0, 0, 0)); \
        else if constexpr (F16) acc[ai][bj][m][n] = __builtin_amdgcn_mfma_f32_16x16x32_f16(__builtin_bit_cast(f16x8, Bt[n][k]), __builtin_bit_cast(f16x8, At[m][k]), acc[ai][bj][m][n], 0, 0, 0); \
        else acc[ai][bj][m][n] = __builtin_amdgcn_mfma_f32_16x16x32_bf16(Bt[n][k], At[m][k], acc[ai][bj][m][n], 0, 0, 0); } \
        __builtin_amdgcn_s_setprio(0); } while (0)
#define PG8_STA(bufoff, gbase, h, nx) do { if constexpr (GATHER) { unsigned vo_[2]; vo_[0] = (nx) ? gnx[h][0] : gcur[h][0]; vo_[1] = (nx) ? gnx[h][1] : gcur[h][1]; PG8_STAGE(bufoff, gbase, vo_); } \
        else { PG8_STAGE(bufoff, (gbase) + (h) * hstep, voffA); } } while (0)
#define PG8_WAIT_V(n) asm volatile("s_waitcnt vmcnt(" #n ")" ::: "memory")
#define PG8_WAIT_L(n) asm volatile("s_waitcnt lgkmcnt(" #n ")" ::: "memory")
#define PG8_BAR __builtin_amdgcn_s_barrier()
#define PG8_SCHED __builtin_amdgcn_sched_barrier(0)
    Unit cur, nxt; int ui = 0;
    if (!S.next(0, cur)) return;
    f32x4 acc[2][2][4][2];
#pragma unroll
    for (int a = 0; a < 2; ++a)
#pragma unroll
        for (int b = 0; b < 2; ++b)
#pragma unroll
            for (int m = 0; m < 4; ++m)
#pragma unroll
                for (int n = 0; n < 2; ++n) acc[a][b][m][n] = (f32x4){0.f, 0.f, 0.f, 0.f};
    bf16x8 At[4][2], B0[2][2], B1[2][2];
    const char* cA = (const char*)g.A + (size_t)cur.br * g.a_brstride + (GATHER ? (size_t)0 : (size_t)cur.pm * tstep); const char* cB = (const char*)g.Bt + (size_t)cur.br * g.b_brstride + (size_t)((cur.pm >> 1) & 15) * g.gstride + (size_t)cur.pn * tstep;
    S.a_ready(cur);
    if constexpr (GATHER) PG8_GOFF(gcur, cur);
    if constexpr (SP2) {
        PG8_STAGE(PG8_SB(0, 0), cB, voffB); PG8_STAGE(PG8_SB(0, 1), cB + hstep, voffB); PG8_STA(PG8_SA(0, 0), cA, 0, false); PG8_STA(PG8_SA(0, 1), cA, 1, false);
        if (wr == 1) PG8_BAR;
        PG8_WAIT_V(2); PG8_BAR;
        PG8_STAGE(PG8_SB(1, 0), cB + kstep, voffB); PG8_STA(PG8_SA(1, 0), cA + kstep, 0, false); PG8_STAGE(PG8_SB(1, 1), cB + hstep + kstep, voffB);
        PG8_WAIT_V(6); PG8_BAR;
    } else {
        PG8_STAGE(PG8_SB(0, 0), cB, voffB); PG8_STAGE(PG8_SA(0, 0), cA, voffA); PG8_STAGE(PG8_SB(0, 1), cB + hstep, voffB); PG8_STAGE(PG8_SA(0, 1), cA + hstep, voffA);
        if (wr == 1) PG8_BAR;
        PG8_WAIT_V(4); PG8_BAR;
        PG8_STAGE(PG8_SB(1, 0), cB + kstep, voffB); PG8_STAGE(PG8_SA(1, 0), cA + kstep, voffA); PG8_STAGE(PG8_SB(1, 1), cB + hstep + kstep, voffB);
        PG8_WAIT_V(6); PG8_BAR;
    }
#if defined(STAMP_SEL)
    unsigned long long st_t0 = 0, st_t1 = 0, st_t2 = 0, st_r0 = 0, st_r1 = 0;
#endif
    for (;;) {
        const bool has_next = S.next(ui + 1, nxt);
#if defined(STAMP_SEL)
        if (g.stamp && ui == 5) { st_t0 = __builtin_amdgcn_s_memtime(); st_r0 = __builtin_amdgcn_s_memrealtime(); }
#endif
        const char* nA = has_next ? (const char*)g.A + (size_t)nxt.br * g.a_brstride + (GATHER ? (size_t)0 : (size_t)nxt.pm * tstep) : cA; const char* nB = has_next ? (const char*)g.Bt + (size_t)nxt.br * g.b_brstride + (size_t)((nxt.pm >> 1) & 15) * g.gstride + (size_t)nxt.pn * tstep : cB;
        const int ntu = S.ntiles(cur, nt);
        if constexpr (GATHER) { if (has_next) PG8_GOFF(gnx, nxt); else { gnx[0][0] = gcur[0][0]; gnx[0][1] = gcur[0][1]; gnx[1][0] = gcur[1][0]; gnx[1][1] = gcur[1][1]; } }
        for (int t = 0; t < ntu; t += 2) {
            const bool last = (t == ntu - 2);
            const char* a1 = cA + (size_t)(t + 1) * kstep;
            const char* a2 = last ? nA : cA + (size_t)(t + 2) * kstep; const char* b2 = last ? nB : cB + (size_t)(t + 2) * kstep;
            const char* a3 = a2 + kstep; const char* b3 = b2 + kstep;
            if (last && has_next) S.a_ready(nxt);
            if constexpr (SP2) {
            PG8_LDB(B0, 0, 0); PG8_LDB(B1, 0, 1); PG8_SCHED; PG8_LDA(At, 0, 0); PG8_STA(PG8_SA(1, 1), a1, 1, false);
            PG8_WAIT_V(8); PG8_WAIT_L(0); PG8_BAR; PG8_MMA(0, 0, At, B0); PG8_MMA(0, 1, At, B1); PG8_BAR; PG8_SCHED;
            PG8_LDA(At, 0, 1); PG8_STAGE(PG8_SB(0, 0), b2, voffB); PG8_STAGE(PG8_SB(0, 1), b2 + hstep, voffB); PG8_STA(PG8_SA(0, 0), a2, 0, last);
            PG8_WAIT_V(8); PG8_WAIT_L(0); PG8_BAR; PG8_MMA(1, 0, At, B0); PG8_MMA(1, 1, At, B1); PG8_BAR; PG8_SCHED;
            PG8_LDB(B0, 1, 0); PG8_LDB(B1, 1, 1); PG8_SCHED; PG8_LDA(At, 1, 0); PG8_STA(PG8_SA(0, 1), a2, 1, last);
            PG8_WAIT_V(8); PG8_WAIT_L(0); PG8_BAR; PG8_MMA(0, 0, At, B0); PG8_MMA(0, 1, At, B1); PG8_BAR; PG8_SCHED;
            PG8_LDA(At, 1, 1); PG8_STAGE(PG8_SB(1, 0), b3, voffB); PG8_STAGE(PG8_SB(1, 1), b3 + hstep, voffB); PG8_STA(PG8_SA(1, 0), a3, 0, last);
            PG8_WAIT_V(8); PG8_WAIT_L(0); PG8_BAR; PG8_MMA(1, 0, At, B0); PG8_MMA(1, 1, At, B1); PG8_BAR; PG8_SCHED;
            } else {
            PG8_LDB(B0, 0, 0); PG8_SCHED; PG8_LDA(At, 0, 0); PG8_STAGE(PG8_SA(1, 1), a1 + hstep, voffA);
            PG8_WAIT_L(8); PG8_BAR; PG8_WAIT_L(0); PG8_MMA(0, 0, At, B0); PG8_BAR; PG8_SCHED;
            PG8_LDB(B1, 0, 1); PG8_STAGE(PG8_SB(0, 0), b2, voffB);
            PG8_BAR; PG8_WAIT_L(0); PG8_MMA(0, 1, At, B1); PG8_BAR;
            PG8_LDA(At, 0, 1); PG8_STAGE(PG8_SA(0, 0), a2, voffA);
            PG8_BAR; PG8_WAIT_L(0); PG8_MMA(1, 0, At, B0); PG8_BAR; PG8_SCHED;
            PG8_STAGE(PG8_SB(0, 1), b2 + hstep, voffB);
            PG8_WAIT_V(6); PG8_BAR; PG8_MMA(1, 1, At, B1); PG8_BAR;
            PG8_LDB(B0, 1, 0); PG8_SCHED; PG8_LDA(At, 1, 0); PG8_STAGE(PG8_SA(0, 1), a2 + hstep, voffA);
            PG8_WAIT_L(8); PG8_BAR; PG8_WAIT_L(0); PG8_MMA(0, 0, At, B0); PG8_BAR; PG8_SCHED;
            PG8_LDB(B1, 1, 1); PG8_STAGE(PG8_SB(1, 0), b3, voffB);
            PG8_BAR; PG8_WAIT_L(0); PG8_MMA(0, 1, At, B1); PG8_BAR;
            PG8_LDA(At, 1, 1); PG8_STAGE(PG8_SA(1, 0), a3, voffA);
            PG8_BAR; PG8_WAIT_L(0); PG8_MMA(1, 0, At, B0); PG8_BAR; PG8_SCHED;
            PG8_STAGE(PG8_SB(1, 1), b3 + hstep, voffB);
            PG8_WAIT_V(6); PG8_BAR; PG8_MMA(1, 1, At, B1); PG8_BAR;
            }
        }
#if defined(STAMP_SEL)
        if (g.stamp && ui == 5) st_t1 = __builtin_amdgcn_s_memtime();
#endif
        if constexpr (ALIGN_EPI) { if (wr == 0) PG8_BAR; }
        if constexpr (!Epi::AFTER_DRAIN) { E(acc, cur, wr, wc, fr, fq);
#if defined(PROBE_EPI2)
            if constexpr (!Epi::RMW) { asm volatile("" ::: "memory"); E(acc, cur, wr, wc, fr, fq); }
#endif
            S.done(cur); }
#if defined(STAMP_SEL)
        if (g.stamp && ui == 5) { st_t2 = __builtin_amdgcn_s_memtime(); st_r1 = __builtin_amdgcn_s_memrealtime(); }
#endif
        if (!has_next) break;
#pragma unroll
        for (int a = 0; a < 2; ++a)
#pragma unroll
            for (int b = 0; b < 2; ++b)
#pragma unroll
                for (int m = 0; m < 4; ++m)
#pragma unroll
                    for (int n = 0; n < 2; ++n) acc[a][b][m][n] = (f32x4){0.f, 0.f, 0.f, 0.f};
        cur = nxt; cA = nA; cB = nB; ++ui;
        if constexpr (GATHER) { gcur[0][0] = gnx[0][0]; gcur[0][1] = gnx[0][1]; gcur[1][0] = gnx[1][0]; gcur[1][1] = gnx[1][1]; }
        if constexpr (ALIGN_EPI) { if (wr == 1) PG8_BAR; }
    }
    PG8_WAIT_V(0);
    if constexpr (!ALIGN_EPI) { if (wr == 0) PG8_BAR; }
    PG8_BAR;
    if constexpr (Epi::AFTER_DRAIN) { E.fused(acc, cur, wr, wc, fr, fq, lds, wid, lane); S.done(cur); }
#if defined(STAMP_SEL)
    if (g.stamp && tid == 0) { g.stamp[0] = st_t0; g.stamp[1] = st_t1; g.stamp[2] = st_t2; g.stamp[3] = st_r0; g.stamp[4] = st_r1; }
#endif
#undef PG8_SA
#undef PG8_SB
#undef PG8_STAGE
#undef PG8_LDA
#undef PG8_LDB
#undef PG8_MMA
#undef PG8_STA
#undef PG8_GOFF
#undef PG8_WAIT_V
#undef PG8_WAIT_L
#undef PG8_BAR
#undef PG8_SCHED
}
}

#if defined(STAMP_SEL)
#define STAMP_ARG(x) , x
#else
#define STAMP_ARG(x)
#endif

constexpr int DM = 2048, NBATCH = 4, SEQ = 4096, DEPTH = 4, MTOK = NBATCH * SEQ;
constexpr int IN_TOTAL = 22784, PROJ_PITCH = 14592;
constexpr int OFF_QA = 0, OFF_KA = 2304, OFF_VA = 4608, OFF_QB = 6912, OFF_KB = 7936, OFF_VB = 8960, OFF_QC = 9984, OFF_KC = 11008, OFF_VC = 11264, OFF_QD = 11520, OFF_KD = 12544, OFF_VD = 13568, OFF_GATE = 14592;
constexpr int BR_TOTAL = 3840;
constexpr int NEXP = 16, CAP = 512, DEXP = 1024, NGRP = NBATCH * NEXP;
constexpr float LN_EPS = 1e-5f, SUBLN_EPS = 1e-5f;
constexpr float ALPHA = 1.6817928305074290f;
constexpr size_t MiB = 1u << 20;
constexpr size_t WS_CTL = 0, CTL_ZERO_BYTES = 1 * MiB;
constexpr size_t WS_ROPE128 = 1 * MiB, WS_ROPE64 = 3 * MiB, WS_AFF = 4 * MiB, WS_IDX = 5 * MiB, WS_GV = 5 * MiB + 131072, WS_SLOT = 6 * MiB, WS_LSE = 7 * MiB, WS_STATS = 9 * MiB;
constexpr size_t WS_XF = 16 * MiB, WS_XB = 144 * MiB;
constexpr size_t WS_X8 = 208 * MiB;
constexpr size_t WS_W8G = 240 * MiB;
constexpr float QSIG = 4.0f;
constexpr float QX = 127.0f / QSIG, QWG = 127.0f / (QSIG * 0.022097086912079608f), QWU = 127.0f / (QSIG * 0.022097086912079608f * 0.42044820762685725f),
                QO = 127.0f / 0.5f, QWBA = 127.0f / (QSIG * 0.42044820762685725f * 0.036084391824351615f), QWBC = 127.0f / (QSIG * 0.42044820762685725f * 0.03125f),
                QY = 127.0f / (5.0f * 0.1054f), QH = 127.0f / 4.0f, QWD = 127.0f / (QSIG * 0.03125f * 0.42044820762685725f);
constexpr size_t WS_O4 = 2552 * MiB, WS_OA = WS_O4, WS_OB = WS_O4 + 32 * MiB, WS_OC = WS_O4 + 64 * MiB, WS_OD = WS_O4 + 96 * MiB;
constexpr size_t WS_AG = 328 * MiB;
constexpr size_t WS_MIXED8 = 400 * MiB;
constexpr size_t WS_MIXED = 432 * MiB;
constexpr size_t WS_PRELN = 496 * MiB;
constexpr size_t WS_PROJ = 624 * MiB;
constexpr size_t WS_GATE = WS_PROJ + 456 * MiB;
constexpr size_t WS_XG = WS_PROJ, WS_H = WS_PROJ + 128 * MiB, WS_Y = WS_PROJ + 192 * MiB;
constexpr size_t WS_W8Q = 1336 * MiB;
constexpr size_t WS_WIN = 1432 * MiB;
constexpr size_t WS_W8BR = 1692 * MiB;
constexpr size_t WS_O8 = 2616 * MiB;
constexpr size_t WS_WOUT = 1752 * MiB;
constexpr size_t WS_WGU = 1784 * MiB;
constexpr size_t WS_WDN = 2296 * MiB;
constexpr size_t WS_END = 2744 * MiB;
static_assert(WS_PROJ + (size_t)MTOK * IN_TOTAL * 2 == WS_W8Q && WS_W8Q + (size_t)DEPTH * 11520 * DM <= WS_WIN && WS_WIN + (size_t)DEPTH * 3072 * DM * 2 <= 1692 * MiB, "ws map");
constexpr int CW_BAR = 4096;
constexpr int LDS_BYTES = 155648, LDSCTL_OFF = 155136;
constexpr int NWAVES = 8;
#ifndef LB_WAVES
#define LB_WAVES 2
#endif
constexpr int NPL = 10, NPHASES = 1 + DEPTH * NPL;

#define GAS __attribute__((address_space(1)))
#define LAS __attribute__((address_space(3)))
typedef unsigned short bf16_t;
typedef float f32x4 __attribute__((ext_vector_type(4)));
typedef float f32x2 __attribute__((ext_vector_type(2)));
typedef unsigned u32x4 __attribute__((ext_vector_type(4)));
typedef unsigned u32x2 __attribute__((ext_vector_type(2)));
using pg8::cvt_pk_bf16; using pg8::bflo; using pg8::bfhi; using pg8::pk_f16; using pg8::f16lo; using pg8::f16hi;
__device__ __forceinline__ float bf2f(bf16_t h) { return __uint_as_float(((unsigned)h) << 16); }
__device__ __forceinline__ float wave_sum(float v) {
#pragma unroll
    for (int o = 1; o < 64; o <<= 1) v += __shfl_xor(v, o);
    return v;
}
__device__ __forceinline__ float wave_max(float v) {
#pragma unroll
    for (int o = 1; o < 64; o <<= 1) v = fmaxf(v, __shfl_xor(v, o));
    return v;
}
__device__ __forceinline__ int wave_sum_i(int v) {
#pragma unroll
    for (int o = 1; o < 64; o <<= 1) v += __shfl_xor(v, o);
    return v;
}

#define XB_TMO      128
#define XB_XCNT(j)  (256  + 64 * (j))
#define XB_XSUB(j)  (1280 + 64 * (j))
#define XB_XGEN(j)  (2304 + 64 * (j))
#define XB_TOP      3328
#define XB_TOPGEN   3392
#define XCD_BAR_WORDS 3456
#define XB_SPIN_CAP (1u << 23)

__device__ __forceinline__ unsigned xb_ld(unsigned* p)              { return __hip_atomic_load(p, __ATOMIC_RELAXED, __HIP_MEMORY_SCOPE_AGENT); }
__device__ __forceinline__ unsigned xb_add(unsigned* p, unsigned v) { return __hip_atomic_fetch_add(p, v, __ATOMIC_RELAXED, __HIP_MEMORY_SCOPE_AGENT); }
__device__ __forceinline__ unsigned xb_xcc_id() { return (unsigned)__builtin_amdgcn_s_getreg((3 << 11) | 20) & 0xFu; }
#define XB_SPIN(cond, bar) do { unsigned _sp = 0; while (cond) { __builtin_amdgcn_s_sleep(1); \
    if ((++_sp & 255u) == 0u) { if (xb_ld(&(bar)[XB_TMO])) break; if (_sp > XB_SPIN_CAP) { atomicAdd(&(bar)[XB_TMO], 1u); break; } } } } while (0)

struct XcdBarrier {
    unsigned* bar; unsigned x;
    volatile LAS unsigned* st;
};
__device__ __forceinline__ XcdBarrier xcd_barrier_post(unsigned* bar, volatile LAS unsigned* st) {
    XcdBarrier b; b.bar = bar; b.x = xb_xcc_id(); b.st = st;
    if (threadIdx.x == 0) (void)xb_add(&bar[XB_XCNT(b.x)], 1u);
    return b;
}
__device__ __forceinline__ void xcd_barrier_complete(unsigned* bar, unsigned x, unsigned& nloc, unsigned& nx) {
    const unsigned G = gridDim.x * gridDim.y * gridDim.z;
    unsigned sum, cnt, mine, sp = 0u;
    for (;;) {
        sum = 0u; cnt = 0u; mine = 0u;
#pragma unroll
        for (unsigned j = 0; j < 16; ++j) { const unsigned c = xb_ld(&bar[XB_XCNT(j)]); sum += c; cnt += (c > 0u) ? 1u : 0u; mine = (j == x) ? c : mine; }
        if (sum == G) break;
        __builtin_amdgcn_s_sleep(1);
        if ((++sp & 255u) == 0u) { if (xb_ld(&bar[XB_TMO])) break; if (sp > XB_SPIN_CAP) { atomicAdd(&bar[XB_TMO], 1u); break; } }
    }
    nloc = mine > 0u ? mine : 1u; nx = cnt > 0u ? cnt : 1u;
}
__device__ __forceinline__ void xcd_barrier(const XcdBarrier& b) {
    asm volatile("s_waitcnt vmcnt(0)" ::: "memory");
    __syncthreads();
    if (threadIdx.x == 0) {
        unsigned* bar = b.bar;
        __builtin_amdgcn_s_waitcnt(0);
        unsigned nloc = b.st[0], nx = b.st[1];
        if (nloc == 0u) { xcd_barrier_complete(bar, b.x, nloc, nx); b.st[0] = nloc; b.st[1] = nx; }
        const unsigned old = xb_add(&bar[XB_XSUB(b.x)], 1u);
        const unsigned gen = old / nloc;
        if (old + 1u == (gen + 1u) * nloc) {
            __builtin_amdgcn_fence(__ATOMIC_RELEASE, "agent");
            asm volatile("s_waitcnt vmcnt(0)" ::: "memory");
            const unsigned og = xb_add(&bar[XB_TOP], 1u);
            const unsigned tg = og / nx;
            if (og + 1u == (tg + 1u) * nx) xb_add(&bar[XB_TOPGEN], 1u);
            else XB_SPIN(xb_ld(&bar[XB_TOPGEN]) == tg, bar);
            __builtin_amdgcn_fence(__ATOMIC_ACQUIRE, "agent");
            xb_add(&bar[XB_XGEN(b.x)], 1u);
            asm volatile("s_waitcnt vmcnt(0)" ::: "memory");
        } else {
            XB_SPIN(xb_ld(&bar[XB_XGEN(b.x)]) == gen, bar);
            __builtin_amdgcn_fence(__ATOMIC_ACQUIRE, "agent");
            asm volatile("s_waitcnt vmcnt(0)" ::: "memory");
        }
    }
    __syncthreads();
}

__device__ __forceinline__ int win_src_col(int n) {
    if (n < OFF_VA || (n >= OFF_QC && n < OFF_VC)) { const int hb = n & ~127, j = n & 127; return hb + (j >> 1) + (j & 1) * 64; }
    if (n >= OFF_QB && n < OFF_VB) { const int hb = n & ~63, j = n & 63; return hb + (j >> 1) + (j & 1) * 32; }
    return n;
}
__device__ __forceinline__ void tr_item(const float* __restrict__ src, size_t ld, int srccol, int k0, bf16_t* __restrict__ dst_tile, size_t dld, LAS unsigned char* scr, int lane) {
    const float* p = src + (size_t)k0 * ld + srccol;
    float v[64];
#pragma unroll
    for (int j = 0; j < 64; ++j) v[j] = __builtin_nontemporal_load(p + (size_t)j * ld);
    __builtin_amdgcn_sched_barrier(0);
#pragma unroll
    for (int kk = 0; kk < 8; ++kk) { const int o = kk * 8;
        u32x4 w; w.x = pk_f16(v[o + 0], v[o + 1]); w.y = pk_f16(v[o + 2], v[o + 3]); w.z = pk_f16(v[o + 4], v[o + 5]); w.w = pk_f16(v[o + 6], v[o + 7]);
        *(LAS u32x4*)(scr + lane * 144 + kk * 16) = w;
    }
    bf16_t* d = dst_tile + (size_t)(lane >> 3) * dld + (lane & 7) * 8;
#pragma unroll
    for (int i = 0; i < 8; ++i) { const u32x4 w = *(const LAS u32x4*)(scr + (8 * i + (lane >> 3)) * 144 + (lane & 7) * 16); *(u32x4*)(d + (size_t)(8 * i) * dld) = w; }
}
__device__ __forceinline__ unsigned q8x4(float a, float b, float c, float d, float s) {
    const float ca = fminf(fmaxf(a * s, -127.0f), 127.0f) + 12582912.0f, cb = fminf(fmaxf(b * s, -127.0f), 127.0f) + 12582912.0f;
    const float cc = fminf(fmaxf(c * s, -127.0f), 127.0f) + 12582912.0f, cd = fminf(fmaxf(d * s, -127.0f), 127.0f) + 12582912.0f;
    const unsigned lo = __builtin_amdgcn_perm(__float_as_uint(cb), __float_as_uint(ca), 0x0c0c0400u), hi = __builtin_amdgcn_perm(__float_as_uint(cd), __float_as_uint(cc), 0x0c0c0400u);
    return __builtin_amdgcn_perm(hi, lo, 0x05040100u);
}
__device__ __forceinline__ void tr_item8(const float* __restrict__ src, size_t ld, int srccol, int k0, unsigned char* __restrict__ dst_tile, size_t dld, float scale, LAS unsigned char* scr, int lane) {
    const float* p = src + (size_t)k0 * ld + srccol;
    float v[64];
#pragma unroll
    for (int j = 0; j < 64; ++j) v[j] = __builtin_nontemporal_load(p + (size_t)j * ld);
    __builtin_amdgcn_sched_barrier(0);
#pragma unroll
    for (int kk = 0; kk < 4; ++kk) { const int o = kk * 16;
        u32x4 w; w.x = q8x4(v[o + 0], v[o + 1], v[o + 2], v[o + 3], scale); w.y = q8x4(v[o + 4], v[o + 5], v[o + 6], v[o + 7], scale); w.z = q8x4(v[o + 8], v[o + 9], v[o + 10], v[o + 11], scale); w.w = q8x4(v[o + 12], v[o + 13], v[o + 14], v[o + 15], scale);
        *(LAS u32x4*)(scr + lane * 80 + kk * 16) = w;
    }
    unsigned char* d = dst_tile + (size_t)(lane >> 2) * dld + (lane & 3) * 16;
#pragma unroll
    for (int i = 0; i < 4; ++i) { const u32x4 w = *(const LAS u32x4*)(scr + (16 * i + (lane >> 2)) * 80 + (lane & 3) * 16); *(u32x4*)(d + (size_t)(16 * i) * dld) = w; }
}

struct KeyA { int s, r;
    __device__ __forceinline__ int pos(int idx, float& bias) const { bias = 0.f; const int p = s + r * (idx - 64); return (p >= 0 && p < SEQ) ? p : -1; } };
struct KeyB {
    __device__ __forceinline__ int pos(int idx, float& bias) const { bias = 0.f; return idx; } };
struct KeyC { int s;
    __device__ __forceinline__ int pos(int idx, float& bias) const { bias = 0.f; const int p = s + idx - 128; return (p >= 0 && p < SEQ) ? p : -1; } };
struct KeyD { int r, c, rs, cs; const float* rpb;
    __device__ __forceinline__ int pos(int idx, float& bias) const { const int kr = rs + (idx >> 4), kc = cs + (idx & 15); int dc = kc - c; dc = dc < -15 ? -15 : (dc > 15 ? 15 : dc);
        bias = rpb[(kr - r + 7) * 31 + dc + 15]; return kr * 64 + kc; } };

template <int DK, class KF>
__device__ __forceinline__ void sattn(const bf16_t* q, const bf16_t* kb, const bf16_t* vb, const KF& kf, int nkeys, float scale, bool has_sink, float sink,
                                      LAS float* sq, LAS float* ss, int lane, float& o0, float& o1, float& m_out, float& l_out) {
    for (int d = lane; d < DK; d += 64) sq[d] = bf2f(q[d]);
    asm volatile("s_waitcnt lgkmcnt(0)" ::: "memory");
    float mx = -1e30f;
    for (int idx = lane; idx < nkeys; idx += 64) {
        float bias; const int p = kf.pos(idx, bias); float s = -1e30f;
        if (p >= 0) {
            const u32x4* kr = (const u32x4*)(kb + (size_t)p * PROJ_PITCH); float acc = 0.f;
#pragma unroll
            for (int d8 = 0; d8 < DK / 8; ++d8) { const u32x4 w = kr[d8]; const LAS f32x4* qq = (const LAS f32x4*)(sq + d8 * 8); const f32x4 qa = qq[0], qb = qq[1];
                acc += qa[0] * bflo(w.x) + qa[1] * bfhi(w.x) + qa[2] * bflo(w.y) + qa[3] * bfhi(w.y) + qb[0] * bflo(w.z) + qb[1] * bfhi(w.z) + qb[2] * bflo(w.w) + qb[3] * bfhi(w.w); }
            s = acc * scale + bias;
        }
        ss[idx] = s; mx = fmaxf(mx, s);
    }
    mx = wave_max(mx); if (has_sink) mx = fmaxf(mx, sink);
    float sum = 0.f;
    for (int idx = lane; idx < nkeys; idx += 64) { const float s = ss[idx]; const float p = (s > -1e29f) ? __expf(s - mx) : 0.f; ss[idx] = p; sum += p; }
    sum = wave_sum(sum); if (has_sink) sum += __expf(sink - mx);
    asm volatile("s_waitcnt lgkmcnt(0)" ::: "memory");
    o0 = 0.f; o1 = 0.f;
    for (int idx = 0; idx < nkeys; ++idx) {
        const float p = ss[idx];
        if (p != 0.f) { float bias; const int pp = kf.pos(idx, bias); const unsigned w = *(const unsigned*)(vb + (size_t)pp * PROJ_PITCH + 2 * lane); o0 += p * bflo(w); o1 += p * bfhi(w); }
    }
    const float inv = 1.0f / sum; o0 *= inv; o1 *= inv; m_out = mx; l_out = sum;
    asm volatile("s_waitcnt lgkmcnt(0)" ::: "memory");
}

struct AttnPtrs { const bf16_t* proj; bf16_t* ag; float* lse; bf16_t* ob; bf16_t* oc; bf16_t* od; const float* lam; const float* subln; const float* sink; const float* rpb; float lambda_init; };

template <int WHICH>
__device__ __forceinline__ void scalar_attn_phase(const AttnPtrs& P, LAS unsigned char* lds, int gw, int NGW, int wave, int lane) {
    LAS float* sq = (LAS float*)(lds + wave * 16896); LAS float* ss = sq + 128;
    constexpr int NH = WHICH == 0 ? 18 : 8;
    float lmbda = 0.f;
    if constexpr (WHICH == 1) { const float d01 = wave_sum(P.lam[lane] * P.lam[64 + lane]), d23 = wave_sum(P.lam[128 + lane] * P.lam[192 + lane]); lmbda = __expf(d01) - __expf(d23) + P.lambda_init; }
    for (int task = gw; task < NH * MTOK; task += NGW) {
        const int hs = task / MTOK, row = task % MTOK, b = row >> 12, s = row & 4095;
        const bf16_t* prow = P.proj + (size_t)row * PROJ_PITCH; const bf16_t* pb = P.proj + (size_t)(b * SEQ) * PROJ_PITCH;
        float o0, o1, mm, ll;
        if constexpr (WHICH == 0) {
            const int hh = hs, g = hh / 6, r = (g == 0) ? 1 : ((g == 1) ? 4 : 16); KeyA kf{s, r};
            sattn<128>(prow + OFF_QA + hh * 128, pb + OFF_KA + hh * 128, pb + OFF_VA + hh * 128, kf, 129, 0.08838834764831845f, false, 0.f, sq, ss, lane, o0, o1, mm, ll);
            *(unsigned*)(P.ag + ((size_t)g * MTOK + row) * 768 + (hh % 6) * 128 + 2 * lane) = cvt_pk_bf16(o0, o1);
            if (lane == 0) P.lse[((size_t)g * MTOK + row) * 6 + (hh % 6)] = mm + __logf(ll);
        } else if constexpr (WHICH == 1) {
            const int h = hs; KeyB kf; float a0, a1, b0, b1;
            sattn<64>(prow + OFF_QB + (2 * h) * 64, pb + OFF_KB + (2 * h) * 64, pb + OFF_VB + h * 128, kf, SEQ, 0.125f, false, 0.f, sq, ss, lane, a0, a1, mm, ll);
            sattn<64>(prow + OFF_QB + (2 * h + 1) * 64, pb + OFF_KB + (2 * h + 1) * 64, pb + OFF_VB + h * 128, kf, SEQ, 0.125f, false, 0.f, sq, ss, lane, b0, b1, mm, ll);
            const float v0 = a0 - lmbda * b0, v1 = a1 - lmbda * b1;
            const float rinv = rsqrtf(wave_sum(v0 * v0 + v1 * v1) * (1.0f / 128.0f) + SUBLN_EPS) * (1.0f - P.lambda_init);
            *(unsigned*)(P.ob + (size_t)row * 1024 + h * 128 + 2 * lane) = cvt_pk_bf16(v0 * rinv * P.subln[2 * lane], v1 * rinv * P.subln[2 * lane + 1]);
        } else if constexpr (WHICH == 2) {
            const int qh = hs, kvh = qh >> 2; KeyC kf{s};
            sattn<128>(prow + OFF_QC + qh * 128, pb + OFF_KC + kvh * 128, pb + OFF_VC + kvh * 128, kf, 257, 0.08838834764831845f, true, P.sink[qh], sq, ss, lane, o0, o1, mm, ll);
            *(unsigned*)(P.oc + (size_t)row * 1024 + qh * 128 + 2 * lane) = cvt_pk_bf16(o0, o1);
        } else {
            const int h = hs, r = s >> 6, c = s & 63; int rs = r - 4; rs = rs < 0 ? 0 : (rs > 56 ? 56 : rs); int cs = c - 8; cs = cs < 0 ? 0 : (cs > 48 ? 48 : cs);
            KeyD kf{r, c, rs, cs, P.rpb + h * 465};
            sattn<128>(prow + OFF_QD + h * 128, pb + OFF_KD + h * 128, pb + OFF_VD + h * 128, kf, 128, 0.08838834764831845f, false, 0.f, sq, ss, lane, o0, o1, mm, ll);
            *(unsigned*)(P.od + (size_t)row * 1024 + h * 128 + 2 * lane) = cvt_pk_bf16(o0, o1);
        }
    }
}

__device__ __forceinline__ void combine_a_phase(const bf16_t* ag, const float* lse, unsigned* oa8, int gw, int NGW, int lane) {
    for (int row0 = gw; row0 < MTOK; row0 += 4 * NGW) {
        float lc[4][3][3]; u32x2 ac[4][3][3];
#pragma unroll
        for (int u = 0; u < 4; ++u) { const int row = row0 + u * NGW; if (row < MTOK) {
#pragma unroll
            for (int j = 0; j < 3; ++j) { const int e = 4 * lane + 256 * j, head = e >> 7;
#pragma unroll
                for (int g = 0; g < 3; ++g) { lc[u][j][g] = lse[((size_t)g * MTOK + row) * 6 + head]; ac[u][j][g] = *(const u32x2*)(ag + ((size_t)g * MTOK + row) * 768 + e); } } } }
#pragma unroll
        for (int u = 0; u < 4; ++u) { const int row = row0 + u * NGW; if (row >= MTOK) break;
#pragma unroll
            for (int j = 0; j < 3; ++j) {
                const int e = 4 * lane + 256 * j;
                const float l0 = lc[u][j][0], l1 = lc[u][j][1], l2 = lc[u][j][2];
                const float mx = fmaxf(l0, fmaxf(l1, l2)); float w0 = __expf(l0 - mx), w1 = __expf(l1 - mx), w2 = __expf(l2 - mx); const float inv = 1.0f / (w0 + w1 + w2); w0 *= inv; w1 *= inv; w2 *= inv;
                const u32x2 a0 = ac[u][j][0], a1 = ac[u][j][1], a2 = ac[u][j][2];
                oa8[(size_t)row * 256 + (e >> 2)] = q8x4(w0 * bflo(a0.x) + w1 * bflo(a1.x) + w2 * bflo(a2.x), w0 * bfhi(a0.x) + w1 * bfhi(a1.x) + w2 * bfhi(a2.x),
                                                      w0 * bflo(a0.y) + w1 * bflo(a1.y) + w2 * bflo(a2.y), w0 * bfhi(a0.y) + w1 * bfhi(a1.y) + w2 * bfhi(a2.y), QO);
            } }
    }
}
__device__ __forceinline__ void ln1_router_phase(const bf16_t* preln, const float* gain, const float* bias, const float* wr, float* stats, unsigned* x8, float* aff,
                                                 LAS unsigned char* lds, int tid, int gw, int NGW, int lane) {
    LAS float* W = (LAS float*)lds;
    u32x2 vn[8];
    if (gw < MTOK) {
#pragma unroll
        for (int j = 0; j < 8; ++j) vn[j] = *(const u32x2*)(preln + (size_t)gw * DM + 4 * lane + 256 * j);
    }
    f32x4 g[8], bb[8];
#pragma unroll
    for (int j = 0; j < 8; ++j) { g[j] = *(const f32x4*)(gain + 256 * j + 4 * lane); bb[j] = *(const f32x4*)(bias + 256 * j + 4 * lane); }
    { f32x4 w4[16];
#pragma unroll
      for (int it = 0; it < 16; ++it) w4[it] = *(const f32x4*)(wr + 4 * (size_t)(tid + it * (NWAVES * 64)));
#pragma unroll
      for (int it = 0; it < 16; ++it) { const int i4 = tid + it * (NWAVES * 64), k = i4 >> 2, e0 = (i4 & 3) * 4;
          W[(e0 + 0) * DM + k] = w4[it][0]; W[(e0 + 1) * DM + k] = w4[it][1]; W[(e0 + 2) * DM + k] = w4[it][2]; W[(e0 + 3) * DM + k] = w4[it][3]; } }
    __syncthreads();
    for (int row = gw; row < MTOK; row += NGW) {
        f32x4 v[8]; float s = 0.f;
#pragma unroll
        for (int j = 0; j < 8; ++j) { v[j] = (f32x4){f16lo(vn[j].x), f16hi(vn[j].x), f16lo(vn[j].y), f16hi(vn[j].y)}; s += (v[j][0] + v[j][1]) + (v[j][2] + v[j][3]); }
        if (row + NGW < MTOK) {
#pragma unroll
            for (int j = 0; j < 8; ++j) vn[j] = *(const u32x2*)(preln + (size_t)(row + NGW) * DM + 4 * lane + 256 * j);
        }
        const float mean = wave_sum(s) * (1.0f / DM); float q = 0.f;
#pragma unroll
        for (int j = 0; j < 8; ++j) { v[j] = v[j] - mean; q += (v[j][0] * v[j][0] + v[j][1] * v[j][1]) + (v[j][2] * v[j][2] + v[j][3] * v[j][3]); }
        const float rstd = rsqrtf(wave_sum(q) * (1.0f / DM) + LN_EPS);
        if (lane == 0) *(f32x2*)(stats + 2 * (size_t)row) = (f32x2){mean, rstd};
        unsigned* x8o = x8 + (size_t)row * (DM / 4) + lane;
#pragma unroll
        for (int j = 0; j < 8; ++j) { v[j] = v[j] * rstd * g[j] + bb[j]; x8o[64 * j] = q8x4(v[j][0], v[j][1], v[j][2], v[j][3], QX); }
        float a[16];
        f32x4 wa[8], wb[8];
#define LN1_LDW(dst, e) do { _Pragma("unroll") for (int j = 0; j < 8; ++j) dst[j] = *(const LAS f32x4*)(W + (e) * DM + 256 * j + 4 * lane); } while (0)
#define LN1_DOT(src, e) do { f32x2 t2 = {0.f, 0.f}; _Pragma("unroll") for (int j = 0; j < 8; ++j) { \
            t2 = __builtin_elementwise_fma((f32x2){v[j][0], v[j][1]}, (f32x2){src[j][0], src[j][1]}, t2); t2 = __builtin_elementwise_fma((f32x2){v[j][2], v[j][3]}, (f32x2){src[j][2], src[j][3]}, t2); } \
            a[e] = t2[0] + t2[1]; } while (0)
        LN1_LDW(wa, 0);
#pragma unroll
        for (int e = 0; e < 16; e += 2) {
            LN1_LDW(wb, e + 1); asm volatile("" ::: "memory"); LN1_DOT(wa, e); asm volatile("" ::: "memory");
            if (e + 2 < 16) LN1_LDW(wa, e + 2);
            asm volatile("" ::: "memory"); LN1_DOT(wb, e + 1); asm volatile("" ::: "memory"); }
#undef LN1_LDW
#undef LN1_DOT
        float r8[8], r4[4], r2[2], r1;
        { const bool up = (lane & 32) != 0;
#pragma unroll
          for (int i = 0; i < 8; ++i) { const float keep = up ? a[i + 8] : a[i], send = up ? a[i] : a[i + 8]; r8[i] = keep + __shfl_xor(send, 32); } }
        { const bool up = (lane & 16) != 0;
#pragma unroll
          for (int i = 0; i < 4; ++i) { const float keep = up ? r8[i + 4] : r8[i], send = up ? r8[i] : r8[i + 4]; r4[i] = keep + __shfl_xor(send, 16); } }
        { const bool up = (lane & 8) != 0;
#pragma unroll
          for (int i = 0; i < 2; ++i) { const float keep = up ? r4[i + 2] : r4[i], send = up ? r4[i] : r4[i + 2]; r2[i] = keep + __shfl_xor(send, 8); } }
        { const bool up = (lane & 4) != 0; const float keep = up ? r2[1] : r2[0], send = up ? r2[0] : r2[1]; r1 = keep + __shfl_xor(send, 4); }
        r1 += __shfl_xor(r1, 1); r1 += __shfl_xor(r1, 2);
        float mx = r1;
#pragma unroll
        for (int o = 4; o < 64; o <<= 1) mx = fmaxf(mx, __shfl_xor(mx, o));
        const float ex = expf(r1 - mx); float den = ex;
#pragma unroll
        for (int o = 4; o < 64; o <<= 1) den += __shfl_xor(den, o);
        const int eidx = ((lane >> 5) & 1) * 8 + ((lane >> 4) & 1) * 4 + ((lane >> 3) & 1) * 2 + ((lane >> 2) & 1);
        if ((lane & 3) == 0) aff[((size_t)(row >> 12) * NEXP + eidx) * SEQ + (row & 4095)] = ex / den;
    }
    __syncthreads();
}
__device__ __forceinline__ void topk_phase(const float* aff, int* idxo, float* gvo, int* sloto, LAS unsigned char* lds, int tid, int wave, int lane, int wg, int G) {
    LAS int* cnt = (LAS int*)lds;
    for (int be = wg; be < NGRP; be += G) {
        const float* a = aff + (size_t)be * SEQ + tid * 8;
        const f32x4 a0 = *(const f32x4*)a, a1 = *(const f32x4*)(a + 4);
        unsigned v[8] = {__float_as_uint(a0[0]), __float_as_uint(a0[1]), __float_as_uint(a0[2]), __float_as_uint(a0[3]), __float_as_uint(a1[0]), __float_as_uint(a1[1]), __float_as_uint(a1[2]), __float_as_uint(a1[3])};
        unsigned T = 0u;
        for (int bit = 30; bit >= 0; --bit) {
            const unsigned cand = T | (1u << bit); int c = 0;
#pragma unroll
            for (int k = 0; k < 8; ++k) c += (v[k] >= cand) ? 1 : 0;
            c = wave_sum_i(c);
            if (lane == 0) cnt[(bit & 1) * 8 + wave] = c;
            __syncthreads();
            int tot = 0;
#pragma unroll
            for (int w = 0; w < 8; ++w) tot += cnt[(bit & 1) * 8 + w];
            if (tot >= CAP) T = cand;
        }
        int ngt = 0, neq = 0;
#pragma unroll
        for (int k = 0; k < 8; ++k) { ngt += (v[k] > T) ? 1 : 0; neq += (v[k] == T) ? 1 : 0; }
        int sgt = ngt, seq = neq;
#pragma unroll
        for (int o = 1; o < 64; o <<= 1) { const int tg = __shfl_up(sgt, o), te = __shfl_up(seq, o); if (lane >= o) { sgt += tg; seq += te; } }
        __syncthreads();
        if (lane == 63) { cnt[64 + wave] = sgt; cnt[64 + 8 + wave] = seq; }
        __syncthreads();
        int pgt = sgt - ngt, peq = seq - neq, totgt = 0;
#pragma unroll
        for (int w = 0; w < 8; ++w) { const int tg = cnt[64 + w], te = cnt[64 + 8 + w]; if (w < wave) { pgt += tg; peq += te; } totgt += tg; }
        const int need = CAP - totgt;
        const int b = be >> 4, e = be & 15;
#pragma unroll
        for (int k = 0; k < 8; ++k) {
            const bool gt = v[k] > T, eq = v[k] == T; const bool sel = gt || (eq && peq < need);
            const int slot = pgt + (peq < need ? peq : need);
            const int tok = tid * 8 + k;
            if (sel) { idxo[be * CAP + slot] = tok; gvo[be * CAP + slot] = __uint_as_float(v[k]); }
            sloto[((size_t)b * SEQ + tok) * NEXP + e] = sel ? slot : -1;
            pgt += gt ? 1 : 0; peq += eq ? 1 : 0;
        }
        __syncthreads();
    }
}
__device__ __forceinline__ void gather_phase(const bf16_t* xb, const int* idx, bf16_t* xg, int gw, int NGW, int lane) {
    for (int r = gw; r < NGRP * CAP; r += NGW) {
        const int be = r >> 9, b = be >> 4; const int tok = idx[r];
        const u32x4* src = (const u32x4*)(xb + ((size_t)b * SEQ + tok) * DM); u32x4* dst = (u32x4*)(xg + (size_t)r * DM);
#pragma unroll
        for (int j = 0; j < 4; ++j) dst[64 * j + lane] = src[64 * j + lane];
    }
}
__device__ __forceinline__ void ln2_phase(const bf16_t* x1, const float* stats, const float* gain1, const float* bias1, const unsigned char* y, const float* gvp, const int* slot, const float* gain, const float* bias, float* xo_base, bf16_t* xh, bf16_t* xb, unsigned char* x8, int gw, int NGW, int lane) {
    u32x4 xn[4]; int slot_n = -1;
    if (gw < MTOK) { slot_n = slot[(size_t)gw * NEXP + (lane & 15)];
#pragma unroll
        for (int j = 0; j < 4; ++j) xn[j] = *(const u32x4*)(x1 + (size_t)gw * DM + 512 * j + 8 * lane); }
    for (int row = gw; row < MTOK; row += NGW) {
        const int b = row >> 12; const int myslot = slot_n;
        f32x4 xc[8];
#pragma unroll
        for (int j = 0; j < 4; ++j) { xc[2 * j] = (f32x4){f16lo(xn[j].x), f16hi(xn[j].x), f16lo(xn[j].y), f16hi(xn[j].y)}; xc[2 * j + 1] = (f32x4){f16lo(xn[j].z), f16hi(xn[j].z), f16lo(xn[j].w), f16hi(xn[j].w)}; }
        unsigned hits = (unsigned)(__ballot(myslot >= 0) & 0xffffull);
        const bool h0 = hits != 0u; const int e0 = h0 ? __builtin_ctz(hits) : 0; if (h0) hits &= hits - 1;
        const bool h1 = hits != 0u; const int e1 = h1 ? __builtin_ctz(hits) : e0; if (h1) hits &= hits - 1;
        int sl0 = __shfl(myslot, e0), sl1 = __shfl(myslot, e1); sl0 = sl0 < 0 ? 0 : sl0; sl1 = sl1 < 0 ? 0 : sl1;
        const f32x2 st = *(const f32x2*)(stats + 2 * (size_t)row);
        f32x4 ga[4], gb[4], ba[4], bv[4];
#pragma unroll
        for (int j = 0; j < 4; ++j) { ga[j] = *(const f32x4*)(gain1 + 512 * j + 8 * lane); gb[j] = *(const f32x4*)(gain1 + 512 * j + 8 * lane + 4);
            ba[j] = *(const f32x4*)(bias1 + 512 * j + 8 * lane); bv[j] = *(const f32x4*)(bias1 + 512 * j + 8 * lane + 4); }
        u32x2 ya[4], yb[4]; float ga_, gb_;
        { const size_t r0_ = (size_t)(b * NEXP + e0) * CAP + sl0, r1_ = (size_t)(b * NEXP + e1) * CAP + sl1;
          const unsigned char* yr0 = y + r0_ * DM + 8 * lane; const unsigned char* yr1 = y + r1_ * DM + 8 * lane;
          ga_ = gvp[r0_]; gb_ = gvp[r1_];
#pragma unroll
          for (int j = 0; j < 4; ++j) ya[j] = *(const u32x2*)(yr0 + 512 * j);
#pragma unroll
          for (int j = 0; j < 4; ++j) yb[j] = *(const u32x2*)(yr1 + 512 * j); }
        if (row + NGW < MTOK) { slot_n = slot[(size_t)(row + NGW) * NEXP + (lane & 15)];
#pragma unroll
            for (int j = 0; j < 4; ++j) xn[j] = *(const u32x4*)(x1 + (size_t)(row + NGW) * DM + 512 * j + 8 * lane); }
#pragma unroll
        for (int j = 0; j < 4; ++j) { xc[2 * j] = (xc[2 * j] - st[0]) * st[1] * ga[j] + ba[j]; xc[2 * j + 1] = (xc[2 * j + 1] - st[0]) * st[1] * gb[j] + bv[j]; }
        f32x4 acc[8];
#pragma unroll
        for (int j = 0; j < 8; ++j) acc[j] = (f32x4){0.f, 0.f, 0.f, 0.f};
#define LN2_ACC(Y_, j, gs) do { acc[2 * j][0] = fmaf((float)((Y_).x & 0xffu), gs, acc[2 * j][0]); acc[2 * j][1] = fmaf((float)(((Y_).x >> 8) & 0xffu), gs, acc[2 * j][1]); \
            acc[2 * j][2] = fmaf((float)(((Y_).x >> 16) & 0xffu), gs, acc[2 * j][2]); acc[2 * j][3] = fmaf((float)((Y_).x >> 24), gs, acc[2 * j][3]); \
            acc[2 * j + 1][0] = fmaf((float)((Y_).y & 0xffu), gs, acc[2 * j + 1][0]); acc[2 * j + 1][1] = fmaf((float)(((Y_).y >> 8) & 0xffu), gs, acc[2 * j + 1][1]); \
            acc[2 * j + 1][2] = fmaf((float)(((Y_).y >> 16) & 0xffu), gs, acc[2 * j + 1][2]); acc[2 * j + 1][3] = fmaf((float)((Y_).y >> 24), gs, acc[2 * j + 1][3]); } while (0)
        float corr = 0.f;
        if (h0) { const float gs = ga_ * (1.0f / QY); corr += 128.0f * gs;
#pragma unroll
            for (int j = 0; j < 4; ++j) LN2_ACC(ya[j], j, gs); }
        if (h1) { const float gs = gb_ * (1.0f / QY); corr += 128.0f * gs;
#pragma unroll
            for (int j = 0; j < 4; ++j) LN2_ACC(yb[j], j, gs); }
        while (hits) {
            const int e = __builtin_ctz(hits); hits &= hits - 1;
            const int sl = __shfl(myslot, e);
            const size_t r_ = (size_t)(b * NEXP + e) * CAP + sl; const unsigned char* yr = y + r_ * DM + 8 * lane;
            const float gs = gvp[r_] * (1.0f / QY); corr += 128.0f * gs;
#pragma unroll
            for (int j = 0; j < 4; ++j) { const u32x2 w = *(const u32x2*)(yr + 512 * j); LN2_ACC(w, j, gs); }
        }
#undef LN2_ACC
        float s = 0.f;
#pragma unroll
        for (int j = 0; j < 8; ++j) { acc[j] = xc[j] * ALPHA + (acc[j] - corr); s += (acc[j][0] + acc[j][1]) + (acc[j][2] + acc[j][3]); }
        const float mean = wave_sum(s) * (1.0f / DM); float q = 0.f;
#pragma unroll
        for (int j = 0; j < 8; ++j) { acc[j] = acc[j] - mean; q += (acc[j][0] * acc[j][0] + acc[j][1] * acc[j][1]) + (acc[j][2] * acc[j][2] + acc[j][3] * acc[j][3]); }
        const float rstd = rsqrtf(wave_sum(q) * (1.0f / DM) + LN_EPS);
        float* xo = xo_base + (size_t)row * DM + 8 * lane; (void)xb; bf16_t* xho = xh + (size_t)row * DM + 8 * lane;
#pragma unroll
        for (int j = 0; j < 4; ++j) { const f32x4 g0 = *(const f32x4*)(gain + 512 * j + 8 * lane), g1 = *(const f32x4*)(gain + 512 * j + 8 * lane + 4), b0 = *(const f32x4*)(bias + 512 * j + 8 * lane), b1 = *(const f32x4*)(bias + 512 * j + 8 * lane + 4);
            const f32x4 o0 = acc[2 * j] * rstd * g0 + b0, o1 = acc[2 * j + 1] * rstd * g1 + b1;
            if (!x8) { *(f32x4*)(xo + 512 * j) = o0; *(f32x4*)(xo + 512 * j + 4) = o1; }
            else { u32x4 hw; hw.x = pk_f16(o0[0], o0[1]); hw.y = pk_f16(o0[2], o0[3]); hw.z = pk_f16(o1[0], o1[1]); hw.w = pk_f16(o1[2], o1[3]); *(u32x4*)(xho + 512 * j) = hw; }
            if (x8) {
                u32x2 q; q.x = q8x4(o0[0], o0[1], o0[2], o0[3], QX); q.y = q8x4(o1[0], o1[1], o1[2], o1[3], QX); *(u32x2*)(x8 + (size_t)row * DM + 8 * lane + 512 * j) = q; } }
    }
}

namespace att {
typedef short bf16x8 __attribute__((ext_vector_type(8)));
typedef short s16x4 __attribute__((ext_vector_type(4)));
typedef float f32x16 __attribute__((ext_vector_type(16)));
constexpr int VBYTES = 16384, KOFF = 2 * VBYTES, WSOFF = 65536, TABOFF = WSOFF + 2048, QOFF = TABOFF + 2048, ATTN_LDS = QOFF + 32768;
constexpr float NEG = -1e30f, M0 = -1e29f;
#define ATT_SBAR() __builtin_amdgcn_sched_barrier(0)
__device__ __forceinline__ int crow(int r, int hi) { return (r & 3) + 8 * (r >> 2) + 4 * hi; }
__device__ __forceinline__ unsigned cvtpk(float lo, float hi) { unsigned r; asm volatile("v_cvt_pk_bf16_f32 %0, %1, %2" : "=v"(r) : "v"(lo), "v"(hi)); return r; }
__device__ __forceinline__ int kswz128(int row, int colB) { return row * 256 + (colB ^ ((row & 7) << 4)); }
__device__ __forceinline__ int kswz64(int row, int colB) { return row * 128 + (colB ^ (((row >> 1) & 7) << 4)); }

__device__ __forceinline__ void partialSM(f32x16& p0, f32x16& p1, float& m_reg, float& mn, float& alpha, const float C, const float thr_raw) {
    float pmax = p0[0];
#pragma unroll
    for (int r = 1; r < 16; ++r) pmax = fmaxf(pmax, p0[r]);
#pragma unroll
    for (int r = 0; r < 16; ++r) pmax = fmaxf(pmax, p1[r]);
    { auto rr = __builtin_amdgcn_permlane32_swap(__float_as_uint(pmax), __float_as_uint(pmax), false, false); pmax = fmaxf(__uint_as_float(rr[0]), __uint_as_float(rr[1])); }
    if (__all(pmax - m_reg <= thr_raw)) { mn = m_reg; alpha = 1.f; }
    else { mn = fmaxf(m_reg, pmax); alpha = __builtin_amdgcn_exp2f((m_reg - mn) * C); m_reg = mn; }
    const float mnC = -mn * C;
#pragma unroll
    for (int r = 0; r < 16; ++r) p0[r] = fmaf(p0[r], C, mnC);
#pragma unroll
    for (int r = 0; r < 16; ++r) p1[r] = fmaf(p1[r], C, mnC);
#pragma unroll
    for (int r = 0; r < 16; ++r) p0[r] = __builtin_amdgcn_exp2f(p0[r]);
}
__device__ __forceinline__ void finishSM(f32x16& p0, f32x16& p1, float alpha, float& l_reg, bf16x8& pa0, bf16x8& pa1, bf16x8& pa2, bf16x8& pa3) {
#pragma unroll
    for (int r = 0; r < 16; ++r) p1[r] = __builtin_amdgcn_exp2f(p1[r]);
    float ps = 0;
#pragma unroll
    for (int r = 0; r < 16; ++r) ps += p0[r];
#pragma unroll
    for (int r = 0; r < 16; ++r) ps += p1[r];
    { auto rr = __builtin_amdgcn_permlane32_swap(__float_as_uint(ps), __float_as_uint(ps), false, false); ps = __uint_as_float(rr[0]) + __uint_as_float(rr[1]); }
    l_reg = l_reg * alpha + ps;
#define ATT_PK4(P, BASE, OUT) do { unsigned a0 = cvtpk(P[BASE + 0], P[BASE + 1]), a1 = cvtpk(P[BASE + 2], P[BASE + 3]);   \
    unsigned b0 = cvtpk(P[BASE + 4], P[BASE + 5]), b1 = cvtpk(P[BASE + 6], P[BASE + 7]);                              \
    auto r0 = __builtin_amdgcn_permlane32_swap(a0, b0, false, false); auto r1 = __builtin_amdgcn_permlane32_swap(a1, b1, false, false); \
    u32x4 w = {r0[0], r1[0], r0[1], r1[1]}; OUT = __builtin_bit_cast(bf16x8, w); } while (0)
    ATT_PK4(p0, 0, pa0); ATT_PK4(p0, 8, pa1); ATT_PK4(p1, 0, pa2); ATT_PK4(p1, 8, pa3);
#undef ATT_PK4
}
template <int DK>
__device__ __forceinline__ void qkt(f32x16& p0, f32x16& p1, const LAS char* Ks, const bf16x8* qr, int r32, int hi) {
    p0 = f32x16{}; p1 = f32x16{};
#pragma unroll
    for (int d0 = 0; d0 < DK / 16; ++d0) { const int cb = (d0 * 16 + hi * 8) * 2;
        const bf16x8 b0 = *(const LAS bf16x8*)(Ks + (DK == 128 ? kswz128(r32, cb) : kswz64(r32, cb)));
        const bf16x8 b1 = *(const LAS bf16x8*)(Ks + (DK == 128 ? kswz128(32 + r32, cb) : kswz64(32 + r32, cb)));
        p0 = __builtin_amdgcn_mfma_f32_32x32x16_bf16(b0, qr[d0], p0, 0, 0, 0);
        p1 = __builtin_amdgcn_mfma_f32_32x32x16_bf16(b1, qr[d0], p1, 0, 0, 0); }
}
__device__ __forceinline__ void qkt64_ldsq(f32x16& p0, f32x16& p1, const LAS char* Ks, const LAS char* qb_l, int r32, int hi) {
    unsigned qa = (unsigned)(__UINTPTR_TYPE__)qb_l; asm volatile("" : "+v"(qa)); const LAS char* qp = (const LAS char*)(__UINTPTR_TYPE__)qa;
    p0 = f32x16{}; p1 = f32x16{};
#pragma unroll
    for (int d0 = 0; d0 < 4; ++d0) { const int cb = (d0 * 16 + hi * 8) * 2;
        const bf16x8 q = *(const LAS bf16x8*)(qp + d0 * 1024);
        const bf16x8 b0 = *(const LAS bf16x8*)(Ks + kswz64(r32, cb));
        const bf16x8 b1 = *(const LAS bf16x8*)(Ks + kswz64(32 + r32, cb));
        p0 = __builtin_amdgcn_mfma_f32_32x32x16_bf16(b0, q, p0, 0, 0, 0);
        p1 = __builtin_amdgcn_mfma_f32_32x32x16_bf16(b1, q, p1, 0, 0, 0); }
}
__device__ __forceinline__ int v_st(int k, int c) { const int kk = (k & ~0xC) | ((k & 4) << 1) | ((k & 8) >> 1); return ((kk >> 3) * 4 + (c >> 5)) * 512 + ((kk & 7) * 32 + (c & 31)) * 2; }
__device__ __forceinline__ int v_rd_base(int lane) { return ((lane & 3) << 3) | (((lane >> 2) & 3) << 6) | (((lane >> 4) & 1) << 5) | (((lane >> 5) & 1) << 8); }
constexpr int v_rd_off(int d0, int ks, int half) { return d0 * 512 + ks * 4096 + half * 2048; }
template <int OFF> __device__ __forceinline__ s16x4 tr_read(int vb) { s16x4 r; asm volatile("ds_read_b64_tr_b16 %0, %1 offset:%2" : "=&v"(r) : "v"(vb), "i"(OFF) : "memory"); return r; }
template <int D0> __device__ __forceinline__ void pv_one(f32x16& od, int vb, bf16x8 pa0, bf16x8 pa1, bf16x8 pa2, bf16x8 pa3) {
    const s16x4 l0 = tr_read<v_rd_off(D0, 0, 0)>(vb), h0 = tr_read<v_rd_off(D0, 0, 1)>(vb), l1 = tr_read<v_rd_off(D0, 1, 0)>(vb), h1 = tr_read<v_rd_off(D0, 1, 1)>(vb);
    const s16x4 l2 = tr_read<v_rd_off(D0, 2, 0)>(vb), h2 = tr_read<v_rd_off(D0, 2, 1)>(vb), l3 = tr_read<v_rd_off(D0, 3, 0)>(vb), h3 = tr_read<v_rd_off(D0, 3, 1)>(vb);
    asm volatile("s_waitcnt lgkmcnt(0)" ::: "memory"); ATT_SBAR();
#define ATT_PK(L, H) (bf16x8){L[0], L[1], L[2], L[3], H[0], H[1], H[2], H[3]}
    od = __builtin_amdgcn_mfma_f32_32x32x16_bf16(pa0, ATT_PK(l0, h0), od, 0, 0, 0);
    od = __builtin_amdgcn_mfma_f32_32x32x16_bf16(pa1, ATT_PK(l1, h1), od, 0, 0, 0);
    od = __builtin_amdgcn_mfma_f32_32x32x16_bf16(pa2, ATT_PK(l2, h2), od, 0, 0, 0);
    od = __builtin_amdgcn_mfma_f32_32x32x16_bf16(pa3, ATT_PK(l3, h3), od, 0, 0, 0);
#undef ATT_PK
}
__device__ __forceinline__ void pv_d0(f32x16* o, int vb, bf16x8 pa0, bf16x8 pa1, bf16x8 pa2, bf16x8 pa3) {
    pv_one<0>(o[0], vb, pa0, pa1, pa2, pa3); pv_one<1>(o[1], vb, pa0, pa1, pa2, pa3); pv_one<2>(o[2], vb, pa0, pa1, pa2, pa3); pv_one<3>(o[3], vb, pa0, pa1, pa2, pa3);
}

template <int DK, class Pol>
__device__ __forceinline__ void attn_unit(const Pol& P, LAS char* lds, const int tid_in) {
    int tid = tid_in; asm volatile("" : "+v"(tid));
    const int wid = __builtin_amdgcn_readfirstlane(tid >> 6), lane = tid & 63, r32 = lane & 31, hi = lane >> 5;
    LAS char* V_lds = lds; LAS char* K_lds = lds + KOFF; constexpr int KBYTES = 64 * DK * 2;
    LAS float* wsx = (LAS float*)(lds + WSOFF) + wid * 64; LAS float* li_l = wsx; LAS float* al_l = wsx + 32;
    const float C = Pol::SCALE * 1.4426950408889634f, thr_raw = 8.0f / Pol::SCALE;
    float m_reg = P.m0w(wid), l_reg = P.l0(); f32x16 o[4] = {}; bf16x8 qr[DK / 16];
    { const bf16_t* qp = P.q_row(wid * 32 + r32) + hi * 8;
#pragma unroll
      for (int d0 = 0; d0 < DK / 16; ++d0) qr[d0] = *(const bf16x8*)(qp + d0 * 16); }
    const int sr = tid >> 4, sc = (tid & 15) * 8, vst0 = v_st(sr, sc), vst1 = v_st(32 + sr, sc);
    const int k64r = tid >> 3, k64c = (tid & 7) * 8;
    const int vb0 = (int)(unsigned)(__UINTPTR_TYPE__)V_lds + v_rd_base(lane);
    bf16x8 aV0, aV1, aK0, aK1, bV0, bV1, bK0, bK1;
#define ATT_LOADX(V0, V1, K0, K1, t) do { V0 = *(const bf16x8*)(P.v_row((t), sr) + sc); V1 = *(const bf16x8*)(P.v_row((t), 32 + sr) + sc); \
        if constexpr (DK == 128) { K0 = *(const bf16x8*)(P.k_row((t), sr) + sc); K1 = *(const bf16x8*)(P.k_row((t), 32 + sr) + sc); } \
        else { K0 = *(const bf16x8*)(P.k_row((t), k64r) + k64c); K1 = K0; } } while (0)
#define ATT_WRITEX(V0, V1, K0, K1, b) do { *(LAS bf16x8*)(V_lds + (b) * VBYTES + vst0) = V0; *(LAS bf16x8*)(V_lds + (b) * VBYTES + vst1) = V1; \
        if constexpr (DK == 128) { *(LAS bf16x8*)(K_lds + (b) * KBYTES + kswz128(sr, sc * 2)) = K0; *(LAS bf16x8*)(K_lds + (b) * KBYTES + kswz128(32 + sr, sc * 2)) = K1; } \
        else { *(LAS bf16x8*)(K_lds + (b) * KBYTES + kswz64(k64r, k64c * 2)) = K0; } } while (0)
#define ATT_COMPUTE(t, b) do { if (P.wave_needs((t), wid)) { \
            f32x16 p0, p1; float mn, alpha; bf16x8 pa0, pa1, pa2, pa3; \
            qkt<DK>(p0, p1, K_lds + (b) * KBYTES, qr, r32, hi); \
            P.mask(p0, p1, (t), wid, r32, hi, lds); \
            partialSM(p0, p1, m_reg, mn, alpha, C, thr_raw); \
            if (__any(alpha < 1.f)) { if (hi == 0) al_l[r32] = alpha; asm volatile("s_waitcnt lgkmcnt(0)" ::: "memory"); \
                _Pragma("unroll") for (int d = 0; d < 4; ++d) _Pragma("unroll") for (int r = 0; r < 16; ++r) o[d][r] *= al_l[crow(r, hi)]; } \
            finishSM(p0, p1, alpha, l_reg, pa0, pa1, pa2, pa3); ATT_SBAR(); \
            pv_d0(o, vb0 + (b) * VBYTES, pa0, pa1, pa2, pa3); } } while (0)
    const int NT = P.ntiles();
    ATT_LOADX(aV0, aV1, aK0, aK1, 0);
    if (NT > 1) ATT_LOADX(bV0, bV1, bK0, bK1, 1);
    for (int t = 0; t < NT; t += 2) {
        ATT_WRITEX(aV0, aV1, aK0, aK1, 0);
        __syncthreads();
        if (t + 2 < NT) ATT_LOADX(aV0, aV1, aK0, aK1, t + 2);
        ATT_COMPUTE(t, 0);
        if (t + 1 < NT) {
            ATT_WRITEX(bV0, bV1, bK0, bK1, 1);
            __syncthreads();
            if (t + 3 < NT) ATT_LOADX(bV0, bV1, bK0, bK1, t + 3);
            ATT_COMPUTE(t + 1, 1);
        }
    }
#undef ATT_LOADX
#undef ATT_WRITEX
#undef ATT_COMPUTE
    if (hi == 0) li_l[r32] = l_reg;
    asm volatile("s_waitcnt lgkmcnt(0)" ::: "memory");
    P.finish(o, m_reg, l_reg, li_l, wid, r32, hi);
    __syncthreads();
}

template <class Pol>
__device__ __forceinline__ void attn_unit_dense64(const Pol& P, LAS char* lds, const int tid_in) {
    int tid = tid_in; asm volatile("" : "+v"(tid));
    const int wid = __builtin_amdgcn_readfirstlane(tid >> 6), lane = tid & 63, r32 = lane & 31, hi = lane >> 5;
    LAS char* V_lds = lds; LAS char* K_lds = lds + KOFF; constexpr int KBYTES = 64 * 64 * 2;
    LAS float* wsx = (LAS float*)(lds + WSOFF) + wid * 64; LAS float* li_l = wsx; LAS float* al_l = wsx + 32;
    const float C = Pol::SCALE * 1.4426950408889634f, thr_raw = 8.0f / Pol::SCALE;
    float m_reg = M0, l_reg = 0.f; f32x16 o[4] = {};
    LAS char* qb_l = lds + QOFF + wid * 4096 + lane * 16;
    { const bf16_t* qp = P.q_row(wid * 32 + r32) + hi * 8;
#pragma unroll
      for (int d0 = 0; d0 < 4; ++d0) *(LAS bf16x8*)(qb_l + d0 * 1024) = *(const bf16x8*)(qp + d0 * 16); }
    const int sr = tid >> 4, sc = (tid & 15) * 8, vst0 = v_st(sr, sc), vst1 = v_st(32 + sr, sc);
    const int k64r = tid >> 3, k64c = (tid & 7) * 8, kst = kswz64(k64r, k64c * 2);
    const int vb0 = (int)(unsigned)(__UINTPTR_TYPE__)V_lds + v_rd_base(lane);
    bf16x8 sAv0, sAv1, sAk, sBv0, sBv1, sBk;
#define D64_LOADA(t) do { sAv0 = *(const bf16x8*)(P.v_row((t), sr) + sc); sAv1 = *(const bf16x8*)(P.v_row((t), 32 + sr) + sc); sAk = *(const bf16x8*)(P.k_row((t), k64r) + k64c); } while (0)
#define D64_LOADB(t) do { sBv0 = *(const bf16x8*)(P.v_row((t), sr) + sc); sBv1 = *(const bf16x8*)(P.v_row((t), 32 + sr) + sc); sBk = *(const bf16x8*)(P.k_row((t), k64r) + k64c); } while (0)
#define D64_WRITEA() do { *(LAS bf16x8*)(V_lds + vst0) = sAv0; *(LAS bf16x8*)(V_lds + vst1) = sAv1; *(LAS bf16x8*)(K_lds + kst) = sAk; } while (0)
#define D64_WRITEB() do { *(LAS bf16x8*)(V_lds + VBYTES + vst0) = sBv0; *(LAS bf16x8*)(V_lds + VBYTES + vst1) = sBv1; *(LAS bf16x8*)(K_lds + KBYTES + kst) = sBk; } while (0)
#define D64_WAIT() asm volatile("s_waitcnt vmcnt(3)" ::: "memory")
#define D64_RESC(a) do { if (__any((a) < 1.f)) { if (hi == 0) al_l[r32] = (a); asm volatile("s_waitcnt lgkmcnt(0)" ::: "memory"); \
    _Pragma("unroll") for (int d = 0; d < 4; ++d) _Pragma("unroll") for (int r = 0; r < 16; ++r) o[d][r] *= al_l[crow(r, hi)]; } } while (0)
    f32x16 pA0, pA1, pB0, pB1; float mnA, mnB, alA, alB; bf16x8 pa0, pa1, pa2, pa3; const int NT = P.ntiles();
    D64_LOADA(0); asm volatile("s_waitcnt vmcnt(0)" ::: "memory"); D64_WRITEA(); __syncthreads();
    qkt64_ldsq(pA0, pA1, K_lds, qb_l, r32, hi); partialSM(pA0, pA1, m_reg, mnA, alA, C, thr_raw);
    D64_LOADB(1); D64_LOADA(2);
    D64_WAIT(); D64_WRITEB(); __syncthreads();
#if defined(STAMP_SEL)
    unsigned long long sa0 = 0, sa1 = 0, sa2 = 0, sr0 = 0, sr1 = 0; if (P.stamp) { sa0 = __builtin_amdgcn_s_memtime(); sr0 = __builtin_amdgcn_s_memrealtime(); }
#endif
    for (int j = 1; j + 1 < NT; j += 2) {
        ATT_SBAR(); qkt64_ldsq(pB0, pB1, K_lds + KBYTES, qb_l, r32, hi);
        finishSM(pA0, pA1, alA, l_reg, pa0, pa1, pa2, pa3); ATT_SBAR();
        D64_LOADB(j + 2); ATT_SBAR();
        pv_d0(o, vb0, pa0, pa1, pa2, pa3); partialSM(pB0, pB1, m_reg, mnB, alB, C, thr_raw);
        __syncthreads(); D64_WAIT(); D64_WRITEA();
        D64_RESC(alB); __syncthreads();
        ATT_SBAR(); qkt64_ldsq(pA0, pA1, K_lds, qb_l, r32, hi);
        finishSM(pB0, pB1, alB, l_reg, pa0, pa1, pa2, pa3); ATT_SBAR();
        if (j + 3 < NT) D64_LOADA(j + 3); ATT_SBAR();
        pv_d0(o, vb0 + VBYTES, pa0, pa1, pa2, pa3); partialSM(pA0, pA1, m_reg, mnA, alA, C, thr_raw);
        __syncthreads(); D64_WAIT(); D64_WRITEB();
        D64_RESC(alA); __syncthreads();
    }
    ATT_SBAR(); qkt64_ldsq(pB0, pB1, K_lds + KBYTES, qb_l, r32, hi);
    finishSM(pA0, pA1, alA, l_reg, pa0, pa1, pa2, pa3); ATT_SBAR();
    pv_d0(o, vb0, pa0, pa1, pa2, pa3); partialSM(pB0, pB1, m_reg, mnB, alB, C, thr_raw);
    __syncthreads(); D64_RESC(alB);
    finishSM(pB0, pB1, alB, l_reg, pa0, pa1, pa2, pa3); ATT_SBAR();
    pv_d0(o, vb0 + VBYTES, pa0, pa1, pa2, pa3);
#undef D64_LOADA
#undef D64_LOADB
#undef D64_WRITEA
#undef D64_WRITEB
#undef D64_WAIT
#undef D64_RESC
#if defined(STAMP_SEL)
    if (P.stamp) { sa1 = __builtin_amdgcn_s_memtime(); sr1 = __builtin_amdgcn_s_memrealtime(); }
#endif
    if (hi == 0) li_l[r32] = l_reg;
    asm volatile("s_waitcnt lgkmcnt(0)" ::: "memory");
    P.finish(o, m_reg, l_reg, li_l, wid, r32, hi);
    __syncthreads();
#if defined(STAMP_SEL)
    if (P.stamp && tid == 0) { sa2 = __builtin_amdgcn_s_memtime(); P.stamp[10] = sa0; P.stamp[12] = sa1; P.stamp[13] = sa2; P.stamp[14] = sr0; P.stamp[15] = sr1; }
#endif
}

typedef short v4i16_t __attribute__((ext_vector_type(4)));
__device__ __forceinline__ s16x4 vtr(const LAS char* p) { return __builtin_bit_cast(s16x4, __builtin_amdgcn_ds_read_tr16_b64_v4i16((LAS v4i16_t*)p)); }
template <class Pol>
__device__ __forceinline__ void attn_unit_b2(const Pol& P, LAS char* lds, const int tid_in) {
    int tid = tid_in; asm volatile("" : "+v"(tid));
    const int wid = __builtin_amdgcn_readfirstlane(tid >> 6), lane = tid & 63, r32 = lane & 31, hi = lane >> 5;
    const bool trail = wid >= 4;
    constexpr int KB = 8192, VB = 16384, KR = 3 * VB, WSB = KR + 3 * KB;
    LAS char* V_lds = lds; LAS char* K_lds = lds + KR;
    LAS float* wsx = (LAS float*)(lds + WSB) + wid * 64; LAS float* li_l = wsx; LAS float* al_l = wsx + 32;
    const float C = Pol::SCALE * 1.4426950408889634f, thr_raw = 8.0f / Pol::SCALE;
    float m_reg = M0, l_reg = 0.f; f32x16 o[4] = {}; bf16x8 qr[4];
    { const bf16_t* qp = P.q_row(wid * 32 + r32) + hi * 8;
#pragma unroll
      for (int d0 = 0; d0 < 4; ++d0) qr[d0] = *(const bf16x8*)(qp + d0 * 16); }
    const int sr = tid >> 4, sc = (tid & 15) * 8, vst0 = v_st(sr, sc), vst1 = v_st(32 + sr, sc);
    const int k64r = tid >> 3, k64c = (tid & 7) * 8, kst = kswz64(k64r, k64c * 2);
    const LAS char* vrd = V_lds + v_rd_base(lane);
    bf16x8 sAv0, sAv1, sAk, sBv0, sBv1, sBk;
#define B2_LOADA(t) do { sAv0 = *(const bf16x8*)(P.v_row((t), sr) + sc); sAv1 = *(const bf16x8*)(P.v_row((t), 32 + sr) + sc); sAk = *(const bf16x8*)(P.k_row((t), k64r) + k64c); } while (0)
#define B2_LOADB(t) do { sBv0 = *(const bf16x8*)(P.v_row((t), sr) + sc); sBv1 = *(const bf16x8*)(P.v_row((t), 32 + sr) + sc); sBk = *(const bf16x8*)(P.k_row((t), k64r) + k64c); } while (0)
#define B2_WRITEA(r) do { *(LAS bf16x8*)(V_lds + (r) * VB + vst0) = sAv0; *(LAS bf16x8*)(V_lds + (r) * VB + vst1) = sAv1; *(LAS bf16x8*)(K_lds + (r) * KB + kst) = sAk; } while (0)
#define B2_WRITEB(r) do { *(LAS bf16x8*)(V_lds + (r) * VB + vst0) = sBv0; *(LAS bf16x8*)(V_lds + (r) * VB + vst1) = sBv1; *(LAS bf16x8*)(K_lds + (r) * KB + kst) = sBk; } while (0)
#define B2_BAR() do { asm volatile("s_waitcnt lgkmcnt(0)" ::: "memory"); __builtin_amdgcn_sched_barrier(0); __builtin_amdgcn_s_barrier(); __builtin_amdgcn_sched_barrier(0); } while (0)
#define B2_QK(r) do { const LAS char* Ks_ = K_lds + (r) * KB; p0 = f32x16{}; p1 = f32x16{}; \
    _Pragma("unroll") for (int d0 = 0; d0 < 4; ++d0) { const int cb = (d0 * 16 + hi * 8) * 2; \
        const bf16x8 b0 = *(const LAS bf16x8*)(Ks_ + kswz64(r32, cb)); const bf16x8 b1 = *(const LAS bf16x8*)(Ks_ + kswz64(32 + r32, cb)); \
        p0 = __builtin_amdgcn_mfma_f32_32x32x16_bf16(b0, qr[d0], p0, 0, 0, 0); p1 = __builtin_amdgcn_mfma_f32_32x32x16_bf16(b1, qr[d0], p1, 0, 0, 0); } } while (0)
#define B2_PKV(L, H) (bf16x8){L[0], L[1], L[2], L[3], H[0], H[1], H[2], H[3]}
#define B2_PV(r) do { const LAS char* vb_ = vrd + (r) * VB; \
    _Pragma("unroll") for (int d0 = 0; d0 < 4; ++d0) { \
        const s16x4 l0 = vtr(vb_ + v_rd_off(d0, 0, 0)), h0 = vtr(vb_ + v_rd_off(d0, 0, 1)), l1 = vtr(vb_ + v_rd_off(d0, 1, 0)), h1 = vtr(vb_ + v_rd_off(d0, 1, 1)); \
        const s16x4 l2 = vtr(vb_ + v_rd_off(d0, 2, 0)), h2 = vtr(vb_ + v_rd_off(d0, 2, 1)), l3 = vtr(vb_ + v_rd_off(d0, 3, 0)), h3 = vtr(vb_ + v_rd_off(d0, 3, 1)); \
        o[d0] = __builtin_amdgcn_mfma_f32_32x32x16_bf16(pa0, B2_PKV(l0, h0), o[d0], 0, 0, 0); o[d0] = __builtin_amdgcn_mfma_f32_32x32x16_bf16(pa1, B2_PKV(l1, h1), o[d0], 0, 0, 0); \
        o[d0] = __builtin_amdgcn_mfma_f32_32x32x16_bf16(pa2, B2_PKV(l2, h2), o[d0], 0, 0, 0); o[d0] = __builtin_amdgcn_mfma_f32_32x32x16_bf16(pa3, B2_PKV(l3, h3), o[d0], 0, 0, 0); } } while (0)
#define B2_SM() do { float mn_, alpha_; partialSM(p0, p1, m_reg, mn_, alpha_, C, thr_raw); \
    if (__any(alpha_ < 1.f)) { if (hi == 0) al_l[r32] = alpha_; asm volatile("s_waitcnt lgkmcnt(0)" ::: "memory"); \
        _Pragma("unroll") for (int d = 0; d < 4; ++d) _Pragma("unroll") for (int r = 0; r < 16; ++r) o[d][r] *= al_l[crow(r, hi)]; } \
    finishSM(p0, p1, alpha_, l_reg, pa0, pa1, pa2, pa3); } while (0)
    f32x16 p0, p1; bf16x8 pa0, pa1, pa2, pa3; const int NT = P.ntiles();
    B2_LOADA(0); B2_LOADB(1);
    B2_WRITEA(0);
    B2_LOADA(2);
    B2_BAR();
    if (trail) B2_BAR();
    B2_QK(0); B2_WRITEB(1); B2_LOADB(3);
    B2_BAR();
    B2_SM();
    B2_BAR();
    int rk = 1, rv = 0, rw = 2;
    for (int j = 1; j < NT - 1; j += 2) {
        B2_QK(rk); B2_PV(rv); B2_WRITEA(rw); if (j + 3 < NT) B2_LOADA(j + 3);
        B2_BAR();
        B2_SM();
        B2_BAR();
        rv = rk; rk = rw; rw = (rw == 2) ? 0 : rw + 1;
        B2_QK(rk); B2_PV(rv); B2_WRITEB(rw); if (j + 4 < NT) B2_LOADB(j + 4);
        B2_BAR();
        B2_SM();
        B2_BAR();
        rv = rk; rk = rw; rw = (rw == 2) ? 0 : rw + 1;
    }
    B2_QK(rk); B2_PV(rv);
    B2_BAR();
    B2_SM();
    B2_BAR();
    rv = rk;
    B2_PV(rv);
    if (!trail) B2_BAR();
#undef B2_LOADA
#undef B2_LOADB
#undef B2_WRITEA
#undef B2_WRITEB
#undef B2_QK
#undef B2_PKV
#undef B2_PV
#undef B2_SM
    if (hi == 0) li_l[r32] = l_reg;
    asm volatile("s_waitcnt lgkmcnt(0)" ::: "memory");
    P.finish(o, m_reg, l_reg, li_l, wid, r32, hi);
    __syncthreads();
#undef B2_BAR
}

template <class Pol>
__device__ __forceinline__ void attn_unit_b3(const Pol& P, LAS char* lds, const int tid_in, unsigned long long* stamp_ = nullptr) {
    int tid = tid_in; asm volatile("" : "+v"(tid));
    const int wid = __builtin_amdgcn_readfirstlane(tid >> 6), lane = tid & 63, r32 = lane & 31, hi = lane >> 5;
    constexpr int KB = 8192, VB = 16384, K0OFF = 3 * VB, K1OFF = K0OFF + 2 * KB, WS3 = K1OFF + 2 * KB, Q3OFF = WS3 + 2048;
    static_assert(Q3OFF + 65536 <= LDSCTL_OFF, "mixer B LDS image overlaps the control words");
    LAS char* V_lds = lds;
    LAS float* wsx = (LAS float*)(lds + WS3) + wid * 64; LAS float* li_l = wsx; LAS float* al_l = wsx + 32;
    const float C = Pol::SCALE * 1.4426950408889634f, thr_raw = 8.0f / Pol::SCALE;
    float m0 = M0, l0 = 0.f, m1 = M0, l1 = 0.f; f32x16 o0[4] = {}, o1[4] = {};
    LAS char* qb_l = lds + Q3OFF + wid * 8192 + lane * 16;
#pragma unroll
    for (int mp = 0; mp < 2; ++mp) { const bf16_t* qp = P.q_row(mp, wid * 32 + r32) + hi * 8;
#pragma unroll
        for (int d0 = 0; d0 < 4; ++d0) *(LAS bf16x8*)(qb_l + mp * 4096 + d0 * 1024) = *(const bf16x8*)(qp + d0 * 16); }
    const int sr = tid >> 4, sc = (tid & 15) * 8, vst0 = v_st(sr, sc), vst1 = v_st(32 + sr, sc);
    const int k64r = tid >> 3, k64c = (tid & 7) * 8, kst = kswz64(k64r, k64c * 2);
    const int vb0 = (int)(unsigned)(__UINTPTR_TYPE__)V_lds + v_rd_base(lane);
    bf16x8 aV0, aV1, aK0, aK1;
#define B3_LOAD(V0, V1, K0, K1, t) do { V0 = *(const bf16x8*)(P.v_row((t), sr) + sc); V1 = *(const bf16x8*)(P.v_row((t), 32 + sr) + sc); \
        K0 = *(const bf16x8*)(P.k_row(0, (t), k64r) + k64c); K1 = *(const bf16x8*)(P.k_row(1, (t), k64r) + k64c); } while (0)
#define B3_WRITE(V0, V1, K0, K1, b, vs_) do { *(LAS bf16x8*)(V_lds + (vs_) * VB + vst0) = V0; *(LAS bf16x8*)(V_lds + (vs_) * VB + vst1) = V1; \
        *(LAS bf16x8*)(lds + K0OFF + (b) * KB + kst) = K0; *(LAS bf16x8*)(lds + K1OFF + (b) * KB + kst) = K1; } while (0)
#if defined(B3_PRIO) && B3_PRIO == 1
#define B3_P1() do { __builtin_amdgcn_s_setprio(1); ATT_SBAR(); } while (0)
#define B3_P0() do { ATT_SBAR(); __builtin_amdgcn_s_setprio(0); } while (0)
#else
#define B3_P1() do { } while (0)
#define B3_P0() do { } while (0)
#endif
#define B3_QS(KOFF_, QO_, m_, l_, o_, b, A0, A1, A2, A3) do { f32x16 p0, p1; float mn, alpha; \
        B3_P1(); qkt64_ldsq(p0, p1, lds + (KOFF_) + (b) * KB, qb_l + (QO_), r32, hi); B3_P0(); \
        partialSM(p0, p1, m_, mn, alpha, C, thr_raw); \
        if (__any(alpha < 1.f)) { if (hi == 0) al_l[r32] = alpha; asm volatile("s_waitcnt lgkmcnt(0)" ::: "memory"); \
            _Pragma("unroll") for (int d = 0; d < 4; ++d) _Pragma("unroll") for (int r = 0; r < 16; ++r) o_[d][r] *= al_l[crow(r, hi)]; } \
        finishSM(p0, p1, alpha, l_, A0, A1, A2, A3); ATT_SBAR(); } while (0)
#define B3_PV(o_, vs_, A0, A1, A2, A3) do { B3_P1(); pv_d0(o_, vb0 + (vs_) * VB, A0, A1, A2, A3); B3_P0(); } while (0)
#define B3_MAP(KOFF_, QO_, m_, l_, o_, b, vs_) do { bf16x8 pa0, pa1, pa2, pa3; B3_QS(KOFF_, QO_, m_, l_, o_, b, pa0, pa1, pa2, pa3); B3_PV(o_, vs_, pa0, pa1, pa2, pa3); } while (0)
    const int NT = P.ntiles();
    const bool young = wid >= 4;
    bf16x8 c0 = {}, c1 = {}, c2 = {}, c3 = {};
    int vs = 0, vprev = 0;
#if defined(STAMP_SEL)
    unsigned long long sa0 = 0, sa1 = 0, sr0 = 0, sr1 = 0; if (stamp_) { sa0 = __builtin_amdgcn_s_memtime(); sr0 = __builtin_amdgcn_s_memrealtime(); }
#endif
    B3_LOAD(aV0, aV1, aK0, aK1, 0);
    for (int t = 0; t < NT; ++t) {
        const int b = t & 1;
        B3_WRITE(aV0, aV1, aK0, aK1, b, vs);
        __syncthreads();
        if (t + 1 < NT) B3_LOAD(aV0, aV1, aK0, aK1, t + 1);
        if (young && t > 0) B3_PV(o1, vprev, c0, c1, c2, c3);
        B3_MAP(K0OFF, 0, m0, l0, o0, b, vs);
        B3_QS(K1OFF, 4096, m1, l1, o1, b, c0, c1, c2, c3);
        if (!young) B3_PV(o1, vs, c0, c1, c2, c3);
        vprev = vs; vs = (vs == 2) ? 0 : vs + 1;
    }
    if (young) B3_PV(o1, vprev, c0, c1, c2, c3);
#if defined(STAMP_SEL)
    if (stamp_ && wid == STAMP_WAVE) { sa1 = __builtin_amdgcn_s_memtime(); sr1 = __builtin_amdgcn_s_memrealtime(); if (lane == 0) { stamp_[10] = sa0; stamp_[12] = sa1; stamp_[13] = sa1; stamp_[14] = sr0; stamp_[15] = sr1; } }
#endif
#undef B3_LOAD
#undef B3_WRITE
#undef B3_MAP
#undef B3_QS
#undef B3_PV
#undef B3_P1
#undef B3_P0
    if (hi == 0) { li_l[r32] = l0; al_l[r32] = l1; }
    asm volatile("s_waitcnt lgkmcnt(0)" ::: "memory");
    P.finish2(o0, o1, li_l, al_l, wid, r32, hi);
    __syncthreads();
}

template <class RowFn>
__device__ __forceinline__ void store_o_i8(const f32x16* o, const LAS float* li_l, int wid, int r32, int hi, float qo, const RowFn& orow) {
#pragma unroll
    for (int r = 0; r < 16; ++r) { const int i = crow(r, hi); const float inv = __builtin_amdgcn_rcpf(li_l[i]) * qo; unsigned char* p = orow(wid * 32 + i) + r32;
#pragma unroll
        for (int d0 = 0; d0 < 4; ++d0) { int q = (int)__builtin_rintf(o[d0][r] * inv); q = q < -127 ? -127 : (q > 127 ? 127 : q); p[d0 * 32] = (unsigned char)q; } }
}
template <class RowFn>
__device__ __forceinline__ void store_o_bf16(const f32x16* o, const LAS float* li_l, int wid, int r32, int hi, const RowFn& orow) {
#pragma unroll
    for (int r = 0; r < 16; ++r) { const int i = crow(r, hi); const float inv = __builtin_amdgcn_rcpf(li_l[i]); bf16_t* p = orow(wid * 32 + i) + r32;
#pragma unroll
        for (int d0 = 0; d0 < 4; ++d0) p[d0 * 32] = (bf16_t)(cvtpk(o[d0][r] * inv, 0.f) & 0xffffu); }
}
struct PolA {
    static constexpr float SCALE = 0.08838834764831845f;
    const bf16_t* proj; bf16_t* ag; float* lse;
    int b, hh, j, r, L, qb, tlo, nt;
    __device__ __forceinline__ const bf16_t* tok(int pos) const { return proj + (size_t)(b * SEQ + pos) * PROJ_PITCH; }
    __device__ __forceinline__ const bf16_t* q_row(int i) const { return tok(j + r * (qb * 256 + i)) + OFF_QA + hh * 128; }
    __device__ __forceinline__ int ntiles() const { return nt; }
    __device__ __forceinline__ int kidx(int t, int kk) const { int ki = qb * 256 - 64 + 64 * (t + tlo) + kk; ki = ki < 0 ? 0 : (ki > L - 1 ? L - 1 : ki); return j + r * ki; }
    __device__ __forceinline__ const bf16_t* k_row(int t, int kk) const { return tok(kidx(t, kk)) + OFF_KA + hh * 128; }
    __device__ __forceinline__ const bf16_t* v_row(int t, int kk) const { return tok(kidx(t, kk)) + OFF_VA + hh * 128; }
    __device__ __forceinline__ bool wave_needs(int t, int wid) const { const int kbase = qb * 256 - 64 + 64 * (t + tlo), q0 = qb * 256 + wid * 32; return kbase <= q0 + 95 && kbase + 63 >= q0 - 64; }
    __device__ __forceinline__ void mask(f32x16& p0, f32x16& p1, int t, int wid, int r32, int hi, LAS char*) const {
        const int qi = qb * 256 + wid * 32 + r32; const int lo = qi - 64 < 0 ? 0 : qi - 64, hi_ = qi + 64 > L - 1 ? L - 1 : qi + 64;
        const unsigned span = (unsigned)(hi_ - lo); const int t0 = qb * 256 - 64 + 64 * (t + tlo) + 4 * hi - lo;
#pragma unroll
        for (int r = 0; r < 16; ++r) { const int kk = (r & 3) + 8 * (r >> 2);
            p0[r] = ((unsigned)(t0 + kk) <= span) ? p0[r] : NEG; p1[r] = ((unsigned)(t0 + kk + 32) <= span) ? p1[r] : NEG; }
    }
    __device__ __forceinline__ float m0w(int) const { return M0; }
    __device__ __forceinline__ float l0() const { return 0.f; }
    __device__ __forceinline__ void finish(const f32x16* o, float m_reg, float l_reg, const LAS float* li_l, int wid, int r32, int hi) const {
        const int h6 = hh % 6;
        store_o_bf16(o, li_l, wid, r32, hi, [&](int i) { return ag + (size_t)(b * SEQ + j + r * (qb * 256 + i)) * 768 + h6 * 128; });
        if (hi == 0) lse[(size_t)(b * SEQ + j + r * (qb * 256 + wid * 32 + r32)) * 6 + h6] = m_reg * SCALE + __logf(l_reg);
    }
};
struct PolC2 {
    static constexpr float SCALE = 0.08838834764831845f;
    const bf16_t* proj; unsigned char* oc; const float* sinkp; int b, kvh, qb;
    __device__ __forceinline__ const bf16_t* tok(int pos) const { return proj + (size_t)(b * SEQ + pos) * PROJ_PITCH; }
    __device__ __forceinline__ const bf16_t* q_row(int i) const { return tok(qb * 64 + (i & 63)) + OFF_QC + (kvh * 4 + (i >> 6)) * 128; }
    __device__ __forceinline__ int ntiles() const { return 5; }
    __device__ __forceinline__ int kpos(int t, int kk) const { int k = qb * 64 - 128 + 64 * t + kk; return k < 0 ? 0 : (k > SEQ - 1 ? SEQ - 1 : k); }
    __device__ __forceinline__ const bf16_t* k_row(int t, int kk) const { return tok(kpos(t, kk)) + OFF_KC + kvh * 128; }
    __device__ __forceinline__ const bf16_t* v_row(int t, int kk) const { return tok(kpos(t, kk)) + OFF_VC + kvh * 128; }
    __device__ __forceinline__ bool wave_needs(int t, int) const { const int kbase = qb * 64 - 128 + 64 * t; return kbase + 63 >= 0 && kbase < SEQ; }
    __device__ __forceinline__ void mask(f32x16& p0, f32x16& p1, int t, int wid, int r32, int hi, LAS char*) const {
        const int qi = qb * 64 + (wid & 1) * 32 + r32; const int lo = qi - 128 < 0 ? 0 : qi - 128, hi_ = qi + 128 > SEQ - 1 ? SEQ - 1 : qi + 128;
        const unsigned span = (unsigned)(hi_ - lo); const int t0 = qb * 64 - 128 + 64 * t + 4 * hi - lo;
#pragma unroll
        for (int r = 0; r < 16; ++r) { const int kk = (r & 3) + 8 * (r >> 2);
            p0[r] = ((unsigned)(t0 + kk) <= span) ? p0[r] : NEG; p1[r] = ((unsigned)(t0 + kk + 32) <= span) ? p1[r] : NEG; }
    }
    __device__ __forceinline__ float m0w(int wid) const { return sinkp[kvh * 4 + (wid >> 1)] * (1.0f / SCALE); }
    __device__ __forceinline__ float l0() const { return 1.f; }
    __device__ __forceinline__ void finish(const f32x16* o, float, float, const LAS float* li_l, int wid, int r32, int hi) const {
        store_o_i8(o, li_l, wid, r32, hi, QO, [&](int i) { return oc + (size_t)(b * SEQ + qb * 64 + (i & 63)) * 1024 + (kvh * 4 + (i >> 6)) * 128; });
    }
};
struct PolD {
    static constexpr float SCALE = 0.08838834764831845f;
    const bf16_t* proj; unsigned char* od; int b, h, rb, lo, nt;
    __device__ __forceinline__ const bf16_t* tok(int pos) const { return proj + (size_t)(b * SEQ + pos) * PROJ_PITCH; }
    __device__ __forceinline__ const bf16_t* q_row(int i) const { return tok(rb * 256 + i) + OFF_QD + h * 128; }
    __device__ __forceinline__ int ntiles() const { return nt; }
    __device__ __forceinline__ const bf16_t* k_row(int t, int kk) const { return tok((lo + t) * 64 + kk) + OFF_KD + h * 128; }
    __device__ __forceinline__ const bf16_t* v_row(int t, int kk) const { return tok((lo + t) * 64 + kk) + OFF_VD + h * 128; }
    __device__ __forceinline__ bool wave_needs(int t, int wid) const { const int qr_ = rb * 4 + (wid >> 1); int rs = qr_ - 4; rs = rs < 0 ? 0 : (rs > 56 ? 56 : rs); const int kr = lo + t; return kr >= rs && kr < rs + 8; }
    __device__ __forceinline__ void mask(f32x16& p0, f32x16& p1, int t, int wid, int r32, int hi, LAS char* lds) const {
        const int qr_ = rb * 4 + (wid >> 1), qc = 32 * (wid & 1) + r32, kr = lo + t; int cs = qc - 8; cs = cs < 0 ? 0 : (cs > 48 ? 48 : cs);
        const LAS float* T = (const LAS float*)(lds + TABOFF) + (kr - qr_ + 7) * 31 + 15 - qc + 4 * hi; const int kc0 = 4 * hi - cs;
#pragma unroll
        for (int r = 0; r < 16; ++r) { const int kk = (r & 3) + 8 * (r >> 2);
            const float b0 = T[kk], b1 = T[kk + 32];
            p0[r] = ((unsigned)(kc0 + kk) < 16u) ? p0[r] + b0 : NEG; p1[r] = ((unsigned)(kc0 + kk + 32) < 16u) ? p1[r] + b1 : NEG; }
    }
    __device__ __forceinline__ float m0w(int) const { return M0; }
    __device__ __forceinline__ float l0() const { return 0.f; }
    __device__ __forceinline__ void finish(const f32x16* o, float, float, const LAS float* li_l, int wid, int r32, int hi) const {
        store_o_i8(o, li_l, wid, r32, hi, QO, [&](int i) { return od + (size_t)(b * SEQ + rb * 256 + i) * 1024 + h * 128; });
    }
};
struct PolB {
    static constexpr float SCALE = 0.125f;
    const bf16_t* proj; bf16_t* ob; float* scr; const float* subln; const float* lam; float lambda_init; int b, h, qb, map;
#if defined(STAMP_SEL)
    unsigned long long* stamp;
#endif
    __device__ __forceinline__ const bf16_t* tok(int pos) const { return proj + (size_t)(b * SEQ + pos) * PROJ_PITCH; }
    __device__ __forceinline__ const bf16_t* q_row(int i) const { return tok(qb * 256 + i) + OFF_QB + (2 * h + map) * 64; }
    __device__ __forceinline__ int ntiles() const { return SEQ / 64; }
    __device__ __forceinline__ const bf16_t* k_row(int t, int kk) const { return tok(64 * t + kk) + OFF_KB + (2 * h + map) * 64; }
    __device__ __forceinline__ const bf16_t* v_row(int t, int kk) const { return tok(64 * t + kk) + OFF_VB + h * 128; }
    __device__ __forceinline__ bool wave_needs(int, int) const { return true; }
    __device__ __forceinline__ void mask(f32x16&, f32x16&, int, int, int, int, LAS char*) const {}
    __device__ __forceinline__ float m0w(int) const { return M0; }
    __device__ __forceinline__ float l0() const { return 0.f; }
    __device__ __forceinline__ void finish(const f32x16* o, float, float, const LAS float* li_l, int wid, int r32, int hi) const {
        if (map == 0) {
#pragma unroll
            for (int r = 0; r < 16; ++r) { const int i = crow(r, hi); const float inv = __builtin_amdgcn_rcpf(li_l[i]); float* p = scr + (size_t)(wid * 32 + i) * 128 + r32;
#pragma unroll
                for (int d0 = 0; d0 < 4; ++d0) p[d0 * 32] = o[d0][r] * inv; }
        } else {
            const int ln_ = r32 + 32 * hi; const float d01 = wave_sum(lam[ln_] * lam[64 + ln_]), d23 = wave_sum(lam[128 + ln_] * lam[192 + ln_]);
            const float lmbda = __expf(d01) - __expf(d23) + lambda_init, oscale = 1.0f - lambda_init;
            float sw[4];
#pragma unroll
            for (int d0 = 0; d0 < 4; ++d0) sw[d0] = subln[d0 * 32 + r32] * oscale;
#pragma unroll
            for (int r = 0; r < 16; ++r) { const int i = crow(r, hi); const float inv = __builtin_amdgcn_rcpf(li_l[i]); const float* p = scr + (size_t)(wid * 32 + i) * 128 + r32;
                float v[4]; float ss = 0.f;
#pragma unroll
                for (int d0 = 0; d0 < 4; ++d0) { v[d0] = p[d0 * 32] - lmbda * (o[d0][r] * inv); ss += v[d0] * v[d0]; }
#pragma unroll
                for (int s = 1; s < 32; s <<= 1) ss += __shfl_xor(ss, s);
                const float rinv = rsqrtf(ss * (1.0f / 128.0f) + SUBLN_EPS);
                bf16_t* q = ob + (size_t)(b * SEQ + qb * 256 + wid * 32 + i) * 1024 + h * 128 + r32;
#pragma unroll
                for (int d0 = 0; d0 < 4; ++d0) q[d0 * 32] = (bf16_t)(cvtpk(v[d0] * rinv * sw[d0], 0.f) & 0xffffu); }
        }
    }
};

struct PolB2 {
    static constexpr float SCALE = 0.125f;
    const bf16_t* proj; unsigned char* ob; const float* subln; const float* lam; float lambda_init; int b, h, qb;
    __device__ __forceinline__ const bf16_t* tok(int pos) const { return proj + (size_t)(b * SEQ + pos) * PROJ_PITCH; }
    __device__ __forceinline__ const bf16_t* q_row(int mp, int i) const { return tok(qb * 256 + i) + OFF_QB + (2 * h + mp) * 64; }
    __device__ __forceinline__ int ntiles() const { return SEQ / 64; }
    __device__ __forceinline__ const bf16_t* k_row(int mp, int t, int kk) const { return tok(64 * t + kk) + OFF_KB + (2 * h + mp) * 64; }
    __device__ __forceinline__ const bf16_t* v_row(int t, int kk) const { return tok(64 * t + kk) + OFF_VB + h * 128; }
    __device__ __forceinline__ void finish2(const f32x16* o0, const f32x16* o1, const LAS float* l0_l, const LAS float* l1_l, int wid, int r32, int hi) const {
        const int ln_ = r32 + 32 * hi; const float d01 = wave_sum(lam[ln_] * lam[64 + ln_]), d23 = wave_sum(lam[128 + ln_] * lam[192 + ln_]);
        const float lmbda = __expf(d01) - __expf(d23) + lambda_init;
        float sw[4];
#pragma unroll
        for (int d0 = 0; d0 < 4; ++d0) sw[d0] = subln[d0 * 32 + r32] * QX;
#pragma unroll
        for (int r = 0; r < 16; ++r) { const int i = crow(r, hi); const float inv0 = __builtin_amdgcn_rcpf(l0_l[i]), inv1 = lmbda * __builtin_amdgcn_rcpf(l1_l[i]);
            float v[4]; float ss = 0.f;
#pragma unroll
            for (int d0 = 0; d0 < 4; ++d0) { v[d0] = o0[d0][r] * inv0 - o1[d0][r] * inv1; ss += v[d0] * v[d0]; }
#pragma unroll
            for (int s = 1; s < 32; s <<= 1) ss += __shfl_xor(ss, s);
            const float rinv = rsqrtf(ss * (1.0f / 128.0f) + SUBLN_EPS);
            unsigned char* q = ob + (size_t)(b * SEQ + qb * 256 + wid * 32 + i) * 1024 + h * 128 + r32;
#pragma unroll
            for (int d0 = 0; d0 < 4; ++d0) { int t = (int)__builtin_rintf(v[d0] * rinv * sw[d0]); t = t < -127 ? -127 : (t > 127 ? 127 : t); q[d0 * 32] = (unsigned char)t; } }
    }
};

#ifndef ATT_MASK
#define ATT_MASK 15
#endif
#define ATT_ON(k) ((ATT_MASK >> (k)) & 1)
#ifndef ATT_REP
#define ATT_REP 0
#endif
#define ATT_NREP(k) (((ATT_REP >> (k)) & 1) ? 2 : 1)
struct Ptrs { const bf16_t* proj; bf16_t* ag; float* lse; unsigned char* ob; unsigned char* oc; unsigned char* od; const float* lam; const float* subln; const float* sink; const float* rpb; float lambda_init;
#if defined(STAMP_SEL)
    unsigned long long* stamp;
#endif
};
__device__ __forceinline__ void attn_phase(const Ptrs& X, LAS char* lds, const int tid, const int vcu, const int G, const int wgid) {
    const int lane = tid & 63;
    if (ATT_ON(0)) for (int rep = 0; rep < ATT_NREP(0); ++rep) {
        for (int u = vcu; u < 512; u += G) {
            PolB2 P{X.proj, X.ob, X.subln, X.lam, X.lambda_init, u >> 7, (u >> 4) & 7, u & 15};
#if defined(STAMP_SEL)
            attn_unit_b3<PolB2>(P, lds, tid, (wgid == STAMP_WG && u == vcu && rep == 0) ? X.stamp : nullptr);
#else
            attn_unit_b3<PolB2>(P, lds, tid);
#endif
        }
    }
    if (ATT_ON(1)) for (int rep = 0; rep < ATT_NREP(1); ++rep) for (int u = vcu; u < 512; u += G) {
        const int rb = u & 15, h = (u >> 4) & 7, b = u >> 7; int lo = rb * 4 - 4; lo = lo < 0 ? 0 : (lo > 56 ? 56 : lo); int hi_ = rb * 4 + 3 - 4; hi_ = hi_ < 0 ? 0 : (hi_ > 56 ? 56 : hi_); hi_ += 7;
        { LAS float* T = (LAS float*)(lds + TABOFF); for (int i = tid; i < 465; i += 512) T[i] = X.rpb[h * 465 + i] * (1.0f / PolD::SCALE); }
        PolD P{X.proj, X.od, b, h, rb, lo, hi_ - lo + 1};
        attn_unit<128, PolD>(P, lds, tid);
    }
    if (ATT_ON(2)) for (int rep = 0; rep < ATT_NREP(2); ++rep) for (int u = vcu; u < 512; u += G) {
        const int qb = u & 63, kvh = (u >> 6) & 1, b = u >> 7;
        PolC2 P{X.proj, X.oc, X.sink, b, kvh, qb};
        attn_unit<128, PolC2>(P, lds, tid);
    }
    if (ATT_ON(3)) for (int rep = 0; rep < ATT_NREP(3); ++rep) for (int u = vcu; u < 1152; u += G) {
        const int g = u / 384, v = u % 384, w16 = v & 15, bh = v >> 4, h6 = bh % 6, b = bh / 6;
        const int r = g == 0 ? 1 : (g == 1 ? 4 : 16), L = SEQ / r;
        const int qb = w16 / r, tlo = qb == 0 ? 1 : 0; int thi = (L - qb * 256 + 64 + 63) / 64; thi = thi > 6 ? 6 : thi;
        PolA P{X.proj, X.ag + (size_t)g * MTOK * 768, X.lse + (size_t)g * MTOK * 6, b, g * 6 + h6, w16 % r, r, L, qb, tlo, thi - tlo};
        attn_unit<128, PolA>(P, lds, tid);
    }
}
#undef ATT_SBAR
}

struct InPtrs { const float *x, *w_in, *b_gate, *w_branch, *w_out, *diff_lambda, *diff_subln, *sink_logit, *na_rpb, *w_router, *w_exp_gate, *w_exp_up, *w_exp_down, *ln_gain, *ln_bias; };

__device__ __forceinline__ void prologue_phase(const InPtrs& I, unsigned char* ws, LAS unsigned char* lds, int gw, int NGW, int wave, int lane) {
    LAS unsigned char* scr = lds + wave * 9216;
    { const f32x4* xs = (const f32x4*)I.x;
      for (size_t i = (size_t)gw * 64 + lane; i < (size_t)MTOK * DM / 8; i += (size_t)NGW * 64) {
          const f32x4 a = xs[2 * i], b = xs[2 * i + 1];
          u32x2 q; q.x = q8x4(a[0], a[1], a[2], a[3], QX); q.y = q8x4(b[0], b[1], b[2], b[3], QX); ((u32x2*)(ws + WS_X8))[i] = q; } }
    { float* r128 = (float*)(ws + WS_ROPE128); float* r64 = (float*)(ws + WS_ROPE64);
      for (int i = gw * 64 + lane; i < SEQ * 64 + SEQ * 32; i += NGW * 64) {
          int pos, ii, half; float* dst;
          if (i < SEQ * 64) { pos = i >> 6; ii = i & 63; half = 64; dst = r128 + 2 * (size_t)i; } else { const int k = i - SEQ * 64; pos = k >> 5; ii = k & 31; half = 32; dst = r64 + 2 * (size_t)k; }
          const float inv = (float)pow(10000.0, -(double)ii / (double)half); const float ang = (float)pos * inv;
          dst[0] = (float)cos((double)ang); dst[1] = (float)sin((double)ang); } }
    bf16_t* WIN = (bf16_t*)(ws + WS_WIN); bf16_t* WOUT = (bf16_t*)(ws + WS_WOUT); bf16_t* WGU = (bf16_t*)(ws + WS_WGU); bf16_t* WDN = (bf16_t*)(ws + WS_WDN);
    constexpr int N1 = DEPTH * 32 * 356, N2 = DEPTH * 60 * 32, N3 = DEPTH * 32 * 32, N4 = DEPTH * NEXP * 32 * 32, N5 = DEPTH * NEXP * 16 * 32;
    for (int it = gw; it < N1 + N2 + N3 + N4 + N5; it += NGW) {
        int r = it;
        if (r < N1) { const int sub = r & 15, grp = r >> 4; const int nb = (grp % 89) * 4 + (sub & 3), kb = ((grp / 89) & 7) * 4 + (sub >> 2), l = grp / (89 * 8); const int n = nb * 64 + lane;
            const int c0 = nb * 64;
            if (c0 >= 14592) tr_item8(I.w_in + (size_t)l * DM * IN_TOTAL, IN_TOTAL, n, kb * 64, (unsigned char*)(ws + WS_W8G) + ((size_t)l * 8192 + (c0 - 14592)) * DM + kb * 64, DM, QWG, scr, lane);
            else { const bool isv = (c0 >= 4608 && c0 < 6912) || (c0 >= 8960 && c0 < 9984) || (c0 >= 11264 && c0 < 11520) || (c0 >= 13568);
                tr_item8(I.w_in + (size_t)l * DM * IN_TOTAL, IN_TOTAL, win_src_col(n), kb * 64, (unsigned char*)(ws + WS_W8Q) + ((size_t)l * 14592 + c0) * DM + kb * 64, DM, isv ? QWU : QWG, scr, lane); }
            continue; }
        r -= N1;
        if (r < N2) { const int nb = r % 32, kbg = (r / 32) % 60, l = r / (32 * 60); const int n = nb * 64 + lane;
            int ro, Kb, kb; if (kbg < 12) { ro = 0; Kb = 768; kb = kbg; } else { const int q = (kbg - 12) >> 4; ro = 768 + 1024 * q; Kb = 1024; kb = (kbg - 12) & 15; }
            const int brn = kbg < 12 ? 0 : 1 + ((kbg - 12) >> 4); (void)Kb;
            tr_item8(I.w_branch + ((size_t)l * BR_TOTAL + ro) * DM, DM, n, kb * 64, (unsigned char*)(ws + WS_W8BR) + ((size_t)(l * 4 + brn) * DM + nb * 64) * 1024 + kb * 64, 1024, brn == 0 ? QWBA : QWBC, scr, lane);
            continue; }
        r -= N2;
        if (r < N3) { const int nb = r % 32, kb = (r / 32) % 32, l = r / (32 * 32); const int n = nb * 64 + lane;
            tr_item8(I.w_out + (size_t)l * DM * DM, DM, n, kb * 64, (unsigned char*)WOUT + ((size_t)l * DM + nb * 64) * DM + kb * 64, DM, QWU, scr, lane); continue; }
        r -= N3;
        if (r < N4) { const int sub = r & 15, grp = r >> 4; const int nb = (grp & 7) * 4 + (sub & 3), kb = ((grp >> 3) & 7) * 4 + (sub >> 2), le = grp >> 6; const int n = nb * 64 + lane, pn = n >> 8, bj = (n >> 7) & 1, jj = n & 127;
            tr_item8((bj ? I.w_exp_up : I.w_exp_gate) + (size_t)le * DM * DEXP, DEXP, pn * 128 + jj, kb * 64, (unsigned char*)WGU + ((size_t)le * 2048 + nb * 64) * DM + kb * 64, DM, bj ? QWU : QWG, scr, lane); continue; }
        r -= N4;
        { const int sub = r & 15, grp = r >> 4; const int nb = (grp & 7) * 4 + (sub & 3), kb = ((grp >> 3) & 3) * 4 + (sub >> 2), le = grp >> 5; const int n = nb * 64 + lane;
            tr_item8(I.w_exp_down + (size_t)le * DEXP * DM, DM, n, kb * 64, (unsigned char*)WDN + ((size_t)le * DM + nb * 64) * DEXP + kb * 64, DEXP, QWD, scr, lane); }
    }
}

struct Args { const float* in[15]; float* out; unsigned char* ws; int ph_lo, ph_hi; };
__global__ void __launch_bounds__(NWAVES * 64, LB_WAVES) fwd(Args args) {
    extern __shared__ __attribute__((aligned(16))) unsigned char lds_raw[];
    LAS unsigned char* lds = (LAS unsigned char*)lds_raw;
    for (int u = threadIdx.x; u < (LDS_BYTES - LDSCTL_OFF) / 4; u += NWAVES * 64) ((LAS unsigned*)(lds + LDSCTL_OFF))[u] = 0u;
    __syncthreads();
    unsigned* ctl = (unsigned*)(args.ws + WS_CTL);
    XcdBarrier bar = xcd_barrier_post(ctl + CW_BAR, (volatile LAS unsigned*)(lds + LDSCTL_OFF));
    const int lo = args.ph_lo, hi = args.ph_hi;
#ifndef SCALAR_ATTN
#define SCALAR_ATTN 0
#endif
#ifndef REP_MASK
#define REP_MASK 0
#endif
#define NREP(k) (((REP_MASK >> (k)) & 1) ? 2 : 1)
#ifndef PH_MASK
#define PH_MASK 0xFFFF
#endif
#define PHON(k) ((PH_MASK >> (k)) & 1)
#define IN(k) (lo <= (k) && (k) < hi)
#define PHASE_LOCALS long zz = 0; asm volatile("" : "+s"(zz)); unsigned char* const ws = args.ws + zz; int tid = threadIdx.x; asm volatile("" : "+v"(tid)); int bx = blockIdx.x, G = gridDim.x; asm volatile("" : "+s"(bx), "+s"(G)); \
    const int lane = tid & 63, wave = __builtin_amdgcn_readfirstlane(tid >> 6); const int vcu = (G % 8 == 0) ? (bx % 8) * (G / 8) + bx / 8 : bx; \
    const int gw = vcu * NWAVES + wave, NGW = G * NWAVES; (void)lane; (void)gw; (void)NGW
#if defined(STAMP_SEL)
#define SEAM(k) do { if (IN(k) && IN((k) + 1)) { const unsigned long long b0_ = __builtin_amdgcn_s_memrealtime(); xcd_barrier(bar); \
    if (__builtin_amdgcn_readfirstlane((int)blockIdx.x) == STAMP_WG && threadIdx.x == 0) { unsigned long long* st_ = (unsigned long long*)(args.ws + WS_CTL + 65536); st_[20] += __builtin_amdgcn_s_memrealtime() - b0_; } } } while (0)
#else
#define SEAM(k) do { if (IN(k) && IN((k) + 1)) xcd_barrier(bar); } while (0)
#endif

#define XF ((float*)(ws + WS_XF))
#define XB ((bf16_t*)(ws + WS_XB))
#define PROJ ((bf16_t*)(ws + WS_PROJ))
#define OA ((bf16_t*)(ws + WS_OA))
#define OB ((bf16_t*)(ws + WS_OB))
#define OC ((bf16_t*)(ws + WS_OC))
#define OD ((bf16_t*)(ws + WS_OD))
#define AG ((bf16_t*)(ws + WS_AG))
#define LSE ((float*)(ws + WS_LSE))
#define MIXED ((bf16_t*)(ws + WS_MIXED))
#define PRELN ((float*)(ws + WS_PRELN))
#define XG ((bf16_t*)(ws + WS_XG))
#define HB ((bf16_t*)(ws + WS_H))
#define YB ((bf16_t*)(ws + WS_Y))
#define AFF ((float*)(ws + WS_AFF))
#define IDX ((int*)(ws + WS_IDX))
#define GV ((float*)(ws + WS_GV))
#define SLOT ((int*)(ws + WS_SLOT))

    if (PHON(0) && IN(0)) for (int rep = 0; rep < NREP(0); ++rep) { PHASE_LOCALS;
        InPtrs I; I.x = args.in[0 + zz]; I.w_in = args.in[1 + zz]; I.b_gate = args.in[2 + zz]; I.w_branch = args.in[3 + zz]; I.w_out = args.in[4 + zz]; I.diff_lambda = args.in[5 + zz]; I.diff_subln = args.in[6 + zz];
        I.sink_logit = args.in[7 + zz]; I.na_rpb = args.in[8 + zz]; I.w_router = args.in[9 + zz]; I.w_exp_gate = args.in[10 + zz]; I.w_exp_up = args.in[11 + zz]; I.w_exp_down = args.in[12 + zz]; I.ln_gain = args.in[13 + zz]; I.ln_bias = args.in[14 + zz];
        prologue_phase(I, ws, lds, gw, NGW, wave, lane); if (rep == NREP(0) - 1) SEAM(0); else xcd_barrier(bar); }

    for (int l = 0; l < DEPTH; ++l) {
        const int pb = 1 + l * NPL;
        if (PHON(1) && IN(pb + 0)) for (int rep = 0; rep < NREP(1); ++rep) { PHASE_LOCALS;
            { pg8::Gemm g{(const bf16_t*)(ws + WS_X8), (const bf16_t*)(ws + WS_W8Q + (size_t)l * 14592 * DM), MTOK, 14592, DM / 2, 0, 0, 0, nullptr STAMP_ARG(nullptr)}; pg8::StaticOrder S; S.init(MTOK, 14592, G, bx);
              pg8::EpiProjT<true> E{PROJ, (const float*)(ws + WS_ROPE128), (const float*)(ws + WS_ROPE64), 0, 1 << 30, 0, 1.0f / (QX * QWG), 1.0f / (QX * QWU)};
              pg8::gemm_phase<pg8::EpiProjT<true>, pg8::StaticOrder, true, true, false, true>(lds, g, S, E, tid); }
            { pg8::Gemm g{(const bf16_t*)(ws + WS_X8), (const bf16_t*)(ws + WS_W8G + (size_t)l * 8192 * DM), MTOK, 8192, DM / 2, 0, 0, 0, nullptr STAMP_ARG(nullptr)}; pg8::StaticOrder S; S.init(MTOK, 8192, G, bx);
              pg8::EpiGate8 E{(unsigned char*)(ws + WS_GATE), args.in[2 + zz] + (size_t)l * 8192, 1.0f / (QX * QWG)};
              int tid2 = tid; asm volatile("" : "+v"(tid2));
              pg8::gemm_phase<pg8::EpiGate8, pg8::StaticOrder, true, true, false, true>(lds, g, S, E, tid2); }
            if (rep == NREP(1) - 1) SEAM(pb + 0); else xcd_barrier(bar);
        }
        if (PHON(2) && IN(pb + 1)) for (int rep = 0; rep < NREP(2); ++rep) { PHASE_LOCALS;
            const float li = l == 0 ? 0.2f : (l == 1 ? 0.35550906759096926f : (l == 2 ? 0.47071301834358416f : 0.5560582041556405f));
#if SCALAR_ATTN
            { AttnPtrs P{PROJ, AG, LSE, nullptr, nullptr, nullptr, nullptr, nullptr, nullptr, nullptr, li}; scalar_attn_phase<0>(P, lds, gw, NGW, wave, lane); }
            { AttnPtrs P{PROJ, nullptr, nullptr, OB, nullptr, nullptr, args.in[5 + zz] + l * 256, args.in[6 + zz] + l * 128, nullptr, nullptr, li}; scalar_attn_phase<1>(P, lds, gw, NGW, wave, lane); }
            { AttnPtrs P{PROJ, nullptr, nullptr, nullptr, OC, nullptr, nullptr, nullptr, args.in[7 + zz] + l * 8, nullptr, li}; scalar_attn_phase<2>(P, lds, gw, NGW, wave, lane); }
            { AttnPtrs P{PROJ, nullptr, nullptr, nullptr, nullptr, OD, nullptr, nullptr, nullptr, args.in[8 + zz] + (size_t)l * 8 * 465, li}; scalar_attn_phase<3>(P, lds, gw, NGW, wave, lane); }
#else
            att::Ptrs X{PROJ, AG, LSE, (unsigned char*)(ws + WS_O8 + (size_t)1 * MTOK * 1024), (unsigned char*)(ws + WS_O8 + (size_t)2 * MTOK * 1024), (unsigned char*)(ws + WS_O8 + (size_t)3 * MTOK * 1024), args.in[5 + zz] + l * 256, args.in[6 + zz] + l * 128, args.in[7 + zz] + l * 8, args.in[8 + zz] + (size_t)l * 8 * 465, li STAMP_ARG((unsigned long long*)(ws + WS_CTL + 65536))};
            att::attn_phase(X, (LAS char*)lds, tid, vcu, G, bx);
#endif
            if (rep == NREP(2) - 1) SEAM(pb + 1); else xcd_barrier(bar);
        }
        if (PHON(3) && IN(pb + 2)) for (int rep = 0; rep < NREP(3); ++rep) { PHASE_LOCALS; combine_a_phase(AG, LSE, (unsigned*)(ws + WS_O8), gw, NGW, lane); if (rep == NREP(3) - 1) SEAM(pb + 2); else xcd_barrier(bar); }
        if (PHON(4) && IN(pb + 3)) for (int rep = 0; rep < NREP(4); ++rep) { PHASE_LOCALS;
            { const float one_m_li = 1.0f - (l == 0 ? 0.2f : (l == 1 ? 0.35550906759096926f : (l == 2 ? 0.47071301834358416f : 0.5560582041556405f)));
              const float qm = 127.0f / (6.0f * 0.2275f * one_m_li);
              pg8::Gemm g{(const bf16_t*)(ws + WS_O8), (const bf16_t*)(ws + WS_W8BR + (size_t)l * 4 * DM * 1024), MTOK, DM, 512, 0, (size_t)MTOK * 1024, (size_t)DM * 1024, nullptr STAMP_ARG(nullptr)}; pg8::BranchOrder4 S; S.init(MTOK, DM, G, bx);
              pg8::EpiGate4 E{MIXED, (const unsigned char*)(ws + WS_GATE), 1.0f / (QO * QWBA), one_m_li / (QX * QWBC), 1.0f / (QO * QWBC), (unsigned char*)(ws + WS_MIXED8), qm};
              pg8::gemm_phase<pg8::EpiGate4, pg8::BranchOrder4, true, true, false, true>(lds, g, S, E, tid); }
            if (rep == NREP(4) - 1) SEAM(pb + 3); else xcd_barrier(bar);
        }
        if (PHON(5) && IN(pb + 4)) for (int rep = 0; rep < NREP(5); ++rep) { PHASE_LOCALS;
            const float one_m_li = 1.0f - (l == 0 ? 0.2f : (l == 1 ? 0.35550906759096926f : (l == 2 ? 0.47071301834358416f : 0.5560582041556405f)));
            const float qm = 127.0f / (6.0f * 0.2275f * one_m_li);
            pg8::Gemm g{(const bf16_t*)(ws + WS_MIXED8), (const bf16_t*)(ws + WS_WOUT + (size_t)l * DM * DM), MTOK, DM, DM / 2, 0, 0, 0, nullptr STAMP_ARG(nullptr)}; pg8::StaticOrder S; S.init(MTOK, DM, G, bx);
            pg8::EpiResid E{(bf16_t*)PRELN, l == 0 ? args.in[0 + zz] : (const float*)nullptr, (const bf16_t*)XF, ALPHA, 1.0f / (qm * QWU)};
            pg8::gemm_phase<pg8::EpiResid, pg8::StaticOrder, true, true, false, true>(lds, g, S, E, tid);
            if (rep == NREP(5) - 1) SEAM(pb + 4); else xcd_barrier(bar);
        }
        if (PHON(6) && IN(pb + 5)) for (int rep = 0; rep < NREP(6); ++rep) { PHASE_LOCALS; ln1_router_phase((const bf16_t*)PRELN, args.in[13 + zz] + (size_t)(l * 2) * DM, args.in[14 + zz] + (size_t)(l * 2) * DM, args.in[9 + zz] + (size_t)l * DM * NEXP, (float*)(ws + WS_STATS), (unsigned*)(ws + WS_X8), AFF, lds, tid, gw, NGW, lane); if (rep == NREP(6) - 1) SEAM(pb + 5); else xcd_barrier(bar); }
        if (PHON(7) && IN(pb + 6)) for (int rep = 0; rep < NREP(7); ++rep) { PHASE_LOCALS; topk_phase(AFF, IDX, GV, SLOT, lds, tid, wave, lane, bx, G); if (rep == NREP(7) - 1) SEAM(pb + 6); else xcd_barrier(bar); }
        if (PHON(9) && IN(pb + 7)) for (int rep = 0; rep < NREP(9); ++rep) { PHASE_LOCALS;
            pg8::Gemm g{(const bf16_t*)(ws + WS_X8), (const bf16_t*)(ws + WS_WGU + (size_t)l * NEXP * 2048 * DM), NGRP * CAP, 2048, DM / 2, (size_t)2048 * DM, 0, 0, IDX STAMP_ARG(nullptr)};
            pg8::StaticOrder S; S.init(NGRP * CAP, 2048, G, bx);
            pg8::EpiSwiGLU E{(unsigned char*)(ws + WS_H), 1.0f / (QX * QWG), 1.0f / (QX * QWU), QH};
            pg8::gemm_phase<pg8::EpiSwiGLU, pg8::StaticOrder, true, true, true, true>(lds, g, S, E, tid);
            if (rep == NREP(9) - 1) SEAM(pb + 7); else xcd_barrier(bar);
        }
        if (PHON(10) && IN(pb + 8)) for (int rep = 0; rep < NREP(10); ++rep) { PHASE_LOCALS;
            pg8::Gemm g{(const bf16_t*)(ws + WS_H), (const bf16_t*)(ws + WS_WDN + (size_t)l * NEXP * DM * DEXP), NGRP * CAP, DM, DEXP / 2, (size_t)DM * DEXP, 0, 0, nullptr STAMP_ARG(nullptr)};
            pg8::StaticOrder S; S.init(NGRP * CAP, DM, G, bx);
            pg8::EpiDown E{(unsigned char*)YB, QY / (QH * QWD)};
            pg8::gemm_phase<pg8::EpiDown, pg8::StaticOrder, true, true, false, true>(lds, g, S, E, tid);
            if (rep == NREP(10) - 1) SEAM(pb + 8); else xcd_barrier(bar);
        }
        if (PHON(11) && IN(pb + 9)) for (int rep = 0; rep < NREP(11); ++rep) { PHASE_LOCALS;
            if (NREP(11) == 2 && rep == 0) ln2_phase((const bf16_t*)PRELN, (const float*)(ws + WS_STATS), args.in[13 + zz] + (size_t)(l * 2) * DM, args.in[14 + zz] + (size_t)(l * 2) * DM, (const unsigned char*)YB, GV, SLOT, args.in[13 + zz] + (size_t)(l * 2 + 1) * DM, args.in[14 + zz] + (size_t)(l * 2 + 1) * DM, (float*)(ws + WS_O8), (bf16_t*)(ws + WS_O8), MIXED, (unsigned char*)(ws + WS_AG), gw, NGW, lane); else
            ln2_phase((const bf16_t*)PRELN, (const float*)(ws + WS_STATS), args.in[13 + zz] + (size_t)(l * 2) * DM, args.in[14 + zz] + (size_t)(l * 2) * DM, (const unsigned char*)YB, GV, SLOT, args.in[13 + zz] + (size_t)(l * 2 + 1) * DM, args.in[14 + zz] + (size_t)(l * 2 + 1) * DM, (l == DEPTH - 1) ? args.out : XF, (bf16_t*)XF, XB, (l == DEPTH - 1) ? (unsigned char*)nullptr : (unsigned char*)(ws + WS_X8), gw, NGW, lane);
            if (rep == NREP(11) - 1) SEAM(pb + 9); else xcd_barrier(bar);
#if defined(PROBE_XBAR)
            for (int xb_ = 0; xb_ < PROBE_XBAR; ++xb_) xcd_barrier(bar);
#endif
#if defined(STAMP_SEL)
            if (l == DEPTH - 1 && bx == STAMP_WG && tid == 0) { asm volatile("s_waitcnt vmcnt(0)" ::: "memory");
                const unsigned long long* st = (const unsigned long long*)(ws + WS_CTL + 65536);
                float val = 0.f;
                if (STAMP_SEL == 1) val = (float)(st[1] - st[0]) * (1.0f / 32.0f);
                if (STAMP_SEL == 2) val = (float)(st[2] - st[1]);
                if (STAMP_SEL == 3) val = (float)(st[2] - st[0]) / ((float)(st[4] - st[3]) * 0.01f);
                if (STAMP_SEL == 4) val = (float)(st[12] - st[10]) * (1.0f / 63.0f);
                if (STAMP_SEL == 5) val = (float)(st[13] - st[12]);
                if (STAMP_SEL == 7) val = (float)st[20] * 0.01f;
                if (STAMP_SEL == 6) val = (float)(st[12] - st[10]) / ((float)(st[15] - st[14]) * 0.01f);
                const unsigned long long w0 = __builtin_amdgcn_s_memrealtime(), wt = (unsigned long long)(val * (float)STAMP_SCALE);
                while (__builtin_amdgcn_s_memrealtime() - w0 < wt) __builtin_amdgcn_s_sleep(16); }
#endif
        }
    }
#undef IN
#undef SEAM
}

#ifndef MK_ONE_LAUNCH
#define MK_ONE_LAUNCH 1
#endif
extern "C" void kernel_launch(void* const* d_in, const int* in_sizes, int n_in, void* d_out, int out_size, void* d_ws, size_t ws_size, hipStream_t stream) {
    static int grid = 0;
    if (grid == 0) {
        if (n_in != 15 || out_size != MTOK * DM || ws_size < WS_END) { fprintf(stderr, "kernel_launch: unexpected shapes (n_in %d out %d ws %zu, need ws >= %zu)\n", n_in, out_size, ws_size, (size_t)WS_END); grid = -1; return; }
        int dev = 0, cus = 0, per_cu = 0;
        if (hipGetDevice(&dev) != hipSuccess || hipDeviceGetAttribute(&cus, hipDeviceAttributeMultiprocessorCount, dev) != hipSuccess) { grid = -1; return; }
        if (hipFuncSetAttribute((const void*)fwd, hipFuncAttributeMaxDynamicSharedMemorySize, LDS_BYTES) != hipSuccess) { fprintf(stderr, "kernel_launch: hipFuncSetAttribute failed\n"); grid = -1; return; }
        if (hipOccupancyMaxActiveBlocksPerMultiprocessor(&per_cu, (const void*)fwd, NWAVES * 64, LDS_BYTES) != hipSuccess || per_cu < 1) { fprintf(stderr, "kernel_launch: occupancy query says %d\n", per_cu); }
        (void)hipGetLastError();
        grid = cus;
    }
    if (grid < 0) return;
    if (hipMemsetAsync((char*)d_ws + WS_CTL, 0, CTL_ZERO_BYTES, stream) != hipSuccess) return;
    Args a{};
    for (int i = 0; i < 15; ++i) a.in[i] = (const float*)d_in[i];
    a.out = (float*)d_out; a.ws = (unsigned char*)d_ws;
#if MK_ONE_LAUNCH
    a.ph_lo = 0; a.ph_hi = NPHASES;
    hipLaunchKernelGGL(fwd, dim3(grid), dim3(NWAVES * 64), LDS_BYTES, stream, a);
#else
    for (int p = 0; p < NPHASES; ++p) { a.ph_lo = p; a.ph_hi = p + 1; hipLaunchKernelGGL(fwd, dim3(grid), dim3(NWAVES * 64), LDS_BYTES, stream, a); }
#endif
}
```

```cpp
#include <hip/hip_runtime.h>
#include <cstdio>
#include <cstdint>
#include <cmath>
#define B3_PRIO 1
namespace pg8 {
#define PG8_LAS __attribute__((address_space(3)))
typedef unsigned short bf16_t;
typedef short bf16x8 __attribute__((ext_vector_type(8)));
typedef float f32x4 __attribute__((ext_vector_type(4)));
typedef unsigned u32x4 __attribute__((ext_vector_type(4)));
typedef unsigned u32x2 __attribute__((ext_vector_type(2)));
typedef _Float16 f16x8 __attribute__((ext_vector_type(8)));
typedef int i32x4 __attribute__((ext_vector_type(4)));
constexpr int BM = 256, BK = 64, HALF = 128, HTB = HALF * BK * 2  , STAGE_BYTES = 8 * HTB, NXCD = 8, WGM = 8;

__host__ __device__ __forceinline__ int lds_byte(int r, int c) { const int st = (r >> 4) * 2 + (c >> 5), rr = r & 15, cc = c & 31, ob = rr * 64 + cc * 2; return st * 1024 + (ob ^ (((ob >> 9) & 1) << 5)); }
__host__ __device__ __forceinline__ void stage_rc(int b, int& R, int& C) { const int st = b / 1024, sb = b % 1024, swz = sb ^ (((sb >> 9) & 1) << 5); R = (st >> 1) * 16 + swz / 64; C = (st & 1) * 32 + (swz % 64) / 2; }
__host__ __device__ __forceinline__ int perm32(int rho) { const int n = rho >> 4, i = rho & 15; return 8 * (i >> 2) + 4 * n + (i & 3); }

struct Unit { int pm, pn, br; };
struct Gemm { const bf16_t* A; const bf16_t* Bt; int M, N, K; size_t gstride; size_t a_brstride, b_brstride; const int* gidx;
#if defined(STAMP_SEL)
    unsigned long long* stamp;
#endif
};

struct StaticOrder {
    int nM, nN, nwg, G, c;
    __host__ __device__ void init(int M, int N, int G_, int c_) { nM = M / BM; nN = N / BM; nwg = nM * nN; G = G_; c = c_; }
    __host__ __device__ bool next(int i, Unit& u) const {
        const long L = (long)i * G + c; if (L >= nwg) return false;
        int wgid = (int)L; { const int q = nwg / NXCD, r = nwg % NXCD, xcd = wgid % NXCD, off = wgid / NXCD; wgid = (xcd < r ? xcd * (q + 1) : r * (q + 1) + (xcd - r) * q) + off; }
        const int nig = WGM * nN, gid = wgid / nig, fm = gid * WGM, gsz = (nM - fm) < WGM ? (nM - fm) : WGM;
        u.pm = fm + ((wgid % nig) % gsz); u.pn = (wgid % nig) / gsz; u.br = 0; return true;
    }
    __device__ __forceinline__ int ntiles(const Unit&, int nt_full) const { return nt_full; }
    __device__ __forceinline__ void a_ready(const Unit&) const {}
    __device__ __forceinline__ void done(const Unit&) const {}
};
struct BranchOrder4 : StaticOrder {
    __device__ bool next(int i, Unit& u) const { if (!StaticOrder::next(i >> 2, u)) return false; u.br = i & 3; return true; }
    __device__ __forceinline__ int ntiles(const Unit& u, int) const { return u.br == 0 ? 6 : 8; }
};

__device__ __forceinline__ unsigned cvt_pk_bf16(float lo, float hi) { unsigned r; asm volatile("v_cvt_pk_bf16_f32 %0, %1, %2" : "=v"(r) : "v"(lo), "v"(hi)); return r; }
__device__ __forceinline__ float bflo(unsigned w) { return __uint_as_float(w << 16); }
__device__ __forceinline__ float bfhi(unsigned w) { return __uint_as_float(w & 0xffff0000u); }
typedef _Float16 h16x2 __attribute__((ext_vector_type(2)));
__device__ __forceinline__ unsigned pk_f16(float a, float b) { const h16x2 h = {(_Float16)a, (_Float16)b}; return __builtin_bit_cast(unsigned, h); }
__device__ __forceinline__ float f16lo(unsigned w) { return (float)__builtin_bit_cast(h16x2, w)[0]; }
__device__ __forceinline__ float f16hi(unsigned w) { return (float)__builtin_bit_cast(h16x2, w)[1]; }
__device__ __forceinline__ float sigmoidf_(float x) { return 1.0f / (1.0f + __expf(-x)); }
__device__ __forceinline__ unsigned q8x4e(float a, float b, float c, float d, float s) {
    const float ca = fminf(fmaxf(a * s, -127.0f), 127.0f) + 12582912.0f, cb = fminf(fmaxf(b * s, -127.0f), 127.0f) + 12582912.0f;
    const float cc = fminf(fmaxf(c * s, -127.0f), 127.0f) + 12582912.0f, cd = fminf(fmaxf(d * s, -127.0f), 127.0f) + 12582912.0f;
    const unsigned lo = __builtin_amdgcn_perm(__float_as_uint(cb), __float_as_uint(ca), 0x0c0c0400u), hi = __builtin_amdgcn_perm(__float_as_uint(cd), __float_as_uint(cc), 0x0c0c0400u);
    return __builtin_amdgcn_perm(hi, lo, 0x05040100u);
}

template <bool I8> struct EpiProjT {
    static constexpr bool PERM = true, AFTER_DRAIN = false, RMW = false;
    bf16_t* O; const float* rope128; const float* rope64; int cbase, csplit, cskip; float inv_qk, inv_v;
    __device__ __forceinline__ void operator()(const f32x4 (&acc)[2][2][4][2], const Unit& u, int wr, int wc, int fr, int fq) const {
        const int ct = u.pn * BM; const int colt = cbase + ct + (ct >= csplit ? cskip : 0);
        int mode;
        if (colt < 4608) mode = 1; else if (colt < 6912) mode = 0; else if (colt < 8960) mode = 2; else if (colt < 9984) mode = 0; else if (colt < 11264) mode = 1; else mode = 0;
        const bool isv = (colt >= 4608 && colt < 6912) || (colt >= 8960 && colt < 9984) || (colt >= 11264 && colt < 11520) || (colt >= 13568);
        const float inv = isv ? inv_v : inv_qk;
        const int row0 = u.pm * BM + wr * 64 + fr, col0 = colt + wc * 32 + 8 * fq;
        const int i128 = 16 * wc + 4 * fq, i64 = 16 * (wc & 1) + 4 * fq;
        f32x4 cs0[2][4], cs1[2][4];
        if (mode == 1 || mode == 2) {
#pragma unroll
            for (int ai = 0; ai < 2; ++ai)
#pragma unroll
                for (int m = 0; m < 4; ++m) { const int pos = (row0 + ai * HALF + m * 16) & 4095;
                    const f32x4* t = (mode == 1) ? (const f32x4*)(rope128 + ((size_t)pos * 64 + i128) * 2) : (const f32x4*)(rope64 + ((size_t)pos * 32 + i64) * 2);
                    cs0[ai][m] = t[0]; cs1[ai][m] = t[1]; }
        }
#pragma unroll
        for (int ai = 0; ai < 2; ++ai)
#pragma unroll
            for (int m = 0; m < 4; ++m) {
                const int row = row0 + ai * HALF + m * 16;
                bf16_t* rowp = O + (size_t)row * 14592 + col0;
#pragma unroll
                for (int bj = 0; bj < 2; ++bj) {
                    f32x4 v0 = acc[ai][bj][m][0], v1 = acc[ai][bj][m][1];
                    if constexpr (I8) { const i32x4 i0 = __builtin_bit_cast(i32x4, v0), i1 = __builtin_bit_cast(i32x4, v1);
                        v0 = (f32x4){(float)i0[0], (float)i0[1], (float)i0[2], (float)i0[3]} * inv; v1 = (f32x4){(float)i1[0], (float)i1[1], (float)i1[2], (float)i1[3]} * inv; }
                    if (mode == 1 || mode == 2) {
                        const f32x4 c0 = cs0[ai][m], c1 = cs1[ai][m];
                        f32x4 r0, r1;
                        r0[0] = v0[0] * c0[0] - v0[1] * c0[1]; r0[1] = v0[1] * c0[0] + v0[0] * c0[1];
                        r0[2] = v0[2] * c0[2] - v0[3] * c0[3]; r0[3] = v0[3] * c0[2] + v0[2] * c0[3];
                        r1[0] = v1[0] * c1[0] - v1[1] * c1[1]; r1[1] = v1[1] * c1[0] + v1[0] * c1[1];
                        r1[2] = v1[2] * c1[2] - v1[3] * c1[3]; r1[3] = v1[3] * c1[2] + v1[2] * c1[3];
                        v0 = r0; v1 = r1;
                    }
                    {
                        u32x4 w; w.x = cvt_pk_bf16(v0[0], v0[1]); w.y = cvt_pk_bf16(v0[2], v0[3]); w.z = cvt_pk_bf16(v1[0], v1[1]); w.w = cvt_pk_bf16(v1[2], v1[3]);
                        *(u32x4*)(rowp + bj * HALF) = w;
                    }
                }
            }
    }
};
struct EpiGate8 {
    static constexpr bool PERM = true, AFTER_DRAIN = false, RMW = false;
    unsigned char* G8; const float* bgate; float inv;
    __device__ __forceinline__ void operator()(const f32x4 (&acc)[2][2][4][2], const Unit& u, int wr, int wc, int fr, int fq) const {
        const int row0 = u.pm * BM + wr * 64 + fr, col0 = u.pn * BM + wc * 32 + 8 * fq;
        const float ninv = -inv * 1.4426950408889634f;
        f32x4 gb[2][2];
#pragma unroll
        for (int bj = 0; bj < 2; ++bj)
#pragma unroll
            for (int n = 0; n < 2; ++n) gb[bj][n] = *(const f32x4*)(bgate + col0 + bj * HALF + 4 * n) * (-1.4426950408889634f);
#pragma unroll
        for (int ai = 0; ai < 2; ++ai)
#pragma unroll
            for (int m = 0; m < 4; ++m) { unsigned char* growp = G8 + (size_t)(row0 + ai * HALF + m * 16) * 8192 + col0;
#pragma unroll
                for (int bj = 0; bj < 2; ++bj) { const i32x4 a0 = __builtin_bit_cast(i32x4, acc[ai][bj][m][0]), a1 = __builtin_bit_cast(i32x4, acc[ai][bj][m][1]);
                    unsigned q[8];
#pragma unroll
                    for (int j = 0; j < 4; ++j) {
                        const float e0 = __builtin_amdgcn_exp2f(fmaf((float)a0[j], ninv, gb[bj][0][j])), e1 = __builtin_amdgcn_exp2f(fmaf((float)a1[j], ninv, gb[bj][1][j]));
                        q[j] = __float_as_uint(__builtin_amdgcn_rcpf(fmaf(e0, 1.0f / 255.0f, 1.0f / 255.0f)) + 12582912.0f);
                        q[4 + j] = __float_as_uint(__builtin_amdgcn_rcpf(fmaf(e1, 1.0f / 255.0f, 1.0f / 255.0f)) + 12582912.0f); }
                    u32x2 wq;
                    wq.x = __builtin_amdgcn_perm(__builtin_amdgcn_perm(q[3], q[2], 0x0c0c0400u), __builtin_amdgcn_perm(q[1], q[0], 0x0c0c0400u), 0x05040100u);
                    wq.y = __builtin_amdgcn_perm(__builtin_amdgcn_perm(q[7], q[6], 0x0c0c0400u), __builtin_amdgcn_perm(q[5], q[4], 0x0c0c0400u), 0x05040100u);
                    *(u32x2*)(growp + bj * HALF) = wq; } }
    }
};
struct EpiGate4 {
    static constexpr bool PERM = true, AFTER_DRAIN = false, RMW = true;
    bf16_t* mixed; const unsigned char* gate; float inv_a, inv_b, inv_cd; unsigned char* mixed8; float qm;
    __device__ __forceinline__ void operator()(const f32x4 (&acc)[2][2][4][2], const Unit& u, int wr, int wc, int fr, int fq) const {
        const int row0 = u.pm * BM + wr * 64 + fr, col0 = u.pn * BM + wc * 32 + 8 * fq;
        const unsigned char* gate_b = gate + u.br * 2048; const bool first = u.br == 0, last = u.br == 3;
        const float sc = (inv_cd + (u.br == 0 ? 1.0f : 0.0f) * (inv_a - inv_cd) + (u.br == 1 ? 1.0f : 0.0f) * (inv_b - inv_cd)) * (1.0f / 255.0f);
#pragma unroll
        for (int ai = 0; ai < 2; ++ai) {
            u32x2 g[4][2]; u32x4 p[4][2];
#pragma unroll
            for (int m = 0; m < 4; ++m) { const int row = row0 + ai * HALF + m * 16;
#pragma unroll
                for (int bj = 0; bj < 2; ++bj) { g[m][bj] = *(const u32x2*)(gate_b + (size_t)row * 8192 + col0 + bj * HALF);
                    p[m][bj] = (u32x4){0u, 0u, 0u, 0u}; if (!first) p[m][bj] = *(const u32x4*)(mixed + (size_t)row * 2048 + col0 + bj * HALF); } }
#pragma unroll
            for (int m = 0; m < 4; ++m) { const int row = row0 + ai * HALF + m * 16; bf16_t* mp = mixed + (size_t)row * 2048 + col0;
#pragma unroll
                for (int bj = 0; bj < 2; ++bj) {
                    const u32x2 gg = g[m][bj]; const u32x4 pp = p[m][bj]; const i32x4 i0 = __builtin_bit_cast(i32x4, acc[ai][bj][m][0]), i1 = __builtin_bit_cast(i32x4, acc[ai][bj][m][1]);
                    const f32x4 v0 = (f32x4){(float)i0[0], (float)i0[1], (float)i0[2], (float)i0[3]} * sc, v1 = (f32x4){(float)i1[0], (float)i1[1], (float)i1[2], (float)i1[3]} * sc;
                    const float s0 = bflo(pp.x) + (float)(gg.x & 0xffu) * v0[0], s1 = bfhi(pp.x) + (float)((gg.x >> 8) & 0xffu) * v0[1], s2 = bflo(pp.y) + (float)((gg.x >> 16) & 0xffu) * v0[2], s3 = bfhi(pp.y) + (float)(gg.x >> 24) * v0[3];
                    const float s4 = bflo(pp.z) + (float)(gg.y & 0xffu) * v1[0], s5 = bfhi(pp.z) + (float)((gg.y >> 8) & 0xffu) * v1[1], s6 = bflo(pp.w) + (float)((gg.y >> 16) & 0xffu) * v1[2], s7 = bfhi(pp.w) + (float)(gg.y >> 24) * v1[3];
                    if (last) { u32x2 q8; q8.x = q8x4e(s0, s1, s2, s3, qm); q8.y = q8x4e(s4, s5, s6, s7, qm); *(u32x2*)(mixed8 + (size_t)row * 2048 + col0 + bj * HALF) = q8; }
                    else { u32x4 w; w.x = cvt_pk_bf16(s0, s1); w.y = cvt_pk_bf16(s2, s3); w.z = cvt_pk_bf16(s4, s5); w.w = cvt_pk_bf16(s6, s7); *(u32x4*)(mp + bj * HALF) = w; }
                } }
        }
    }
};
struct EpiResid {
    static constexpr bool PERM = false, AFTER_DRAIN = false, RMW = false;
    bf16_t* out; const float* xf; const bf16_t* xh; float alpha, inv;
    __device__ __forceinline__ void operator()(const f32x4 (&acc)[2][2][4][2], const Unit& u, int wr, int wc, int fr, int fq) const {
        const int row0 = u.pm * BM + wr * 64 + fr, col0 = u.pn * BM + wc * 32 + 4 * fq;
#pragma unroll
        for (int ai = 0; ai < 2; ++ai) {
            f32x4 x[4][2][2];
#pragma unroll
            for (int m = 0; m < 4; ++m) { const size_t off = (size_t)(row0 + ai * HALF + m * 16) * 2048 + col0;
#pragma unroll
                for (int bj = 0; bj < 2; ++bj)
#pragma unroll
                    for (int n = 0; n < 2; ++n) { if (xf) x[m][bj][n] = *(const f32x4*)(xf + off + bj * HALF + n * 16);
                        else { const u32x2 w = *(const u32x2*)(xh + off + bj * HALF + n * 16); x[m][bj][n] = (f32x4){f16lo(w.x), f16hi(w.x), f16lo(w.y), f16hi(w.y)}; } } }
#pragma unroll
            for (int m = 0; m < 4; ++m) { const size_t off = (size_t)(row0 + ai * HALF + m * 16) * 2048 + col0;
#pragma unroll
                for (int bj = 0; bj < 2; ++bj)
#pragma unroll
                    for (int n = 0; n < 2; ++n) { const i32x4 ia = __builtin_bit_cast(i32x4, acc[ai][bj][m][n]); const f32x4 r = x[m][bj][n] * alpha + (f32x4){(float)ia[0], (float)ia[1], (float)ia[2], (float)ia[3]} * inv;
                        u32x2 w; w.x = pk_f16(r[0], r[1]); w.y = pk_f16(r[2], r[3]); *(u32x2*)(out + off + bj * HALF + n * 16) = w; } }
        }
    }
};
struct EpiSwiGLU {
    static constexpr bool PERM = true, AFTER_DRAIN = false, RMW = false;
    unsigned char* H; float inv_g, inv_u, qh;
    __device__ __forceinline__ void operator()(const f32x4 (&acc)[2][2][4][2], const Unit& u, int wr, int wc, int fr, int fq) const {
        const int row0 = u.pm * BM + wr * 64 + fr, col0 = u.pn * HALF + wc * 32 + 8 * fq;
        const float ksc = qh * inv_g * inv_u, kexp = -inv_g * 1.4426950408889634f;
#pragma unroll
        for (int ai = 0; ai < 2; ++ai)
#pragma unroll
            for (int m = 0; m < 4; ++m) {
                unsigned char* hp = H + (size_t)(row0 + ai * HALF + m * 16) * 1024 + col0;
                f32x4 h0, h1;
                const i32x4 ig0 = __builtin_bit_cast(i32x4, acc[ai][0][m][0]), ig1 = __builtin_bit_cast(i32x4, acc[ai][0][m][1]), iu0 = __builtin_bit_cast(i32x4, acc[ai][1][m][0]), iu1 = __builtin_bit_cast(i32x4, acc[ai][1][m][1]);
#pragma unroll
                for (int j = 0; j < 4; ++j) { const float fg0 = (float)ig0[j], fg1 = (float)ig1[j];
                    h0[j] = fg0 * (float)iu0[j] * ksc * __builtin_amdgcn_rcpf(1.0f + __builtin_amdgcn_exp2f(fg0 * kexp));
                    h1[j] = fg1 * (float)iu1[j] * ksc * __builtin_amdgcn_rcpf(1.0f + __builtin_amdgcn_exp2f(fg1 * kexp)); }
                u32x2 w; w.x = q8x4e(h0[0], h0[1], h0[2], h0[3], 1.0f); w.y = q8x4e(h1[0], h1[1], h1[2], h1[3], 1.0f);
                *(u32x2*)hp = w;
            }
    }
};
struct EpiDown {
    static constexpr bool PERM = true, AFTER_DRAIN = false, RMW = false;
    unsigned char* Y; float sc;
    __device__ __forceinline__ void operator()(const f32x4 (&acc)[2][2][4][2], const Unit& u, int wr, int wc, int fr, int fq) const {
        const int row0 = u.pm * BM + wr * 64 + fr, col0 = u.pn * BM + wc * 32 + 8 * fq;
#pragma unroll
        for (int ai = 0; ai < 2; ++ai)
#pragma unroll
            for (int m = 0; m < 4; ++m) {
                const int row = row0 + ai * HALF + m * 16;
                unsigned char* yp = Y + (size_t)row * 2048 + col0;
#pragma unroll
                for (int bj = 0; bj < 2; ++bj) { const i32x4 i0 = __builtin_bit_cast(i32x4, acc[ai][bj][m][0]), i1 = __builtin_bit_cast(i32x4, acc[ai][bj][m][1]);
                    u32x2 w; w.x = q8x4e((float)i0[0], (float)i0[1], (float)i0[2], (float)i0[3], sc) ^ 0x80808080u; w.y = q8x4e((float)i1[0], (float)i1[1], (float)i1[2], (float)i1[3], sc) ^ 0x80808080u;
                    *(u32x2*)(yp + bj * HALF) = w; }
            }
    }
};

template <class Epi, class Sched, bool ALIGN_EPI = false, bool SP2 = false, bool GATHER = false, bool I8 = false, bool F16 = false>
__device__ __forceinline__ void gemm_phase(PG8_LAS unsigned char* lds, const Gemm g, const Sched& S, const Epi& E, const int tid) {
    const int wid = __builtin_amdgcn_readfirstlane(tid >> 6), lane = tid & 63, wr = wid >> 2, wc = wid & 3, fr = lane & 15, fq = lane >> 4;
    const int K = g.K, nt = K / BK;
    unsigned voffA[2], voffB[2];
#pragma unroll
    for (int i = 0; i < 2; ++i) { int R, C; stage_rc(tid * 16 + i * 8192, R, C); const int Rb = Epi::PERM ? ((R & ~31) + perm32(R & 31)) : R;
        voffA[i] = (unsigned)(R * K + C) * 2u; voffB[i] = (unsigned)(Rb * K + C) * 2u; }
    unsigned gcur[2][2] = {{0u, 0u}, {0u, 0u}}, gnx[2][2] = {{0u, 0u}, {0u, 0u}};
#define PG8_GOFF(dst, U) do { _Pragma("unroll") for (int _h = 0; _h < 2; ++_h) _Pragma("unroll") for (int _i = 0; _i < 2; ++_i) { int R_, C_; stage_rc(tid * 16 + _i * 8192, R_, C_); \
        const int r_ = (U).pm * BM + _h * HALF + R_; const int tok_ = g.gidx[r_]; dst[_h][_i] = (unsigned)(((r_ >> 13) * 4096 + tok_) * K + C_) * 2u; } } while (0)
    const size_t kstep = (size_t)(BK * 2);
    const size_t hstep = (size_t)HALF * K * 2;
    const size_t tstep = 2 * hstep;
    const unsigned ldsw = (unsigned)wid * 1024u;
    const int aoff = lds_byte(wr * 64 + fr, fq * 8), boff = lds_byte(wc * 32 + fr, fq * 8);
#define PG8_SA(b, h) (((b) * 2 + (h)) * HTB)
#define PG8_SB(b, h) ((4 + (b) * 2 + (h)) * HTB)
#define PG8_STAGE(bufoff, gbase, voff) do { _Pragma("unroll") for (int _i = 0; _i < 2; ++_i) \
        __builtin_amdgcn_global_load_lds((const unsigned*)((const char*)(gbase) + (voff)[_i]), (PG8_LAS unsigned*)(lds + (bufoff) + ldsw + _i * 8192), 16, 0, 0); } while (0)
#define PG8_LDA(dst, b, h) do { _Pragma("unroll") for (int m = 0; m < 4; ++m) _Pragma("unroll") for (int k = 0; k < 2; ++k) dst[m][k] = *(const PG8_LAS bf16x8*)(lds + PG8_SA(b, h) + aoff + m * 2048 + k * 1024); } while (0)
#define PG8_LDB(dst, b, h) do { _Pragma("unroll") for (int n = 0; n < 2; ++n) _Pragma("unroll") for (int k = 0; k < 2; ++k) dst[n][k] = *(const PG8_LAS bf16x8*)(lds + PG8_SB(b, h) + boff + n * 2048 + k * 1024); } while (0)
#define PG8_MMA(ai, bj, At, Bt) do { __builtin_amdgcn_s_setprio(1); _Pragma("unroll") for (int m = 0; m < 4; ++m) _Pragma("unroll") for (int n = 0; n < 2; ++n) _Pragma("unroll") for (int k = 0; k < 2; ++k) { \
        if constexpr (I8) acc[ai][bj][m][n] = __builtin_bit_cast(f32x4, __builtin_amdgcn_mfma_i32_16x16x64_i8(__builtin_bit_cast(i32x4, Bt[n][k]), __builtin_bit_cast(i32x4, At[m][k]), __builtin_bit_cast(i32x4, acc[ai][bj][m][n]), 0, 0, 0)); \
        else if constexpr (F16) acc[ai][bj][m][n] = __builtin_amdgcn_mfma_f32_16x16x32_f16(__builtin_bit_cast(f16x8, Bt[n][k]), __builtin_bit_cast(f16x8, At[m][k]), acc[ai][bj][m][n], 0, 0, 0); \
        else acc[ai][bj][m][n] = __builtin_amdgcn_mfma_f32_16x16x32_bf16(Bt[n][k], At[m][k], acc[ai][bj][m][n], 0, 0, 0); } \
        __builtin_amdgcn_s_setprio(0); } while (0)
#define PG8_STA(bufoff, gbase, h, nx) do { if constexpr (GATHER) { unsigned vo_[2]; vo_[0] = (nx) ? gnx[h][0] : gcur[h][0]; vo_[1] = (nx) ? gnx[h][1] : gcur[h][1]; PG8_STAGE(bufoff, gbase, vo_); } \
        else { PG8_STAGE(bufoff, (gbase) + (h) * hstep, voffA); } } while (0)
#define PG8_WAIT_V(n) asm volatile("s_waitcnt vmcnt(" #n ")" ::: "memory")
#define PG8_WAIT_L(n) asm volatile("s_waitcnt lgkmcnt(" #n ")" ::: "memory")
#define PG8_BAR __builtin_amdgcn_s_barrier()
#define PG8_SCHED __builtin_amdgcn_sched_barrier(0)
    Unit cur, nxt; int ui = 0;
    if (!S.next(0, cur)) return;
    f32x4 acc[2][2][4][2];
#pragma unroll
    for (int a = 0; a < 2; ++a)
#pragma unroll
        for (int b = 0; b < 2; ++b)
#pragma unroll
            for (int m = 0; m < 4; ++m)
#pragma unroll
                for (int n = 0; n < 2; ++n) acc[a][b][m][n] = (f32x4){0.f, 0.f, 0.f, 0.f};
    bf16x8 At[4][2], B0[2][2], B1[2][2];
    const char* cA = (const char*)g.A + (size_t)cur.br * g.a_brstride + (GATHER ? (size_t)0 : (size_t)cur.pm * tstep); const char* cB = (const char*)g.Bt + (size_t)cur.br * g.b_brstride + (size_t)((cur.pm >> 1) & 15) * g.gstride + (size_t)cur.pn * tstep;
    S.a_ready(cur);
    if constexpr (GATHER) PG8_GOFF(gcur, cur);
    if constexpr (SP2) {
        PG8_STAGE(PG8_SB(0, 0), cB, voffB); PG8_STAGE(PG8_SB(0, 1), cB + hstep, voffB); PG8_STA(PG8_SA(0, 0), cA, 0, false); PG8_STA(PG8_SA(0, 1), cA, 1, false);
        if (wr == 1) PG8_BAR;
        PG8_WAIT_V(2); PG8_BAR;
        PG8_STAGE(PG8_SB(1, 0), cB + kstep, voffB); PG8_STA(PG8_SA(1, 0), cA + kstep, 0, false); PG8_STAGE(PG8_SB(1, 1), cB + hstep + kstep, voffB);
        PG8_WAIT_V(6); PG8_BAR;
    } else {
        PG8_STAGE(PG8_SB(0, 0), cB, voffB); PG8_STAGE(PG8_SA(0, 0), cA, voffA); PG8_STAGE(PG8_SB(0, 1), cB + hstep, voffB); PG8_STAGE(PG8_SA(0, 1), cA + hstep, voffA);
        if (wr == 1) PG8_BAR;
        PG8_WAIT_V(4); PG8_BAR;
        PG8_STAGE(PG8_SB(1, 0), cB + kstep, voffB); PG8_STAGE(PG8_SA(1, 0), cA + kstep, voffA); PG8_STAGE(PG8_SB(1, 1), cB + hstep + kstep, voffB);
        PG8_WAIT_V(6); PG8_BAR;
    }
#if defined(STAMP_SEL)
    unsigned long long st_t0 = 0, st_t1 = 0, st_t2 = 0, st_r0 = 0, st_r1 = 0;
#endif
    for (;;) {
        const bool has_next = S.next(ui + 1, nxt);
#if defined(STAMP_SEL)
        if (g.stamp && ui == 5) { st_t0 = __builtin_amdgcn_s_memtime(); st_r0 = __builtin_amdgcn_s_memrealtime(); }
#endif
        const char* nA = has_next ? (const char*)g.A + (size_t)nxt.br * g.a_brstride + (GATHER ? (size_t)0 : (size_t)nxt.pm * tstep) : cA; const char* nB = has_next ? (const char*)g.Bt + (size_t)nxt.br * g.b_brstride + (size_t)((nxt.pm >> 1) & 15) * g.gstride + (size_t)nxt.pn * tstep : cB;
        const int ntu = S.ntiles(cur, nt);
        if constexpr (GATHER) { if (has_next) PG8_GOFF(gnx, nxt); else { gnx[0][0] = gcur[0][0]; gnx[0][1] = gcur[0][1]; gnx[1][0] = gcur[1][0]; gnx[1][1] = gcur[1][1]; } }
        for (int t = 0; t < ntu; t += 2) {
            const bool last = (t == ntu - 2);
            const char* a1 = cA + (size_t)(t + 1) * kstep;
            const char* a2 = last ? nA : cA + (size_t)(t + 2) * kstep; const char* b2 = last ? nB : cB + (size_t)(t + 2) * kstep;
            const char* a3 = a2 + kstep; const char* b3 = b2 + kstep;
            if (last && has_next) S.a_ready(nxt);
            if constexpr (SP2) {
            PG8_LDB(B0, 0, 0); PG8_LDB(B1, 0, 1); PG8_SCHED; PG8_LDA(At, 0, 0); PG8_STA(PG8_SA(1, 1), a1, 1, false);
            PG8_WAIT_V(8); PG8_WAIT_L(0); PG8_BAR; PG8_MMA(0, 0, At, B0); PG8_MMA(0, 1, At, B1); PG8_BAR; PG8_SCHED;
            PG8_LDA(At, 0, 1); PG8_STAGE(PG8_SB(0, 0), b2, voffB); PG8_STAGE(PG8_SB(0, 1), b2 + hstep, voffB); PG8_STA(PG8_SA(0, 0), a2, 0, last);
            PG8_WAIT_V(8); PG8_WAIT_L(0); PG8_BAR; PG8_MMA(1, 0, At, B0); PG8_MMA(1, 1, At, B1); PG8_BAR; PG8_SCHED;
            PG8_LDB(B0, 1, 0); PG8_LDB(B1, 1, 1); PG8_SCHED; PG8_LDA(At, 1, 0); PG8_STA(PG8_SA(0, 1), a2, 1, last);
            PG8_WAIT_V(8); PG8_WAIT_L(0); PG8_BAR; PG8_MMA(0, 0, At, B0); PG8_MMA(0, 1, At, B1); PG8_BAR; PG8_SCHED;
            PG8_LDA(At, 1, 1); PG8_STAGE(PG8_SB(1, 0), b3, voffB); PG8_STAGE(PG8_SB(1, 1), b3 + hstep, voffB); PG8_STA(PG8_SA(1, 0), a3, 0, last);
            PG8_WAIT_V(8); PG8_WAIT_L(0); PG8_BAR; PG8_MMA(1, 0, At, B0); PG8_MMA(1, 1, At, B1); PG8_BAR; PG8_SCHED;
            } else {
            PG8_LDB(B0, 0, 0); PG8_SCHED; PG8_LDA(At, 0, 0); PG8_STAGE(PG8_SA(1, 1), a1 + hstep, voffA);
            PG8_WAIT_L(8); PG8_BAR; PG8_WAIT_L(0); PG8_MMA(0, 0, At, B0); PG8_BAR; PG8_SCHED;
            PG8_LDB(B1, 0, 1); PG8_STAGE(PG8_SB(0, 0), b2, voffB);
            PG8_BAR; PG8_WAIT_L(0); PG8_MMA(0, 1, At, B1); PG8_BAR;
            PG8_LDA(At, 0, 1); PG8_STAGE(PG8_SA(0, 0), a2, voffA);
            PG8_BAR; PG8_WAIT_L(0); PG8_MMA(1, 0, At, B0); PG8_BAR; PG8_SCHED;
            PG8_STAGE(PG8_SB(0, 1), b2 + hstep, voffB);
            PG8_WAIT_V(6); PG8_BAR; PG8_MMA(1, 1, At, B1); PG8_BAR;
            PG8_LDB(B0, 1, 0); PG8_SCHED; PG8_LDA(At, 1, 0); PG8_STAGE(PG8_SA(0, 1), a2 + hstep, voffA);
            PG8_WAIT_L(8); PG8_BAR; PG8_WAIT_L(0); PG8_MMA(0, 0, At, B0); PG8_BAR; PG8_SCHED;
            PG8_LDB(B1, 1, 1); PG8_STAGE(PG8_SB(1, 0), b3, voffB);
            PG8_BAR; PG8_WAIT_L(0); PG8_MMA(0, 1, At, B1); PG8_BAR;
            PG8_LDA(At, 1, 1); PG8_STAGE(PG8_SA(1, 0), a3, voffA);
            PG8_BAR; PG8_WAIT_L(0); PG8_MMA(1, 0, At, B0); PG8_BAR; PG8_SCHED;
            PG8_STAGE(PG8_SB(1, 1), b3 + hstep, voffB);
            PG8_WAIT_V(6); PG8_BAR; PG8_MMA(1, 1, At, B1); PG8_BAR;
            }
        }
#if defined(STAMP_SEL)
        if (g.stamp && ui == 5) st_t1 = __builtin_amdgcn_s_memtime();
#endif
        if constexpr (ALIGN_EPI) { if (wr == 0) PG8_BAR; }
        if constexpr (!Epi::AFTER_DRAIN) { E(acc, cur, wr, wc, fr, fq);
#if defined(PROBE_EPI2)
            if constexpr (!Epi::RMW) { asm volatile("" ::: "memory"); E(acc, cur, wr, wc, fr, fq); }
#endif
            S.done(cur); }
#if defined(STAMP_SEL)
        if (g.stamp && ui == 5) { st_t2 = __builtin_amdgcn_s_memtime(); st_r1 = __builtin_amdgcn_s_memrealtime(); }
#endif
        if (!has_next) break;
#pragma unroll
        for (int a = 0; a < 2; ++a)
#pragma unroll
            for (int b = 0; b < 2; ++b)
#pragma unroll
                for (int m = 0; m < 4; ++m)
#pragma unroll
                    for (int n = 0; n < 2; ++n) acc[a][b][m][n] = (f32x4){0.f, 0.f, 0.f, 0.f};
        cur = nxt; cA = nA; cB = nB; ++ui;
        if constexpr (GATHER) { gcur[0][0] = gnx[0][0]; gcur[0][1] = gnx[0][1]; gcur[1][0] = gnx[1][0]; gcur[1][1] = gnx[1][1]; }
        if constexpr (ALIGN_EPI) { if (wr == 1) PG8_BAR; }
    }
    PG8_WAIT_V(0);
    if constexpr (!ALIGN_EPI) { if (wr == 0) PG8_BAR; }
    PG8_BAR;
    if constexpr (Epi::AFTER_DRAIN) { E.fused(acc, cur, wr, wc, fr, fq, lds, wid, lane); S.done(cur); }
#if defined(STAMP_SEL)
    if (g.stamp && tid == 0) { g.stamp[0] = st_t0; g.stamp[1] = st_t1; g.stamp[2] = st_t2; g.stamp[3] = st_r0; g.stamp[4] = st_r1; }
#endif
#undef PG8_SA
#undef PG8_SB
#undef PG8_STAGE
#undef PG8_LDA
#undef PG8_LDB
#undef PG8_MMA
#undef PG8_STA
#undef PG8_GOFF
#undef PG8_WAIT_V
#undef PG8_WAIT_L
#undef PG8_BAR
#undef PG8_SCHED
}
}

#if defined(STAMP_SEL)
#define STAMP_ARG(x) , x
#else
#define STAMP_ARG(x)
#endif

constexpr int DM = 2048, NBATCH = 4, SEQ = 4096, DEPTH = 4, MTOK = NBATCH * SEQ;
constexpr int IN_TOTAL = 22784, PROJ_PITCH = 14592;
constexpr int OFF_QA = 0, OFF_KA = 2304, OFF_VA = 4608, OFF_QB = 6912, OFF_KB = 7936, OFF_VB = 8960, OFF_QC = 9984, OFF_KC = 11008, OFF_VC = 11264, OFF_QD = 11520, OFF_KD = 12544, OFF_VD = 13568, OFF_GATE = 14592;
constexpr int BR_TOTAL = 3840;
constexpr int NEXP = 16, CAP = 512, DEXP = 1024, NGRP = NBATCH * NEXP;
constexpr float LN_EPS = 1e-5f, SUBLN_EPS = 1e-5f;
constexpr float ALPHA = 1.6817928305074290f;
constexpr size_t MiB = 1u << 20;
constexpr size_t WS_CTL = 0, CTL_ZERO_BYTES = 1 * MiB;
constexpr size_t WS_ROPE128 = 1 * MiB, WS_ROPE64 = 3 * MiB, WS_AFF = 4 * MiB, WS_IDX = 5 * MiB, WS_GV = 5 * MiB + 131072, WS_SLOT = 6 * MiB, WS_LSE = 7 * MiB, WS_STATS = 9 * MiB;
constexpr size_t WS_XF = 16 * MiB, WS_XB = 144 * MiB;
constexpr size_t WS_X8 = 208 * MiB;
constexpr size_t WS_W8G = 240 * MiB;
constexpr float QSIG = 4.0f;
constexpr float QX = 127.0f / QSIG, QWG = 127.0f / (QSIG * 0.022097086912079608f), QWU = 127.0f / (QSIG * 0.022097086912079608f * 0.42044820762685725f),
                QO = 127.0f / 0.5f, QWBA = 127.0f / (QSIG * 0.42044820762685725f * 0.036084391824351615f), QWBC = 127.0f / (QSIG * 0.42044820762685725f * 0.03125f),
                QY = 127.0f / (5.0f * 0.1054f), QH = 127.0f / 4.0f, QWD = 127.0f / (QSIG * 0.03125f * 0.42044820762685725f);
constexpr size_t WS_O4 = 2552 * MiB, WS_OA = WS_O4, WS_OB = WS_O4 + 32 * MiB, WS_OC = WS_O4 + 64 * MiB, WS_OD = WS_O4 + 96 * MiB;
constexpr size_t WS_AG = 328 * MiB;
constexpr size_t WS_MIXED8 = 400 * MiB;
constexpr size_t WS_MIXED = 432 * MiB;
constexpr size_t WS_PRELN = 496 * MiB;
constexpr size_t WS_PROJ = 624 * MiB;
constexpr size_t WS_GATE = WS_PROJ + 456 * MiB;
constexpr size_t WS_XG = WS_PROJ, WS_H = WS_PROJ + 128 * MiB, WS_Y = WS_PROJ + 192 * MiB;
constexpr size_t WS_W8Q = 1336 * MiB;
constexpr size_t WS_WIN = 1432 * MiB;
constexpr size_t WS_W8BR = 1692 * MiB;
constexpr size_t WS_O8 = 2616 * MiB;
constexpr size_t WS_WOUT = 1752 * MiB;
constexpr size_t WS_WGU = 1784 * MiB;
constexpr size_t WS_WDN = 2296 * MiB;
constexpr size_t WS_END = 2744 * MiB;
static_assert(WS_PROJ + (size_t)MTOK * IN_TOTAL * 2 == WS_W8Q && WS_W8Q + (size_t)DEPTH * 11520 * DM <= WS_WIN && WS_WIN + (size_t)DEPTH * 3072 * DM * 2 <= 1692 * MiB, "ws map");
constexpr int CW_BAR = 4096;
constexpr int LDS_BYTES = 155648, LDSCTL_OFF = 155136;
constexpr int NWAVES = 8;
#ifndef LB_WAVES
#define LB_WAVES 2
#endif
constexpr int NPL = 10, NPHASES = 1 + DEPTH * NPL;

#define GAS __attribute__((address_space(1)))
#define LAS __attribute__((address_space(3)))
typedef unsigned short bf16_t;
typedef float f32x4 __attribute__((ext_vector_type(4)));
typedef float f32x2 __attribute__((ext_vector_type(2)));
typedef unsigned u32x4 __attribute__((ext_vector_type(4)));
typedef unsigned u32x2 __attribute__((ext_vector_type(2)));
using pg8::cvt_pk_bf16; using pg8::bflo; using pg8::bfhi; using pg8::pk_f16; using pg8::f16lo; using pg8::f16hi;
__device__ __forceinline__ float bf2f(bf16_t h) { return __uint_as_float(((unsigned)h) << 16); }
__device__ __forceinline__ float wave_sum(float v) {
#pragma unroll
    for (int o = 1; o < 64; o <<= 1) v += __shfl_xor(v, o);
    return v;
}
__device__ __forceinline__ float wave_max(float v) {
#pragma unroll
    for (int o = 1; o < 64; o <<= 1) v = fmaxf(v, __shfl_xor(v, o));
    return v;
}
__device__ __forceinline__ int wave_sum_i(int v) {
#pragma unroll
    for (int o = 1; o < 64; o <<= 1) v += __shfl_xor(v, o);
    return v;
}

#define XB_TMO      128
#define XB_XCNT(j)  (256  + 64 * (j))
#define XB_XSUB(j)  (1280 + 64 * (j))
#define XB_XGEN(j)  (2304 + 64 * (j))
#define XB_TOP      3328
#define XB_TOPGEN   3392
#define XCD_BAR_WORDS 3456
#define XB_SPIN_CAP (1u << 23)

__device__ __forceinline__ unsigned xb_ld(unsigned* p)              { return __hip_atomic_load(p, __ATOMIC_RELAXED, __HIP_MEMORY_SCOPE_AGENT); }
__device__ __forceinline__ unsigned xb_add(unsigned* p, unsigned v) { return __hip_atomic_fetch_add(p, v, __ATOMIC_RELAXED, __HIP_MEMORY_SCOPE_AGENT); }
__device__ __forceinline__ unsigned xb_xcc_id() { return (unsigned)__builtin_amdgcn_s_getreg((3 << 11) | 20) & 0xFu; }
#define XB_SPIN(cond, bar) do { unsigned _sp = 0; while (cond) { __builtin_amdgcn_s_sleep(1); \
    if ((++_sp & 255u) == 0u) { if (xb_ld(&(bar)[XB_TMO])) break; if (_sp > XB_SPIN_CAP) { atomicAdd(&(bar)[XB_TMO], 1u); break; } } } } while (0)

struct XcdBarrier {
    unsigned* bar; unsigned x;
    volatile LAS unsigned* st;
};
__device__ __forceinline__ XcdBarrier xcd_barrier_post(unsigned* bar, volatile LAS unsigned* st) {
    XcdBarrier b; b.bar = bar; b.x = xb_xcc_id(); b.st = st;
    if (threadIdx.x == 0) (void)xb_add(&bar[XB_XCNT(b.x)], 1u);
    return b;
}
__device__ __forceinline__ void xcd_barrier_complete(unsigned* bar, unsigned x, unsigned& nloc, unsigned& nx) {
    const unsigned G = gridDim.x * gridDim.y * gridDim.z;
    unsigned sum, cnt, mine, sp = 0u;
    for (;;) {
        sum = 0u; cnt = 0u; mine = 0u;
#pragma unroll
        for (unsigned j = 0; j < 16; ++j) { const unsigned c = xb_ld(&bar[XB_XCNT(j)]); sum += c; cnt += (c > 0u) ? 1u : 0u; mine = (j == x) ? c : mine; }
        if (sum == G) break;
        __builtin_amdgcn_s_sleep(1);
        if ((++sp & 255u) == 0u) { if (xb_ld(&bar[XB_TMO])) break; if (sp > XB_SPIN_CAP) { atomicAdd(&bar[XB_TMO], 1u); break; } }
    }
    nloc = mine > 0u ? mine : 1u; nx = cnt > 0u ? cnt : 1u;
}
__device__ __forceinline__ void xcd_barrier(const XcdBarrier& b) {
    asm volatile("s_waitcnt vmcnt(0)" ::: "memory");
    __syncthreads();
    if (threadIdx.x == 0) {
        unsigned* bar = b.bar;
        __builtin_amdgcn_s_waitcnt(0);
        unsigned nloc = b.st[0], nx = b.st[1];
        if (nloc == 0u) { xcd_barrier_complete(bar, b.x, nloc, nx); b.st[0] = nloc; b.st[1] = nx; }
        const unsigned old = xb_add(&bar[XB_XSUB(b.x)], 1u);
        const unsigned gen = old / nloc;
        if (old + 1u == (gen + 1u) * nloc) {
            __builtin_amdgcn_fence(__ATOMIC_RELEASE, "agent");
            asm volatile("s_waitcnt vmcnt(0)" ::: "memory");
            const unsigned og = xb_add(&bar[XB_TOP], 1u);
            const unsigned tg = og / nx;
            if (og + 1u == (tg + 1u) * nx) xb_add(&bar[XB_TOPGEN], 1u);
            else XB_SPIN(xb_ld(&bar[XB_TOPGEN]) == tg, bar);
            __builtin_amdgcn_fence(__ATOMIC_ACQUIRE, "agent");
            xb_add(&bar[XB_XGEN(b.x)], 1u);
            asm volatile("s_waitcnt vmcnt(0)" ::: "memory");
        } else {
            XB_SPIN(xb_ld(&bar[XB_XGEN(b.x)]) == gen, bar);
            __builtin_amdgcn_fence(__ATOMIC_ACQUIRE, "agent");
            asm volatile("s_waitcnt vmcnt(0)" ::: "memory");
        }
    }
    __syncthreads();
}

__device__ __forceinline__ int win_src_col(int n) {
    if (n < OFF_VA || (n >= OFF_QC && n < OFF_VC)) { const int hb = n & ~127, j = n & 127; return hb + (j >> 1) + (j & 1) * 64; }
    if (n >= OFF_QB && n < OFF_VB) { const int hb = n & ~63, j = n & 63; return hb + (j >> 1) + (j & 1) * 32; }
    return n;
}
__device__ __forceinline__ void tr_item(const float* __restrict__ src, size_t ld, int srccol, int k0, bf16_t* __restrict__ dst_tile, size_t dld, LAS unsigned char* scr, int lane) {
    const float* p = src + (size_t)k0 * ld + srccol;
    float v[64];
#pragma unroll
    for (int j = 0; j < 64; ++j) v[j] = __builtin_nontemporal_load(p + (size_t)j * ld);
    __builtin_amdgcn_sched_barrier(0);
#pragma unroll
    for (int kk = 0; kk < 8; ++kk) { const int o = kk * 8;
        u32x4 w; w.x = pk_f16(v[o + 0], v[o + 1]); w.y = pk_f16(v[o + 2], v[o + 3]); w.z = pk_f16(v[o + 4], v[o + 5]); w.w = pk_f16(v[o + 6], v[o + 7]);
        *(LAS u32x4*)(scr + lane * 144 + kk * 16) = w;
    }
    bf16_t* d = dst_tile + (size_t)(lane >> 3) * dld + (lane & 7) * 8;
#pragma unroll
    for (int i = 0; i < 8; ++i) { const u32x4 w = *(const LAS u32x4*)(scr + (8 * i + (lane >> 3)) * 144 + (lane & 7) * 16); *(u32x4*)(d + (size_t)(8 * i) * dld) = w; }
}
__device__ __forceinline__ unsigned q8x4(float a, float b, float c, float d, float s) {
    const float ca = fminf(fmaxf(a * s, -127.0f), 127.0f) + 12582912.0f, cb = fminf(fmaxf(b * s, -127.0f), 127.0f) + 12582912.0f;
    const float cc = fminf(fmaxf(c * s, -127.0f), 127.0f) + 12582912.0f, cd = fminf(fmaxf(d * s, -127.0f), 127.0f) + 12582912.0f;
    const unsigned lo = __builtin_amdgcn_perm(__float_as_uint(cb), __float_as_uint(ca), 0x0c0c0400u), hi = __builtin_amdgcn_perm(__float_as_uint(cd), __float_as_uint(cc), 0x0c0c0400u);
    return __builtin_amdgcn_perm(hi, lo, 0x05040100u);
}
__device__ __forceinline__ void tr_item8(const float* __restrict__ src, size_t ld, int srccol, int k0, unsigned char* __restrict__ dst_tile, size_t dld, float scale, LAS unsigned char* scr, int lane) {
    const float* p = src + (size_t)k0 * ld + srccol;
    float v[64];
#pragma unroll
    for (int j = 0; j < 64; ++j) v[j] = __builtin_nontemporal_load(p + (size_t)j * ld);
    __builtin_amdgcn_sched_barrier(0);
#pragma unroll
    for (int kk = 0; kk < 4; ++kk) { const int o = kk * 16;
        u32x4 w; w.x = q8x4(v[o + 0], v[o + 1], v[o + 2], v[o + 3], scale); w.y = q8x4(v[o + 4], v[o + 5], v[o + 6], v[o + 7], scale); w.z = q8x4(v[o + 8], v[o + 9], v[o + 10], v[o + 11], scale); w.w = q8x4(v[o + 12], v[o + 13], v[o + 14], v[o + 15], scale);
        *(LAS u32x4*)(scr + lane * 80 + kk * 16) = w;
    }
    unsigned char* d = dst_tile + (size_t)(lane >> 2) * dld + (lane & 3) * 16;
#pragma unroll
    for (int i = 0; i < 4; ++i) { const u32x4 w = *(const LAS u32x4*)(scr + (16 * i + (lane >> 2)) * 80 + (lane & 3) * 16); *(u32x4*)(d + (size_t)(16 * i) * dld) = w; }
}

struct KeyA { int s, r;
    __device__ __forceinline__ int pos(int idx, float& bias) const { bias = 0.f; const int p = s + r * (idx - 64); return (p >= 0 && p < SEQ) ? p : -1; } };
struct KeyB {
    __device__ __forceinline__ int pos(int idx, float& bias) const { bias = 0.f; return idx; } };
struct KeyC { int s;
    __device__ __forceinline__ int pos(int idx, float& bias) const { bias = 0.f; const int p = s + idx - 128; return (p >= 0 && p < SEQ) ? p : -1; } };
struct KeyD { int r, c, rs, cs; const float* rpb;
    __device__ __forceinline__ int pos(int idx, float& bias) const { const int kr = rs + (idx >> 4), kc = cs + (idx & 15); int dc = kc - c; dc = dc < -15 ? -15 : (dc > 15 ? 15 : dc);
        bias = rpb[(kr - r + 7) * 31 + dc + 15]; return kr * 64 + kc; } };

template <int DK, class KF>
__device__ __forceinline__ void sattn(const bf16_t* q, const bf16_t* kb, const bf16_t* vb, const KF& kf, int nkeys, float scale, bool has_sink, float sink,
                                      LAS float* sq, LAS float* ss, int lane, float& o0, float& o1, float& m_out, float& l_out) {
    for (int d = lane; d < DK; d += 64) sq[d] = bf2f(q[d]);
    asm volatile("s_waitcnt lgkmcnt(0)" ::: "memory");
    float mx = -1e30f;
    for (int idx = lane; idx < nkeys; idx += 64) {
        float bias; const int p = kf.pos(idx, bias); float s = -1e30f;
        if (p >= 0) {
            const u32x4* kr = (const u32x4*)(kb + (size_t)p * PROJ_PITCH); float acc = 0.f;
#pragma unroll
            for (int d8 = 0; d8 < DK / 8; ++d8) { const u32x4 w = kr[d8]; const LAS f32x4* qq = (const LAS f32x4*)(sq + d8 * 8); const f32x4 qa = qq[0], qb = qq[1];
                acc += qa[0] * bflo(w.x) + qa[1] * bfhi(w.x) + qa[2] * bflo(w.y) + qa[3] * bfhi(w.y) + qb[0] * bflo(w.z) + qb[1] * bfhi(w.z) + qb[2] * bflo(w.w) + qb[3] * bfhi(w.w); }
            s = acc * scale + bias;
        }
        ss[idx] = s; mx = fmaxf(mx, s);
    }
    mx = wave_max(mx); if (has_sink) mx = fmaxf(mx, sink);
    float sum = 0.f;
    for (int idx = lane; idx < nkeys; idx += 64) { const float s = ss[idx]; const float p = (s > -1e29f) ? __expf(s - mx) : 0.f; ss[idx] = p; sum += p; }
    sum = wave_sum(sum); if (has_sink) sum += __expf(sink - mx);
    asm volatile("s_waitcnt lgkmcnt(0)" ::: "memory");
    o0 = 0.f; o1 = 0.f;
    for (int idx = 0; idx < nkeys; ++idx) {
        const float p = ss[idx];
        if (p != 0.f) { float bias; const int pp = kf.pos(idx, bias); const unsigned w = *(const unsigned*)(vb + (size_t)pp * PROJ_PITCH + 2 * lane); o0 += p * bflo(w); o1 += p * bfhi(w); }
    }
    const float inv = 1.0f / sum; o0 *= inv; o1 *= inv; m_out = mx; l_out = sum;
    asm volatile("s_waitcnt lgkmcnt(0)" ::: "memory");
}

struct AttnPtrs { const bf16_t* proj; bf16_t* ag; float* lse; bf16_t* ob; bf16_t* oc; bf16_t* od; const float* lam; const float* subln; const float* sink; const float* rpb; float lambda_init; };

template <int WHICH>
__device__ __forceinline__ void scalar_attn_phase(const AttnPtrs& P, LAS unsigned char* lds, int gw, int NGW, int wave, int lane) {
    LAS float* sq = (LAS float*)(lds + wave * 16896); LAS float* ss = sq + 128;
    constexpr int NH = WHICH == 0 ? 18 : 8;
    float lmbda = 0.f;
    if constexpr (WHICH == 1) { const float d01 = wave_sum(P.lam[lane] * P.lam[64 + lane]), d23 = wave_sum(P.lam[128 + lane] * P.lam[192 + lane]); lmbda = __expf(d01) - __expf(d23) + P.lambda_init; }
    for (int task = gw; task < NH * MTOK; task += NGW) {
        const int hs = task / MTOK, row = task % MTOK, b = row >> 12, s = row & 4095;
        const bf16_t* prow = P.proj + (size_t)row * PROJ_PITCH; const bf16_t* pb = P.proj + (size_t)(b * SEQ) * PROJ_PITCH;
        float o0, o1, mm, ll;
        if constexpr (WHICH == 0) {
            const int hh = hs, g = hh / 6, r = (g == 0) ? 1 : ((g == 1) ? 4 : 16); KeyA kf{s, r};
            sattn<128>(prow + OFF_QA + hh * 128, pb + OFF_KA + hh * 128, pb + OFF_VA + hh * 128, kf, 129, 0.08838834764831845f, false, 0.f, sq, ss, lane, o0, o1, mm, ll);
            *(unsigned*)(P.ag + ((size_t)g * MTOK + row) * 768 + (hh % 6) * 128 + 2 * lane) = cvt_pk_bf16(o0, o1);
            if (lane == 0) P.lse[((size_t)g * MTOK + row) * 6 + (hh % 6)] = mm + __logf(ll);
        } else if constexpr (WHICH == 1) {
            const int h = hs; KeyB kf; float a0, a1, b0, b1;
            sattn<64>(prow + OFF_QB + (2 * h) * 64, pb + OFF_KB + (2 * h) * 64, pb + OFF_VB + h * 128, kf, SEQ, 0.125f, false, 0.f, sq, ss, lane, a0, a1, mm, ll);
            sattn<64>(prow + OFF_QB + (2 * h + 1) * 64, pb + OFF_KB + (2 * h + 1) * 64, pb + OFF_VB + h * 128, kf, SEQ, 0.125f, false, 0.f, sq, ss, lane, b0, b1, mm, ll);
            const float v0 = a0 - lmbda * b0, v1 = a1 - lmbda * b1;
            const float rinv = rsqrtf(wave_sum(v0 * v0 + v1 * v1) * (1.0f / 128.0f) + SUBLN_EPS) * (1.0f - P.lambda_init);
            *(unsigned*)(P.ob + (size_t)row * 1024 + h * 128 + 2 * lane) = cvt_pk_bf16(v0 * rinv * P.subln[2 * lane], v1 * rinv * P.subln[2 * lane + 1]);
        } else if constexpr (WHICH == 2) {
            const int qh = hs, kvh = qh >> 2; KeyC kf{s};
            sattn<128>(prow + OFF_QC + qh * 128, pb + OFF_KC + kvh * 128, pb + OFF_VC + kvh * 128, kf, 257, 0.08838834764831845f, true, P.sink[qh], sq, ss, lane, o0, o1, mm, ll);
            *(unsigned*)(P.oc + (size_t)row * 1024 + qh * 128 + 2 * lane) = cvt_pk_bf16(o0, o1);
        } else {
            const int h = hs, r = s >> 6, c = s & 63; int rs = r - 4; rs = rs < 0 ? 0 : (rs > 56 ? 56 : rs); int cs = c - 8; cs = cs < 0 ? 0 : (cs > 48 ? 48 : cs);
            KeyD kf{r, c, rs, cs, P.rpb + h * 465};
            sattn<128>(prow + OFF_QD + h * 128, pb + OFF_KD + h * 128, pb + OFF_VD + h * 128, kf, 128, 0.08838834764831845f, false, 0.f, sq, ss, lane, o0, o1, mm, ll);
            *(unsigned*)(P.od + (size_t)row * 1024 + h * 128 + 2 * lane) = cvt_pk_bf16(o0, o1);
        }
    }
}

__device__ __forceinline__ void combine_a_phase(const unsigned char* ag, const float* lse, unsigned* oa8, int gw, int NGW, int lane) {
    for (int row0 = gw; row0 < MTOK; row0 += 4 * NGW) {
        float lc[4][3][3]; unsigned ac[4][3][3];
#pragma unroll
        for (int u = 0; u < 4; ++u) { const int row = row0 + u * NGW; if (row < MTOK) {
#pragma unroll
            for (int j = 0; j < 3; ++j) { const int e = 4 * lane + 256 * j, head = e >> 7;
#pragma unroll
                for (int g = 0; g < 3; ++g) { lc[u][j][g] = lse[((size_t)g * MTOK + row) * 6 + head]; ac[u][j][g] = *(const unsigned*)(ag + ((size_t)g * MTOK + row) * 768 + e); } } } }
#pragma unroll
        for (int u = 0; u < 4; ++u) { const int row = row0 + u * NGW; if (row >= MTOK) break;
#pragma unroll
            for (int j = 0; j < 3; ++j) {
                const int e = 4 * lane + 256 * j;
                const float l0 = lc[u][j][0], l1 = lc[u][j][1], l2 = lc[u][j][2];
                const float mx = fmaxf(l0, fmaxf(l1, l2)); float w0 = __expf(l0 - mx), w1 = __expf(l1 - mx), w2 = __expf(l2 - mx); const float inv = 1.0f / (w0 + w1 + w2); w0 *= inv; w1 *= inv; w2 *= inv;
                const unsigned a0 = ac[u][j][0], a1 = ac[u][j][1], a2 = ac[u][j][2];
#define CMB_B(w_, k_) ((float)(int)(signed char)(((w_) >> (8 * (k_))) & 0xffu))
                oa8[(size_t)row * 256 + (e >> 2)] = q8x4(w0 * CMB_B(a0, 0) + w1 * CMB_B(a1, 0) + w2 * CMB_B(a2, 0), w0 * CMB_B(a0, 1) + w1 * CMB_B(a1, 1) + w2 * CMB_B(a2, 1),
                                                      w0 * CMB_B(a0, 2) + w1 * CMB_B(a1, 2) + w2 * CMB_B(a2, 2), w0 * CMB_B(a0, 3) + w1 * CMB_B(a1, 3) + w2 * CMB_B(a2, 3), 1.0f);
#undef CMB_B
            } }
    }
}
__device__ __forceinline__ void ln1_router_phase(const bf16_t* preln, const float* gain, const float* bias, const float* wr, float* stats, unsigned* x8, float* aff,
                                                 LAS unsigned char* lds, int tid, int gw, int NGW, int lane) {
    LAS float* W = (LAS float*)lds;
    u32x2 vn[8];
    if (gw < MTOK) {
#pragma unroll
        for (int j = 0; j < 8; ++j) vn[j] = *(const u32x2*)(preln + (size_t)gw * DM + 4 * lane + 256 * j);
    }
    f32x4 g[8], bb[8];
#pragma unroll
    for (int j = 0; j < 8; ++j) { g[j] = *(const f32x4*)(gain + 256 * j + 4 * lane); bb[j] = *(const f32x4*)(bias + 256 * j + 4 * lane); }
    { f32x4 w4[16];
#pragma unroll
      for (int it = 0; it < 16; ++it) w4[it] = *(const f32x4*)(wr + 4 * (size_t)(tid + it * (NWAVES * 64)));
#pragma unroll
      for (int it = 0; it < 16; ++it) { const int i4 = tid + it * (NWAVES * 64), k = i4 >> 2, e0 = (i4 & 3) * 4;
          W[(e0 + 0) * DM + k] = w4[it][0]; W[(e0 + 1) * DM + k] = w4[it][1]; W[(e0 + 2) * DM + k] = w4[it][2]; W[(e0 + 3) * DM + k] = w4[it][3]; } }
    __syncthreads();
    for (int row = gw; row < MTOK; row += NGW) {
        f32x4 v[8]; float s = 0.f;
#pragma unroll
        for (int j = 0; j < 8; ++j) { v[j] = (f32x4){f16lo(vn[j].x), f16hi(vn[j].x), f16lo(vn[j].y), f16hi(vn[j].y)}; s += (v[j][0] + v[j][1]) + (v[j][2] + v[j][3]); }
        if (row + NGW < MTOK) {
#pragma unroll
            for (int j = 0; j < 8; ++j) vn[j] = *(const u32x2*)(preln + (size_t)(row + NGW) * DM + 4 * lane + 256 * j);
        }
        const float mean = wave_sum(s) * (1.0f / DM); float q = 0.f;
#pragma unroll
        for (int j = 0; j < 8; ++j) { v[j] = v[j] - mean; q += (v[j][0] * v[j][0] + v[j][1] * v[j][1]) + (v[j][2] * v[j][2] + v[j][3] * v[j][3]); }
        const float rstd = rsqrtf(wave_sum(q) * (1.0f / DM) + LN_EPS);
        if (lane == 0) *(f32x2*)(stats + 2 * (size_t)row) = (f32x2){mean, rstd};
        unsigned* x8o = x8 + (size_t)row * (DM / 4) + lane;
#pragma unroll
        for (int j = 0; j < 8; ++j) { v[j] = v[j] * rstd * g[j] + bb[j]; x8o[64 * j] = q8x4(v[j][0], v[j][1], v[j][2], v[j][3], QX); }
        float a[16];
        f32x4 wa[8], wb[8];
#define LN1_LDW(dst, e) do { _Pragma("unroll") for (int j = 0; j < 8; ++j) dst[j] = *(const LAS f32x4*)(W + (e) * DM + 256 * j + 4 * lane); } while (0)
#define LN1_DOT(src, e) do { f32x2 t2 = {0.f, 0.f}; _Pragma("unroll") for (int j = 0; j < 8; ++j) { \
            t2 = __builtin_elementwise_fma((f32x2){v[j][0], v[j][1]}, (f32x2){src[j][0], src[j][1]}, t2); t2 = __builtin_elementwise_fma((f32x2){v[j][2], v[j][3]}, (f32x2){src[j][2], src[j][3]}, t2); } \
            a[e] = t2[0] + t2[1]; } while (0)
        LN1_LDW(wa, 0);
#pragma unroll
        for (int e = 0; e < 16; e += 2) {
            LN1_LDW(wb, e + 1); asm volatile("" ::: "memory"); LN1_DOT(wa, e); asm volatile("" ::: "memory");
            if (e + 2 < 16) LN1_LDW(wa, e + 2);
            asm volatile("" ::: "memory"); LN1_DOT(wb, e + 1); asm volatile("" ::: "memory"); }
#undef LN1_LDW
#undef LN1_DOT
        float r8[8], r4[4], r2[2], r1;
        { const bool up = (lane & 32) != 0;
#pragma unroll
          for (int i = 0; i < 8; ++i) { const float keep = up ? a[i + 8] : a[i], send = up ? a[i] : a[i + 8]; r8[i] = keep + __shfl_xor(send, 32); } }
        { const bool up = (lane & 16) != 0;
#pragma unroll
          for (int i = 0; i < 4; ++i) { const float keep = up ? r8[i + 4] : r8[i], send = up ? r8[i] : r8[i + 4]; r4[i] = keep + __shfl_xor(send, 16); } }
        { const bool up = (lane & 8) != 0;
#pragma unroll
          for (int i = 0; i < 2; ++i) { const float keep = up ? r4[i + 2] : r4[i], send = up ? r4[i] : r4[i + 2]; r2[i] = keep + __shfl_xor(send, 8); } }
        { const bool up = (lane & 4) != 0; const float keep = up ? r2[1] : r2[0], send = up ? r2[0] : r2[1]; r1 = keep + __shfl_xor(send, 4); }
        r1 += __shfl_xor(r1, 1); r1 += __shfl_xor(r1, 2);
        float mx = r1;
#pragma unroll
        for (int o = 4; o < 64; o <<= 1) mx = fmaxf(mx, __shfl_xor(mx, o));
        const float ex = expf(r1 - mx); float den = ex;
#pragma unroll
        for (int o = 4; o < 64; o <<= 1) den += __shfl_xor(den, o);
        const int eidx = ((lane >> 5) & 1) * 8 + ((lane >> 4) & 1) * 4 + ((lane >> 3) & 1) * 2 + ((lane >> 2) & 1);
        if ((lane & 3) == 0) aff[((size_t)(row >> 12) * NEXP + eidx) * SEQ + (row & 4095)] = ex / den;
    }
    __syncthreads();
}
__device__ __forceinline__ void topk_phase(const float* aff, int* idxo, float* gvo, int* sloto, LAS unsigned char* lds, int tid, int wave, int lane, int wg, int G) {
    LAS int* cnt = (LAS int*)lds;
    for (int be = wg; be < NGRP; be += G) {
        const float* a = aff + (size_t)be * SEQ + tid * 8;
        const f32x4 a0 = *(const f32x4*)a, a1 = *(const f32x4*)(a + 4);
        unsigned v[8] = {__float_as_uint(a0[0]), __float_as_uint(a0[1]), __float_as_uint(a0[2]), __float_as_uint(a0[3]), __float_as_uint(a1[0]), __float_as_uint(a1[1]), __float_as_uint(a1[2]), __float_as_uint(a1[3])};
        unsigned T = 0u;
        for (int bit = 30; bit >= 0; --bit) {
            const unsigned cand = T | (1u << bit); int c = 0;
#pragma unroll
            for (int k = 0; k < 8; ++k) c += (v[k] >= cand) ? 1 : 0;
            c = wave_sum_i(c);
            if (lane == 0) cnt[(bit & 1) * 8 + wave] = c;
            __syncthreads();
            int tot = 0;
#pragma unroll
            for (int w = 0; w < 8; ++w) tot += cnt[(bit & 1) * 8 + w];
            if (tot >= CAP) T = cand;
        }
        int ngt = 0, neq = 0;
#pragma unroll
        for (int k = 0; k < 8; ++k) { ngt += (v[k] > T) ? 1 : 0; neq += (v[k] == T) ? 1 : 0; }
        int sgt = ngt, seq = neq;
#pragma unroll
        for (int o = 1; o < 64; o <<= 1) { const int tg = __shfl_up(sgt, o), te = __shfl_up(seq, o); if (lane >= o) { sgt += tg; seq += te; } }
        __syncthreads();
        if (lane == 63) { cnt[64 + wave] = sgt; cnt[64 + 8 + wave] = seq; }
        __syncthreads();
        int pgt = sgt - ngt, peq = seq - neq, totgt = 0;
#pragma unroll
        for (int w = 0; w < 8; ++w) { const int tg = cnt[64 + w], te = cnt[64 + 8 + w]; if (w < wave) { pgt += tg; peq += te; } totgt += tg; }
        const int need = CAP - totgt;
        const int b = be >> 4, e = be & 15;
#pragma unroll
        for (int k = 0; k < 8; ++k) {
            const bool gt = v[k] > T, eq = v[k] == T; const bool sel = gt || (eq && peq < need);
            const int slot = pgt + (peq < need ? peq : need);
            const int tok = tid * 8 + k;
            if (sel) { idxo[be * CAP + slot] = tok; gvo[be * CAP + slot] = __uint_as_float(v[k]); }
            sloto[((size_t)b * SEQ + tok) * NEXP + e] = sel ? slot : -1;
            pgt += gt ? 1 : 0; peq += eq ? 1 : 0;
        }
        __syncthreads();
    }
}
__device__ __forceinline__ void gather_phase(const bf16_t* xb, const int* idx, bf16_t* xg, int gw, int NGW, int lane) {
    for (int r = gw; r < NGRP * CAP; r += NGW) {
        const int be = r >> 9, b = be >> 4; const int tok = idx[r];
        const u32x4* src = (const u32x4*)(xb + ((size_t)b * SEQ + tok) * DM); u32x4* dst = (u32x4*)(xg + (size_t)r * DM);
#pragma unroll
        for (int j = 0; j < 4; ++j) dst[64 * j + lane] = src[64 * j + lane];
    }
}
__device__ __forceinline__ void ln2_phase(const bf16_t* x1, const float* stats, const float* gain1, const float* bias1, const unsigned char* y, const float* gvp, const int* slot, const float* gain, const float* bias, float* xo_base, bf16_t* xh, bf16_t* xb, unsigned char* x8, int gw, int NGW, int lane) {
    u32x4 xn[4]; int slot_n = -1;
    if (gw < MTOK) { slot_n = slot[(size_t)gw * NEXP + (lane & 15)];
#pragma unroll
        for (int j = 0; j < 4; ++j) xn[j] = *(const u32x4*)(x1 + (size_t)gw * DM + 512 * j + 8 * lane); }
    for (int row = gw; row < MTOK; row += NGW) {
        const int b = row >> 12; const int myslot = slot_n;
        f32x4 xc[8];
#pragma unroll
        for (int j = 0; j < 4; ++j) { xc[2 * j] = (f32x4){f16lo(xn[j].x), f16hi(xn[j].x), f16lo(xn[j].y), f16hi(xn[j].y)}; xc[2 * j + 1] = (f32x4){f16lo(xn[j].z), f16hi(xn[j].z), f16lo(xn[j].w), f16hi(xn[j].w)}; }
        unsigned hits = (unsigned)(__ballot(myslot >= 0) & 0xffffull);
        const bool h0 = hits != 0u; const int e0 = h0 ? __builtin_ctz(hits) : 0; if (h0) hits &= hits - 1;
        const bool h1 = hits != 0u; const int e1 = h1 ? __builtin_ctz(hits) : e0; if (h1) hits &= hits - 1;
        int sl0 = __shfl(myslot, e0), sl1 = __shfl(myslot, e1); sl0 = sl0 < 0 ? 0 : sl0; sl1 = sl1 < 0 ? 0 : sl1;
        const f32x2 st = *(const f32x2*)(stats + 2 * (size_t)row);
        f32x4 ga[4], gb[4], ba[4], bv[4];
#pragma unroll
        for (int j = 0; j < 4; ++j) { ga[j] = *(const f32x4*)(gain1 + 512 * j + 8 * lane); gb[j] = *(const f32x4*)(gain1 + 512 * j + 8 * lane + 4);
            ba[j] = *(const f32x4*)(bias1 + 512 * j + 8 * lane); bv[j] = *(const f32x4*)(bias1 + 512 * j + 8 * lane + 4); }
        u32x2 ya[4], yb[4]; float ga_, gb_;
        { const size_t r0_ = (size_t)(b * NEXP + e0) * CAP + sl0, r1_ = (size_t)(b * NEXP + e1) * CAP + sl1;
          const unsigned char* yr0 = y + r0_ * DM + 8 * lane; const unsigned char* yr1 = y + r1_ * DM + 8 * lane;
          ga_ = gvp[r0_]; gb_ = gvp[r1_];
#pragma unroll
          for (int j = 0; j < 4; ++j) ya[j] = *(const u32x2*)(yr0 + 512 * j);
#pragma unroll
          for (int j = 0; j < 4; ++j) yb[j] = *(const u32x2*)(yr1 + 512 * j); }
        if (row + NGW < MTOK) { slot_n = slot[(size_t)(row + NGW) * NEXP + (lane & 15)];
#pragma unroll
            for (int j = 0; j < 4; ++j) xn[j] = *(const u32x4*)(x1 + (size_t)(row + NGW) * DM + 512 * j + 8 * lane); }
#pragma unroll
        for (int j = 0; j < 4; ++j) { xc[2 * j] = (xc[2 * j] - st[0]) * st[1] * ga[j] + ba[j]; xc[2 * j + 1] = (xc[2 * j + 1] - st[0]) * st[1] * gb[j] + bv[j]; }
        f32x4 acc[8];
#pragma unroll
        for (int j = 0; j < 8; ++j) acc[j] = (f32x4){0.f, 0.f, 0.f, 0.f};
#define LN2_ACC(Y_, j, gs) do { acc[2 * j][0] = fmaf((float)((Y_).x & 0xffu), gs, acc[2 * j][0]); acc[2 * j][1] = fmaf((float)(((Y_).x >> 8) & 0xffu), gs, acc[2 * j][1]); \
            acc[2 * j][2] = fmaf((float)(((Y_).x >> 16) & 0xffu), gs, acc[2 * j][2]); acc[2 * j][3] = fmaf((float)((Y_).x >> 24), gs, acc[2 * j][3]); \
            acc[2 * j + 1][0] = fmaf((float)((Y_).y & 0xffu), gs, acc[2 * j + 1][0]); acc[2 * j + 1][1] = fmaf((float)(((Y_).y >> 8) & 0xffu), gs, acc[2 * j + 1][1]); \
            acc[2 * j + 1][2] = fmaf((float)(((Y_).y >> 16) & 0xffu), gs, acc[2 * j + 1][2]); acc[2 * j + 1][3] = fmaf((float)((Y_).y >> 24), gs, acc[2 * j + 1][3]); } while (0)
        float corr = 0.f;
        if (h0) { const float gs = ga_ * (1.0f / QY); corr += 128.0f * gs;
#pragma unroll
            for (int j = 0; j < 4; ++j) LN2_ACC(ya[j], j, gs); }
        if (h1) { const float gs = gb_ * (1.0f / QY); corr += 128.0f * gs;
#pragma unroll
            for (int j = 0; j < 4; ++j) LN2_ACC(yb[j], j, gs); }
        while (hits) {
            const int e = __builtin_ctz(hits); hits &= hits - 1;
            const int sl = __shfl(myslot, e);
            const size_t r_ = (size_t)(b * NEXP + e) * CAP + sl; const unsigned char* yr = y + r_ * DM + 8 * lane;
            const float gs = gvp[r_] * (1.0f / QY); corr += 128.0f * gs;
#pragma unroll
            for (int j = 0; j < 4; ++j) { const u32x2 w = *(const u32x2*)(yr + 512 * j); LN2_ACC(w, j, gs); }
        }
#undef LN2_ACC
        float s = 0.f;
#pragma unroll
        for (int j = 0; j < 8; ++j) { acc[j] = xc[j] * ALPHA + (acc[j] - corr); s += (acc[j][0] + acc[j][1]) + (acc[j][2] + acc[j][3]); }
        const float mean = wave_sum(s) * (1.0f / DM); float q = 0.f;
#pragma unroll
        for (int j = 0; j < 8; ++j) { acc[j] = acc[j] - mean; q += (acc[j][0] * acc[j][0] + acc[j][1] * acc[j][1]) + (acc[j][2] * acc[j][2] + acc[j][3] * acc[j][3]); }
        const float rstd = rsqrtf(wave_sum(q) * (1.0f / DM) + LN_EPS);
        float* xo = xo_base + (size_t)row * DM + 8 * lane; (void)xb; bf16_t* xho = xh + (size_t)row * DM + 8 * lane;
#pragma unroll
        for (int j = 0; j < 4; ++j) { const f32x4 g0 = *(const f32x4*)(gain + 512 * j + 8 * lane), g1 = *(const f32x4*)(gain + 512 * j + 8 * lane + 4), b0 = *(const f32x4*)(bias + 512 * j + 8 * lane), b1 = *(const f32x4*)(bias + 512 * j + 8 * lane + 4);
            const f32x4 o0 = acc[2 * j] * rstd * g0 + b0, o1 = acc[2 * j + 1] * rstd * g1 + b1;
            if (!x8) { *(f32x4*)(xo + 512 * j) = o0; *(f32x4*)(xo + 512 * j + 4) = o1; }
            else { u32x4 hw; hw.x = pk_f16(o0[0], o0[1]); hw.y = pk_f16(o0[2], o0[3]); hw.z = pk_f16(o1[0], o1[1]); hw.w = pk_f16(o1[2], o1[3]); *(u32x4*)(xho + 512 * j) = hw; }
            if (x8) {
                u32x2 q; q.x = q8x4(o0[0], o0[1], o0[2], o0[3], QX); q.y = q8x4(o1[0], o1[1], o1[2], o1[3], QX); *(u32x2*)(x8 + (size_t)row * DM + 8 * lane + 512 * j) = q; } }
    }
}

namespace att {
typedef short bf16x8 __attribute__((ext_vector_type(8)));
typedef short s16x4 __attribute__((ext_vector_type(4)));
typedef float f32x16 __attribute__((ext_vector_type(16)));
constexpr int VBYTES = 16384, KOFF = 2 * VBYTES, WSOFF = 65536, TABOFF = WSOFF + 2048, QOFF = TABOFF + 2048, ATTN_LDS = QOFF + 32768;
constexpr float NEG = -1e30f, M0 = -1e29f;
#define ATT_SBAR() __builtin_amdgcn_sched_barrier(0)
__device__ __forceinline__ int crow(int r, int hi) { return (r & 3) + 8 * (r >> 2) + 4 * hi; }
__device__ __forceinline__ unsigned cvtpk(float lo, float hi) { unsigned r; asm volatile("v_cvt_pk_bf16_f32 %0, %1, %2" : "=v"(r) : "v"(lo), "v"(hi)); return r; }
__device__ __forceinline__ int kswz128(int row, int colB) { return row * 256 + (colB ^ ((row & 7) << 4)); }
__device__ __forceinline__ int kswz64(int row, int colB) { return row * 128 + (colB ^ (((row >> 1) & 7) << 4)); }

__device__ __forceinline__ void partialSM(f32x16& p0, f32x16& p1, float& m_reg, float& mn, float& alpha, const float C, const float thr_raw) {
    float pmax = p0[0];
#pragma unroll
    for (int r = 1; r < 16; ++r) pmax = fmaxf(pmax, p0[r]);
#pragma unroll
    for (int r = 0; r < 16; ++r) pmax = fmaxf(pmax, p1[r]);
    { auto rr = __builtin_amdgcn_permlane32_swap(__float_as_uint(pmax), __float_as_uint(pmax), false, false); pmax = fmaxf(__uint_as_float(rr[0]), __uint_as_float(rr[1])); }
    if (__all(pmax - m_reg <= thr_raw)) { mn = m_reg; alpha = 1.f; }
    else { mn = fmaxf(m_reg, pmax); alpha = __builtin_amdgcn_exp2f((m_reg - mn) * C); m_reg = mn; }
    const float mnC = -mn * C;
#pragma unroll
    for (int r = 0; r < 16; ++r) p0[r] = fmaf(p0[r], C, mnC);
#pragma unroll
    for (int r = 0; r < 16; ++r) p1[r] = fmaf(p1[r], C, mnC);
#pragma unroll
    for (int r = 0; r < 16; ++r) p0[r] = __builtin_amdgcn_exp2f(p0[r]);
}
__device__ __forceinline__ void finishSM(f32x16& p0, f32x16& p1, float alpha, float& l_reg, bf16x8& pa0, bf16x8& pa1, bf16x8& pa2, bf16x8& pa3) {
#pragma unroll
    for (int r = 0; r < 16; ++r) p1[r] = __builtin_amdgcn_exp2f(p1[r]);
    float ps = 0;
#pragma unroll
    for (int r = 0; r < 16; ++r) ps += p0[r];
#pragma unroll
    for (int r = 0; r < 16; ++r) ps += p1[r];
    { auto rr = __builtin_amdgcn_permlane32_swap(__float_as_uint(ps), __float_as_uint(ps), false, false); ps = __uint_as_float(rr[0]) + __uint_as_float(rr[1]); }
    l_reg = l_reg * alpha + ps;
#define ATT_PK4(P, BASE, OUT) do { unsigned a0 = cvtpk(P[BASE + 0], P[BASE + 1]), a1 = cvtpk(P[BASE + 2], P[BASE + 3]);   \
    unsigned b0 = cvtpk(P[BASE + 4], P[BASE + 5]), b1 = cvtpk(P[BASE + 6], P[BASE + 7]);                              \
    auto r0 = __builtin_amdgcn_permlane32_swap(a0, b0, false, false); auto r1 = __builtin_amdgcn_permlane32_swap(a1, b1, false, false); \
    u32x4 w = {r0[0], r1[0], r0[1], r1[1]}; OUT = __builtin_bit_cast(bf16x8, w); } while (0)
    ATT_PK4(p0, 0, pa0); ATT_PK4(p0, 8, pa1); ATT_PK4(p1, 0, pa2); ATT_PK4(p1, 8, pa3);
#undef ATT_PK4
}
template <int DK>
__device__ __forceinline__ void qkt(f32x16& p0, f32x16& p1, const LAS char* Ks, const bf16x8* qr, int r32, int hi) {
    p0 = f32x16{}; p1 = f32x16{};
#pragma unroll
    for (int d0 = 0; d0 < DK / 16; ++d0) { const int cb = (d0 * 16 + hi * 8) * 2;
        const bf16x8 b0 = *(const LAS bf16x8*)(Ks + (DK == 128 ? kswz128(r32, cb) : kswz64(r32, cb)));
        const bf16x8 b1 = *(const LAS bf16x8*)(Ks + (DK == 128 ? kswz128(32 + r32, cb) : kswz64(32 + r32, cb)));
        p0 = __builtin_amdgcn_mfma_f32_32x32x16_bf16(b0, qr[d0], p0, 0, 0, 0);
        p1 = __builtin_amdgcn_mfma_f32_32x32x16_bf16(b1, qr[d0], p1, 0, 0, 0); }
}
__device__ __forceinline__ void qkt64_ldsq(f32x16& p0, f32x16& p1, const LAS char* Ks, const LAS char* qb_l, int r32, int hi) {
    unsigned qa = (unsigned)(__UINTPTR_TYPE__)qb_l; asm volatile("" : "+v"(qa)); const LAS char* qp = (const LAS char*)(__UINTPTR_TYPE__)qa;
    p0 = f32x16{}; p1 = f32x16{};
#pragma unroll
    for (int d0 = 0; d0 < 4; ++d0) { const int cb = (d0 * 16 + hi * 8) * 2;
        const bf16x8 q = *(const LAS bf16x8*)(qp + d0 * 1024);
        const bf16x8 b0 = *(const LAS bf16x8*)(Ks + kswz64(r32, cb));
        const bf16x8 b1 = *(const LAS bf16x8*)(Ks + kswz64(32 + r32, cb));
        p0 = __builtin_amdgcn_mfma_f32_32x32x16_bf16(b0, q, p0, 0, 0, 0);
        p1 = __builtin_amdgcn_mfma_f32_32x32x16_bf16(b1, q, p1, 0, 0, 0); }
}
__device__ __forceinline__ int v_st(int k, int c) { const int kk = (k & ~0xC) | ((k & 4) << 1) | ((k & 8) >> 1); return ((kk >> 3) * 4 + (c >> 5)) * 512 + ((kk & 7) * 32 + (c & 31)) * 2; }
__device__ __forceinline__ int v_rd_base(int lane) { return ((lane & 3) << 3) | (((lane >> 2) & 3) << 6) | (((lane >> 4) & 1) << 5) | (((lane >> 5) & 1) << 8); }
constexpr int v_rd_off(int d0, int ks, int half) { return d0 * 512 + ks * 4096 + half * 2048; }
template <int OFF> __device__ __forceinline__ s16x4 tr_read(int vb) { s16x4 r; asm volatile("ds_read_b64_tr_b16 %0, %1 offset:%2" : "=&v"(r) : "v"(vb), "i"(OFF) : "memory"); return r; }
template <int D0> __device__ __forceinline__ void pv_one(f32x16& od, int vb, bf16x8 pa0, bf16x8 pa1, bf16x8 pa2, bf16x8 pa3) {
    const s16x4 l0 = tr_read<v_rd_off(D0, 0, 0)>(vb), h0 = tr_read<v_rd_off(D0, 0, 1)>(vb), l1 = tr_read<v_rd_off(D0, 1, 0)>(vb), h1 = tr_read<v_rd_off(D0, 1, 1)>(vb);
    const s16x4 l2 = tr_read<v_rd_off(D0, 2, 0)>(vb), h2 = tr_read<v_rd_off(D0, 2, 1)>(vb), l3 = tr_read<v_rd_off(D0, 3, 0)>(vb), h3 = tr_read<v_rd_off(D0, 3, 1)>(vb);
    asm volatile("s_waitcnt lgkmcnt(0)" ::: "memory"); ATT_SBAR();
#define ATT_PK(L, H) (bf16x8){L[0], L[1], L[2], L[3], H[0], H[1], H[2], H[3]}
    od = __builtin_amdgcn_mfma_f32_32x32x16_bf16(pa0, ATT_PK(l0, h0), od, 0, 0, 0);
    od = __builtin_amdgcn_mfma_f32_32x32x16_bf16(pa1, ATT_PK(l1, h1), od, 0, 0, 0);
    od = __builtin_amdgcn_mfma_f32_32x32x16_bf16(pa2, ATT_PK(l2, h2), od, 0, 0, 0);
    od = __builtin_amdgcn_mfma_f32_32x32x16_bf16(pa3, ATT_PK(l3, h3), od, 0, 0, 0);
#undef ATT_PK
}
__device__ __forceinline__ void pv_d0(f32x16* o, int vb, bf16x8 pa0, bf16x8 pa1, bf16x8 pa2, bf16x8 pa3) {
    pv_one<0>(o[0], vb, pa0, pa1, pa2, pa3); pv_one<1>(o[1], vb, pa0, pa1, pa2, pa3); pv_one<2>(o[2], vb, pa0, pa1, pa2, pa3); pv_one<3>(o[3], vb, pa0, pa1, pa2, pa3);
}

template <int DK, class Pol>
__device__ __forceinline__ void attn_unit(const Pol& P, LAS char* lds, const int tid_in) {
    int tid = tid_in; asm volatile("" : "+v"(tid));
    const int wid = __builtin_amdgcn_readfirstlane(tid >> 6), lane = tid & 63, r32 = lane & 31, hi = lane >> 5;
    LAS char* V_lds = lds; LAS char* K_lds = lds + KOFF; constexpr int KBYTES = 64 * DK * 2;
    LAS float* wsx = (LAS float*)(lds + WSOFF) + wid * 64; LAS float* li_l = wsx; LAS float* al_l = wsx + 32;
    const float C = Pol::SCALE * 1.4426950408889634f, thr_raw = 8.0f / Pol::SCALE;
    float m_reg = P.m0w(wid), l_reg = P.l0(); f32x16 o[4] = {}; bf16x8 qr[DK / 16];
    { const bf16_t* qp = P.q_row(wid * 32 + r32) + hi * 8;
#pragma unroll
      for (int d0 = 0; d0 < DK / 16; ++d0) qr[d0] = *(const bf16x8*)(qp + d0 * 16); }
    const int sr = tid >> 4, sc = (tid & 15) * 8, vst0 = v_st(sr, sc), vst1 = v_st(32 + sr, sc);
    const int k64r = tid >> 3, k64c = (tid & 7) * 8;
    const int vb0 = (int)(unsigned)(__UINTPTR_TYPE__)V_lds + v_rd_base(lane);
    bf16x8 aV0, aV1, aK0, aK1, bV0, bV1, bK0, bK1;
#define ATT_LOADX(V0, V1, K0, K1, t) do { V0 = *(const bf16x8*)(P.v_row((t), sr) + sc); V1 = *(const bf16x8*)(P.v_row((t), 32 + sr) + sc); \
        if constexpr (DK == 128) { K0 = *(const bf16x8*)(P.k_row((t), sr) + sc); K1 = *(const bf16x8*)(P.k_row((t), 32 + sr) + sc); } \
        else { K0 = *(const bf16x8*)(P.k_row((t), k64r) + k64c); K1 = K0; } } while (0)
#define ATT_WRITEX(V0, V1, K0, K1, b) do { *(LAS bf16x8*)(V_lds + (b) * VBYTES + vst0) = V0; *(LAS bf16x8*)(V_lds + (b) * VBYTES + vst1) = V1; \
        if constexpr (DK == 128) { *(LAS bf16x8*)(K_lds + (b) * KBYTES + kswz128(sr, sc * 2)) = K0; *(LAS bf16x8*)(K_lds + (b) * KBYTES + kswz128(32 + sr, sc * 2)) = K1; } \
        else { *(LAS bf16x8*)(K_lds + (b) * KBYTES + kswz64(k64r, k64c * 2)) = K0; } } while (0)
#define ATT_COMPUTE(t, b) do { if (P.wave_needs((t), wid)) { \
            f32x16 p0, p1; float mn, alpha; bf16x8 pa0, pa1, pa2, pa3; \
            qkt<DK>(p0, p1, K_lds + (b) * KBYTES, qr, r32, hi); \
            P.mask(p0, p1, (t), wid, r32, hi, lds); \
            partialSM(p0, p1, m_reg, mn, alpha, C, thr_raw); \
            if (__any(alpha < 1.f)) { if (hi == 0) al_l[r32] = alpha; asm volatile("s_waitcnt lgkmcnt(0)" ::: "memory"); \
                _Pragma("unroll") for (int d = 0; d < 4; ++d) _Pragma("unroll") for (int r = 0; r < 16; ++r) o[d][r] *= al_l[crow(r, hi)]; } \
            finishSM(p0, p1, alpha, l_reg, pa0, pa1, pa2, pa3); ATT_SBAR(); \
            pv_d0(o, vb0 + (b) * VBYTES, pa0, pa1, pa2, pa3); } } while (0)
    const int NT = P.ntiles();
    ATT_LOADX(aV0, aV1, aK0, aK1, 0);
    if (NT > 1) ATT_LOADX(bV0, bV1, bK0, bK1, 1);
    for (int t = 0; t < NT; t += 2) {
        ATT_WRITEX(aV0, aV1, aK0, aK1, 0);
        __syncthreads();
        if (t + 2 < NT) ATT_LOADX(aV0, aV1, aK0, aK1, t + 2);
        ATT_COMPUTE(t, 0);
        if (t + 1 < NT) {
            ATT_WRITEX(bV0, bV1, bK0, bK1, 1);
            __syncthreads();
            if (t + 3 < NT) ATT_LOADX(bV0, bV1, bK0, bK1, t + 3);
            ATT_COMPUTE(t + 1, 1);
        }
    }
#undef ATT_LOADX
#undef ATT_WRITEX
#undef ATT_COMPUTE
    if (hi == 0) li_l[r32] = l_reg;
    asm volatile("s_waitcnt lgkmcnt(0)" ::: "memory");
    P.finish(o, m_reg, l_reg, li_l, wid, r32, hi);
    __syncthreads();
}

template <class Pol>
__device__ __forceinline__ void attn_unit_dense64(const Pol& P, LAS char* lds, const int tid_in) {
    int tid = tid_in; asm volatile("" : "+v"(tid));
    const int wid = __builtin_amdgcn_readfirstlane(tid >> 6), lane = tid & 63, r32 = lane & 31, hi = lane >> 5;
    LAS char* V_lds = lds; LAS char* K_lds = lds + KOFF; constexpr int KBYTES = 64 * 64 * 2;
    LAS float* wsx = (LAS float*)(lds + WSOFF) + wid * 64; LAS float* li_l = wsx; LAS float* al_l = wsx + 32;
    const float C = Pol::SCALE * 1.4426950408889634f, thr_raw = 8.0f / Pol::SCALE;
    float m_reg = M0, l_reg = 0.f; f32x16 o[4] = {};
    LAS char* qb_l = lds + QOFF + wid * 4096 + lane * 16;
    { const bf16_t* qp = P.q_row(wid * 32 + r32) + hi * 8;
#pragma unroll
      for (int d0 = 0; d0 < 4; ++d0) *(LAS bf16x8*)(qb_l + d0 * 1024) = *(const bf16x8*)(qp + d0 * 16); }
    const int sr = tid >> 4, sc = (tid & 15) * 8, vst0 = v_st(sr, sc), vst1 = v_st(32 + sr, sc);
    const int k64r = tid >> 3, k64c = (tid & 7) * 8, kst = kswz64(k64r, k64c * 2);
    const int vb0 = (int)(unsigned)(__UINTPTR_TYPE__)V_lds + v_rd_base(lane);
    bf16x8 sAv0, sAv1, sAk, sBv0, sBv1, sBk;
#define D64_LOADA(t) do { sAv0 = *(const bf16x8*)(P.v_row((t), sr) + sc); sAv1 = *(const bf16x8*)(P.v_row((t), 32 + sr) + sc); sAk = *(const bf16x8*)(P.k_row((t), k64r) + k64c); } while (0)
#define D64_LOADB(t) do { sBv0 = *(const bf16x8*)(P.v_row((t), sr) + sc); sBv1 = *(const bf16x8*)(P.v_row((t), 32 + sr) + sc); sBk = *(const bf16x8*)(P.k_row((t), k64r) + k64c); } while (0)
#define D64_WRITEA() do { *(LAS bf16x8*)(V_lds + vst0) = sAv0; *(LAS bf16x8*)(V_lds + vst1) = sAv1; *(LAS bf16x8*)(K_lds + kst) = sAk; } while (0)
#define D64_WRITEB() do { *(LAS bf16x8*)(V_lds + VBYTES + vst0) = sBv0; *(LAS bf16x8*)(V_lds + VBYTES + vst1) = sBv1; *(LAS bf16x8*)(K_lds + KBYTES + kst) = sBk; } while (0)
#define D64_WAIT() asm volatile("s_waitcnt vmcnt(3)" ::: "memory")
#define D64_RESC(a) do { if (__any((a) < 1.f)) { if (hi == 0) al_l[r32] = (a); asm volatile("s_waitcnt lgkmcnt(0)" ::: "memory"); \
    _Pragma("unroll") for (int d = 0; d < 4; ++d) _Pragma("unroll") for (int r = 0; r < 16; ++r) o[d][r] *= al_l[crow(r, hi)]; } } while (0)
    f32x16 pA0, pA1, pB0, pB1; float mnA, mnB, alA, alB; bf16x8 pa0, pa1, pa2, pa3; const int NT = P.ntiles();
    D64_LOADA(0); asm volatile("s_waitcnt vmcnt(0)" ::: "memory"); D64_WRITEA(); __syncthreads();
    qkt64_ldsq(pA0, pA1, K_lds, qb_l, r32, hi); partialSM(pA0, pA1, m_reg, mnA, alA, C, thr_raw);
    D64_LOADB(1); D64_LOADA(2);
    D64_WAIT(); D64_WRITEB(); __syncthreads();
#if defined(STAMP_SEL)
    unsigned long long sa0 = 0, sa1 = 0, sa2 = 0, sr0 = 0, sr1 = 0; if (P.stamp) { sa0 = __builtin_amdgcn_s_memtime(); sr0 = __builtin_amdgcn_s_memrealtime(); }
#endif
    for (int j = 1; j + 1 < NT; j += 2) {
        ATT_SBAR(); qkt64_ldsq(pB0, pB1, K_lds + KBYTES, qb_l, r32, hi);
        finishSM(pA0, pA1, alA, l_reg, pa0, pa1, pa2, pa3); ATT_SBAR();
        D64_LOADB(j + 2); ATT_SBAR();
        pv_d0(o, vb0, pa0, pa1, pa2, pa3); partialSM(pB0, pB1, m_reg, mnB, alB, C, thr_raw);
        __syncthreads(); D64_WAIT(); D64_WRITEA();
        D64_RESC(alB); __syncthreads();
        ATT_SBAR(); qkt64_ldsq(pA0, pA1, K_lds, qb_l, r32, hi);
        finishSM(pB0, pB1, alB, l_reg, pa0, pa1, pa2, pa3); ATT_SBAR();
        if (j + 3 < NT) D64_LOADA(j + 3); ATT_SBAR();
        pv_d0(o, vb0 + VBYTES, pa0, pa1, pa2, pa3); partialSM(pA0, pA1, m_reg, mnA, alA, C, thr_raw);
        __syncthreads(); D64_WAIT(); D64_WRITEB();
        D64_RESC(alA); __syncthreads();
    }
    ATT_SBAR(); qkt64_ldsq(pB0, pB1, K_lds + KBYTES, qb_l, r32, hi);
    finishSM(pA0, pA1, alA, l_reg, pa0, pa1, pa2, pa3); ATT_SBAR();
    pv_d0(o, vb0, pa0, pa1, pa2, pa3); partialSM(pB0, pB1, m_reg, mnB, alB, C, thr_raw);
    __syncthreads(); D64_RESC(alB);
    finishSM(pB0, pB1, alB, l_reg, pa0, pa1, pa2, pa3); ATT_SBAR();
    pv_d0(o, vb0 + VBYTES, pa0, pa1, pa2, pa3);
#undef D64_LOADA
#undef D64_LOADB
#undef D64_WRITEA
#undef D64_WRITEB
#undef D64_WAIT
#undef D64_RESC
#if defined(STAMP_SEL)
    if (P.stamp) { sa1 = __builtin_amdgcn_s_memtime(); sr1 = __builtin_amdgcn_s_memrealtime(); }
#endif
    if (hi == 0) li_l[r32] = l_reg;
    asm volatile("s_waitcnt lgkmcnt(0)" ::: "memory");
    P.finish(o, m_reg, l_reg, li_l, wid, r32, hi);
    __syncthreads();
#if defined(STAMP_SEL)
    if (P.stamp && tid == 0) { sa2 = __builtin_amdgcn_s_memtime(); P.stamp[10] = sa0; P.stamp[12] = sa1; P.stamp[13] = sa2; P.stamp[14] = sr0; P.stamp[15] = sr1; }
#endif
}

typedef short v4i16_t __attribute__((ext_vector_type(4)));
__device__ __forceinline__ s16x4 vtr(const LAS char* p) { return __builtin_bit_cast(s16x4, __builtin_amdgcn_ds_read_tr16_b64_v4i16((LAS v4i16_t*)p)); }
template <class Pol>
__device__ __forceinline__ void attn_unit_b2(const Pol& P, LAS char* lds, const int tid_in) {
    int tid = tid_in; asm volatile("" : "+v"(tid));
    const int wid = __builtin_amdgcn_readfirstlane(tid >> 6), lane = tid & 63, r32 = lane & 31, hi = lane >> 5;
    const bool trail = wid >= 4;
    constexpr int KB = 8192, VB = 16384, KR = 3 * VB, WSB = KR + 3 * KB;
    LAS char* V_lds = lds; LAS char* K_lds = lds + KR;
    LAS float* wsx = (LAS float*)(lds + WSB) + wid * 64; LAS float* li_l = wsx; LAS float* al_l = wsx + 32;
    const float C = Pol::SCALE * 1.4426950408889634f, thr_raw = 8.0f / Pol::SCALE;
    float m_reg = M0, l_reg = 0.f; f32x16 o[4] = {}; bf16x8 qr[4];
    { const bf16_t* qp = P.q_row(wid * 32 + r32) + hi * 8;
#pragma unroll
      for (int d0 = 0; d0 < 4; ++d0) qr[d0] = *(const bf16x8*)(qp + d0 * 16); }
    const int sr = tid >> 4, sc = (tid & 15) * 8, vst0 = v_st(sr, sc), vst1 = v_st(32 + sr, sc);
    const int k64r = tid >> 3, k64c = (tid & 7) * 8, kst = kswz64(k64r, k64c * 2);
    const LAS char* vrd = V_lds + v_rd_base(lane);
    bf16x8 sAv0, sAv1, sAk, sBv0, sBv1, sBk;
#define B2_LOADA(t) do { sAv0 = *(const bf16x8*)(P.v_row((t), sr) + sc); sAv1 = *(const bf16x8*)(P.v_row((t), 32 + sr) + sc); sAk = *(const bf16x8*)(P.k_row((t), k64r) + k64c); } while (0)
#define B2_LOADB(t) do { sBv0 = *(const bf16x8*)(P.v_row((t), sr) + sc); sBv1 = *(const bf16x8*)(P.v_row((t), 32 + sr) + sc); sBk = *(const bf16x8*)(P.k_row((t), k64r) + k64c); } while (0)
#define B2_WRITEA(r) do { *(LAS bf16x8*)(V_lds + (r) * VB + vst0) = sAv0; *(LAS bf16x8*)(V_lds + (r) * VB + vst1) = sAv1; *(LAS bf16x8*)(K_lds + (r) * KB + kst) = sAk; } while (0)
#define B2_WRITEB(r) do { *(LAS bf16x8*)(V_lds + (r) * VB + vst0) = sBv0; *(LAS bf16x8*)(V_lds + (r) * VB + vst1) = sBv1; *(LAS bf16x8*)(K_lds + (r) * KB + kst) = sBk; } while (0)
#define B2_BAR() do { asm volatile("s_waitcnt lgkmcnt(0)" ::: "memory"); __builtin_amdgcn_sched_barrier(0); __builtin_amdgcn_s_barrier(); __builtin_amdgcn_sched_barrier(0); } while (0)
#define B2_QK(r) do { const LAS char* Ks_ = K_lds + (r) * KB; p0 = f32x16{}; p1 = f32x16{}; \
    _Pragma("unroll") for (int d0 = 0; d0 < 4; ++d0) { const int cb = (d0 * 16 + hi * 8) * 2; \
        const bf16x8 b0 = *(const LAS bf16x8*)(Ks_ + kswz64(r32, cb)); const bf16x8 b1 = *(const LAS bf16x8*)(Ks_ + kswz64(32 + r32, cb)); \
        p0 = __builtin_amdgcn_mfma_f32_32x32x16_bf16(b0, qr[d0], p0, 0, 0, 0); p1 = __builtin_amdgcn_mfma_f32_32x32x16_bf16(b1, qr[d0], p1, 0, 0, 0); } } while (0)
#define B2_PKV(L, H) (bf16x8){L[0], L[1], L[2], L[3], H[0], H[1], H[2], H[3]}
#define B2_PV(r) do { const LAS char* vb_ = vrd + (r) * VB; \
    _Pragma("unroll") for (int d0 = 0; d0 < 4; ++d0) { \
        const s16x4 l0 = vtr(vb_ + v_rd_off(d0, 0, 0)), h0 = vtr(vb_ + v_rd_off(d0, 0, 1)), l1 = vtr(vb_ + v_rd_off(d0, 1, 0)), h1 = vtr(vb_ + v_rd_off(d0, 1, 1)); \
        const s16x4 l2 = vtr(vb_ + v_rd_off(d0, 2, 0)), h2 = vtr(vb_ + v_rd_off(d0, 2, 1)), l3 = vtr(vb_ + v_rd_off(d0, 3, 0)), h3 = vtr(vb_ + v_rd_off(d0, 3, 1)); \
        o[d0] = __builtin_amdgcn_mfma_f32_32x32x16_bf16(pa0, B2_PKV(l0, h0), o[d0], 0, 0, 0); o[d0] = __builtin_amdgcn_mfma_f32_32x32x16_bf16(pa1, B2_PKV(l1, h1), o[d0], 0, 0, 0); \
        o[d0] = __builtin_amdgcn_mfma_f32_32x32x16_bf16(pa2, B2_PKV(l2, h2), o[d0], 0, 0, 0); o[d0] = __builtin_amdgcn_mfma_f32_32x32x16_bf16(pa3, B2_PKV(l3, h3), o[d0], 0, 0, 0); } } while (0)
#define B2_SM() do { float mn_, alpha_; partialSM(p0, p1, m_reg, mn_, alpha_, C, thr_raw); \
    if (__any(alpha_ < 1.f)) { if (hi == 0) al_l[r32] = alpha_; asm volatile("s_waitcnt lgkmcnt(0)" ::: "memory"); \
        _Pragma("unroll") for (int d = 0; d < 4; ++d) _Pragma("unroll") for (int r = 0; r < 16; ++r) o[d][r] *= al_l[crow(r, hi)]; } \
    finishSM(p0, p1, alpha_, l_reg, pa0, pa1, pa2, pa3); } while (0)
    f32x16 p0, p1; bf16x8 pa0, pa1, pa2, pa3; const int NT = P.ntiles();
    B2_LOADA(0); B2_LOADB(1);
    B2_WRITEA(0);
    B2_LOADA(2);
    B2_BAR();
    if (trail) B2_BAR();
    B2_QK(0); B2_WRITEB(1); B2_LOADB(3);
    B2_BAR();
    B2_SM();
    B2_BAR();
    int rk = 1, rv = 0, rw = 2;
    for (int j = 1; j < NT - 1; j += 2) {
        B2_QK(rk); B2_PV(rv); B2_WRITEA(rw); if (j + 3 < NT) B2_LOADA(j + 3);
        B2_BAR();
        B2_SM();
        B2_BAR();
        rv = rk; rk = rw; rw = (rw == 2) ? 0 : rw + 1;
        B2_QK(rk); B2_PV(rv); B2_WRITEB(rw); if (j + 4 < NT) B2_LOADB(j + 4);
        B2_BAR();
        B2_SM();
        B2_BAR();
        rv = rk; rk = rw; rw = (rw == 2) ? 0 : rw + 1;
    }
    B2_QK(rk); B2_PV(rv);
    B2_BAR();
    B2_SM();
    B2_BAR();
    rv = rk;
    B2_PV(rv);
    if (!trail) B2_BAR();
#undef B2_LOADA
#undef B2_LOADB
#undef B2_WRITEA
#undef B2_WRITEB
#undef B2_QK
#undef B2_PKV
#undef B2_PV
#undef B2_SM
    if (hi == 0) li_l[r32] = l_reg;
    asm volatile("s_waitcnt lgkmcnt(0)" ::: "memory");
    P.finish(o, m_reg, l_reg, li_l, wid, r32, hi);
    __syncthreads();
#undef B2_BAR
}

template <class Pol>
__device__ __forceinline__ void attn_unit_b3(const Pol& P, LAS char* lds, const int tid_in, unsigned long long* stamp_ = nullptr) {
    int tid = tid_in; asm volatile("" : "+v"(tid));
    const int wid = __builtin_amdgcn_readfirstlane(tid >> 6), lane = tid & 63, r32 = lane & 31, hi = lane >> 5;
    constexpr int KB = 8192, VB = 16384, K0OFF = 3 * VB, K1OFF = K0OFF + 2 * KB, WS3 = K1OFF + 2 * KB, Q3OFF = WS3 + 2048;
    static_assert(Q3OFF + 65536 <= LDSCTL_OFF, "mixer B LDS image overlaps the control words");
    LAS char* V_lds = lds;
    LAS float* wsx = (LAS float*)(lds + WS3) + wid * 64; LAS float* li_l = wsx; LAS float* al_l = wsx + 32;
    const float C = Pol::SCALE * 1.4426950408889634f, thr_raw = 8.0f / Pol::SCALE;
    float m0 = M0, l0 = 0.f, m1 = M0, l1 = 0.f; f32x16 o0[4] = {}, o1[4] = {};
    LAS char* qb_l = lds + Q3OFF + wid * 8192 + lane * 16;
#pragma unroll
    for (int mp = 0; mp < 2; ++mp) { const bf16_t* qp = P.q_row(mp, wid * 32 + r32) + hi * 8;
#pragma unroll
        for (int d0 = 0; d0 < 4; ++d0) *(LAS bf16x8*)(qb_l + mp * 4096 + d0 * 1024) = *(const bf16x8*)(qp + d0 * 16); }
    const int sr = tid >> 4, sc = (tid & 15) * 8, vst0 = v_st(sr, sc), vst1 = v_st(32 + sr, sc);
    const int k64r = tid >> 3, k64c = (tid & 7) * 8, kst = kswz64(k64r, k64c * 2);
    const int vb0 = (int)(unsigned)(__UINTPTR_TYPE__)V_lds + v_rd_base(lane);
    bf16x8 aV0, aV1, aK0, aK1;
#define B3_LOAD(V0, V1, K0, K1, t) do { V0 = *(const bf16x8*)(P.v_row((t), sr) + sc); V1 = *(const bf16x8*)(P.v_row((t), 32 + sr) + sc); \
        K0 = *(const bf16x8*)(P.k_row(0, (t), k64r) + k64c); K1 = *(const bf16x8*)(P.k_row(1, (t), k64r) + k64c); } while (0)
#define B3_WRITE(V0, V1, K0, K1, b, vs_) do { *(LAS bf16x8*)(V_lds + (vs_) * VB + vst0) = V0; *(LAS bf16x8*)(V_lds + (vs_) * VB + vst1) = V1; \
        *(LAS bf16x8*)(lds + K0OFF + (b) * KB + kst) = K0; *(LAS bf16x8*)(lds + K1OFF + (b) * KB + kst) = K1; } while (0)
#if defined(B3_PRIO) && B3_PRIO == 1
#define B3_P1() do { __builtin_amdgcn_s_setprio(1); ATT_SBAR(); } while (0)
#define B3_P0() do { ATT_SBAR(); __builtin_amdgcn_s_setprio(0); } while (0)
#else
#define B3_P1() do { } while (0)
#define B3_P0() do { } while (0)
#endif
#define B3_QS(KOFF_, QO_, m_, l_, o_, b, A0, A1, A2, A3) do { f32x16 p0, p1; float mn, alpha; \
        B3_P1(); qkt64_ldsq(p0, p1, lds + (KOFF_) + (b) * KB, qb_l + (QO_), r32, hi); B3_P0(); \
        partialSM(p0, p1, m_, mn, alpha, C, thr_raw); \
        if (__any(alpha < 1.f)) { if (hi == 0) al_l[r32] = alpha; asm volatile("s_waitcnt lgkmcnt(0)" ::: "memory"); \
            _Pragma("unroll") for (int d = 0; d < 4; ++d) _Pragma("unroll") for (int r = 0; r < 16; ++r) o_[d][r] *= al_l[crow(r, hi)]; } \
        finishSM(p0, p1, alpha, l_, A0, A1, A2, A3); ATT_SBAR(); } while (0)
#define B3_PV(o_, vs_, A0, A1, A2, A3) do { B3_P1(); pv_d0(o_, vb0 + (vs_) * VB, A0, A1, A2, A3); B3_P0(); } while (0)
#define B3_MAP(KOFF_, QO_, m_, l_, o_, b, vs_) do { bf16x8 pa0, pa1, pa2, pa3; B3_QS(KOFF_, QO_, m_, l_, o_, b, pa0, pa1, pa2, pa3); B3_PV(o_, vs_, pa0, pa1, pa2, pa3); } while (0)
    const int NT = P.ntiles();
    const bool young = wid >= 4;
    bf16x8 c0 = {}, c1 = {}, c2 = {}, c3 = {};
    int vs = 0, vprev = 0;
#if defined(STAMP_SEL)
    unsigned long long sa0 = 0, sa1 = 0, sr0 = 0, sr1 = 0; if (stamp_) { sa0 = __builtin_amdgcn_s_memtime(); sr0 = __builtin_amdgcn_s_memrealtime(); }
#endif
    B3_LOAD(aV0, aV1, aK0, aK1, 0);
    for (int t = 0; t < NT; ++t) {
        const int b = t & 1;
        B3_WRITE(aV0, aV1, aK0, aK1, b, vs);
        __syncthreads();
        if (t + 1 < NT) B3_LOAD(aV0, aV1, aK0, aK1, t + 1);
        if (young && t > 0) B3_PV(o1, vprev, c0, c1, c2, c3);
        B3_MAP(K0OFF, 0, m0, l0, o0, b, vs);
        B3_QS(K1OFF, 4096, m1, l1, o1, b, c0, c1, c2, c3);
        if (!young) B3_PV(o1, vs, c0, c1, c2, c3);
        vprev = vs; vs = (vs == 2) ? 0 : vs + 1;
    }
    if (young) B3_PV(o1, vprev, c0, c1, c2, c3);
#if defined(STAMP_SEL)
    if (stamp_ && wid == STAMP_WAVE) { sa1 = __builtin_amdgcn_s_memtime(); sr1 = __builtin_amdgcn_s_memrealtime(); if (lane == 0) { stamp_[10] = sa0; stamp_[12] = sa1; stamp_[13] = sa1; stamp_[14] = sr0; stamp_[15] = sr1; } }
#endif
#undef B3_LOAD
#undef B3_WRITE
#undef B3_MAP
#undef B3_QS
#undef B3_PV
#undef B3_P1
#undef B3_P0
    if (hi == 0) { li_l[r32] = l0; al_l[r32] = l1; }
    asm volatile("s_waitcnt lgkmcnt(0)" ::: "memory");
    P.finish2(o0, o1, li_l, al_l, wid, r32, hi);
    __syncthreads();
}

template <class RowFn>
__device__ __forceinline__ void store_o_i8(const f32x16* o, const LAS float* li_l, int wid, int r32, int hi, float qo, const RowFn& orow) {
#pragma unroll
    for (int r = 0; r < 16; ++r) { const int i = crow(r, hi); const float inv = __builtin_amdgcn_rcpf(li_l[i]) * qo; unsigned char* p = orow(wid * 32 + i) + r32;
#pragma unroll
        for (int d0 = 0; d0 < 4; ++d0) { int q = (int)__builtin_rintf(o[d0][r] * inv); q = q < -127 ? -127 : (q > 127 ? 127 : q); p[d0 * 32] = (unsigned char)q; } }
}
template <class RowFn>
__device__ __forceinline__ void store_o_bf16(const f32x16* o, const LAS float* li_l, int wid, int r32, int hi, const RowFn& orow) {
#pragma unroll
    for (int r = 0; r < 16; ++r) { const int i = crow(r, hi); const float inv = __builtin_amdgcn_rcpf(li_l[i]); bf16_t* p = orow(wid * 32 + i) + r32;
#pragma unroll
        for (int d0 = 0; d0 < 4; ++d0) p[d0 * 32] = (bf16_t)(cvtpk(o[d0][r] * inv, 0.f) & 0xffffu); }
}
struct PolA {
    static constexpr float SCALE = 0.08838834764831845f;
    const bf16_t* proj; unsigned char* ag; float* lse;
    int b, hh, j, r, L, qb, tlo, nt;
    __device__ __forceinline__ const bf16_t* tok(int pos) const { return proj + (size_t)(b * SEQ + pos) * PROJ_PITCH; }
    __device__ __forceinline__ const bf16_t* q_row(int i) const { return tok(j + r * (qb * 256 + i)) + OFF_QA + hh * 128; }
    __device__ __forceinline__ int ntiles() const { return nt; }
    __device__ __forceinline__ int kidx(int t, int kk) const { int ki = qb * 256 - 64 + 64 * (t + tlo) + kk; ki = ki < 0 ? 0 : (ki > L - 1 ? L - 1 : ki); return j + r * ki; }
    __device__ __forceinline__ const bf16_t* k_row(int t, int kk) const { return tok(kidx(t, kk)) + OFF_KA + hh * 128; }
    __device__ __forceinline__ const bf16_t* v_row(int t, int kk) const { return tok(kidx(t, kk)) + OFF_VA + hh * 128; }
    __device__ __forceinline__ bool wave_needs(int t, int wid) const { const int kbase = qb * 256 - 64 + 64 * (t + tlo), q0 = qb * 256 + wid * 32; return kbase <= q0 + 95 && kbase + 63 >= q0 - 64; }
    __device__ __forceinline__ void mask(f32x16& p0, f32x16& p1, int t, int wid, int r32, int hi, LAS char*) const {
        const int qi = qb * 256 + wid * 32 + r32; const int lo = qi - 64 < 0 ? 0 : qi - 64, hi_ = qi + 64 > L - 1 ? L - 1 : qi + 64;
        const unsigned span = (unsigned)(hi_ - lo); const int t0 = qb * 256 - 64 + 64 * (t + tlo) + 4 * hi - lo;
#pragma unroll
        for (int r = 0; r < 16; ++r) { const int kk = (r & 3) + 8 * (r >> 2);
            p0[r] = ((unsigned)(t0 + kk) <= span) ? p0[r] : NEG; p1[r] = ((unsigned)(t0 + kk + 32) <= span) ? p1[r] : NEG; }
    }
    __device__ __forceinline__ float m0w(int) const { return M0; }
    __device__ __forceinline__ float l0() const { return 0.f; }
    __device__ __forceinline__ void finish(const f32x16* o, float m_reg, float l_reg, const LAS float* li_l, int wid, int r32, int hi) const {
        const int h6 = hh % 6;
        store_o_i8(o, li_l, wid, r32, hi, QO, [&](int i) { return ag + (size_t)(b * SEQ + j + r * (qb * 256 + i)) * 768 + h6 * 128; });
        if (hi == 0) lse[(size_t)(b * SEQ + j + r * (qb * 256 + wid * 32 + r32)) * 6 + h6] = m_reg * SCALE + __logf(l_reg);
    }
};
struct PolC2 {
    static constexpr float SCALE = 0.08838834764831845f;
    const bf16_t* proj; unsigned char* oc; const float* sinkp; int b, kvh, qb;
    __device__ __forceinline__ const bf16_t* tok(int pos) const { return proj + (size_t)(b * SEQ + pos) * PROJ_PITCH; }
    __device__ __forceinline__ const bf16_t* q_row(int i) const { return tok(qb * 64 + (i & 63)) + OFF_QC + (kvh * 4 + (i >> 6)) * 128; }
    __device__ __forceinline__ int ntiles() const { return 5; }
    __device__ __forceinline__ int kpos(int t, int kk) const { int k = qb * 64 - 128 + 64 * t + kk; return k < 0 ? 0 : (k > SEQ - 1 ? SEQ - 1 : k); }
    __device__ __forceinline__ const bf16_t* k_row(int t, int kk) const { return tok(kpos(t, kk)) + OFF_KC + kvh * 128; }
    __device__ __forceinline__ const bf16_t* v_row(int t, int kk) const { return tok(kpos(t, kk)) + OFF_VC + kvh * 128; }
    __device__ __forceinline__ bool wave_needs(int t, int) const { const int kbase = qb * 64 - 128 + 64 * t; return kbase + 63 >= 0 && kbase < SEQ; }
    __device__ __forceinline__ void mask(f32x16& p0, f32x16& p1, int t, int wid, int r32, int hi, LAS char*) const {
        const int qi = qb * 64 + (wid & 1) * 32 + r32; const int lo = qi - 128 < 0 ? 0 : qi - 128, hi_ = qi + 128 > SEQ - 1 ? SEQ - 1 : qi + 128;
        const unsigned span = (unsigned)(hi_ - lo); const int t0 = qb * 64 - 128 + 64 * t + 4 * hi - lo;
#pragma unroll
        for (int r = 0; r < 16; ++r) { const int kk = (r & 3) + 8 * (r >> 2);
            p0[r] = ((unsigned)(t0 + kk) <= span) ? p0[r] : NEG; p1[r] = ((unsigned)(t0 + kk + 32) <= span) ? p1[r] : NEG; }
    }
    __device__ __forceinline__ float m0w(int wid) const { return sinkp[kvh * 4 + (wid >> 1)] * (1.0f / SCALE); }
    __device__ __forceinline__ float l0() const { return 1.f; }
    __device__ __forceinline__ void finish(const f32x16* o, float, float, const LAS float* li_l, int wid, int r32, int hi) const {
        store_o_i8(o, li_l, wid, r32, hi, QO, [&](int i) { return oc + (size_t)(b * SEQ + qb * 64 + (i & 63)) * 1024 + (kvh * 4 + (i >> 6)) * 128; });
    }
};
struct PolD {
    static constexpr float SCALE = 0.08838834764831845f;
    const bf16_t* proj; unsigned char* od; int b, h, rb, lo, nt;
    __device__ __forceinline__ const bf16_t* tok(int pos) const { return proj + (size_t)(b * SEQ + pos) * PROJ_PITCH; }
    __device__ __forceinline__ const bf16_t* q_row(int i) const { return tok(rb * 256 + i) + OFF_QD + h * 128; }
    __device__ __forceinline__ int ntiles() const { return nt; }
    __device__ __forceinline__ const bf16_t* k_row(int t, int kk) const { return tok((lo + t) * 64 + kk) + OFF_KD + h * 128; }
    __device__ __forceinline__ const bf16_t* v_row(int t, int kk) const { return tok((lo + t) * 64 + kk) + OFF_VD + h * 128; }
    __device__ __forceinline__ bool wave_needs(int t, int wid) const { const int qr_ = rb * 4 + (wid >> 1); int rs = qr_ - 4; rs = rs < 0 ? 0 : (rs > 56 ? 56 : rs); const int kr = lo + t; return kr >= rs && kr < rs + 8; }
    __device__ __forceinline__ void mask(f32x16& p0, f32x16& p1, int t, int wid, int r32, int hi, LAS char* lds) const {
        const int qr_ = rb * 4 + (wid >> 1), qc = 32 * (wid & 1) + r32, kr = lo + t; int cs = qc - 8; cs = cs < 0 ? 0 : (cs > 48 ? 48 : cs);
        const LAS float* T = (const LAS float*)(lds + TABOFF) + (kr - qr_ + 7) * 31 + 15 - qc + 4 * hi; const int kc0 = 4 * hi - cs;
#pragma unroll
        for (int r = 0; r < 16; ++r) { const int kk = (r & 3) + 8 * (r >> 2);
            const float b0 = T[kk], b1 = T[kk + 32];
            p0[r] = ((unsigned)(kc0 + kk) < 16u) ? p0[r] + b0 : NEG; p1[r] = ((unsigned)(kc0 + kk + 32) < 16u) ? p1[r] + b1 : NEG; }
    }
    __device__ __forceinline__ float m0w(int) const { return M0; }
    __device__ __forceinline__ float l0() const { return 0.f; }
    __device__ __forceinline__ void finish(const f32x16* o, float, float, const LAS float* li_l, int wid, int r32, int hi) const {
        store_o_i8(o, li_l, wid, r32, hi, QO, [&](int i) { return od + (size_t)(b * SEQ + rb * 256 + i) * 1024 + h * 128; });
    }
};
struct PolB {
    static constexpr float SCALE = 0.125f;
    const bf16_t* proj; bf16_t* ob; float* scr; const float* subln; const float* lam; float lambda_init; int b, h, qb, map;
#if defined(STAMP_SEL)
    unsigned long long* stamp;
#endif
    __device__ __forceinline__ const bf16_t* tok(int pos) const { return proj + (size_t)(b * SEQ + pos) * PROJ_PITCH; }
    __device__ __forceinline__ const bf16_t* q_row(int i) const { return tok(qb * 256 + i) + OFF_QB + (2 * h + map) * 64; }
    __device__ __forceinline__ int ntiles() const { return SEQ / 64; }
    __device__ __forceinline__ const bf16_t* k_row(int t, int kk) const { return tok(64 * t + kk) + OFF_KB + (2 * h + map) * 64; }
    __device__ __forceinline__ const bf16_t* v_row(int t, int kk) const { return tok(64 * t + kk) + OFF_VB + h * 128; }
    __device__ __forceinline__ bool wave_needs(int, int) const { return true; }
    __device__ __forceinline__ void mask(f32x16&, f32x16&, int, int, int, int, LAS char*) const {}
    __device__ __forceinline__ float m0w(int) const { return M0; }
    __device__ __forceinline__ float l0() const { return 0.f; }
    __device__ __forceinline__ void finish(const f32x16* o, float, float, const LAS float* li_l, int wid, int r32, int hi) const {
        if (map == 0) {
#pragma unroll
            for (int r = 0; r < 16; ++r) { const int i = crow(r, hi); const float inv = __builtin_amdgcn_rcpf(li_l[i]); float* p = scr + (size_t)(wid * 32 + i) * 128 + r32;
#pragma unroll
                for (int d0 = 0; d0 < 4; ++d0) p[d0 * 32] = o[d0][r] * inv; }
        } else {
            const int ln_ = r32 + 32 * hi; const float d01 = wave_sum(lam[ln_] * lam[64 + ln_]), d23 = wave_sum(lam[128 + ln_] * lam[192 + ln_]);
            const float lmbda = __expf(d01) - __expf(d23) + lambda_init, oscale = 1.0f - lambda_init;
            float sw[4];
#pragma unroll
            for (int d0 = 0; d0 < 4; ++d0) sw[d0] = subln[d0 * 32 + r32] * oscale;
#pragma unroll
            for (int r = 0; r < 16; ++r) { const int i = crow(r, hi); const float inv = __builtin_amdgcn_rcpf(li_l[i]); const float* p = scr + (size_t)(wid * 32 + i) * 128 + r32;
                float v[4]; float ss = 0.f;
#pragma unroll
                for (int d0 = 0; d0 < 4; ++d0) { v[d0] = p[d0 * 32] - lmbda * (o[d0][r] * inv); ss += v[d0] * v[d0]; }
#pragma unroll
                for (int s = 1; s < 32; s <<= 1) ss += __shfl_xor(ss, s);
                const float rinv = rsqrtf(ss * (1.0f / 128.0f) + SUBLN_EPS);
                bf16_t* q = ob + (size_t)(b * SEQ + qb * 256 + wid * 32 + i) * 1024 + h * 128 + r32;
#pragma unroll
                for (int d0 = 0; d0 < 4; ++d0) q[d0 * 32] = (bf16_t)(cvtpk(v[d0] * rinv * sw[d0], 0.f) & 0xffffu); }
        }
    }
};

struct PolB2 {
    static constexpr float SCALE = 0.125f;
    const bf16_t* proj; unsigned char* ob; const float* subln; const float* lam; float lambda_init; int b, h, qb;
    __device__ __forceinline__ const bf16_t* tok(int pos) const { return proj + (size_t)(b * SEQ + pos) * PROJ_PITCH; }
    __device__ __forceinline__ const bf16_t* q_row(int mp, int i) const { return tok(qb * 256 + i) + OFF_QB + (2 * h + mp) * 64; }
    __device__ __forceinline__ int ntiles() const { return SEQ / 64; }
    __device__ __forceinline__ const bf16_t* k_row(int mp, int t, int kk) const { return tok(64 * t + kk) + OFF_KB + (2 * h + mp) * 64; }
    __device__ __forceinline__ const bf16_t* v_row(int t, int kk) const { return tok(64 * t + kk) + OFF_VB + h * 128; }
    __device__ __forceinline__ void finish2(const f32x16* o0, const f32x16* o1, const LAS float* l0_l, const LAS float* l1_l, int wid, int r32, int hi) const {
        const int ln_ = r32 + 32 * hi; const float d01 = wave_sum(lam[ln_] * lam[64 + ln_]), d23 = wave_sum(lam[128 + ln_] * lam[192 + ln_]);
        const float lmbda = __expf(d01) - __expf(d23) + lambda_init;
        float sw[4];
#pragma unroll
        for (int d0 = 0; d0 < 4; ++d0) sw[d0] = subln[d0 * 32 + r32] * QX;
#pragma unroll
        for (int r = 0; r < 16; ++r) { const int i = crow(r, hi); const float inv0 = __builtin_amdgcn_rcpf(l0_l[i]), inv1 = lmbda * __builtin_amdgcn_rcpf(l1_l[i]);
            float v[4]; float ss = 0.f;
#pragma unroll
            for (int d0 = 0; d0 < 4; ++d0) { v[d0] = o0[d0][r] * inv0 - o1[d0][r] * inv1; ss += v[d0] * v[d0]; }
#pragma unroll
            for (int s = 1; s < 32; s <<= 1) ss += __shfl_xor(ss, s);
            const float rinv = rsqrtf(ss * (1.0f / 128.0f) + SUBLN_EPS);
            unsigned char* q = ob + (size_t)(b * SEQ + qb * 256 + wid * 32 + i) * 1024 + h * 128 + r32;
#pragma unroll
            for (int d0 = 0; d0 < 4; ++d0) { int t = (int)__builtin_rintf(v[d0] * rinv * sw[d0]); t = t < -127 ? -127 : (t > 127 ? 127 : t); q[d0 * 32] = (unsigned char)t; } }
    }
};

#ifndef ATT_MASK
#define ATT_MASK 15
#endif
#define ATT_ON(k) ((ATT_MASK >> (k)) & 1)
#ifndef ATT_REP
#define ATT_REP 0
#endif
#define ATT_NREP(k) (((ATT_REP >> (k)) & 1) ? 2 : 1)
struct Ptrs { const bf16_t* proj; bf16_t* ag; float* lse; unsigned char* ob; unsigned char* oc; unsigned char* od; const float* lam; const float* subln; const float* sink; const float* rpb; float lambda_init;
#if defined(STAMP_SEL)
    unsigned long long* stamp;
#endif
};
__device__ __forceinline__ void attn_phase(const Ptrs& X, LAS char* lds, const int tid, const int vcu, const int G, const int wgid) {
    const int lane = tid & 63;
    if (ATT_ON(0)) for (int rep = 0; rep < ATT_NREP(0); ++rep) {
        for (int u = vcu; u < 512; u += G) {
            PolB2 P{X.proj, X.ob, X.subln, X.lam, X.lambda_init, u >> 7, (u >> 4) & 7, u & 15};
#if defined(STAMP_SEL)
            attn_unit_b3<PolB2>(P, lds, tid, (wgid == STAMP_WG && u == vcu && rep == 0) ? X.stamp : nullptr);
#else
            attn_unit_b3<PolB2>(P, lds, tid);
#endif
        }
    }
    if (ATT_ON(1)) for (int rep = 0; rep < ATT_NREP(1); ++rep) for (int u = vcu; u < 512; u += G) {
        const int rb = u & 15, h = (u >> 4) & 7, b = u >> 7; int lo = rb * 4 - 4; lo = lo < 0 ? 0 : (lo > 56 ? 56 : lo); int hi_ = rb * 4 + 3 - 4; hi_ = hi_ < 0 ? 0 : (hi_ > 56 ? 56 : hi_); hi_ += 7;
        { LAS float* T = (LAS float*)(lds + TABOFF); for (int i = tid; i < 465; i += 512) T[i] = X.rpb[h * 465 + i] * (1.0f / PolD::SCALE); }
        PolD P{X.proj, X.od, b, h, rb, lo, hi_ - lo + 1};
        attn_unit<128, PolD>(P, lds, tid);
    }
    if (ATT_ON(2)) for (int rep = 0; rep < ATT_NREP(2); ++rep) for (int u = vcu; u < 512; u += G) {
        const int qb = u & 63, kvh = (u >> 6) & 1, b = u >> 7;
        PolC2 P{X.proj, X.oc, X.sink, b, kvh, qb};
        attn_unit<128, PolC2>(P, lds, tid);
    }
    if (ATT_ON(3)) for (int rep = 0; rep < ATT_NREP(3); ++rep) for (int u = vcu; u < 1152; u += G) {
        const int g = u / 384, v = u % 384, w16 = v & 15, bh = v >> 4, h6 = bh % 6, b = bh / 6;
        const int r = g == 0 ? 1 : (g == 1 ? 4 : 16), L = SEQ / r;
        const int qb = w16 / r, tlo = qb == 0 ? 1 : 0; int thi = (L - qb * 256 + 64 + 63) / 64; thi = thi > 6 ? 6 : thi;
        PolA P{X.proj, (unsigned char*)X.ag + (size_t)g * MTOK * 768, X.lse + (size_t)g * MTOK * 6, b, g * 6 + h6, w16 % r, r, L, qb, tlo, thi - tlo};
        attn_unit<128, PolA>(P, lds, tid);
    }
}
#undef ATT_SBAR
}

struct InPtrs { const float *x, *w_in, *b_gate, *w_branch, *w_out, *diff_lambda, *diff_subln, *sink_logit, *na_rpb, *w_router, *w_exp_gate, *w_exp_up, *w_exp_down, *ln_gain, *ln_bias; };

__device__ __forceinline__ void prologue_phase(const InPtrs& I, unsigned char* ws, LAS unsigned char* lds, int gw, int NGW, int wave, int lane) {
    LAS unsigned char* scr = lds + wave * 9216;
    { const f32x4* xs = (const f32x4*)I.x;
      for (size_t i = (size_t)gw * 64 + lane; i < (size_t)MTOK * DM / 8; i += (size_t)NGW * 64) {
          const f32x4 a = xs[2 * i], b = xs[2 * i + 1];
          u32x2 q; q.x = q8x4(a[0], a[1], a[2], a[3], QX); q.y = q8x4(b[0], b[1], b[2], b[3], QX); ((u32x2*)(ws + WS_X8))[i] = q; } }
    { float* r128 = (float*)(ws + WS_ROPE128); float* r64 = (float*)(ws + WS_ROPE64);
      for (int i = gw * 64 + lane; i < SEQ * 64 + SEQ * 32; i += NGW * 64) {
          int pos, ii, half; float* dst;
          if (i < SEQ * 64) { pos = i >> 6; ii = i & 63; half = 64; dst = r128 + 2 * (size_t)i; } else { const int k = i - SEQ * 64; pos = k >> 5; ii = k & 31; half = 32; dst = r64 + 2 * (size_t)k; }
          const float inv = (float)pow(10000.0, -(double)ii / (double)half); const float ang = (float)pos * inv;
          dst[0] = (float)cos((double)ang); dst[1] = (float)sin((double)ang); } }
    bf16_t* WIN = (bf16_t*)(ws + WS_WIN); bf16_t* WOUT = (bf16_t*)(ws + WS_WOUT); bf16_t* WGU = (bf16_t*)(ws + WS_WGU); bf16_t* WDN = (bf16_t*)(ws + WS_WDN);
    constexpr int N1 = DEPTH * 32 * 356, N2 = DEPTH * 60 * 32, N3 = DEPTH * 32 * 32, N4 = DEPTH * NEXP * 32 * 32, N5 = DEPTH * NEXP * 16 * 32;
    for (int it = gw; it < N1 + N2 + N3 + N4 + N5; it += NGW) {
        int r = it;
        if (r < N1) { const int sub = r & 15, grp = r >> 4; const int nb = (grp % 89) * 4 + (sub & 3), kb = ((grp / 89) & 7) * 4 + (sub >> 2), l = grp / (89 * 8); const int n = nb * 64 + lane;
            const int c0 = nb * 64;
            if (c0 >= 14592) tr_item8(I.w_in + (size_t)l * DM * IN_TOTAL, IN_TOTAL, n, kb * 64, (unsigned char*)(ws + WS_W8G) + ((size_t)l * 8192 + (c0 - 14592)) * DM + kb * 64, DM, QWG, scr, lane);
            else { const bool isv = (c0 >= 4608 && c0 < 6912) || (c0 >= 8960 && c0 < 9984) || (c0 >= 11264 && c0 < 11520) || (c0 >= 13568);
                tr_item8(I.w_in + (size_t)l * DM * IN_TOTAL, IN_TOTAL, win_src_col(n), kb * 64, (unsigned char*)(ws + WS_W8Q) + ((size_t)l * 14592 + c0) * DM + kb * 64, DM, isv ? QWU : QWG, scr, lane); }
            continue; }
        r -= N1;
        if (r < N2) { const int nb = r % 32, kbg = (r / 32) % 60, l = r / (32 * 60); const int n = nb * 64 + lane;
            int ro, Kb, kb; if (kbg < 12) { ro = 0; Kb = 768; kb = kbg; } else { const int q = (kbg - 12) >> 4; ro = 768 + 1024 * q; Kb = 1024; kb = (kbg - 12) & 15; }
            const int brn = kbg < 12 ? 0 : 1 + ((kbg - 12) >> 4); (void)Kb;
            tr_item8(I.w_branch + ((size_t)l * BR_TOTAL + ro) * DM, DM, n, kb * 64, (unsigned char*)(ws + WS_W8BR) + ((size_t)(l * 4 + brn) * DM + nb * 64) * 1024 + kb * 64, 1024, brn == 0 ? QWBA : QWBC, scr, lane);
            continue; }
        r -= N2;
        if (r < N3) { const int nb = r % 32, kb = (r / 32) % 32, l = r / (32 * 32); const int n = nb * 64 + lane;
            tr_item8(I.w_out + (size_t)l * DM * DM, DM, n, kb * 64, (unsigned char*)WOUT + ((size_t)l * DM + nb * 64) * DM + kb * 64, DM, QWU, scr, lane); continue; }
        r -= N3;
        if (r < N4) { const int sub = r & 15, grp = r >> 4; const int nb = (grp & 7) * 4 + (sub & 3), kb = ((grp >> 3) & 7) * 4 + (sub >> 2), le = grp >> 6; const int n = nb * 64 + lane, pn = n >> 8, bj = (n >> 7) & 1, jj = n & 127;
            tr_item8((bj ? I.w_exp_up : I.w_exp_gate) + (size_t)le * DM * DEXP, DEXP, pn * 128 + jj, kb * 64, (unsigned char*)WGU + ((size_t)le * 2048 + nb * 64) * DM + kb * 64, DM, bj ? QWU : QWG, scr, lane); continue; }
        r -= N4;
        { const int sub = r & 15, grp = r >> 4; const int nb = (grp & 7) * 4 + (sub & 3), kb = ((grp >> 3) & 3) * 4 + (sub >> 2), le = grp >> 5; const int n = nb * 64 + lane;
            tr_item8(I.w_exp_down + (size_t)le * DEXP * DM, DM, n, kb * 64, (unsigned char*)WDN + ((size_t)le * DM + nb * 64) * DEXP + kb * 64, DEXP, QWD, scr, lane); }
    }
}

struct Args { const float* in[15]; float* out; unsigned char* ws; int ph_lo, ph_hi; };
__global__ void __launch_bounds__(NWAVES * 64, LB_WAVES) fwd(Args args) {
    extern __shared__ __attribute__((aligned(16))) unsigned char lds_raw[];
    LAS unsigned char* lds = (LAS unsigned char*)lds_raw;
    for (int u = threadIdx.x; u < (LDS_BYTES - LDSCTL_OFF) / 4; u += NWAVES * 64) ((LAS unsigned*)(lds + LDSCTL_OFF))[u] = 0u;
    __syncthreads();
    unsigned* ctl = (unsigned*)(args.ws + WS_CTL);
    XcdBarrier bar = xcd_barrier_post(ctl + CW_BAR, (volatile LAS unsigned*)(lds + LDSCTL_OFF));
    const int lo = args.ph_lo, hi = args.ph_hi;
#ifndef SCALAR_ATTN
#define SCALAR_ATTN 0
#endif
#ifndef REP_MASK
#define REP_MASK 0
#endif
#define NREP(k) (((REP_MASK >> (k)) & 1) ? 2 : 1)
#ifndef PH_MASK
#define PH_MASK 0xFFFF
#endif
#define PHON(k) ((PH_MASK >> (k)) & 1)
#define IN(k) (lo <= (k) && (k) < hi)
#define PHASE_LOCALS long zz = 0; asm volatile("" : "+s"(zz)); unsigned char* const ws = args.ws + zz; int tid = threadIdx.x; asm volatile("" : "+v"(tid)); int bx = blockIdx.x, G = gridDim.x; asm volatile("" : "+s"(bx), "+s"(G)); \
    const int lane = tid & 63, wave = __builtin_amdgcn_readfirstlane(tid >> 6); const int vcu = (G % 8 == 0) ? (bx % 8) * (G / 8) + bx / 8 : bx; \
    const int gw = vcu * NWAVES + wave, NGW = G * NWAVES; (void)lane; (void)gw; (void)NGW
#if defined(STAMP_SEL)
#define SEAM(k) do { if (IN(k) && IN((k) + 1)) { const unsigned long long b0_ = __builtin_amdgcn_s_memrealtime(); xcd_barrier(bar); \
    if (__builtin_amdgcn_readfirstlane((int)blockIdx.x) == STAMP_WG && threadIdx.x == 0) { unsigned long long* st_ = (unsigned long long*)(args.ws + WS_CTL + 65536); st_[20] += __builtin_amdgcn_s_memrealtime() - b0_; } } } while (0)
#else
#define SEAM(k) do { if (IN(k) && IN((k) + 1)) xcd_barrier(bar); } while (0)
#endif

#define XF ((float*)(ws + WS_XF))
#define XB ((bf16_t*)(ws + WS_XB))
#define PROJ ((bf16_t*)(ws + WS_PROJ))
#define OA ((bf16_t*)(ws + WS_OA))
#define OB ((bf16_t*)(ws + WS_OB))
#define OC ((bf16_t*)(ws + WS_OC))
#define OD ((bf16_t*)(ws + WS_OD))
#define AG ((bf16_t*)(ws + WS_AG))
#define LSE ((float*)(ws + WS_LSE))
#define MIXED ((bf16_t*)(ws + WS_MIXED))
#define PRELN ((float*)(ws + WS_PRELN))
#define XG ((bf16_t*)(ws + WS_XG))
#define HB ((bf16_t*)(ws + WS_H))
#define YB ((bf16_t*)(ws + WS_Y))
#define AFF ((float*)(ws + WS_AFF))
#define IDX ((int*)(ws + WS_IDX))
#define GV ((float*)(ws + WS_GV))
#define SLOT ((int*)(ws + WS_SLOT))

    if (PHON(0) && IN(0)) for (int rep = 0; rep < NREP(0); ++rep) { PHASE_LOCALS;
        InPtrs I; I.x = args.in[0 + zz]; I.w_in = args.in[1 + zz]; I.b_gate = args.in[2 + zz]; I.w_branch = args.in[3 + zz]; I.w_out = args.in[4 + zz]; I.diff_lambda = args.in[5 + zz]; I.diff_subln = args.in[6 + zz];
        I.sink_logit = args.in[7 + zz]; I.na_rpb = args.in[8 + zz]; I.w_router = args.in[9 + zz]; I.w_exp_gate = args.in[10 + zz]; I.w_exp_up = args.in[11 + zz]; I.w_exp_down = args.in[12 + zz]; I.ln_gain = args.in[13 + zz]; I.ln_bias = args.in[14 + zz];
        prologue_phase(I, ws, lds, gw, NGW, wave, lane); if (rep == NREP(0) - 1) SEAM(0); else xcd_barrier(bar); }

    for (int l = 0; l < DEPTH; ++l) {
        const int pb = 1 + l * NPL;
        if (PHON(1) && IN(pb + 0)) for (int rep = 0; rep < NREP(1); ++rep) { PHASE_LOCALS;
            { pg8::Gemm g{(const bf16_t*)(ws + WS_X8), (const bf16_t*)(ws + WS_W8Q + (size_t)l * 14592 * DM), MTOK, 14592, DM / 2, 0, 0, 0, nullptr STAMP_ARG(nullptr)}; pg8::StaticOrder S; S.init(MTOK, 14592, G, bx);
              pg8::EpiProjT<true> E{PROJ, (const float*)(ws + WS_ROPE128), (const float*)(ws + WS_ROPE64), 0, 1 << 30, 0, 1.0f / (QX * QWG), 1.0f / (QX * QWU)};
              pg8::gemm_phase<pg8::EpiProjT<true>, pg8::StaticOrder, true, true, false, true>(lds, g, S, E, tid); }
            { pg8::Gemm g{(const bf16_t*)(ws + WS_X8), (const bf16_t*)(ws + WS_W8G + (size_t)l * 8192 * DM), MTOK, 8192, DM / 2, 0, 0, 0, nullptr STAMP_ARG(nullptr)}; pg8::StaticOrder S; S.init(MTOK, 8192, G, bx);
              pg8::EpiGate8 E{(unsigned char*)(ws + WS_GATE), args.in[2 + zz] + (size_t)l * 8192, 1.0f / (QX * QWG)};
              int tid2 = tid; asm volatile("" : "+v"(tid2));
              pg8::gemm_phase<pg8::EpiGate8, pg8::StaticOrder, true, true, false, true>(lds, g, S, E, tid2); }
            if (rep == NREP(1) - 1) SEAM(pb + 0); else xcd_barrier(bar);
        }
        if (PHON(2) && IN(pb + 1)) for (int rep = 0; rep < NREP(2); ++rep) { PHASE_LOCALS;
            const float li = l == 0 ? 0.2f : (l == 1 ? 0.35550906759096926f : (l == 2 ? 0.47071301834358416f : 0.5560582041556405f));
#if SCALAR_ATTN
            { AttnPtrs P{PROJ, AG, LSE, nullptr, nullptr, nullptr, nullptr, nullptr, nullptr, nullptr, li}; scalar_attn_phase<0>(P, lds, gw, NGW, wave, lane); }
            { AttnPtrs P{PROJ, nullptr, nullptr, OB, nullptr, nullptr, args.in[5 + zz] + l * 256, args.in[6 + zz] + l * 128, nullptr, nullptr, li}; scalar_attn_phase<1>(P, lds, gw, NGW, wave, lane); }
            { AttnPtrs P{PROJ, nullptr, nullptr, nullptr, OC, nullptr, nullptr, nullptr, args.in[7 + zz] + l * 8, nullptr, li}; scalar_attn_phase<2>(P, lds, gw, NGW, wave, lane); }
            { AttnPtrs P{PROJ, nullptr, nullptr, nullptr, nullptr, OD, nullptr, nullptr, nullptr, args.in[8 + zz] + (size_t)l * 8 * 465, li}; scalar_attn_phase<3>(P, lds, gw, NGW, wave, lane); }
#else
            att::Ptrs X{PROJ, AG, LSE, (unsigned char*)(ws + WS_O8 + (size_t)1 * MTOK * 1024), (unsigned char*)(ws + WS_O8 + (size_t)2 * MTOK * 1024), (unsigned char*)(ws + WS_O8 + (size_t)3 * MTOK * 1024), args.in[5 + zz] + l * 256, args.in[6 + zz] + l * 128, args.in[7 + zz] + l * 8, args.in[8 + zz] + (size_t)l * 8 * 465, li STAMP_ARG((unsigned long long*)(ws + WS_CTL + 65536))};
            att::attn_phase(X, (LAS char*)lds, tid, vcu, G, bx);
#endif
            if (rep == NREP(2) - 1) SEAM(pb + 1); else xcd_barrier(bar);
        }
        if (PHON(3) && IN(pb + 2)) for (int rep = 0; rep < NREP(3); ++rep) { PHASE_LOCALS; combine_a_phase((const unsigned char*)AG, LSE, (unsigned*)(ws + WS_O8), gw, NGW, lane); if (rep == NREP(3) - 1) SEAM(pb + 2); else xcd_barrier(bar); }
        if (PHON(4) && IN(pb + 3)) for (int rep = 0; rep < NREP(4); ++rep) { PHASE_LOCALS;
            { const float one_m_li = 1.0f - (l == 0 ? 0.2f : (l == 1 ? 0.35550906759096926f : (l == 2 ? 0.47071301834358416f : 0.5560582041556405f)));
              const float qm = 127.0f / (6.0f * 0.2275f * one_m_li);
              pg8::Gemm g{(const bf16_t*)(ws + WS_O8), (const bf16_t*)(ws + WS_W8BR + (size_t)l * 4 * DM * 1024), MTOK, DM, 512, 0, (size_t)MTOK * 1024, (size_t)DM * 1024, nullptr STAMP_ARG(nullptr)}; pg8::BranchOrder4 S; S.init(MTOK, DM, G, bx);
              pg8::EpiGate4 E{MIXED, (const unsigned char*)(ws + WS_GATE), 1.0f / (QO * QWBA), one_m_li / (QX * QWBC), 1.0f / (QO * QWBC), (unsigned char*)(ws + WS_MIXED8), qm};
              pg8::gemm_phase<pg8::EpiGate4, pg8::BranchOrder4, true, true, false, true>(lds, g, S, E, tid); }
            if (rep == NREP(4) - 1) SEAM(pb + 3); else xcd_barrier(bar);
        }
        if (PHON(5) && IN(pb + 4)) for (int rep = 0; rep < NREP(5); ++rep) { PHASE_LOCALS;
            const float one_m_li = 1.0f - (l == 0 ? 0.2f : (l == 1 ? 0.35550906759096926f : (l == 2 ? 0.47071301834358416f : 0.5560582041556405f)));
            const float qm = 127.0f / (6.0f * 0.2275f * one_m_li);
            pg8::Gemm g{(const bf16_t*)(ws + WS_MIXED8), (const bf16_t*)(ws + WS_WOUT + (size_t)l * DM * DM), MTOK, DM, DM / 2, 0, 0, 0, nullptr STAMP_ARG(nullptr)}; pg8::StaticOrder S; S.init(MTOK, DM, G, bx);
            pg8::EpiResid E{(bf16_t*)PRELN, l == 0 ? args.in[0 + zz] : (const float*)nullptr, (const bf16_t*)XF, ALPHA, 1.0f / (qm * QWU)};
            pg8::gemm_phase<pg8::EpiResid, pg8::StaticOrder, true, true, false, true>(lds, g, S, E, tid);
            if (rep == NREP(5) - 1) SEAM(pb + 4); else xcd_barrier(bar);
        }
        if (PHON(6) && IN(pb + 5)) for (int rep = 0; rep < NREP(6); ++rep) { PHASE_LOCALS; ln1_router_phase((const bf16_t*)PRELN, args.in[13 + zz] + (size_t)(l * 2) * DM, args.in[14 + zz] + (size_t)(l * 2) * DM, args.in[9 + zz] + (size_t)l * DM * NEXP, (float*)(ws + WS_STATS), (unsigned*)(ws + WS_X8), AFF, lds, tid, gw, NGW, lane); if (rep == NREP(6) - 1) SEAM(pb + 5); else xcd_barrier(bar); }
        if (PHON(7) && IN(pb + 6)) for (int rep = 0; rep < NREP(7); ++rep) { PHASE_LOCALS; topk_phase(AFF, IDX, GV, SLOT, lds, tid, wave, lane, bx, G); if (rep == NREP(7) - 1) SEAM(pb + 6); else xcd_barrier(bar); }
        if (PHON(9) && IN(pb + 7)) for (int rep = 0; rep < NREP(9); ++rep) { PHASE_LOCALS;
            pg8::Gemm g{(const bf16_t*)(ws + WS_X8), (const bf16_t*)(ws + WS_WGU + (size_t)l * NEXP * 2048 * DM), NGRP * CAP, 2048, DM / 2, (size_t)2048 * DM, 0, 0, IDX STAMP_ARG(nullptr)};
            pg8::StaticOrder S; S.init(NGRP * CAP, 2048, G, bx);
            pg8::EpiSwiGLU E{(unsigned char*)(ws + WS_H), 1.0f / (QX * QWG), 1.0f / (QX * QWU), QH};
            pg8::gemm_phase<pg8::EpiSwiGLU, pg8::StaticOrder, true, true, true, true>(lds, g, S, E, tid);
            if (rep == NREP(9) - 1) SEAM(pb + 7); else xcd_barrier(bar);
        }
        if (PHON(10) && IN(pb + 8)) for (int rep = 0; rep < NREP(10); ++rep) { PHASE_LOCALS;
            pg8::Gemm g{(const bf16_t*)(ws + WS_H), (const bf16_t*)(ws + WS_WDN + (size_t)l * NEXP * DM * DEXP), NGRP * CAP, DM, DEXP / 2, (size_t)DM * DEXP, 0, 0, nullptr STAMP_ARG(nullptr)};
            pg8::StaticOrder S; S.init(NGRP * CAP, DM, G, bx);
            pg8::EpiDown E{(unsigned char*)YB, QY / (QH * QWD)};
            pg8::gemm_phase<pg8::EpiDown, pg8::StaticOrder, true, true, false, true>(lds, g, S, E, tid);
            if (rep == NREP(10) - 1) SEAM(pb + 8); else xcd_barrier(bar);
        }
        if (PHON(11) && IN(pb + 9)) for (int rep = 0; rep < NREP(11); ++rep) { PHASE_LOCALS;
            if (NREP(11) == 2 && rep == 0) ln2_phase((const bf16_t*)PRELN, (const float*)(ws + WS_STATS), args.in[13 + zz] + (size_t)(l * 2) * DM, args.in[14 + zz] + (size_t)(l * 2) * DM, (const unsigned char*)YB, GV, SLOT, args.in[13 + zz] + (size_t)(l * 2 + 1) * DM, args.in[14 + zz] + (size_t)(l * 2 + 1) * DM, (float*)(ws + WS_O8), (bf16_t*)(ws + WS_O8), MIXED, (unsigned char*)(ws + WS_AG), gw, NGW, lane); else
            ln2_phase((const bf16_t*)PRELN, (const float*)(ws + WS_STATS), args.in[13 + zz] + (size_t)(l * 2) * DM, args.in[14 + zz] + (size_t)(l * 2) * DM, (const unsigned char*)YB, GV, SLOT, args.in[13 + zz] + (size_t)(l * 2 + 1) * DM, args.in[14 + zz] + (size_t)(l * 2 + 1) * DM, (l == DEPTH - 1) ? args.out : XF, (bf16_t*)XF, XB, (l == DEPTH - 1) ? (unsigned char*)nullptr : (unsigned char*)(ws + WS_X8), gw, NGW, lane);
            if (rep == NREP(11) - 1) SEAM(pb + 9); else xcd_barrier(bar);
#if defined(PROBE_XBAR)
            for (int xb_ = 0; xb_ < PROBE_XBAR; ++xb_) xcd_barrier(bar);
#endif
#if defined(STAMP_SEL)
            if (l == DEPTH - 1 && bx == STAMP_WG && tid == 0) { asm volatile("s_waitcnt vmcnt(0)" ::: "memory");
                const unsigned long long* st = (const unsigned long long*)(ws + WS_CTL + 65536);
                float val = 0.f;
                if (STAMP_SEL == 1) val = (float)(st[1] - st[0]) * (1.0f / 32.0f);
                if (STAMP_SEL == 2) val = (float)(st[2] - st[1]);
                if (STAMP_SEL == 3) val = (float)(st[2] - st[0]) / ((float)(st[4] - st[3]) * 0.01f);
                if (STAMP_SEL == 4) val = (float)(st[12] - st[10]) * (1.0f / 63.0f);
                if (STAMP_SEL == 5) val = (float)(st[13] - st[12]);
                if (STAMP_SEL == 7) val = (float)st[20] * 0.01f;
                if (STAMP_SEL == 6) val = (float)(st[12] - st[10]) / ((float)(st[15] - st[14]) * 0.01f);
                const unsigned long long w0 = __builtin_amdgcn_s_memrealtime(), wt = (unsigned long long)(val * (float)STAMP_SCALE);
                while (__builtin_amdgcn_s_memrealtime() - w0 < wt) __builtin_amdgcn_s_sleep(16); }
#endif
        }
    }
#undef IN
#undef SEAM
}

#ifndef MK_ONE_LAUNCH
#define MK_ONE_LAUNCH 1
#endif
extern "C" void kernel_launch(void* const* d_in, const int* in_sizes, int n_in, void* d_out, int out_size, void* d_ws, size_t ws_size, hipStream_t stream) {
    static int grid = 0;
    if (grid == 0) {
        if (n_in != 15 || out_size != MTOK * DM || ws_size < WS_END) { fprintf(stderr, "kernel_launch: unexpected shapes (n_in %d out %d ws %zu, need ws >= %zu)\n", n_in, out_size, ws_size, (size_t)WS_END); grid = -1; return; }
        int dev = 0, cus = 0, per_cu = 0;
        if (hipGetDevice(&dev) != hipSuccess || hipDeviceGetAttribute(&cus, hipDeviceAttributeMultiprocessorCount, dev) != hipSuccess) { grid = -1; return; }
        if (hipFuncSetAttribute((const void*)fwd, hipFuncAttributeMaxDynamicSharedMemorySize, LDS_BYTES) != hipSuccess) { fprintf(stderr, "kernel_launch: hipFuncSetAttribute failed\n"); grid = -1; return; }
        if (hipOccupancyMaxActiveBlocksPerMultiprocessor(&per_cu, (const void*)fwd, NWAVES * 64, LDS_BYTES) != hipSuccess || per_cu < 1) { fprintf(stderr, "kernel_launch: occupancy query says %d\n", per_cu); }
        (void)hipGetLastError();
        grid = cus;
    }
    if (grid < 0) return;
    if (hipMemsetAsync((char*)d_ws + WS_CTL, 0, CTL_ZERO_BYTES, stream) != hipSuccess) return;
    Args a{};
    for (int i = 0; i < 15; ++i) a.in[i] = (const float*)d_in[i];
    a.out = (float*)d_out; a.ws = (unsigned char*)d_ws;
#if MK_ONE_LAUNCH
    a.ph_lo = 0; a.ph_hi = NPHASES;
    hipLaunchKernelGGL(fwd, dim3(grid), dim3(NWAVES * 64), LDS_BYTES, stream, a);
#else
    for (int p = 0; p < NPHASES; ++p) { a.ph_lo = p; a.ph_hi = p + 1; hipLaunchKernelGGL(fwd, dim3(grid), dim3(NWAVES * 64), LDS_BYTES, stream, a); }
#endif
}
```

```cpp
#include <hip/hip_runtime.h>
#include <cstdio>
#include <cstdint>
#include <cmath>
#define B3_PRIO 1
namespace pg8 {
#define PG8_LAS __attribute__((address_space(3)))
typedef unsigned short bf16_t;
typedef short bf16x8 __attribute__((ext_vector_type(8)));
typedef float f32x4 __attribute__((ext_vector_type(4)));
typedef unsigned u32x4 __attribute__((ext_vector_type(4)));
typedef unsigned u32x2 __attribute__((ext_vector_type(2)));
typedef _Float16 f16x8 __attribute__((ext_vector_type(8)));
typedef int i32x4 __attribute__((ext_vector_type(4)));
constexpr int BM = 256, BK = 64, HALF = 128, HTB = HALF * BK * 2  , STAGE_BYTES = 8 * HTB, NXCD = 8, WGM = 8;

__host__ __device__ __forceinline__ int lds_byte(int r, int c) { const int st = (r >> 4) * 2 + (c >> 5), rr = r & 15, cc = c & 31, ob = rr * 64 + cc * 2; return st * 1024 + (ob ^ (((ob >> 9) & 1) << 5)); }
__host__ __device__ __forceinline__ void stage_rc(int b, int& R, int& C) { const int st = b / 1024, sb = b % 1024, swz = sb ^ (((sb >> 9) & 1) << 5); R = (st >> 1) * 16 + swz / 64; C = (st & 1) * 32 + (swz % 64) / 2; }
__host__ __device__ __forceinline__ int perm32(int rho) { const int n = rho >> 4, i = rho & 15; return 8 * (i >> 2) + 4 * n + (i & 3); }

struct Unit { int pm, pn, br; };
struct Gemm { const bf16_t* A; const bf16_t* Bt; int M, N, K; size_t gstride; size_t a_brstride, b_brstride; const int* gidx;
#if defined(STAMP_SEL)
    unsigned long long* stamp;
#endif
};

struct StaticOrder {
    int nM, nN, nwg, G, c;
    __host__ __device__ void init(int M, int N, int G_, int c_) { nM = M / BM; nN = N / BM; nwg = nM * nN; G = G_; c = c_; }
    int skip_lo = 1 << 30, skip_hi = 0, only = -1;
    __host__ __device__ bool next(int i, Unit& u) const {
        long L = (long)i * G + c;
        if (only >= 0) { if (i != 0) return false; L = only; }
        if (L >= nwg || (L >= skip_lo && L < skip_hi && only < 0)) return false;
        int wgid = (int)L; { const int q = nwg / NXCD, r = nwg % NXCD, xcd = wgid % NXCD, off = wgid / NXCD; wgid = (xcd < r ? xcd * (q + 1) : r * (q + 1) + (xcd - r) * q) + off; }
        const int nig = WGM * nN, gid = wgid / nig, fm = gid * WGM, gsz = (nM - fm) < WGM ? (nM - fm) : WGM;
        u.pm = fm + ((wgid % nig) % gsz); u.pn = (wgid % nig) / gsz; u.br = 0; return true;
    }
    __device__ __forceinline__ int ntiles(const Unit&, int nt_full) const { return nt_full; }
    __device__ __forceinline__ void a_ready(const Unit&) const {}
    __device__ __forceinline__ void done(const Unit&) const {}
};
struct BranchOrder4 : StaticOrder {
    __device__ bool next(int i, Unit& u) const { if (!StaticOrder::next(i >> 2, u)) return false; u.br = i & 3; return true; }
    __device__ __forceinline__ int ntiles(const Unit& u, int) const { return u.br == 0 ? 6 : 8; }
};

__device__ __forceinline__ unsigned cvt_pk_bf16(float lo, float hi) { unsigned r; asm volatile("v_cvt_pk_bf16_f32 %0, %1, %2" : "=v"(r) : "v"(lo), "v"(hi)); return r; }
__device__ __forceinline__ float bflo(unsigned w) { return __uint_as_float(w << 16); }
__device__ __forceinline__ float bfhi(unsigned w) { return __uint_as_float(w & 0xffff0000u); }
typedef _Float16 h16x2 __attribute__((ext_vector_type(2)));
__device__ __forceinline__ unsigned pk_f16(float a, float b) { const h16x2 h = {(_Float16)a, (_Float16)b}; return __builtin_bit_cast(unsigned, h); }
__device__ __forceinline__ float f16lo(unsigned w) { return (float)__builtin_bit_cast(h16x2, w)[0]; }
__device__ __forceinline__ float f16hi(unsigned w) { return (float)__builtin_bit_cast(h16x2, w)[1]; }
__device__ __forceinline__ float sigmoidf_(float x) { return 1.0f / (1.0f + __expf(-x)); }
__device__ __forceinline__ unsigned q8x4e(float a, float b, float c, float d, float s) {
    const float ca = fminf(fmaxf(a * s, -127.0f), 127.0f) + 12582912.0f, cb = fminf(fmaxf(b * s, -127.0f), 127.0f) + 12582912.0f;
    const float cc = fminf(fmaxf(c * s, -127.0f), 127.0f) + 12582912.0f, cd = fminf(fmaxf(d * s, -127.0f), 127.0f) + 12582912.0f;
    const unsigned lo = __builtin_amdgcn_perm(__float_as_uint(cb), __float_as_uint(ca), 0x0c0c0400u), hi = __builtin_amdgcn_perm(__float_as_uint(cd), __float_as_uint(cc), 0x0c0c0400u);
    return __builtin_amdgcn_perm(hi, lo, 0x05040100u);
}

template <bool I8> struct EpiProjT {
    static constexpr bool PERM = true, AFTER_DRAIN = false, RMW = false;
    bf16_t* O; const float* rope128; const float* rope64; int cbase, csplit, cskip; float inv_qk, inv_v;
    __device__ __forceinline__ void operator()(const f32x4 (&acc)[2][2][4][2], const Unit& u, int wr, int wc, int fr, int fq) const {
        const int ct = u.pn * BM; const int colt = cbase + ct + (ct >= csplit ? cskip : 0);
        int mode;
        if (colt < 4608) mode = 1; else if (colt < 6912) mode = 0; else if (colt < 8960) mode = 2; else if (colt < 9984) mode = 0; else if (colt < 11264) mode = 1; else mode = 0;
        const bool isv = (colt >= 4608 && colt < 6912) || (colt >= 8960 && colt < 9984) || (colt >= 11264 && colt < 11520) || (colt >= 13568);
        const float inv = isv ? inv_v : inv_qk;
        const int row0 = u.pm * BM + wr * 64 + fr, col0 = colt + wc * 32 + 8 * fq;
        const int i128 = 16 * wc + 4 * fq, i64 = 16 * (wc & 1) + 4 * fq;
        f32x4 cs0[2][4], cs1[2][4];
        if (mode == 1 || mode == 2) {
#pragma unroll
            for (int ai = 0; ai < 2; ++ai)
#pragma unroll
                for (int m = 0; m < 4; ++m) { const int pos = (row0 + ai * HALF + m * 16) & 4095;
                    const f32x4* t = (mode == 1) ? (const f32x4*)(rope128 + ((size_t)pos * 64 + i128) * 2) : (const f32x4*)(rope64 + ((size_t)pos * 32 + i64) * 2);
                    cs0[ai][m] = t[0]; cs1[ai][m] = t[1]; }
        }
#pragma unroll
        for (int ai = 0; ai < 2; ++ai)
#pragma unroll
            for (int m = 0; m < 4; ++m) {
                const int row = row0 + ai * HALF + m * 16;
                bf16_t* rowp = O + (size_t)row * 14592 + col0;
#pragma unroll
                for (int bj = 0; bj < 2; ++bj) {
                    f32x4 v0 = acc[ai][bj][m][0], v1 = acc[ai][bj][m][1];
                    if constexpr (I8) { const i32x4 i0 = __builtin_bit_cast(i32x4, v0), i1 = __builtin_bit_cast(i32x4, v1);
                        v0 = (f32x4){(float)i0[0], (float)i0[1], (float)i0[2], (float)i0[3]} * inv; v1 = (f32x4){(float)i1[0], (float)i1[1], (float)i1[2], (float)i1[3]} * inv; }
                    if (mode == 1 || mode == 2) {
                        const f32x4 c0 = cs0[ai][m], c1 = cs1[ai][m];
                        f32x4 r0, r1;
                        r0[0] = v0[0] * c0[0] - v0[1] * c0[1]; r0[1] = v0[1] * c0[0] + v0[0] * c0[1];
                        r0[2] = v0[2] * c0[2] - v0[3] * c0[3]; r0[3] = v0[3] * c0[2] + v0[2] * c0[3];
                        r1[0] = v1[0] * c1[0] - v1[1] * c1[1]; r1[1] = v1[1] * c1[0] + v1[0] * c1[1];
                        r1[2] = v1[2] * c1[2] - v1[3] * c1[3]; r1[3] = v1[3] * c1[2] + v1[2] * c1[3];
                        v0 = r0; v1 = r1;
                    }
                    {
                        u32x4 w; w.x = cvt_pk_bf16(v0[0], v0[1]); w.y = cvt_pk_bf16(v0[2], v0[3]); w.z = cvt_pk_bf16(v1[0], v1[1]); w.w = cvt_pk_bf16(v1[2], v1[3]);
                        *(u32x4*)(rowp + bj * HALF) = w;
                    }
                }
            }
    }
};
struct EpiGate8 {
    static constexpr bool PERM = true, AFTER_DRAIN = false, RMW = false;
    unsigned char* G8; const float* bgate; float inv;
    __device__ __forceinline__ void operator()(const f32x4 (&acc)[2][2][4][2], const Unit& u, int wr, int wc, int fr, int fq) const {
        const int row0 = u.pm * BM + wr * 64 + fr, col0 = u.pn * BM + wc * 32 + 8 * fq;
        const float ninv = -inv * 1.4426950408889634f;
        f32x4 gb[2][2];
#pragma unroll
        for (int bj = 0; bj < 2; ++bj)
#pragma unroll
            for (int n = 0; n < 2; ++n) gb[bj][n] = *(const f32x4*)(bgate + col0 + bj * HALF + 4 * n) * (-1.4426950408889634f);
#pragma unroll
        for (int ai = 0; ai < 2; ++ai)
#pragma unroll
            for (int m = 0; m < 4; ++m) { unsigned char* growp = G8 + (size_t)(row0 + ai * HALF + m * 16) * 8192 + col0;
#pragma unroll
                for (int bj = 0; bj < 2; ++bj) { const i32x4 a0 = __builtin_bit_cast(i32x4, acc[ai][bj][m][0]), a1 = __builtin_bit_cast(i32x4, acc[ai][bj][m][1]);
                    unsigned q[8];
#pragma unroll
                    for (int j = 0; j < 4; ++j) {
                        const float e0 = __builtin_amdgcn_exp2f(fmaf((float)a0[j], ninv, gb[bj][0][j])), e1 = __builtin_amdgcn_exp2f(fmaf((float)a1[j], ninv, gb[bj][1][j]));
                        q[j] = __float_as_uint(__builtin_amdgcn_rcpf(fmaf(e0, 1.0f / 255.0f, 1.0f / 255.0f)) + 12582912.0f);
                        q[4 + j] = __float_as_uint(__builtin_amdgcn_rcpf(fmaf(e1, 1.0f / 255.0f, 1.0f / 255.0f)) + 12582912.0f); }
                    u32x2 wq;
                    wq.x = __builtin_amdgcn_perm(__builtin_amdgcn_perm(q[3], q[2], 0x0c0c0400u), __builtin_amdgcn_perm(q[1], q[0], 0x0c0c0400u), 0x05040100u);
                    wq.y = __builtin_amdgcn_perm(__builtin_amdgcn_perm(q[7], q[6], 0x0c0c0400u), __builtin_amdgcn_perm(q[5], q[4], 0x0c0c0400u), 0x05040100u);
                    *(u32x2*)(growp + bj * HALF) = wq; } }
    }
};
struct EpiGate4 {
    static constexpr bool PERM = true, AFTER_DRAIN = false, RMW = true;
    bf16_t* mixed; const unsigned char* gate; float inv_a, inv_b, inv_cd; unsigned char* mixed8; float qm;
    __device__ __forceinline__ void operator()(const f32x4 (&acc)[2][2][4][2], const Unit& u, int wr, int wc, int fr, int fq) const {
        const int row0 = u.pm * BM + wr * 64 + fr, col0 = u.pn * BM + wc * 32 + 8 * fq;
        const unsigned char* gate_b = gate + u.br * 2048; const bool first = u.br == 0, last = u.br == 3;
        const float sc = (inv_cd + (u.br == 0 ? 1.0f : 0.0f) * (inv_a - inv_cd) + (u.br == 1 ? 1.0f : 0.0f) * (inv_b - inv_cd)) * (1.0f / 255.0f);
#pragma unroll
        for (int ai = 0; ai < 2; ++ai) {
            u32x2 g[4][2]; u32x4 p[4][2];
#pragma unroll
            for (int m = 0; m < 4; ++m) { const int row = row0 + ai * HALF + m * 16;
#pragma unroll
                for (int bj = 0; bj < 2; ++bj) { g[m][bj] = *(const u32x2*)(gate_b + (size_t)row * 8192 + col0 + bj * HALF);
                    p[m][bj] = (u32x4){0u, 0u, 0u, 0u}; if (!first) p[m][bj] = *(const u32x4*)(mixed + (size_t)row * 2048 + col0 + bj * HALF); } }
#pragma unroll
            for (int m = 0; m < 4; ++m) { const int row = row0 + ai * HALF + m * 16; bf16_t* mp = mixed + (size_t)row * 2048 + col0;
#pragma unroll
                for (int bj = 0; bj < 2; ++bj) {
                    const u32x2 gg = g[m][bj]; const u32x4 pp = p[m][bj]; const i32x4 i0 = __builtin_bit_cast(i32x4, acc[ai][bj][m][0]), i1 = __builtin_bit_cast(i32x4, acc[ai][bj][m][1]);
                    const f32x4 v0 = (f32x4){(float)i0[0], (float)i0[1], (float)i0[2], (float)i0[3]} * sc, v1 = (f32x4){(float)i1[0], (float)i1[1], (float)i1[2], (float)i1[3]} * sc;
                    const float s0 = bflo(pp.x) + (float)(gg.x & 0xffu) * v0[0], s1 = bfhi(pp.x) + (float)((gg.x >> 8) & 0xffu) * v0[1], s2 = bflo(pp.y) + (float)((gg.x >> 16) & 0xffu) * v0[2], s3 = bfhi(pp.y) + (float)(gg.x >> 24) * v0[3];
                    const float s4 = bflo(pp.z) + (float)(gg.y & 0xffu) * v1[0], s5 = bfhi(pp.z) + (float)((gg.y >> 8) & 0xffu) * v1[1], s6 = bflo(pp.w) + (float)((gg.y >> 16) & 0xffu) * v1[2], s7 = bfhi(pp.w) + (float)(gg.y >> 24) * v1[3];
                    if (last) { u32x2 q8; q8.x = q8x4e(s0, s1, s2, s3, qm); q8.y = q8x4e(s4, s5, s6, s7, qm); *(u32x2*)(mixed8 + (size_t)row * 2048 + col0 + bj * HALF) = q8; }
                    else { u32x4 w; w.x = cvt_pk_bf16(s0, s1); w.y = cvt_pk_bf16(s2, s3); w.z = cvt_pk_bf16(s4, s5); w.w = cvt_pk_bf16(s6, s7); *(u32x4*)(mp + bj * HALF) = w; }
                } }
        }
    }
};
struct EpiResid {
    static constexpr bool PERM = false, AFTER_DRAIN = false, RMW = false;
    bf16_t* out; const float* xf; const bf16_t* xh; float alpha, inv;
    __device__ __forceinline__ void operator()(const f32x4 (&acc)[2][2][4][2], const Unit& u, int wr, int wc, int fr, int fq) const {
        const int row0 = u.pm * BM + wr * 64 + fr, col0 = u.pn * BM + wc * 32 + 4 * fq;
#pragma unroll
        for (int ai = 0; ai < 2; ++ai) {
            f32x4 x[4][2][2];
#pragma unroll
            for (int m = 0; m < 4; ++m) { const size_t off = (size_t)(row0 + ai * HALF + m * 16) * 2048 + col0;
#pragma unroll
                for (int bj = 0; bj < 2; ++bj)
#pragma unroll
                    for (int n = 0; n < 2; ++n) { if (xf) x[m][bj][n] = *(const f32x4*)(xf + off + bj * HALF + n * 16);
                        else { const u32x2 w = *(const u32x2*)(xh + off + bj * HALF + n * 16); x[m][bj][n] = (f32x4){f16lo(w.x), f16hi(w.x), f16lo(w.y), f16hi(w.y)}; } } }
#pragma unroll
            for (int m = 0; m < 4; ++m) { const size_t off = (size_t)(row0 + ai * HALF + m * 16) * 2048 + col0;
#pragma unroll
                for (int bj = 0; bj < 2; ++bj)
#pragma unroll
                    for (int n = 0; n < 2; ++n) { const i32x4 ia = __builtin_bit_cast(i32x4, acc[ai][bj][m][n]); const f32x4 r = x[m][bj][n] * alpha + (f32x4){(float)ia[0], (float)ia[1], (float)ia[2], (float)ia[3]} * inv;
                        u32x2 w; w.x = pk_f16(r[0], r[1]); w.y = pk_f16(r[2], r[3]); *(u32x2*)(out + off + bj * HALF + n * 16) = w; } }
        }
    }
};
struct EpiSwiGLU {
    static constexpr bool PERM = true, AFTER_DRAIN = false, RMW = false;
    unsigned char* H; float inv_g, inv_u, qh;
    __device__ __forceinline__ void operator()(const f32x4 (&acc)[2][2][4][2], const Unit& u, int wr, int wc, int fr, int fq) const {
        const int row0 = u.pm * BM + wr * 64 + fr, col0 = u.pn * HALF + wc * 32 + 8 * fq;
        const float ksc = qh * inv_g * inv_u, kexp = -inv_g * 1.4426950408889634f;
#pragma unroll
        for (int ai = 0; ai < 2; ++ai)
#pragma unroll
            for (int m = 0; m < 4; ++m) {
                unsigned char* hp = H + (size_t)(row0 + ai * HALF + m * 16) * 1024 + col0;
                f32x4 h0, h1;
                const i32x4 ig0 = __builtin_bit_cast(i32x4, acc[ai][0][m][0]), ig1 = __builtin_bit_cast(i32x4, acc[ai][0][m][1]), iu0 = __builtin_bit_cast(i32x4, acc[ai][1][m][0]), iu1 = __builtin_bit_cast(i32x4, acc[ai][1][m][1]);
#pragma unroll
                for (int j = 0; j < 4; ++j) { const float fg0 = (float)ig0[j], fg1 = (float)ig1[j];
                    h0[j] = fg0 * (float)iu0[j] * ksc * __builtin_amdgcn_rcpf(1.0f + __builtin_amdgcn_exp2f(fg0 * kexp));
                    h1[j] = fg1 * (float)iu1[j] * ksc * __builtin_amdgcn_rcpf(1.0f + __builtin_amdgcn_exp2f(fg1 * kexp)); }
                u32x2 w; w.x = q8x4e(h0[0], h0[1], h0[2], h0[3], 1.0f); w.y = q8x4e(h1[0], h1[1], h1[2], h1[3], 1.0f);
                *(u32x2*)hp = w;
            }
    }
};
struct EpiDown {
    static constexpr bool PERM = true, AFTER_DRAIN = false, RMW = false;
    unsigned char* Y; float sc;
    __device__ __forceinline__ void operator()(const f32x4 (&acc)[2][2][4][2], const Unit& u, int wr, int wc, int fr, int fq) const {
        const int row0 = u.pm * BM + wr * 64 + fr, col0 = u.pn * BM + wc * 32 + 8 * fq;
#pragma unroll
        for (int ai = 0; ai < 2; ++ai)
#pragma unroll
            for (int m = 0; m < 4; ++m) {
                const int row = row0 + ai * HALF + m * 16;
                unsigned char* yp = Y + (size_t)row * 2048 + col0;
#pragma unroll
                for (int bj = 0; bj < 2; ++bj) { const i32x4 i0 = __builtin_bit_cast(i32x4, acc[ai][bj][m][0]), i1 = __builtin_bit_cast(i32x4, acc[ai][bj][m][1]);
                    u32x2 w; w.x = q8x4e((float)i0[0], (float)i0[1], (float)i0[2], (float)i0[3], sc) ^ 0x80808080u; w.y = q8x4e((float)i1[0], (float)i1[1], (float)i1[2], (float)i1[3], sc) ^ 0x80808080u;
                    *(u32x2*)(yp + bj * HALF) = w; }
            }
    }
};

template <class Epi, class Sched, bool ALIGN_EPI = false, bool SP2 = false, bool GATHER = false, bool I8 = false, bool F16 = false>
__device__ __forceinline__ void gemm_phase(PG8_LAS unsigned char* lds, const Gemm g, const Sched& S, const Epi& E, const int tid) {
    const int wid = __builtin_amdgcn_readfirstlane(tid >> 6), lane = tid & 63, wr = wid >> 2, wc = wid & 3, fr = lane & 15, fq = lane >> 4;
    const int K = g.K, nt = K / BK;
    unsigned voffA[2], voffB[2];
#pragma unroll
    for (int i = 0; i < 2; ++i) { int R, C; stage_rc(tid * 16 + i * 8192, R, C); const int Rb = Epi::PERM ? ((R & ~31) + perm32(R & 31)) : R;
        voffA[i] = (unsigned)(R * K + C) * 2u; voffB[i] = (unsigned)(Rb * K + C) * 2u; }
    unsigned gcur[2][2] = {{0u, 0u}, {0u, 0u}}, gnx[2][2] = {{0u, 0u}, {0u, 0u}};
#define PG8_GOFF(dst, U) do { _Pragma("unroll") for (int _h = 0; _h < 2; ++_h) _Pragma("unroll") for (int _i = 0; _i < 2; ++_i) { int R_, C_; stage_rc(tid * 16 + _i * 8192, R_, C_); \
        const int r_ = (U).pm * BM + _h * HALF + R_; const int tok_ = g.gidx[r_]; dst[_h][_i] = (unsigned)(((r_ >> 13) * 4096 + tok_) * K + C_) * 2u; } } while (0)
    const size_t kstep = (size_t)(BK * 2);
    const size_t hstep = (size_t)HALF * K * 2;
    const size_t tstep = 2 * hstep;
    const unsigned ldsw = (unsigned)wid * 1024u;
    const int aoff = lds_byte(wr * 64 + fr, fq * 8), boff = lds_byte(wc * 32 + fr, fq * 8);
#define PG8_SA(b, h) (((b) * 2 + (h)) * HTB)
#define PG8_SB(b, h) ((4 + (b) * 2 + (h)) * HTB)
#define PG8_STAGE(bufoff, gbase, voff) do { _Pragma("unroll") for (int _i = 0; _i < 2; ++_i) \
        __builtin_amdgcn_global_load_lds((const unsigned*)((const char*)(gbase) + (voff)[_i]), (PG8_LAS unsigned*)(lds + (bufoff) + ldsw + _i * 8192), 16, 0, 0); } while (0)
#define PG8_LDA(dst, b, h) do { _Pragma("unroll") for (int m = 0; m < 4; ++m) _Pragma("unroll") for (int k = 0; k < 2; ++k) dst[m][k] = *(const PG8_LAS bf16x8*)(lds + PG8_SA(b, h) + aoff + m * 2048 + k * 1024); } while (0)
#define PG8_LDB(dst, b, h) do { _Pragma("unroll") for (int n = 0; n < 2; ++n) _Pragma("unroll") for (int k = 0; k < 2; ++k) dst[n][k] = *(const PG8_LAS bf16x8*)(lds + PG8_SB(b, h) + boff + n * 2048 + k * 1024); } while (0)
#define PG8_MMA(ai, bj, At, Bt) do { __builtin_amdgcn_s_setprio(1); _Pragma("unroll") for (int m = 0; m < 4; ++m) _Pragma("unroll") for (int n = 0; n < 2; ++n) _Pragma("unroll") for (int k = 0; k < 2; ++k) { \
        if constexpr (I8) acc[ai][bj][m][n] = __builtin_bit_cast(f32x4, __builtin_amdgcn_mfma_i32_16x16x64_i8(__builtin_bit_cast(i32x4, Bt[n][k]), __builtin_bit_cast(i32x4, At[m][k]), __builtin_bit_cast(i32x4, acc[ai][bj][m][n]), 0, 0, 0)); \
        else if constexpr (F16) acc[ai][bj][m][n] = __builtin_amdgcn_mfma_f32_16x16x32_f16(__builtin_bit_cast(f16x8, Bt[n][k]), __builtin_bit_cast(f16x8, At[m][k]), acc[ai][bj][m][n], 0, 0, 0); \
        else acc[ai][bj][m][n] = __builtin_amdgcn_mfma_f32_16x16x32_bf16(Bt[n][k], At[m][k], acc[ai][bj][m][n], 0, 0, 0); } \
        __builtin_amdgcn_s_setprio(0); } while (0)
#define PG8_STA(bufoff, gbase, h, nx) do { if constexpr (GATHER) { unsigned vo_[2]; vo_[0] = (nx) ? gnx[h][0] : gcur[h][0]; vo_[1] = (nx) ? gnx[h][1] : gcur[h][1]; PG8_STAGE(bufoff, gbase, vo_); } \
        else { PG8_STAGE(bufoff, (gbase) + (h) * hstep, voffA); } } while (0)
#define PG8_WAIT_V(n) asm volatile("s_waitcnt vmcnt(" #n ")" ::: "memory")
#define PG8_WAIT_L(n) asm volatile("s_waitcnt lgkmcnt(" #n ")" ::: "memory")
#define PG8_BAR __builtin_amdgcn_s_barrier()
#define PG8_SCHED __builtin_amdgcn_sched_barrier(0)
    Unit cur, nxt; int ui = 0;
    if (!S.next(0, cur)) return;
    f32x4 acc[2][2][4][2];
#pragma unroll
    for (int a = 0; a < 2; ++a)
#pragma unroll
        for (int b = 0; b < 2; ++b)
#pragma unroll
            for (int m = 0; m < 4; ++m)
#pragma unroll
                for (int n = 0; n < 2; ++n) acc[a][b][m][n] = (f32x4){0.f, 0.f, 0.f, 0.f};
    bf16x8 At[4][2], B0[2][2], B1[2][2];
    const char* cA = (const char*)g.A + (size_t)cur.br * g.a_brstride + (GATHER ? (size_t)0 : (size_t)cur.pm * tstep); const char* cB = (const char*)g.Bt + (size_t)cur.br * g.b_brstride + (size_t)((cur.pm >> 1) & 15) * g.gstride + (size_t)cur.pn * tstep;
    S.a_ready(cur);
    if constexpr (GATHER) PG8_GOFF(gcur, cur);
    if constexpr (SP2) {
        PG8_STAGE(PG8_SB(0, 0), cB, voffB); PG8_STAGE(PG8_SB(0, 1), cB + hstep, voffB); PG8_STA(PG8_SA(0, 0), cA, 0, false); PG8_STA(PG8_SA(0, 1), cA, 1, false);
        if (wr == 1) PG8_BAR;
        PG8_WAIT_V(2); PG8_BAR;
        PG8_STAGE(PG8_SB(1, 0), cB + kstep, voffB); PG8_STA(PG8_SA(1, 0), cA + kstep, 0, false); PG8_STAGE(PG8_SB(1, 1), cB + hstep + kstep, voffB);
        PG8_WAIT_V(6); PG8_BAR;
    } else {
        PG8_STAGE(PG8_SB(0, 0), cB, voffB); PG8_STAGE(PG8_SA(0, 0), cA, voffA); PG8_STAGE(PG8_SB(0, 1), cB + hstep, voffB); PG8_STAGE(PG8_SA(0, 1), cA + hstep, voffA);
        if (wr == 1) PG8_BAR;
        PG8_WAIT_V(4); PG8_BAR;
        PG8_STAGE(PG8_SB(1, 0), cB + kstep, voffB); PG8_STAGE(PG8_SA(1, 0), cA + kstep, voffA); PG8_STAGE(PG8_SB(1, 1), cB + hstep + kstep, voffB);
        PG8_WAIT_V(6); PG8_BAR;
    }
#if defined(STAMP_SEL)
    unsigned long long st_t0 = 0, st_t1 = 0, st_t2 = 0, st_r0 = 0, st_r1 = 0;
#endif
    for (;;) {
        const bool has_next = S.next(ui + 1, nxt);
#if defined(STAMP_SEL)
        if (g.stamp && ui == 5) { st_t0 = __builtin_amdgcn_s_memtime(); st_r0 = __builtin_amdgcn_s_memrealtime(); }
#endif
        const char* nA = has_next ? (const char*)g.A + (size_t)nxt.br * g.a_brstride + (GATHER ? (size_t)0 : (size_t)nxt.pm * tstep) : cA; const char* nB = has_next ? (const char*)g.Bt + (size_t)nxt.br * g.b_brstride + (size_t)((nxt.pm >> 1) & 15) * g.gstride + (size_t)nxt.pn * tstep : cB;
        const int ntu = S.ntiles(cur, nt);
        if constexpr (GATHER) { if (has_next) PG8_GOFF(gnx, nxt); else { gnx[0][0] = gcur[0][0]; gnx[0][1] = gcur[0][1]; gnx[1][0] = gcur[1][0]; gnx[1][1] = gcur[1][1]; } }
        for (int t = 0; t < ntu; t += 2) {
            const bool last = (t == ntu - 2);
            const char* a1 = cA + (size_t)(t + 1) * kstep;
            const char* a2 = last ? nA : cA + (size_t)(t + 2) * kstep; const char* b2 = last ? nB : cB + (size_t)(t + 2) * kstep;
            const char* a3 = a2 + kstep; const char* b3 = b2 + kstep;
            if (last && has_next) S.a_ready(nxt);
            if constexpr (SP2) {
            PG8_LDB(B0, 0, 0); PG8_LDB(B1, 0, 1); PG8_SCHED; PG8_LDA(At, 0, 0); PG8_STA(PG8_SA(1, 1), a1, 1, false);
            PG8_WAIT_V(8); PG8_WAIT_L(0); PG8_BAR; PG8_MMA(0, 0, At, B0); PG8_MMA(0, 1, At, B1); PG8_BAR; PG8_SCHED;
            PG8_LDA(At, 0, 1); PG8_STAGE(PG8_SB(0, 0), b2, voffB); PG8_STAGE(PG8_SB(0, 1), b2 + hstep, voffB); PG8_STA(PG8_SA(0, 0), a2, 0, last);
            PG8_WAIT_V(8); PG8_WAIT_L(0); PG8_BAR; PG8_MMA(1, 0, At, B0); PG8_MMA(1, 1, At, B1); PG8_BAR; PG8_SCHED;
            PG8_LDB(B0, 1, 0); PG8_LDB(B1, 1, 1); PG8_SCHED; PG8_LDA(At, 1, 0); PG8_STA(PG8_SA(0, 1), a2, 1, last);
            PG8_WAIT_V(8); PG8_WAIT_L(0); PG8_BAR; PG8_MMA(0, 0, At, B0); PG8_MMA(0, 1, At, B1); PG8_BAR; PG8_SCHED;
            PG8_LDA(At, 1, 1); PG8_STAGE(PG8_SB(1, 0), b3, voffB); PG8_STAGE(PG8_SB(1, 1), b3 + hstep, voffB); PG8_STA(PG8_SA(1, 0), a3, 0, last);
            PG8_WAIT_V(8); PG8_WAIT_L(0); PG8_BAR; PG8_MMA(1, 0, At, B0); PG8_MMA(1, 1, At, B1); PG8_BAR; PG8_SCHED;
            } else {
            PG8_LDB(B0, 0, 0); PG8_SCHED; PG8_LDA(At, 0, 0); PG8_STAGE(PG8_SA(1, 1), a1 + hstep, voffA);
            PG8_WAIT_L(8); PG8_BAR; PG8_WAIT_L(0); PG8_MMA(0, 0, At, B0); PG8_BAR; PG8_SCHED;
            PG8_LDB(B1, 0, 1); PG8_STAGE(PG8_SB(0, 0), b2, voffB);
            PG8_BAR; PG8_WAIT_L(0); PG8_MMA(0, 1, At, B1); PG8_BAR;
            PG8_LDA(At, 0, 1); PG8_STAGE(PG8_SA(0, 0), a2, voffA);
            PG8_BAR; PG8_WAIT_L(0); PG8_MMA(1, 0, At, B0); PG8_BAR; PG8_SCHED;
            PG8_STAGE(PG8_SB(0, 1), b2 + hstep, voffB);
            PG8_WAIT_V(6); PG8_BAR; PG8_MMA(1, 1, At, B1); PG8_BAR;
            PG8_LDB(B0, 1, 0); PG8_SCHED; PG8_LDA(At, 1, 0); PG8_STAGE(PG8_SA(0, 1), a2 + hstep, voffA);
            PG8_WAIT_L(8); PG8_BAR; PG8_WAIT_L(0); PG8_MMA(0, 0, At, B0); PG8_BAR; PG8_SCHED;
            PG8_LDB(B1, 1, 1); PG8_STAGE(PG8_SB(1, 0), b3, voffB);
            PG8_BAR; PG8_WAIT_L(0); PG8_MMA(0, 1, At, B1); PG8_BAR;
            PG8_LDA(At, 1, 1); PG8_STAGE(PG8_SA(1, 0), a3, voffA);
            PG8_BAR; PG8_WAIT_L(0); PG8_MMA(1, 0, At, B0); PG8_BAR; PG8_SCHED;
            PG8_STAGE(PG8_SB(1, 1), b3 + hstep, voffB);
            PG8_WAIT_V(6); PG8_BAR; PG8_MMA(1, 1, At, B1); PG8_BAR;
            }
        }
#if defined(STAMP_SEL)
        if (g.stamp && ui == 5) st_t1 = __builtin_amdgcn_s_memtime();
#endif
        if constexpr (ALIGN_EPI) { if (wr == 0) PG8_BAR; }
        if constexpr (!Epi::AFTER_DRAIN) { E(acc, cur, wr, wc, fr, fq);
#if defined(PROBE_EPI2)
            if constexpr (!Epi::RMW) { asm volatile("" ::: "memory"); E(acc, cur, wr, wc, fr, fq); }
#endif
            S.done(cur); }
#if defined(STAMP_SEL)
        if (g.stamp && ui == 5) { st_t2 = __builtin_amdgcn_s_memtime(); st_r1 = __builtin_amdgcn_s_memrealtime(); }
#endif
        if (!has_next) break;
#pragma unroll
        for (int a = 0; a < 2; ++a)
#pragma unroll
            for (int b = 0; b < 2; ++b)
#pragma unroll
                for (int m = 0; m < 4; ++m)
#pragma unroll
                    for (int n = 0; n < 2; ++n) acc[a][b][m][n] = (f32x4){0.f, 0.f, 0.f, 0.f};
        cur = nxt; cA = nA; cB = nB; ++ui;
        if constexpr (GATHER) { gcur[0][0] = gnx[0][0]; gcur[0][1] = gnx[0][1]; gcur[1][0] = gnx[1][0]; gcur[1][1] = gnx[1][1]; }
        if constexpr (ALIGN_EPI) { if (wr == 1) PG8_BAR; }
    }
    PG8_WAIT_V(0);
    if constexpr (!ALIGN_EPI) { if (wr == 0) PG8_BAR; }
    PG8_BAR;
    if constexpr (Epi::AFTER_DRAIN) { E.fused(acc, cur, wr, wc, fr, fq, lds, wid, lane); S.done(cur); }
#if defined(STAMP_SEL)
    if (g.stamp && tid == 0) { g.stamp[0] = st_t0; g.stamp[1] = st_t1; g.stamp[2] = st_t2; g.stamp[3] = st_r0; g.stamp[4] = st_r1; }
#endif
#undef PG8_SA
#undef PG8_SB
#undef PG8_STAGE
#undef PG8_LDA
#undef PG8_LDB
#undef PG8_MMA
#undef PG8_STA
#undef PG8_GOFF
#undef PG8_WAIT_V
#undef PG8_WAIT_L
#undef PG8_BAR
#undef PG8_SCHED
}
}

#if defined(STAMP_SEL)
#define STAMP_ARG(x) , x
#else
#define STAMP_ARG(x)
#endif

constexpr int DM = 2048, NBATCH = 4, SEQ = 4096, DEPTH = 4, MTOK = NBATCH * SEQ;
constexpr int IN_TOTAL = 22784, PROJ_PITCH = 14592;
constexpr int OFF_QA = 0, OFF_KA = 2304, OFF_VA = 4608, OFF_QB = 6912, OFF_KB = 7936, OFF_VB = 8960, OFF_QC = 9984, OFF_KC = 11008, OFF_VC = 11264, OFF_QD = 11520, OFF_KD = 12544, OFF_VD = 13568, OFF_GATE = 14592;
constexpr int BR_TOTAL = 3840;
constexpr int NEXP = 16, CAP = 512, DEXP = 1024, NGRP = NBATCH * NEXP;
constexpr float LN_EPS = 1e-5f, SUBLN_EPS = 1e-5f;
constexpr float ALPHA = 1.6817928305074290f;
constexpr size_t MiB = 1u << 20;
constexpr size_t WS_CTL = 0, CTL_ZERO_BYTES = 1 * MiB;
constexpr size_t WS_ROPE128 = 1 * MiB, WS_ROPE64 = 3 * MiB, WS_AFF = 4 * MiB, WS_IDX = 5 * MiB, WS_GV = 5 * MiB + 131072, WS_SLOT = 6 * MiB, WS_LSE = 7 * MiB, WS_STATS = 9 * MiB;
constexpr size_t WS_XF = 16 * MiB, WS_XB = 144 * MiB;
constexpr size_t WS_X8 = 208 * MiB;
constexpr size_t WS_W8G = 240 * MiB;
constexpr float QSIG = 4.0f;
constexpr float QX = 127.0f / QSIG, QWG = 127.0f / (QSIG * 0.022097086912079608f), QWU = 127.0f / (QSIG * 0.022097086912079608f * 0.42044820762685725f),
                QO = 127.0f / 0.5f, QWBA = 127.0f / (QSIG * 0.42044820762685725f * 0.036084391824351615f), QWBC = 127.0f / (QSIG * 0.42044820762685725f * 0.03125f),
                QY = 127.0f / (5.0f * 0.1054f), QH = 127.0f / 4.0f, QWD = 127.0f / (QSIG * 0.03125f * 0.42044820762685725f);
constexpr size_t WS_O4 = 2552 * MiB, WS_OA = WS_O4, WS_OB = WS_O4 + 32 * MiB, WS_OC = WS_O4 + 64 * MiB, WS_OD = WS_O4 + 96 * MiB;
constexpr size_t WS_AG = 328 * MiB;
constexpr size_t WS_MIXED8 = 400 * MiB;
constexpr size_t WS_MIXED = 432 * MiB;
constexpr size_t WS_PRELN = 496 * MiB;
constexpr size_t WS_PROJ = 624 * MiB;
constexpr size_t WS_GATE = WS_PROJ + 456 * MiB;
constexpr size_t WS_XG = WS_PROJ, WS_H = WS_PROJ + 128 * MiB, WS_Y = WS_PROJ + 192 * MiB;
constexpr size_t WS_W8Q = 1336 * MiB;
constexpr size_t WS_WIN = 1432 * MiB;
constexpr size_t WS_W8BR = 1692 * MiB;
constexpr size_t WS_O8 = 2616 * MiB;
constexpr size_t WS_WOUT = 1752 * MiB;
constexpr size_t WS_WGU = 1784 * MiB;
constexpr size_t WS_WDN = 2296 * MiB;
constexpr size_t WS_END = 2744 * MiB;
static_assert(WS_PROJ + (size_t)MTOK * IN_TOTAL * 2 == WS_W8Q && WS_W8Q + (size_t)DEPTH * 11520 * DM <= WS_WIN && WS_WIN + (size_t)DEPTH * 3072 * DM * 2 <= 1692 * MiB, "ws map");
constexpr int CW_BAR = 4096;
constexpr int LDS_BYTES = 155648, LDSCTL_OFF = 155136;
constexpr int NWAVES = 8;
#ifndef LB_WAVES
#define LB_WAVES 2
#endif
constexpr int NPL = 10, NPHASES = 1 + DEPTH * NPL;

#define GAS __attribute__((address_space(1)))
#define LAS __attribute__((address_space(3)))
typedef unsigned short bf16_t;
typedef float f32x4 __attribute__((ext_vector_type(4)));
typedef float f32x2 __attribute__((ext_vector_type(2)));
typedef unsigned u32x4 __attribute__((ext_vector_type(4)));
typedef unsigned u32x2 __attribute__((ext_vector_type(2)));
using pg8::cvt_pk_bf16; using pg8::bflo; using pg8::bfhi; using pg8::pk_f16; using pg8::f16lo; using pg8::f16hi;
__device__ __forceinline__ float bf2f(bf16_t h) { return __uint_as_float(((unsigned)h) << 16); }
__device__ __forceinline__ float wave_sum(float v) {
#pragma unroll
    for (int o = 1; o < 64; o <<= 1) v += __shfl_xor(v, o);
    return v;
}
__device__ __forceinline__ float wave_max(float v) {
#pragma unroll
    for (int o = 1; o < 64; o <<= 1) v = fmaxf(v, __shfl_xor(v, o));
    return v;
}
__device__ __forceinline__ int wave_sum_i(int v) {
#pragma unroll
    for (int o = 1; o < 64; o <<= 1) v += __shfl_xor(v, o);
    return v;
}

#define XB_TMO      128
#define XB_XCNT(j)  (256  + 64 * (j))
#define XB_XSUB(j)  (1280 + 64 * (j))
#define XB_XGEN(j)  (2304 + 64 * (j))
#define XB_TOP      3328
#define XB_TOPGEN   3392
#define XCD_BAR_WORDS 3456
#define XB_SPIN_CAP (1u << 23)

__device__ __forceinline__ unsigned xb_ld(unsigned* p)              { return __hip_atomic_load(p, __ATOMIC_RELAXED, __HIP_MEMORY_SCOPE_AGENT); }
__device__ __forceinline__ unsigned xb_add(unsigned* p, unsigned v) { return __hip_atomic_fetch_add(p, v, __ATOMIC_RELAXED, __HIP_MEMORY_SCOPE_AGENT); }
__device__ __forceinline__ unsigned xb_xcc_id() { return (unsigned)__builtin_amdgcn_s_getreg((3 << 11) | 20) & 0xFu; }
#define XB_SPIN(cond, bar) do { unsigned _sp = 0; while (cond) { __builtin_amdgcn_s_sleep(1); \
    if ((++_sp & 255u) == 0u) { if (xb_ld(&(bar)[XB_TMO])) break; if (_sp > XB_SPIN_CAP) { atomicAdd(&(bar)[XB_TMO], 1u); break; } } } } while (0)

struct XcdBarrier {
    unsigned* bar; unsigned x;
    volatile LAS unsigned* st;
};
__device__ __forceinline__ XcdBarrier xcd_barrier_post(unsigned* bar, volatile LAS unsigned* st) {
    XcdBarrier b; b.bar = bar; b.x = xb_xcc_id(); b.st = st;
    if (threadIdx.x == 0) (void)xb_add(&bar[XB_XCNT(b.x)], 1u);
    return b;
}
__device__ __forceinline__ void xcd_barrier_complete(unsigned* bar, unsigned x, unsigned& nloc, unsigned& nx) {
    const unsigned G = gridDim.x * gridDim.y * gridDim.z;
    unsigned sum, cnt, mine, sp = 0u;
    for (;;) {
        sum = 0u; cnt = 0u; mine = 0u;
#pragma unroll
        for (unsigned j = 0; j < 16; ++j) { const unsigned c = xb_ld(&bar[XB_XCNT(j)]); sum += c; cnt += (c > 0u) ? 1u : 0u; mine = (j == x) ? c : mine; }
        if (sum == G) break;
        __builtin_amdgcn_s_sleep(1);
        if ((++sp & 255u) == 0u) { if (xb_ld(&bar[XB_TMO])) break; if (sp > XB_SPIN_CAP) { atomicAdd(&bar[XB_TMO], 1u); break; } }
    }
    nloc = mine > 0u ? mine : 1u; nx = cnt > 0u ? cnt : 1u;
}
__device__ __forceinline__ void xcd_barrier(const XcdBarrier& b) {
    asm volatile("s_waitcnt vmcnt(0)" ::: "memory");
    __syncthreads();
    if (threadIdx.x == 0) {
        unsigned* bar = b.bar;
        __builtin_amdgcn_s_waitcnt(0);
        unsigned nloc = b.st[0], nx = b.st[1];
        if (nloc == 0u) { xcd_barrier_complete(bar, b.x, nloc, nx); b.st[0] = nloc; b.st[1] = nx; }
        const unsigned old = xb_add(&bar[XB_XSUB(b.x)], 1u);
        const unsigned gen = old / nloc;
        if (old + 1u == (gen + 1u) * nloc) {
            __builtin_amdgcn_fence(__ATOMIC_RELEASE, "agent");
            asm volatile("s_waitcnt vmcnt(0)" ::: "memory");
            const unsigned og = xb_add(&bar[XB_TOP], 1u);
            const unsigned tg = og / nx;
            if (og + 1u == (tg + 1u) * nx) xb_add(&bar[XB_TOPGEN], 1u);
            else XB_SPIN(xb_ld(&bar[XB_TOPGEN]) == tg, bar);
            __builtin_amdgcn_fence(__ATOMIC_ACQUIRE, "agent");
            xb_add(&bar[XB_XGEN(b.x)], 1u);
            asm volatile("s_waitcnt vmcnt(0)" ::: "memory");
        } else {
            XB_SPIN(xb_ld(&bar[XB_XGEN(b.x)]) == gen, bar);
            __builtin_amdgcn_fence(__ATOMIC_ACQUIRE, "agent");
            asm volatile("s_waitcnt vmcnt(0)" ::: "memory");
        }
    }
    __syncthreads();
}

__device__ __forceinline__ int win_src_col(int n) {
    if (n < OFF_VA || (n >= OFF_QC && n < OFF_VC)) { const int hb = n & ~127, j = n & 127; return hb + (j >> 1) + (j & 1) * 64; }
    if (n >= OFF_QB && n < OFF_VB) { const int hb = n & ~63, j = n & 63; return hb + (j >> 1) + (j & 1) * 32; }
    return n;
}
__device__ __forceinline__ void tr_item(const float* __restrict__ src, size_t ld, int srccol, int k0, bf16_t* __restrict__ dst_tile, size_t dld, LAS unsigned char* scr, int lane) {
    const float* p = src + (size_t)k0 * ld + srccol;
    float v[64];
#pragma unroll
    for (int j = 0; j < 64; ++j) v[j] = __builtin_nontemporal_load(p + (size_t)j * ld);
    __builtin_amdgcn_sched_barrier(0);
#pragma unroll
    for (int kk = 0; kk < 8; ++kk) { const int o = kk * 8;
        u32x4 w; w.x = pk_f16(v[o + 0], v[o + 1]); w.y = pk_f16(v[o + 2], v[o + 3]); w.z = pk_f16(v[o + 4], v[o + 5]); w.w = pk_f16(v[o + 6], v[o + 7]);
        *(LAS u32x4*)(scr + lane * 144 + kk * 16) = w;
    }
    bf16_t* d = dst_tile + (size_t)(lane >> 3) * dld + (lane & 7) * 8;
#pragma unroll
    for (int i = 0; i < 8; ++i) { const u32x4 w = *(const LAS u32x4*)(scr + (8 * i + (lane >> 3)) * 144 + (lane & 7) * 16); *(u32x4*)(d + (size_t)(8 * i) * dld) = w; }
}
__device__ __forceinline__ unsigned q8x4(float a, float b, float c, float d, float s) {
    const float ca = fminf(fmaxf(a * s, -127.0f), 127.0f) + 12582912.0f, cb = fminf(fmaxf(b * s, -127.0f), 127.0f) + 12582912.0f;
    const float cc = fminf(fmaxf(c * s, -127.0f), 127.0f) + 12582912.0f, cd = fminf(fmaxf(d * s, -127.0f), 127.0f) + 12582912.0f;
    const unsigned lo = __builtin_amdgcn_perm(__float_as_uint(cb), __float_as_uint(ca), 0x0c0c0400u), hi = __builtin_amdgcn_perm(__float_as_uint(cd), __float_as_uint(cc), 0x0c0c0400u);
    return __builtin_amdgcn_perm(hi, lo, 0x05040100u);
}
__device__ __forceinline__ void tr_item8(const float* __restrict__ src, size_t ld, int srccol, int k0, unsigned char* __restrict__ dst_tile, size_t dld, float scale, LAS unsigned char* scr, int lane) {
    const float* p = src + (size_t)k0 * ld + srccol;
    float v[64];
#pragma unroll
    for (int j = 0; j < 64; ++j) v[j] = __builtin_nontemporal_load(p + (size_t)j * ld);
    __builtin_amdgcn_sched_barrier(0);
#pragma unroll
    for (int kk = 0; kk < 4; ++kk) { const int o = kk * 16;
        u32x4 w; w.x = q8x4(v[o + 0], v[o + 1], v[o + 2], v[o + 3], scale); w.y = q8x4(v[o + 4], v[o + 5], v[o + 6], v[o + 7], scale); w.z = q8x4(v[o + 8], v[o + 9], v[o + 10], v[o + 11], scale); w.w = q8x4(v[o + 12], v[o + 13], v[o + 14], v[o + 15], scale);
        *(LAS u32x4*)(scr + lane * 80 + kk * 16) = w;
    }
    unsigned char* d = dst_tile + (size_t)(lane >> 2) * dld + (lane & 3) * 16;
#pragma unroll
    for (int i = 0; i < 4; ++i) { const u32x4 w = *(const LAS u32x4*)(scr + (16 * i + (lane >> 2)) * 80 + (lane & 3) * 16); *(u32x4*)(d + (size_t)(16 * i) * dld) = w; }
}

struct KeyA { int s, r;
    __device__ __forceinline__ int pos(int idx, float& bias) const { bias = 0.f; const int p = s + r * (idx - 64); return (p >= 0 && p < SEQ) ? p : -1; } };
struct KeyB {
    __device__ __forceinline__ int pos(int idx, float& bias) const { bias = 0.f; return idx; } };
struct KeyC { int s;
    __device__ __forceinline__ int pos(int idx, float& bias) const { bias = 0.f; const int p = s + idx - 128; return (p >= 0 && p < SEQ) ? p : -1; } };
struct KeyD { int r, c, rs, cs; const float* rpb;
    __device__ __forceinline__ int pos(int idx, float& bias) const { const int kr = rs + (idx >> 4), kc = cs + (idx & 15); int dc = kc - c; dc = dc < -15 ? -15 : (dc > 15 ? 15 : dc);
        bias = rpb[(kr - r + 7) * 31 + dc + 15]; return kr * 64 + kc; } };

template <int DK, class KF>
__device__ __forceinline__ void sattn(const bf16_t* q, const bf16_t* kb, const bf16_t* vb, const KF& kf, int nkeys, float scale, bool has_sink, float sink,
                                      LAS float* sq, LAS float* ss, int lane, float& o0, float& o1, float& m_out, float& l_out) {
    for (int d = lane; d < DK; d += 64) sq[d] = bf2f(q[d]);
    asm volatile("s_waitcnt lgkmcnt(0)" ::: "memory");
    float mx = -1e30f;
    for (int idx = lane; idx < nkeys; idx += 64) {
        float bias; const int p = kf.pos(idx, bias); float s = -1e30f;
        if (p >= 0) {
            const u32x4* kr = (const u32x4*)(kb + (size_t)p * PROJ_PITCH); float acc = 0.f;
#pragma unroll
            for (int d8 = 0; d8 < DK / 8; ++d8) { const u32x4 w = kr[d8]; const LAS f32x4* qq = (const LAS f32x4*)(sq + d8 * 8); const f32x4 qa = qq[0], qb = qq[1];
                acc += qa[0] * bflo(w.x) + qa[1] * bfhi(w.x) + qa[2] * bflo(w.y) + qa[3] * bfhi(w.y) + qb[0] * bflo(w.z) + qb[1] * bfhi(w.z) + qb[2] * bflo(w.w) + qb[3] * bfhi(w.w); }
            s = acc * scale + bias;
        }
        ss[idx] = s; mx = fmaxf(mx, s);
    }
    mx = wave_max(mx); if (has_sink) mx = fmaxf(mx, sink);
    float sum = 0.f;
    for (int idx = lane; idx < nkeys; idx += 64) { const float s = ss[idx]; const float p = (s > -1e29f) ? __expf(s - mx) : 0.f; ss[idx] = p; sum += p; }
    sum = wave_sum(sum); if (has_sink) sum += __expf(sink - mx);
    asm volatile("s_waitcnt lgkmcnt(0)" ::: "memory");
    o0 = 0.f; o1 = 0.f;
    for (int idx = 0; idx < nkeys; ++idx) {
        const float p = ss[idx];
        if (p != 0.f) { float bias; const int pp = kf.pos(idx, bias); const unsigned w = *(const unsigned*)(vb + (size_t)pp * PROJ_PITCH + 2 * lane); o0 += p * bflo(w); o1 += p * bfhi(w); }
    }
    const float inv = 1.0f / sum; o0 *= inv; o1 *= inv; m_out = mx; l_out = sum;
    asm volatile("s_waitcnt lgkmcnt(0)" ::: "memory");
}

struct AttnPtrs { const bf16_t* proj; bf16_t* ag; float* lse; bf16_t* ob; bf16_t* oc; bf16_t* od; const float* lam; const float* subln; const float* sink; const float* rpb; float lambda_init; };

template <int WHICH>
__device__ __forceinline__ void scalar_attn_phase(const AttnPtrs& P, LAS unsigned char* lds, int gw, int NGW, int wave, int lane) {
    LAS float* sq = (LAS float*)(lds + wave * 16896); LAS float* ss = sq + 128;
    constexpr int NH = WHICH == 0 ? 18 : 8;
    float lmbda = 0.f;
    if constexpr (WHICH == 1) { const float d01 = wave_sum(P.lam[lane] * P.lam[64 + lane]), d23 = wave_sum(P.lam[128 + lane] * P.lam[192 + lane]); lmbda = __expf(d01) - __expf(d23) + P.lambda_init; }
    for (int task = gw; task < NH * MTOK; task += NGW) {
        const int hs = task / MTOK, row = task % MTOK, b = row >> 12, s = row & 4095;
        const bf16_t* prow = P.proj + (size_t)row * PROJ_PITCH; const bf16_t* pb = P.proj + (size_t)(b * SEQ) * PROJ_PITCH;
        float o0, o1, mm, ll;
        if constexpr (WHICH == 0) {
            const int hh = hs, g = hh / 6, r = (g == 0) ? 1 : ((g == 1) ? 4 : 16); KeyA kf{s, r};
            sattn<128>(prow + OFF_QA + hh * 128, pb + OFF_KA + hh * 128, pb + OFF_VA + hh * 128, kf, 129, 0.08838834764831845f, false, 0.f, sq, ss, lane, o0, o1, mm, ll);
            *(unsigned*)(P.ag + ((size_t)g * MTOK + row) * 768 + (hh % 6) * 128 + 2 * lane) = cvt_pk_bf16(o0, o1);
            if (lane == 0) P.lse[((size_t)g * MTOK + row) * 6 + (hh % 6)] = mm + __logf(ll);
        } else if constexpr (WHICH == 1) {
            const int h = hs; KeyB kf; float a0, a1, b0, b1;
            sattn<64>(prow + OFF_QB + (2 * h) * 64, pb + OFF_KB + (2 * h) * 64, pb + OFF_VB + h * 128, kf, SEQ, 0.125f, false, 0.f, sq, ss, lane, a0, a1, mm, ll);
            sattn<64>(prow + OFF_QB + (2 * h + 1) * 64, pb + OFF_KB + (2 * h + 1) * 64, pb + OFF_VB + h * 128, kf, SEQ, 0.125f, false, 0.f, sq, ss, lane, b0, b1, mm, ll);
            const float v0 = a0 - lmbda * b0, v1 = a1 - lmbda * b1;
            const float rinv = rsqrtf(wave_sum(v0 * v0 + v1 * v1) * (1.0f / 128.0f) + SUBLN_EPS) * (1.0f - P.lambda_init);
            *(unsigned*)(P.ob + (size_t)row * 1024 + h * 128 + 2 * lane) = cvt_pk_bf16(v0 * rinv * P.subln[2 * lane], v1 * rinv * P.subln[2 * lane + 1]);
        } else if constexpr (WHICH == 2) {
            const int qh = hs, kvh = qh >> 2; KeyC kf{s};
            sattn<128>(prow + OFF_QC + qh * 128, pb + OFF_KC + kvh * 128, pb + OFF_VC + kvh * 128, kf, 257, 0.08838834764831845f, true, P.sink[qh], sq, ss, lane, o0, o1, mm, ll);
            *(unsigned*)(P.oc + (size_t)row * 1024 + qh * 128 + 2 * lane) = cvt_pk_bf16(o0, o1);
        } else {
            const int h = hs, r = s >> 6, c = s & 63; int rs = r - 4; rs = rs < 0 ? 0 : (rs > 56 ? 56 : rs); int cs = c - 8; cs = cs < 0 ? 0 : (cs > 48 ? 48 : cs);
            KeyD kf{r, c, rs, cs, P.rpb + h * 465};
            sattn<128>(prow + OFF_QD + h * 128, pb + OFF_KD + h * 128, pb + OFF_VD + h * 128, kf, 128, 0.08838834764831845f, false, 0.f, sq, ss, lane, o0, o1, mm, ll);
            *(unsigned*)(P.od + (size_t)row * 1024 + h * 128 + 2 * lane) = cvt_pk_bf16(o0, o1);
        }
    }
}

__device__ __forceinline__ void combine_a_phase(const unsigned char* ag, const float* lse, unsigned* oa8, int gw, int NGW, int lane) {
    for (int row0 = gw; row0 < MTOK; row0 += 4 * NGW) {
        float lc[4][3][3]; unsigned ac[4][3][3];
#pragma unroll
        for (int u = 0; u < 4; ++u) { const int row = row0 + u * NGW; if (row < MTOK) {
#pragma unroll
            for (int j = 0; j < 3; ++j) { const int e = 4 * lane + 256 * j, head = e >> 7;
#pragma unroll
                for (int g = 0; g < 3; ++g) { lc[u][j][g] = lse[((size_t)g * MTOK + row) * 6 + head]; ac[u][j][g] = *(const unsigned*)(ag + ((size_t)g * MTOK + row) * 768 + e); } } } }
#pragma unroll
        for (int u = 0; u < 4; ++u) { const int row = row0 + u * NGW; if (row >= MTOK) break;
#pragma unroll
            for (int j = 0; j < 3; ++j) {
                const int e = 4 * lane + 256 * j;
                const float l0 = lc[u][j][0], l1 = lc[u][j][1], l2 = lc[u][j][2];
                const float mx = fmaxf(l0, fmaxf(l1, l2)); float w0 = __expf(l0 - mx), w1 = __expf(l1 - mx), w2 = __expf(l2 - mx); const float inv = 1.0f / (w0 + w1 + w2); w0 *= inv; w1 *= inv; w2 *= inv;
                const unsigned a0 = ac[u][j][0], a1 = ac[u][j][1], a2 = ac[u][j][2];
#define CMB_B(w_, k_) ((float)(int)(signed char)(((w_) >> (8 * (k_))) & 0xffu))
                oa8[(size_t)row * 256 + (e >> 2)] = q8x4(w0 * CMB_B(a0, 0) + w1 * CMB_B(a1, 0) + w2 * CMB_B(a2, 0), w0 * CMB_B(a0, 1) + w1 * CMB_B(a1, 1) + w2 * CMB_B(a2, 1),
                                                      w0 * CMB_B(a0, 2) + w1 * CMB_B(a1, 2) + w2 * CMB_B(a2, 2), w0 * CMB_B(a0, 3) + w1 * CMB_B(a1, 3) + w2 * CMB_B(a2, 3), 1.0f);
#undef CMB_B
            } }
    }
}
__device__ __forceinline__ void ln1_router_phase(const bf16_t* preln, const float* gain, const float* bias, const float* wr, float* stats, unsigned* x8, float* aff,
                                                 LAS unsigned char* lds, int tid, int gw, int NGW, int lane) {
    LAS float* W = (LAS float*)lds;
    u32x2 vn[8];
    if (gw < MTOK) {
#pragma unroll
        for (int j = 0; j < 8; ++j) vn[j] = *(const u32x2*)(preln + (size_t)gw * DM + 4 * lane + 256 * j);
    }
    f32x4 g[8], bb[8];
#pragma unroll
    for (int j = 0; j < 8; ++j) { g[j] = *(const f32x4*)(gain + 256 * j + 4 * lane); bb[j] = *(const f32x4*)(bias + 256 * j + 4 * lane); }
    { f32x4 w4[16];
#pragma unroll
      for (int it = 0; it < 16; ++it) w4[it] = *(const f32x4*)(wr + 4 * (size_t)(tid + it * (NWAVES * 64)));
#pragma unroll
      for (int it = 0; it < 16; ++it) { const int i4 = tid + it * (NWAVES * 64), k = i4 >> 2, e0 = (i4 & 3) * 4;
          W[(e0 + 0) * DM + k] = w4[it][0]; W[(e0 + 1) * DM + k] = w4[it][1]; W[(e0 + 2) * DM + k] = w4[it][2]; W[(e0 + 3) * DM + k] = w4[it][3]; } }
    __syncthreads();
    for (int row = gw; row < MTOK; row += NGW) {
        f32x4 v[8]; float s = 0.f;
#pragma unroll
        for (int j = 0; j < 8; ++j) { v[j] = (f32x4){f16lo(vn[j].x), f16hi(vn[j].x), f16lo(vn[j].y), f16hi(vn[j].y)}; s += (v[j][0] + v[j][1]) + (v[j][2] + v[j][3]); }
        if (row + NGW < MTOK) {
#pragma unroll
            for (int j = 0; j < 8; ++j) vn[j] = *(const u32x2*)(preln + (size_t)(row + NGW) * DM + 4 * lane + 256 * j);
        }
        const float mean = wave_sum(s) * (1.0f / DM); float q = 0.f;
#pragma unroll
        for (int j = 0; j < 8; ++j) { v[j] = v[j] - mean; q += (v[j][0] * v[j][0] + v[j][1] * v[j][1]) + (v[j][2] * v[j][2] + v[j][3] * v[j][3]); }
        const float rstd = rsqrtf(wave_sum(q) * (1.0f / DM) + LN_EPS);
        if (lane == 0) *(f32x2*)(stats + 2 * (size_t)row) = (f32x2){mean, rstd};
        unsigned* x8o = x8 + (size_t)row * (DM / 4) + lane;
#pragma unroll
        for (int j = 0; j < 8; ++j) { v[j] = v[j] * rstd * g[j] + bb[j]; x8o[64 * j] = q8x4(v[j][0], v[j][1], v[j][2], v[j][3], QX); }
        float a[16];
        f32x4 wa[8], wb[8];
#define LN1_LDW(dst, e) do { _Pragma("unroll") for (int j = 0; j < 8; ++j) dst[j] = *(const LAS f32x4*)(W + (e) * DM + 256 * j + 4 * lane); } while (0)
#define LN1_DOT(src, e) do { f32x2 t2 = {0.f, 0.f}; _Pragma("unroll") for (int j = 0; j < 8; ++j) { \
            t2 = __builtin_elementwise_fma((f32x2){v[j][0], v[j][1]}, (f32x2){src[j][0], src[j][1]}, t2); t2 = __builtin_elementwise_fma((f32x2){v[j][2], v[j][3]}, (f32x2){src[j][2], src[j][3]}, t2); } \
            a[e] = t2[0] + t2[1]; } while (0)
        LN1_LDW(wa, 0);
#pragma unroll
        for (int e = 0; e < 16; e += 2) {
            LN1_LDW(wb, e + 1); asm volatile("" ::: "memory"); LN1_DOT(wa, e); asm volatile("" ::: "memory");
            if (e + 2 < 16) LN1_LDW(wa, e + 2);
            asm volatile("" ::: "memory"); LN1_DOT(wb, e + 1); asm volatile("" ::: "memory"); }
#undef LN1_LDW
#undef LN1_DOT
        float r8[8], r4[4], r2[2], r1;
        { const bool up = (lane & 32) != 0;
#pragma unroll
          for (int i = 0; i < 8; ++i) { const float keep = up ? a[i + 8] : a[i], send = up ? a[i] : a[i + 8]; r8[i] = keep + __shfl_xor(send, 32); } }
        { const bool up = (lane & 16) != 0;
#pragma unroll
          for (int i = 0; i < 4; ++i) { const float keep = up ? r8[i + 4] : r8[i], send = up ? r8[i] : r8[i + 4]; r4[i] = keep + __shfl_xor(send, 16); } }
        { const bool up = (lane & 8) != 0;
#pragma unroll
          for (int i = 0; i < 2; ++i) { const float keep = up ? r4[i + 2] : r4[i], send = up ? r4[i] : r4[i + 2]; r2[i] = keep + __shfl_xor(send, 8); } }
        { const bool up = (lane & 4) != 0; const float keep = up ? r2[1] : r2[0], send = up ? r2[0] : r2[1]; r1 = keep + __shfl_xor(send, 4); }
        r1 += __shfl_xor(r1, 1); r1 += __shfl_xor(r1, 2);
        float mx = r1;
#pragma unroll
        for (int o = 4; o < 64; o <<= 1) mx = fmaxf(mx, __shfl_xor(mx, o));
        const float ex = expf(r1 - mx); float den = ex;
#pragma unroll
        for (int o = 4; o < 64; o <<= 1) den += __shfl_xor(den, o);
        const int eidx = ((lane >> 5) & 1) * 8 + ((lane >> 4) & 1) * 4 + ((lane >> 3) & 1) * 2 + ((lane >> 2) & 1);
        if ((lane & 3) == 0) aff[((size_t)(row >> 12) * NEXP + eidx) * SEQ + (row & 4095)] = ex / den;
    }
    __syncthreads();
}
__device__ __forceinline__ void topk_phase(const float* aff, int* idxo, float* gvo, int* sloto, LAS unsigned char* lds, int tid, int wave, int lane, int wg, int G) {
    LAS int* cnt = (LAS int*)lds;
    for (int be = wg; be < NGRP; be += G) {
        const float* a = aff + (size_t)be * SEQ + tid * 8;
        const f32x4 a0 = *(const f32x4*)a, a1 = *(const f32x4*)(a + 4);
        unsigned v[8] = {__float_as_uint(a0[0]), __float_as_uint(a0[1]), __float_as_uint(a0[2]), __float_as_uint(a0[3]), __float_as_uint(a1[0]), __float_as_uint(a1[1]), __float_as_uint(a1[2]), __float_as_uint(a1[3])};
        unsigned T = 0u;
        for (int bit = 30; bit >= 0; --bit) {
            const unsigned cand = T | (1u << bit); int c = 0;
#pragma unroll
            for (int k = 0; k < 8; ++k) c += (v[k] >= cand) ? 1 : 0;
            c = wave_sum_i(c);
            if (lane == 0) cnt[(bit & 1) * 8 + wave] = c;
            __syncthreads();
            int tot = 0;
#pragma unroll
            for (int w = 0; w < 8; ++w) tot += cnt[(bit & 1) * 8 + w];
            if (tot >= CAP) T = cand;
        }
        int ngt = 0, neq = 0;
#pragma unroll
        for (int k = 0; k < 8; ++k) { ngt += (v[k] > T) ? 1 : 0; neq += (v[k] == T) ? 1 : 0; }
        int sgt = ngt, seq = neq;
#pragma unroll
        for (int o = 1; o < 64; o <<= 1) { const int tg = __shfl_up(sgt, o), te = __shfl_up(seq, o); if (lane >= o) { sgt += tg; seq += te; } }
        __syncthreads();
        if (lane == 63) { cnt[64 + wave] = sgt; cnt[64 + 8 + wave] = seq; }
        __syncthreads();
        int pgt = sgt - ngt, peq = seq - neq, totgt = 0;
#pragma unroll
        for (int w = 0; w < 8; ++w) { const int tg = cnt[64 + w], te = cnt[64 + 8 + w]; if (w < wave) { pgt += tg; peq += te; } totgt += tg; }
        const int need = CAP - totgt;
        const int b = be >> 4, e = be & 15;
#pragma unroll
        for (int k = 0; k < 8; ++k) {
            const bool gt = v[k] > T, eq = v[k] == T; const bool sel = gt || (eq && peq < need);
            const int slot = pgt + (peq < need ? peq : need);
            const int tok = tid * 8 + k;
            if (sel) { idxo[be * CAP + slot] = tok; gvo[be * CAP + slot] = __uint_as_float(v[k]); }
            sloto[((size_t)b * SEQ + tok) * NEXP + e] = sel ? slot : -1;
            pgt += gt ? 1 : 0; peq += eq ? 1 : 0;
        }
        __syncthreads();
    }
}
__device__ __forceinline__ void gather_phase(const bf16_t* xb, const int* idx, bf16_t* xg, int gw, int NGW, int lane) {
    for (int r = gw; r < NGRP * CAP; r += NGW) {
        const int be = r >> 9, b = be >> 4; const int tok = idx[r];
        const u32x4* src = (const u32x4*)(xb + ((size_t)b * SEQ + tok) * DM); u32x4* dst = (u32x4*)(xg + (size_t)r * DM);
#pragma unroll
        for (int j = 0; j < 4; ++j) dst[64 * j + lane] = src[64 * j + lane];
    }
}
__device__ __forceinline__ void ln2_phase(const bf16_t* x1, const float* stats, const float* gain1, const float* bias1, const unsigned char* y, const float* gvp, const int* slot, const float* gain, const float* bias, float* xo_base, bf16_t* xh, bf16_t* xb, unsigned char* x8, int gw, int NGW, int lane) {
    u32x4 xn[4]; int slot_n = -1;
    if (gw < MTOK) { slot_n = slot[(size_t)gw * NEXP + (lane & 15)];
#pragma unroll
        for (int j = 0; j < 4; ++j) xn[j] = *(const u32x4*)(x1 + (size_t)gw * DM + 512 * j + 8 * lane); }
    for (int row = gw; row < MTOK; row += NGW) {
        const int b = row >> 12; const int myslot = slot_n;
        f32x4 xc[8];
#pragma unroll
        for (int j = 0; j < 4; ++j) { xc[2 * j] = (f32x4){f16lo(xn[j].x), f16hi(xn[j].x), f16lo(xn[j].y), f16hi(xn[j].y)}; xc[2 * j + 1] = (f32x4){f16lo(xn[j].z), f16hi(xn[j].z), f16lo(xn[j].w), f16hi(xn[j].w)}; }
        unsigned hits = (unsigned)(__ballot(myslot >= 0) & 0xffffull);
        const bool h0 = hits != 0u; const int e0 = h0 ? __builtin_ctz(hits) : 0; if (h0) hits &= hits - 1;
        const bool h1 = hits != 0u; const int e1 = h1 ? __builtin_ctz(hits) : e0; if (h1) hits &= hits - 1;
        int sl0 = __shfl(myslot, e0), sl1 = __shfl(myslot, e1); sl0 = sl0 < 0 ? 0 : sl0; sl1 = sl1 < 0 ? 0 : sl1;
        const f32x2 st = *(const f32x2*)(stats + 2 * (size_t)row);
        f32x4 ga[4], gb[4], ba[4], bv[4];
#pragma unroll
        for (int j = 0; j < 4; ++j) { ga[j] = *(const f32x4*)(gain1 + 512 * j + 8 * lane); gb[j] = *(const f32x4*)(gain1 + 512 * j + 8 * lane + 4);
            ba[j] = *(const f32x4*)(bias1 + 512 * j + 8 * lane); bv[j] = *(const f32x4*)(bias1 + 512 * j + 8 * lane + 4); }
        u32x2 ya[4], yb[4]; float ga_, gb_;
        { const size_t r0_ = (size_t)(b * NEXP + e0) * CAP + sl0, r1_ = (size_t)(b * NEXP + e1) * CAP + sl1;
          const unsigned char* yr0 = y + r0_ * DM + 8 * lane; const unsigned char* yr1 = y + r1_ * DM + 8 * lane;
          ga_ = gvp[r0_]; gb_ = gvp[r1_];
#pragma unroll
          for (int j = 0; j < 4; ++j) ya[j] = *(const u32x2*)(yr0 + 512 * j);
#pragma unroll
          for (int j = 0; j < 4; ++j) yb[j] = *(const u32x2*)(yr1 + 512 * j); }
        if (row + NGW < MTOK) { slot_n = slot[(size_t)(row + NGW) * NEXP + (lane & 15)];
#pragma unroll
            for (int j = 0; j < 4; ++j) xn[j] = *(const u32x4*)(x1 + (size_t)(row + NGW) * DM + 512 * j + 8 * lane); }
#pragma unroll
        for (int j = 0; j < 4; ++j) { xc[2 * j] = (xc[2 * j] - st[0]) * st[1] * ga[j] + ba[j]; xc[2 * j + 1] = (xc[2 * j + 1] - st[0]) * st[1] * gb[j] + bv[j]; }
        f32x4 acc[8];
#pragma unroll
        for (int j = 0; j < 8; ++j) acc[j] = (f32x4){0.f, 0.f, 0.f, 0.f};
#define LN2_ACC(Y_, j, gs) do { acc[2 * j][0] = fmaf((float)((Y_).x & 0xffu), gs, acc[2 * j][0]); acc[2 * j][1] = fmaf((float)(((Y_).x >> 8) & 0xffu), gs, acc[2 * j][1]); \
            acc[2 * j][2] = fmaf((float)(((Y_).x >> 16) & 0xffu), gs, acc[2 * j][2]); acc[2 * j][3] = fmaf((float)((Y_).x >> 24), gs, acc[2 * j][3]); \
            acc[2 * j + 1][0] = fmaf((float)((Y_).y & 0xffu), gs, acc[2 * j + 1][0]); acc[2 * j + 1][1] = fmaf((float)(((Y_).y >> 8) & 0xffu), gs, acc[2 * j + 1][1]); \
            acc[2 * j + 1][2] = fmaf((float)(((Y_).y >> 16) & 0xffu), gs, acc[2 * j + 1][2]); acc[2 * j + 1][3] = fmaf((float)((Y_).y >> 24), gs, acc[2 * j + 1][3]); } while (0)
        float corr = 0.f;
        if (h0) { const float gs = ga_ * (1.0f / QY); corr += 128.0f * gs;
#pragma unroll
            for (int j = 0; j < 4; ++j) LN2_ACC(ya[j], j, gs); }
        if (h1) { const float gs = gb_ * (1.0f / QY); corr += 128.0f * gs;
#pragma unroll
            for (int j = 0; j < 4; ++j) LN2_ACC(yb[j], j, gs); }
        while (hits) {
            const int e = __builtin_ctz(hits); hits &= hits - 1;
            const int sl = __shfl(myslot, e);
            const size_t r_ = (size_t)(b * NEXP + e) * CAP + sl; const unsigned char* yr = y + r_ * DM + 8 * lane;
            const float gs = gvp[r_] * (1.0f / QY); corr += 128.0f * gs;
#pragma unroll
            for (int j = 0; j < 4; ++j) { const u32x2 w = *(const u32x2*)(yr + 512 * j); LN2_ACC(w, j, gs); }
        }
#undef LN2_ACC
        float s = 0.f;
#pragma unroll
        for (int j = 0; j < 8; ++j) { acc[j] = xc[j] * ALPHA + (acc[j] - corr); s += (acc[j][0] + acc[j][1]) + (acc[j][2] + acc[j][3]); }
        const float mean = wave_sum(s) * (1.0f / DM); float q = 0.f;
#pragma unroll
        for (int j = 0; j < 8; ++j) { acc[j] = acc[j] - mean; q += (acc[j][0] * acc[j][0] + acc[j][1] * acc[j][1]) + (acc[j][2] * acc[j][2] + acc[j][3] * acc[j][3]); }
        const float rstd = rsqrtf(wave_sum(q) * (1.0f / DM) + LN_EPS);
        float* xo = xo_base + (size_t)row * DM + 8 * lane; (void)xb; bf16_t* xho = xh + (size_t)row * DM + 8 * lane;
#pragma unroll
        for (int j = 0; j < 4; ++j) { const f32x4 g0 = *(const f32x4*)(gain + 512 * j + 8 * lane), g1 = *(const f32x4*)(gain + 512 * j + 8 * lane + 4), b0 = *(const f32x4*)(bias + 512 * j + 8 * lane), b1 = *(const f32x4*)(bias + 512 * j + 8 * lane + 4);
            const f32x4 o0 = acc[2 * j] * rstd * g0 + b0, o1 = acc[2 * j + 1] * rstd * g1 + b1;
            if (!x8) { *(f32x4*)(xo + 512 * j) = o0; *(f32x4*)(xo + 512 * j + 4) = o1; }
            else { u32x4 hw; hw.x = pk_f16(o0[0], o0[1]); hw.y = pk_f16(o0[2], o0[3]); hw.z = pk_f16(o1[0], o1[1]); hw.w = pk_f16(o1[2], o1[3]); *(u32x4*)(xho + 512 * j) = hw; }
            if (x8) {
                u32x2 q; q.x = q8x4(o0[0], o0[1], o0[2], o0[3], QX); q.y = q8x4(o1[0], o1[1], o1[2], o1[3], QX); *(u32x2*)(x8 + (size_t)row * DM + 8 * lane + 512 * j) = q; } }
    }
}

namespace att {
typedef short bf16x8 __attribute__((ext_vector_type(8)));
typedef short s16x4 __attribute__((ext_vector_type(4)));
typedef float f32x16 __attribute__((ext_vector_type(16)));
constexpr int VBYTES = 16384, KOFF = 2 * VBYTES, WSOFF = 65536, TABOFF = WSOFF + 2048, QOFF = TABOFF + 2048, ATTN_LDS = QOFF + 32768;
constexpr float NEG = -1e30f, M0 = -1e29f;
#define ATT_SBAR() __builtin_amdgcn_sched_barrier(0)
__device__ __forceinline__ int crow(int r, int hi) { return (r & 3) + 8 * (r >> 2) + 4 * hi; }
__device__ __forceinline__ unsigned cvtpk(float lo, float hi) { unsigned r; asm volatile("v_cvt_pk_bf16_f32 %0, %1, %2" : "=v"(r) : "v"(lo), "v"(hi)); return r; }
__device__ __forceinline__ int kswz128(int row, int colB) { return row * 256 + (colB ^ ((row & 7) << 4)); }
__device__ __forceinline__ int kswz64(int row, int colB) { return row * 128 + (colB ^ (((row >> 1) & 7) << 4)); }

__device__ __forceinline__ void partialSM(f32x16& p0, f32x16& p1, float& m_reg, float& mn, float& alpha, const float C, const float thr_raw) {
    float pmax = p0[0];
#pragma unroll
    for (int r = 1; r < 16; ++r) pmax = fmaxf(pmax, p0[r]);
#pragma unroll
    for (int r = 0; r < 16; ++r) pmax = fmaxf(pmax, p1[r]);
    { auto rr = __builtin_amdgcn_permlane32_swap(__float_as_uint(pmax), __float_as_uint(pmax), false, false); pmax = fmaxf(__uint_as_float(rr[0]), __uint_as_float(rr[1])); }
    if (__all(pmax - m_reg <= thr_raw)) { mn = m_reg; alpha = 1.f; }
    else { mn = fmaxf(m_reg, pmax); alpha = __builtin_amdgcn_exp2f((m_reg - mn) * C); m_reg = mn; }
    const float mnC = -mn * C;
#pragma unroll
    for (int r = 0; r < 16; ++r) p0[r] = fmaf(p0[r], C, mnC);
#pragma unroll
    for (int r = 0; r < 16; ++r) p1[r] = fmaf(p1[r], C, mnC);
#pragma unroll
    for (int r = 0; r < 16; ++r) p0[r] = __builtin_amdgcn_exp2f(p0[r]);
}
__device__ __forceinline__ void finishSM(f32x16& p0, f32x16& p1, float alpha, float& l_reg, bf16x8& pa0, bf16x8& pa1, bf16x8& pa2, bf16x8& pa3) {
#pragma unroll
    for (int r = 0; r < 16; ++r) p1[r] = __builtin_amdgcn_exp2f(p1[r]);
    float ps = 0;
#pragma unroll
    for (int r = 0; r < 16; ++r) ps += p0[r];
#pragma unroll
    for (int r = 0; r < 16; ++r) ps += p1[r];
    { auto rr = __builtin_amdgcn_permlane32_swap(__float_as_uint(ps), __float_as_uint(ps), false, false); ps = __uint_as_float(rr[0]) + __uint_as_float(rr[1]); }
    l_reg = l_reg * alpha + ps;
#define ATT_PK4(P, BASE, OUT) do { unsigned a0 = cvtpk(P[BASE + 0], P[BASE + 1]), a1 = cvtpk(P[BASE + 2], P[BASE + 3]);   \
    unsigned b0 = cvtpk(P[BASE + 4], P[BASE + 5]), b1 = cvtpk(P[BASE + 6], P[BASE + 7]);                              \
    auto r0 = __builtin_amdgcn_permlane32_swap(a0, b0, false, false); auto r1 = __builtin_amdgcn_permlane32_swap(a1, b1, false, false); \
    u32x4 w = {r0[0], r1[0], r0[1], r1[1]}; OUT = __builtin_bit_cast(bf16x8, w); } while (0)
    ATT_PK4(p0, 0, pa0); ATT_PK4(p0, 8, pa1); ATT_PK4(p1, 0, pa2); ATT_PK4(p1, 8, pa3);
#undef ATT_PK4
}
template <int DK>
__device__ __forceinline__ void qkt(f32x16& p0, f32x16& p1, const LAS char* Ks, const bf16x8* qr, int r32, int hi) {
    p0 = f32x16{}; p1 = f32x16{};
#pragma unroll
    for (int d0 = 0; d0 < DK / 16; ++d0) { const int cb = (d0 * 16 + hi * 8) * 2;
        const bf16x8 b0 = *(const LAS bf16x8*)(Ks + (DK == 128 ? kswz128(r32, cb) : kswz64(r32, cb)));
        const bf16x8 b1 = *(const LAS bf16x8*)(Ks + (DK == 128 ? kswz128(32 + r32, cb) : kswz64(32 + r32, cb)));
        p0 = __builtin_amdgcn_mfma_f32_32x32x16_bf16(b0, qr[d0], p0, 0, 0, 0);
        p1 = __builtin_amdgcn_mfma_f32_32x32x16_bf16(b1, qr[d0], p1, 0, 0, 0); }
}
__device__ __forceinline__ void qkt64_ldsq(f32x16& p0, f32x16& p1, const LAS char* Ks, const LAS char* qb_l, int r32, int hi) {
    unsigned qa = (unsigned)(__UINTPTR_TYPE__)qb_l; asm volatile("" : "+v"(qa)); const LAS char* qp = (const LAS char*)(__UINTPTR_TYPE__)qa;
    p0 = f32x16{}; p1 = f32x16{};
#pragma unroll
    for (int d0 = 0; d0 < 4; ++d0) { const int cb = (d0 * 16 + hi * 8) * 2;
        const bf16x8 q = *(const LAS bf16x8*)(qp + d0 * 1024);
        const bf16x8 b0 = *(const LAS bf16x8*)(Ks + kswz64(r32, cb));
        const bf16x8 b1 = *(const LAS bf16x8*)(Ks + kswz64(32 + r32, cb));
        p0 = __builtin_amdgcn_mfma_f32_32x32x16_bf16(b0, q, p0, 0, 0, 0);
        p1 = __builtin_amdgcn_mfma_f32_32x32x16_bf16(b1, q, p1, 0, 0, 0); }
}
__device__ __forceinline__ int v_st(int k, int c) { const int kk = (k & ~0xC) | ((k & 4) << 1) | ((k & 8) >> 1); return ((kk >> 3) * 4 + (c >> 5)) * 512 + ((kk & 7) * 32 + (c & 31)) * 2; }
__device__ __forceinline__ int v_rd_base(int lane) { return ((lane & 3) << 3) | (((lane >> 2) & 3) << 6) | (((lane >> 4) & 1) << 5) | (((lane >> 5) & 1) << 8); }
constexpr int v_rd_off(int d0, int ks, int half) { return d0 * 512 + ks * 4096 + half * 2048; }
template <int OFF> __device__ __forceinline__ s16x4 tr_read(int vb) { s16x4 r; asm volatile("ds_read_b64_tr_b16 %0, %1 offset:%2" : "=&v"(r) : "v"(vb), "i"(OFF) : "memory"); return r; }
template <int D0> __device__ __forceinline__ void pv_one(f32x16& od, int vb, bf16x8 pa0, bf16x8 pa1, bf16x8 pa2, bf16x8 pa3) {
    const s16x4 l0 = tr_read<v_rd_off(D0, 0, 0)>(vb), h0 = tr_read<v_rd_off(D0, 0, 1)>(vb), l1 = tr_read<v_rd_off(D0, 1, 0)>(vb), h1 = tr_read<v_rd_off(D0, 1, 1)>(vb);
    const s16x4 l2 = tr_read<v_rd_off(D0, 2, 0)>(vb), h2 = tr_read<v_rd_off(D0, 2, 1)>(vb), l3 = tr_read<v_rd_off(D0, 3, 0)>(vb), h3 = tr_read<v_rd_off(D0, 3, 1)>(vb);
    asm volatile("s_waitcnt lgkmcnt(0)" ::: "memory"); ATT_SBAR();
#define ATT_PK(L, H) (bf16x8){L[0], L[1], L[2], L[3], H[0], H[1], H[2], H[3]}
    od = __builtin_amdgcn_mfma_f32_32x32x16_bf16(pa0, ATT_PK(l0, h0), od, 0, 0, 0);
    od = __builtin_amdgcn_mfma_f32_32x32x16_bf16(pa1, ATT_PK(l1, h1), od, 0, 0, 0);
    od = __builtin_amdgcn_mfma_f32_32x32x16_bf16(pa2, ATT_PK(l2, h2), od, 0, 0, 0);
    od = __builtin_amdgcn_mfma_f32_32x32x16_bf16(pa3, ATT_PK(l3, h3), od, 0, 0, 0);
#undef ATT_PK
}
__device__ __forceinline__ void pv_d0(f32x16* o, int vb, bf16x8 pa0, bf16x8 pa1, bf16x8 pa2, bf16x8 pa3) {
    pv_one<0>(o[0], vb, pa0, pa1, pa2, pa3); pv_one<1>(o[1], vb, pa0, pa1, pa2, pa3); pv_one<2>(o[2], vb, pa0, pa1, pa2, pa3); pv_one<3>(o[3], vb, pa0, pa1, pa2, pa3);
}

template <int DK, class Pol>
__device__ __forceinline__ void attn_unit(const Pol& P, LAS char* lds, const int tid_in) {
    int tid = tid_in; asm volatile("" : "+v"(tid));
    const int wid = __builtin_amdgcn_readfirstlane(tid >> 6), lane = tid & 63, r32 = lane & 31, hi = lane >> 5;
    LAS char* V_lds = lds; LAS char* K_lds = lds + KOFF; constexpr int KBYTES = 64 * DK * 2;
    LAS float* wsx = (LAS float*)(lds + WSOFF) + wid * 64; LAS float* li_l = wsx; LAS float* al_l = wsx + 32;
    const float C = Pol::SCALE * 1.4426950408889634f, thr_raw = 8.0f / Pol::SCALE;
    float m_reg = P.m0w(wid), l_reg = P.l0(); f32x16 o[4] = {}; bf16x8 qr[DK / 16];
    { const bf16_t* qp = P.q_row(wid * 32 + r32) + hi * 8;
#pragma unroll
      for (int d0 = 0; d0 < DK / 16; ++d0) qr[d0] = *(const bf16x8*)(qp + d0 * 16); }
    const int sr = tid >> 4, sc = (tid & 15) * 8, vst0 = v_st(sr, sc), vst1 = v_st(32 + sr, sc);
    const int k64r = tid >> 3, k64c = (tid & 7) * 8;
    const int vb0 = (int)(unsigned)(__UINTPTR_TYPE__)V_lds + v_rd_base(lane);
    bf16x8 aV0, aV1, aK0, aK1, bV0, bV1, bK0, bK1;
#define ATT_LOADX(V0, V1, K0, K1, t) do { V0 = *(const bf16x8*)(P.v_row((t), sr) + sc); V1 = *(const bf16x8*)(P.v_row((t), 32 + sr) + sc); \
        if constexpr (DK == 128) { K0 = *(const bf16x8*)(P.k_row((t), sr) + sc); K1 = *(const bf16x8*)(P.k_row((t), 32 + sr) + sc); } \
        else { K0 = *(const bf16x8*)(P.k_row((t), k64r) + k64c); K1 = K0; } } while (0)
#define ATT_WRITEX(V0, V1, K0, K1, b) do { *(LAS bf16x8*)(V_lds + (b) * VBYTES + vst0) = V0; *(LAS bf16x8*)(V_lds + (b) * VBYTES + vst1) = V1; \
        if constexpr (DK == 128) { *(LAS bf16x8*)(K_lds + (b) * KBYTES + kswz128(sr, sc * 2)) = K0; *(LAS bf16x8*)(K_lds + (b) * KBYTES + kswz128(32 + sr, sc * 2)) = K1; } \
        else { *(LAS bf16x8*)(K_lds + (b) * KBYTES + kswz64(k64r, k64c * 2)) = K0; } } while (0)
#define ATT_COMPUTE(t, b) do { if (P.wave_needs((t), wid)) { \
            f32x16 p0, p1; float mn, alpha; bf16x8 pa0, pa1, pa2, pa3; \
            qkt<DK>(p0, p1, K_lds + (b) * KBYTES, qr, r32, hi); \
            P.mask(p0, p1, (t), wid, r32, hi, lds); \
            partialSM(p0, p1, m_reg, mn, alpha, C, thr_raw); \
            if (__any(alpha < 1.f)) { if (hi == 0) al_l[r32] = alpha; asm volatile("s_waitcnt lgkmcnt(0)" ::: "memory"); \
                _Pragma("unroll") for (int d = 0; d < 4; ++d) _Pragma("unroll") for (int r = 0; r < 16; ++r) o[d][r] *= al_l[crow(r, hi)]; } \
            finishSM(p0, p1, alpha, l_reg, pa0, pa1, pa2, pa3); ATT_SBAR(); \
            pv_d0(o, vb0 + (b) * VBYTES, pa0, pa1, pa2, pa3); } } while (0)
    const int NT = P.ntiles();
    ATT_LOADX(aV0, aV1, aK0, aK1, 0);
    if (NT > 1) ATT_LOADX(bV0, bV1, bK0, bK1, 1);
    for (int t = 0; t < NT; t += 2) {
        ATT_WRITEX(aV0, aV1, aK0, aK1, 0);
        __syncthreads();
        if (t + 2 < NT) ATT_LOADX(aV0, aV1, aK0, aK1, t + 2);
        ATT_COMPUTE(t, 0);
        if (t + 1 < NT) {
            ATT_WRITEX(bV0, bV1, bK0, bK1, 1);
            __syncthreads();
            if (t + 3 < NT) ATT_LOADX(bV0, bV1, bK0, bK1, t + 3);
            ATT_COMPUTE(t + 1, 1);
        }
    }
#undef ATT_LOADX
#undef ATT_WRITEX
#undef ATT_COMPUTE
    if (hi == 0) li_l[r32] = l_reg;
    asm volatile("s_waitcnt lgkmcnt(0)" ::: "memory");
    P.finish(o, m_reg, l_reg, li_l, wid, r32, hi);
    __syncthreads();
}

template <class Pol>
__device__ __forceinline__ void attn_unit_dense64(const Pol& P, LAS char* lds, const int tid_in) {
    int tid = tid_in; asm volatile("" : "+v"(tid));
    const int wid = __builtin_amdgcn_readfirstlane(tid >> 6), lane = tid & 63, r32 = lane & 31, hi = lane >> 5;
    LAS char* V_lds = lds; LAS char* K_lds = lds + KOFF; constexpr int KBYTES = 64 * 64 * 2;
    LAS float* wsx = (LAS float*)(lds + WSOFF) + wid * 64; LAS float* li_l = wsx; LAS float* al_l = wsx + 32;
    const float C = Pol::SCALE * 1.4426950408889634f, thr_raw = 8.0f / Pol::SCALE;
    float m_reg = M0, l_reg = 0.f; f32x16 o[4] = {};
    LAS char* qb_l = lds + QOFF + wid * 4096 + lane * 16;
    { const bf16_t* qp = P.q_row(wid * 32 + r32) + hi * 8;
#pragma unroll
      for (int d0 = 0; d0 < 4; ++d0) *(LAS bf16x8*)(qb_l + d0 * 1024) = *(const bf16x8*)(qp + d0 * 16); }
    const int sr = tid >> 4, sc = (tid & 15) * 8, vst0 = v_st(sr, sc), vst1 = v_st(32 + sr, sc);
    const int k64r = tid >> 3, k64c = (tid & 7) * 8, kst = kswz64(k64r, k64c * 2);
    const int vb0 = (int)(unsigned)(__UINTPTR_TYPE__)V_lds + v_rd_base(lane);
    bf16x8 sAv0, sAv1, sAk, sBv0, sBv1, sBk;
#define D64_LOADA(t) do { sAv0 = *(const bf16x8*)(P.v_row((t), sr) + sc); sAv1 = *(const bf16x8*)(P.v_row((t), 32 + sr) + sc); sAk = *(const bf16x8*)(P.k_row((t), k64r) + k64c); } while (0)
#define D64_LOADB(t) do { sBv0 = *(const bf16x8*)(P.v_row((t), sr) + sc); sBv1 = *(const bf16x8*)(P.v_row((t), 32 + sr) + sc); sBk = *(const bf16x8*)(P.k_row((t), k64r) + k64c); } while (0)
#define D64_WRITEA() do { *(LAS bf16x8*)(V_lds + vst0) = sAv0; *(LAS bf16x8*)(V_lds + vst1) = sAv1; *(LAS bf16x8*)(K_lds + kst) = sAk; } while (0)
#define D64_WRITEB() do { *(LAS bf16x8*)(V_lds + VBYTES + vst0) = sBv0; *(LAS bf16x8*)(V_lds + VBYTES + vst1) = sBv1; *(LAS bf16x8*)(K_lds + KBYTES + kst) = sBk; } while (0)
#define D64_WAIT() asm volatile("s_waitcnt vmcnt(3)" ::: "memory")
#define D64_RESC(a) do { if (__any((a) < 1.f)) { if (hi == 0) al_l[r32] = (a); asm volatile("s_waitcnt lgkmcnt(0)" ::: "memory"); \
    _Pragma("unroll") for (int d = 0; d < 4; ++d) _Pragma("unroll") for (int r = 0; r < 16; ++r) o[d][r] *= al_l[crow(r, hi)]; } } while (0)
    f32x16 pA0, pA1, pB0, pB1; float mnA, mnB, alA, alB; bf16x8 pa0, pa1, pa2, pa3; const int NT = P.ntiles();
    D64_LOADA(0); asm volatile("s_waitcnt vmcnt(0)" ::: "memory"); D64_WRITEA(); __syncthreads();
    qkt64_ldsq(pA0, pA1, K_lds, qb_l, r32, hi); partialSM(pA0, pA1, m_reg, mnA, alA, C, thr_raw);
    D64_LOADB(1); D64_LOADA(2);
    D64_WAIT(); D64_WRITEB(); __syncthreads();
#if defined(STAMP_SEL)
    unsigned long long sa0 = 0, sa1 = 0, sa2 = 0, sr0 = 0, sr1 = 0; if (P.stamp) { sa0 = __builtin_amdgcn_s_memtime(); sr0 = __builtin_amdgcn_s_memrealtime(); }
#endif
    for (int j = 1; j + 1 < NT; j += 2) {
        ATT_SBAR(); qkt64_ldsq(pB0, pB1, K_lds + KBYTES, qb_l, r32, hi);
        finishSM(pA0, pA1, alA, l_reg, pa0, pa1, pa2, pa3); ATT_SBAR();
        D64_LOADB(j + 2); ATT_SBAR();
        pv_d0(o, vb0, pa0, pa1, pa2, pa3); partialSM(pB0, pB1, m_reg, mnB, alB, C, thr_raw);
        __syncthreads(); D64_WAIT(); D64_WRITEA();
        D64_RESC(alB); __syncthreads();
        ATT_SBAR(); qkt64_ldsq(pA0, pA1, K_lds, qb_l, r32, hi);
        finishSM(pB0, pB1, alB, l_reg, pa0, pa1, pa2, pa3); ATT_SBAR();
        if (j + 3 < NT) D64_LOADA(j + 3); ATT_SBAR();
        pv_d0(o, vb0 + VBYTES, pa0, pa1, pa2, pa3); partialSM(pA0, pA1, m_reg, mnA, alA, C, thr_raw);
        __syncthreads(); D64_WAIT(); D64_WRITEB();
        D64_RESC(alA); __syncthreads();
    }
    ATT_SBAR(); qkt64_ldsq(pB0, pB1, K_lds + KBYTES, qb_l, r32, hi);
    finishSM(pA0, pA1, alA, l_reg, pa0, pa1, pa2, pa3); ATT_SBAR();
    pv_d0(o, vb0, pa0, pa1, pa2, pa3); partialSM(pB0, pB1, m_reg, mnB, alB, C, thr_raw);
    __syncthreads(); D64_RESC(alB);
    finishSM(pB0, pB1, alB, l_reg, pa0, pa1, pa2, pa3); ATT_SBAR();
    pv_d0(o, vb0 + VBYTES, pa0, pa1, pa2, pa3);
#undef D64_LOADA
#undef D64_LOADB
#undef D64_WRITEA
#undef D64_WRITEB
#undef D64_WAIT
#undef D64_RESC
#if defined(STAMP_SEL)
    if (P.stamp) { sa1 = __builtin_amdgcn_s_memtime(); sr1 = __builtin_amdgcn_s_memrealtime(); }
#endif
    if (hi == 0) li_l[r32] = l_reg;
    asm volatile("s_waitcnt lgkmcnt(0)" ::: "memory");
    P.finish(o, m_reg, l_reg, li_l, wid, r32, hi);
    __syncthreads();
#if defined(STAMP_SEL)
    if (P.stamp && tid == 0) { sa2 = __builtin_amdgcn_s_memtime(); P.stamp[10] = sa0; P.stamp[12] = sa1; P.stamp[13] = sa2; P.stamp[14] = sr0; P.stamp[15] = sr1; }
#endif
}

typedef short v4i16_t __attribute__((ext_vector_type(4)));
__device__ __forceinline__ s16x4 vtr(const LAS char* p) { return __builtin_bit_cast(s16x4, __builtin_amdgcn_ds_read_tr16_b64_v4i16((LAS v4i16_t*)p)); }
template <class Pol>
__device__ __forceinline__ void attn_unit_b2(const Pol& P, LAS char* lds, const int tid_in) {
    int tid = tid_in; asm volatile("" : "+v"(tid));
    const int wid = __builtin_amdgcn_readfirstlane(tid >> 6), lane = tid & 63, r32 = lane & 31, hi = lane >> 5;
    const bool trail = wid >= 4;
    constexpr int KB = 8192, VB = 16384, KR = 3 * VB, WSB = KR + 3 * KB;
    LAS char* V_lds = lds; LAS char* K_lds = lds + KR;
    LAS float* wsx = (LAS float*)(lds + WSB) + wid * 64; LAS float* li_l = wsx; LAS float* al_l = wsx + 32;
    const float C = Pol::SCALE * 1.4426950408889634f, thr_raw = 8.0f / Pol::SCALE;
    float m_reg = M0, l_reg = 0.f; f32x16 o[4] = {}; bf16x8 qr[4];
    { const bf16_t* qp = P.q_row(wid * 32 + r32) + hi * 8;
#pragma unroll
      for (int d0 = 0; d0 < 4; ++d0) qr[d0] = *(const bf16x8*)(qp + d0 * 16); }
    const int sr = tid >> 4, sc = (tid & 15) * 8, vst0 = v_st(sr, sc), vst1 = v_st(32 + sr, sc);
    const int k64r = tid >> 3, k64c = (tid & 7) * 8, kst = kswz64(k64r, k64c * 2);
    const LAS char* vrd = V_lds + v_rd_base(lane);
    bf16x8 sAv0, sAv1, sAk, sBv0, sBv1, sBk;
#define B2_LOADA(t) do { sAv0 = *(const bf16x8*)(P.v_row((t), sr) + sc); sAv1 = *(const bf16x8*)(P.v_row((t), 32 + sr) + sc); sAk = *(const bf16x8*)(P.k_row((t), k64r) + k64c); } while (0)
#define B2_LOADB(t) do { sBv0 = *(const bf16x8*)(P.v_row((t), sr) + sc); sBv1 = *(const bf16x8*)(P.v_row((t), 32 + sr) + sc); sBk = *(const bf16x8*)(P.k_row((t), k64r) + k64c); } while (0)
#define B2_WRITEA(r) do { *(LAS bf16x8*)(V_lds + (r) * VB + vst0) = sAv0; *(LAS bf16x8*)(V_lds + (r) * VB + vst1) = sAv1; *(LAS bf16x8*)(K_lds + (r) * KB + kst) = sAk; } while (0)
#define B2_WRITEB(r) do { *(LAS bf16x8*)(V_lds + (r) * VB + vst0) = sBv0; *(LAS bf16x8*)(V_lds + (r) * VB + vst1) = sBv1; *(LAS bf16x8*)(K_lds + (r) * KB + kst) = sBk; } while (0)
#define B2_BAR() do { asm volatile("s_waitcnt lgkmcnt(0)" ::: "memory"); __builtin_amdgcn_sched_barrier(0); __builtin_amdgcn_s_barrier(); __builtin_amdgcn_sched_barrier(0); } while (0)
#define B2_QK(r) do { const LAS char* Ks_ = K_lds + (r) * KB; p0 = f32x16{}; p1 = f32x16{}; \
    _Pragma("unroll") for (int d0 = 0; d0 < 4; ++d0) { const int cb = (d0 * 16 + hi * 8) * 2; \
        const bf16x8 b0 = *(const LAS bf16x8*)(Ks_ + kswz64(r32, cb)); const bf16x8 b1 = *(const LAS bf16x8*)(Ks_ + kswz64(32 + r32, cb)); \
        p0 = __builtin_amdgcn_mfma_f32_32x32x16_bf16(b0, qr[d0], p0, 0, 0, 0); p1 = __builtin_amdgcn_mfma_f32_32x32x16_bf16(b1, qr[d0], p1, 0, 0, 0); } } while (0)
#define B2_PKV(L, H) (bf16x8){L[0], L[1], L[2], L[3], H[0], H[1], H[2], H[3]}
#define B2_PV(r) do { const LAS char* vb_ = vrd + (r) * VB; \
    _Pragma("unroll") for (int d0 = 0; d0 < 4; ++d0) { \
        const s16x4 l0 = vtr(vb_ + v_rd_off(d0, 0, 0)), h0 = vtr(vb_ + v_rd_off(d0, 0, 1)), l1 = vtr(vb_ + v_rd_off(d0, 1, 0)), h1 = vtr(vb_ + v_rd_off(d0, 1, 1)); \
        const s16x4 l2 = vtr(vb_ + v_rd_off(d0, 2, 0)), h2 = vtr(vb_ + v_rd_off(d0, 2, 1)), l3 = vtr(vb_ + v_rd_off(d0, 3, 0)), h3 = vtr(vb_ + v_rd_off(d0, 3, 1)); \
        o[d0] = __builtin_amdgcn_mfma_f32_32x32x16_bf16(pa0, B2_PKV(l0, h0), o[d0], 0, 0, 0); o[d0] = __builtin_amdgcn_mfma_f32_32x32x16_bf16(pa1, B2_PKV(l1, h1), o[d0], 0, 0, 0); \
        o[d0] = __builtin_amdgcn_mfma_f32_32x32x16_bf16(pa2, B2_PKV(l2, h2), o[d0], 0, 0, 0); o[d0] = __builtin_amdgcn_mfma_f32_32x32x16_bf16(pa3, B2_PKV(l3, h3), o[d0], 0, 0, 0); } } while (0)
#define B2_SM() do { float mn_, alpha_; partialSM(p0, p1, m_reg, mn_, alpha_, C, thr_raw); \
    if (__any(alpha_ < 1.f)) { if (hi == 0) al_l[r32] = alpha_; asm volatile("s_waitcnt lgkmcnt(0)" ::: "memory"); \
        _Pragma("unroll") for (int d = 0; d < 4; ++d) _Pragma("unroll") for (int r = 0; r < 16; ++r) o[d][r] *= al_l[crow(r, hi)]; } \
    finishSM(p0, p1, alpha_, l_reg, pa0, pa1, pa2, pa3); } while (0)
    f32x16 p0, p1; bf16x8 pa0, pa1, pa2, pa3; const int NT = P.ntiles();
    B2_LOADA(0); B2_LOADB(1);
    B2_WRITEA(0);
    B2_LOADA(2);
    B2_BAR();
    if (trail) B2_BAR();
    B2_QK(0); B2_WRITEB(1); B2_LOADB(3);
    B2_BAR();
    B2_SM();
    B2_BAR();
    int rk = 1, rv = 0, rw = 2;
    for (int j = 1; j < NT - 1; j += 2) {
        B2_QK(rk); B2_PV(rv); B2_WRITEA(rw); if (j + 3 < NT) B2_LOADA(j + 3);
        B2_BAR();
        B2_SM();
        B2_BAR();
        rv = rk; rk = rw; rw = (rw == 2) ? 0 : rw + 1;
        B2_QK(rk); B2_PV(rv); B2_WRITEB(rw); if (j + 4 < NT) B2_LOADB(j + 4);
        B2_BAR();
        B2_SM();
        B2_BAR();
        rv = rk; rk = rw; rw = (rw == 2) ? 0 : rw + 1;
    }
    B2_QK(rk); B2_PV(rv);
    B2_BAR();
    B2_SM();
    B2_BAR();
    rv = rk;
    B2_PV(rv);
    if (!trail) B2_BAR();
#undef B2_LOADA
#undef B2_LOADB
#undef B2_WRITEA
#undef B2_WRITEB
#undef B2_QK
#undef B2_PKV
#undef B2_PV
#undef B2_SM
    if (hi == 0) li_l[r32] = l_reg;
    asm volatile("s_waitcnt lgkmcnt(0)" ::: "memory");
    P.finish(o, m_reg, l_reg, li_l, wid, r32, hi);
    __syncthreads();
#undef B2_BAR
}

template <class Pol>
__device__ __forceinline__ void attn_unit_b3(const Pol& P, LAS char* lds, const int tid_in, unsigned long long* stamp_ = nullptr) {
    int tid = tid_in; asm volatile("" : "+v"(tid));
    const int wid = __builtin_amdgcn_readfirstlane(tid >> 6), lane = tid & 63, r32 = lane & 31, hi = lane >> 5;
    constexpr int KB = 8192, VB = 16384, K0OFF = 3 * VB, K1OFF = K0OFF + 2 * KB, WS3 = K1OFF + 2 * KB, Q3OFF = WS3 + 2048;
    static_assert(Q3OFF + 65536 <= LDSCTL_OFF, "mixer B LDS image overlaps the control words");
    LAS char* V_lds = lds;
    LAS float* wsx = (LAS float*)(lds + WS3) + wid * 64; LAS float* li_l = wsx; LAS float* al_l = wsx + 32;
    const float C = Pol::SCALE * 1.4426950408889634f, thr_raw = 8.0f / Pol::SCALE;
    float m0 = M0, l0 = 0.f, m1 = M0, l1 = 0.f; f32x16 o0[4] = {}, o1[4] = {};
    LAS char* qb_l = lds + Q3OFF + wid * 8192 + lane * 16;
#pragma unroll
    for (int mp = 0; mp < 2; ++mp) { const bf16_t* qp = P.q_row(mp, wid * 32 + r32) + hi * 8;
#pragma unroll
        for (int d0 = 0; d0 < 4; ++d0) *(LAS bf16x8*)(qb_l + mp * 4096 + d0 * 1024) = *(const bf16x8*)(qp + d0 * 16); }
    const int sr = tid >> 4, sc = (tid & 15) * 8, vst0 = v_st(sr, sc), vst1 = v_st(32 + sr, sc);
    const int k64r = tid >> 3, k64c = (tid & 7) * 8, kst = kswz64(k64r, k64c * 2);
    const int vb0 = (int)(unsigned)(__UINTPTR_TYPE__)V_lds + v_rd_base(lane);
    bf16x8 aV0, aV1, aK0, aK1;
#define B3_LOAD(V0, V1, K0, K1, t) do { V0 = *(const bf16x8*)(P.v_row((t), sr) + sc); V1 = *(const bf16x8*)(P.v_row((t), 32 + sr) + sc); \
        K0 = *(const bf16x8*)(P.k_row(0, (t), k64r) + k64c); K1 = *(const bf16x8*)(P.k_row(1, (t), k64r) + k64c); } while (0)
#define B3_WRITE(V0, V1, K0, K1, b, vs_) do { *(LAS bf16x8*)(V_lds + (vs_) * VB + vst0) = V0; *(LAS bf16x8*)(V_lds + (vs_) * VB + vst1) = V1; \
        *(LAS bf16x8*)(lds + K0OFF + (b) * KB + kst) = K0; *(LAS bf16x8*)(lds + K1OFF + (b) * KB + kst) = K1; } while (0)
#if defined(B3_PRIO) && B3_PRIO == 1
#define B3_P1() do { __builtin_amdgcn_s_setprio(1); ATT_SBAR(); } while (0)
#define B3_P0() do { ATT_SBAR(); __builtin_amdgcn_s_setprio(0); } while (0)
#else
#define B3_P1() do { } while (0)
#define B3_P0() do { } while (0)
#endif
#define B3_QS(KOFF_, QO_, m_, l_, o_, b, A0, A1, A2, A3) do { f32x16 p0, p1; float mn, alpha; \
        B3_P1(); qkt64_ldsq(p0, p1, lds + (KOFF_) + (b) * KB, qb_l + (QO_), r32, hi); B3_P0(); \
        partialSM(p0, p1, m_, mn, alpha, C, thr_raw); \
        if (__any(alpha < 1.f)) { if (hi == 0) al_l[r32] = alpha; asm volatile("s_waitcnt lgkmcnt(0)" ::: "memory"); \
            _Pragma("unroll") for (int d = 0; d < 4; ++d) _Pragma("unroll") for (int r = 0; r < 16; ++r) o_[d][r] *= al_l[crow(r, hi)]; } \
        finishSM(p0, p1, alpha, l_, A0, A1, A2, A3); ATT_SBAR(); } while (0)
#define B3_PV(o_, vs_, A0, A1, A2, A3) do { B3_P1(); pv_d0(o_, vb0 + (vs_) * VB, A0, A1, A2, A3); B3_P0(); } while (0)
#define B3_MAP(KOFF_, QO_, m_, l_, o_, b, vs_) do { bf16x8 pa0, pa1, pa2, pa3; B3_QS(KOFF_, QO_, m_, l_, o_, b, pa0, pa1, pa2, pa3); B3_PV(o_, vs_, pa0, pa1, pa2, pa3); } while (0)
    const int NT = P.ntiles();
    const bool young = wid >= 4;
    bf16x8 c0 = {}, c1 = {}, c2 = {}, c3 = {};
    int vs = 0, vprev = 0;
#if defined(STAMP_SEL)
    unsigned long long sa0 = 0, sa1 = 0, sr0 = 0, sr1 = 0; if (stamp_) { sa0 = __builtin_amdgcn_s_memtime(); sr0 = __builtin_amdgcn_s_memrealtime(); }
#endif
    B3_LOAD(aV0, aV1, aK0, aK1, 0);
    for (int t = 0; t < NT; ++t) {
        const int b = t & 1;
        B3_WRITE(aV0, aV1, aK0, aK1, b, vs);
        __syncthreads();
        if (t + 1 < NT) B3_LOAD(aV0, aV1, aK0, aK1, t + 1);
        if (young && t > 0) B3_PV(o1, vprev, c0, c1, c2, c3);
        B3_MAP(K0OFF, 0, m0, l0, o0, b, vs);
        B3_QS(K1OFF, 4096, m1, l1, o1, b, c0, c1, c2, c3);
        if (!young) B3_PV(o1, vs, c0, c1, c2, c3);
        vprev = vs; vs = (vs == 2) ? 0 : vs + 1;
    }
    if (young) B3_PV(o1, vprev, c0, c1, c2, c3);
#if defined(STAMP_SEL)
    if (stamp_ && wid == STAMP_WAVE) { sa1 = __builtin_amdgcn_s_memtime(); sr1 = __builtin_amdgcn_s_memrealtime(); if (lane == 0) { stamp_[10] = sa0; stamp_[12] = sa1; stamp_[13] = sa1; stamp_[14] = sr0; stamp_[15] = sr1; } }
#endif
#undef B3_LOAD
#undef B3_WRITE
#undef B3_MAP
#undef B3_QS
#undef B3_PV
#undef B3_P1
#undef B3_P0
    if (hi == 0) { li_l[r32] = l0; al_l[r32] = l1; }
    asm volatile("s_waitcnt lgkmcnt(0)" ::: "memory");
    P.finish2(o0, o1, li_l, al_l, wid, r32, hi);
    __syncthreads();
}

template <class RowFn>
__device__ __forceinline__ void store_o_i8(const f32x16* o, const LAS float* li_l, int wid, int r32, int hi, float qo, const RowFn& orow) {
#pragma unroll
    for (int r = 0; r < 16; ++r) { const int i = crow(r, hi); const float inv = __builtin_amdgcn_rcpf(li_l[i]) * qo; unsigned char* p = orow(wid * 32 + i) + r32;
#pragma unroll
        for (int d0 = 0; d0 < 4; ++d0) { int q = (int)__builtin_rintf(o[d0][r] * inv); q = q < -127 ? -127 : (q > 127 ? 127 : q); p[d0 * 32] = (unsigned char)q; } }
}
template <class RowFn>
__device__ __forceinline__ void store_o_bf16(const f32x16* o, const LAS float* li_l, int wid, int r32, int hi, const RowFn& orow) {
#pragma unroll
    for (int r = 0; r < 16; ++r) { const int i = crow(r, hi); const float inv = __builtin_amdgcn_rcpf(li_l[i]); bf16_t* p = orow(wid * 32 + i) + r32;
#pragma unroll
        for (int d0 = 0; d0 < 4; ++d0) p[d0 * 32] = (bf16_t)(cvtpk(o[d0][r] * inv, 0.f) & 0xffffu); }
}
struct PolA {
    static constexpr float SCALE = 0.08838834764831845f;
    const bf16_t* proj; unsigned char* ag; float* lse;
    int b, hh, j, r, L, qb, tlo, nt;
    __device__ __forceinline__ const bf16_t* tok(int pos) const { return proj + (size_t)(b * SEQ + pos) * PROJ_PITCH; }
    __device__ __forceinline__ const bf16_t* q_row(int i) const { return tok(j + r * (qb * 256 + i)) + OFF_QA + hh * 128; }
    __device__ __forceinline__ int ntiles() const { return nt; }
    __device__ __forceinline__ int kidx(int t, int kk) const { int ki = qb * 256 - 64 + 64 * (t + tlo) + kk; ki = ki < 0 ? 0 : (ki > L - 1 ? L - 1 : ki); return j + r * ki; }
    __device__ __forceinline__ const bf16_t* k_row(int t, int kk) const { return tok(kidx(t, kk)) + OFF_KA + hh * 128; }
    __device__ __forceinline__ const bf16_t* v_row(int t, int kk) const { return tok(kidx(t, kk)) + OFF_VA + hh * 128; }
    __device__ __forceinline__ bool wave_needs(int t, int wid) const { const int kbase = qb * 256 - 64 + 64 * (t + tlo), q0 = qb * 256 + wid * 32; return kbase <= q0 + 95 && kbase + 63 >= q0 - 64; }
    __device__ __forceinline__ void mask(f32x16& p0, f32x16& p1, int t, int wid, int r32, int hi, LAS char*) const {
        const int qi = qb * 256 + wid * 32 + r32; const int lo = qi - 64 < 0 ? 0 : qi - 64, hi_ = qi + 64 > L - 1 ? L - 1 : qi + 64;
        const unsigned span = (unsigned)(hi_ - lo); const int t0 = qb * 256 - 64 + 64 * (t + tlo) + 4 * hi - lo;
#pragma unroll
        for (int r = 0; r < 16; ++r) { const int kk = (r & 3) + 8 * (r >> 2);
            p0[r] = ((unsigned)(t0 + kk) <= span) ? p0[r] : NEG; p1[r] = ((unsigned)(t0 + kk + 32) <= span) ? p1[r] : NEG; }
    }
    __device__ __forceinline__ float m0w(int) const { return M0; }
    __device__ __forceinline__ float l0() const { return 0.f; }
    __device__ __forceinline__ void finish(const f32x16* o, float m_reg, float l_reg, const LAS float* li_l, int wid, int r32, int hi) const {
        const int h6 = hh % 6;
        store_o_i8(o, li_l, wid, r32, hi, QO, [&](int i) { return ag + (size_t)(b * SEQ + j + r * (qb * 256 + i)) * 768 + h6 * 128; });
        if (hi == 0) lse[(size_t)(b * SEQ + j + r * (qb * 256 + wid * 32 + r32)) * 6 + h6] = m_reg * SCALE + __logf(l_reg);
    }
};
struct PolC2 {
    static constexpr float SCALE = 0.08838834764831845f;
    const bf16_t* proj; unsigned char* oc; const float* sinkp; int b, kvh, qb;
    __device__ __forceinline__ const bf16_t* tok(int pos) const { return proj + (size_t)(b * SEQ + pos) * PROJ_PITCH; }
    __device__ __forceinline__ const bf16_t* q_row(int i) const { return tok(qb * 64 + (i & 63)) + OFF_QC + (kvh * 4 + (i >> 6)) * 128; }
    __device__ __forceinline__ int ntiles() const { return 5; }
    __device__ __forceinline__ int kpos(int t, int kk) const { int k = qb * 64 - 128 + 64 * t + kk; return k < 0 ? 0 : (k > SEQ - 1 ? SEQ - 1 : k); }
    __device__ __forceinline__ const bf16_t* k_row(int t, int kk) const { return tok(kpos(t, kk)) + OFF_KC + kvh * 128; }
    __device__ __forceinline__ const bf16_t* v_row(int t, int kk) const { return tok(kpos(t, kk)) + OFF_VC + kvh * 128; }
    __device__ __forceinline__ bool wave_needs(int t, int) const { const int kbase = qb * 64 - 128 + 64 * t; return kbase + 63 >= 0 && kbase < SEQ; }
    __device__ __forceinline__ void mask(f32x16& p0, f32x16& p1, int t, int wid, int r32, int hi, LAS char*) const {
        const int qi = qb * 64 + (wid & 1) * 32 + r32; const int lo = qi - 128 < 0 ? 0 : qi - 128, hi_ = qi + 128 > SEQ - 1 ? SEQ - 1 : qi + 128;
        const unsigned span = (unsigned)(hi_ - lo); const int t0 = qb * 64 - 128 + 64 * t + 4 * hi - lo;
#pragma unroll
        for (int r = 0; r < 16; ++r) { const int kk = (r & 3) + 8 * (r >> 2);
            p0[r] = ((unsigned)(t0 + kk) <= span) ? p0[r] : NEG; p1[r] = ((unsigned)(t0 + kk + 32) <= span) ? p1[r] : NEG; }
    }
    __device__ __forceinline__ float m0w(int wid) const { return sinkp[kvh * 4 + (wid >> 1)] * (1.0f / SCALE); }
    __device__ __forceinline__ float l0() const { return 1.f; }
    __device__ __forceinline__ void finish(const f32x16* o, float, float, const LAS float* li_l, int wid, int r32, int hi) const {
        store_o_i8(o, li_l, wid, r32, hi, QO, [&](int i) { return oc + (size_t)(b * SEQ + qb * 64 + (i & 63)) * 1024 + (kvh * 4 + (i >> 6)) * 128; });
    }
};
struct PolD {
    static constexpr float SCALE = 0.08838834764831845f;
    const bf16_t* proj; unsigned char* od; int b, h, rb, lo, nt;
    __device__ __forceinline__ const bf16_t* tok(int pos) const { return proj + (size_t)(b * SEQ + pos) * PROJ_PITCH; }
    __device__ __forceinline__ const bf16_t* q_row(int i) const { return tok(rb * 256 + i) + OFF_QD + h * 128; }
    __device__ __forceinline__ int ntiles() const { return nt; }
    __device__ __forceinline__ const bf16_t* k_row(int t, int kk) const { return tok((lo + t) * 64 + kk) + OFF_KD + h * 128; }
    __device__ __forceinline__ const bf16_t* v_row(int t, int kk) const { return tok((lo + t) * 64 + kk) + OFF_VD + h * 128; }
    __device__ __forceinline__ bool wave_needs(int t, int wid) const { const int qr_ = rb * 4 + (wid >> 1); int rs = qr_ - 4; rs = rs < 0 ? 0 : (rs > 56 ? 56 : rs); const int kr = lo + t; return kr >= rs && kr < rs + 8; }
    __device__ __forceinline__ void mask(f32x16& p0, f32x16& p1, int t, int wid, int r32, int hi, LAS char* lds) const {
        const int qr_ = rb * 4 + (wid >> 1), qc = 32 * (wid & 1) + r32, kr = lo + t; int cs = qc - 8; cs = cs < 0 ? 0 : (cs > 48 ? 48 : cs);
        const LAS float* T = (const LAS float*)(lds + TABOFF) + (kr - qr_ + 7) * 31 + 15 - qc + 4 * hi; const int kc0 = 4 * hi - cs;
#pragma unroll
        for (int r = 0; r < 16; ++r) { const int kk = (r & 3) + 8 * (r >> 2);
            const float b0 = T[kk], b1 = T[kk + 32];
            p0[r] = ((unsigned)(kc0 + kk) < 16u) ? p0[r] + b0 : NEG; p1[r] = ((unsigned)(kc0 + kk + 32) < 16u) ? p1[r] + b1 : NEG; }
    }
    __device__ __forceinline__ float m0w(int) const { return M0; }
    __device__ __forceinline__ float l0() const { return 0.f; }
    __device__ __forceinline__ void finish(const f32x16* o, float, float, const LAS float* li_l, int wid, int r32, int hi) const {
        store_o_i8(o, li_l, wid, r32, hi, QO, [&](int i) { return od + (size_t)(b * SEQ + rb * 256 + i) * 1024 + h * 128; });
    }
};
struct PolB {
    static constexpr float SCALE = 0.125f;
    const bf16_t* proj; bf16_t* ob; float* scr; const float* subln; const float* lam; float lambda_init; int b, h, qb, map;
#if defined(STAMP_SEL)
    unsigned long long* stamp;
#endif
    __device__ __forceinline__ const bf16_t* tok(int pos) const { return proj + (size_t)(b * SEQ + pos) * PROJ_PITCH; }
    __device__ __forceinline__ const bf16_t* q_row(int i) const { return tok(qb * 256 + i) + OFF_QB + (2 * h + map) * 64; }
    __device__ __forceinline__ int ntiles() const { return SEQ / 64; }
    __device__ __forceinline__ const bf16_t* k_row(int t, int kk) const { return tok(64 * t + kk) + OFF_KB + (2 * h + map) * 64; }
    __device__ __forceinline__ const bf16_t* v_row(int t, int kk) const { return tok(64 * t + kk) + OFF_VB + h * 128; }
    __device__ __forceinline__ bool wave_needs(int, int) const { return true; }
    __device__ __forceinline__ void mask(f32x16&, f32x16&, int, int, int, int, LAS char*) const {}
    __device__ __forceinline__ float m0w(int) const { return M0; }
    __device__ __forceinline__ float l0() const { return 0.f; }
    __device__ __forceinline__ void finish(const f32x16* o, float, float, const LAS float* li_l, int wid, int r32, int hi) const {
        if (map == 0) {
#pragma unroll
            for (int r = 0; r < 16; ++r) { const int i = crow(r, hi); const float inv = __builtin_amdgcn_rcpf(li_l[i]); float* p = scr + (size_t)(wid * 32 + i) * 128 + r32;
#pragma unroll
                for (int d0 = 0; d0 < 4; ++d0) p[d0 * 32] = o[d0][r] * inv; }
        } else {
            const int ln_ = r32 + 32 * hi; const float d01 = wave_sum(lam[ln_] * lam[64 + ln_]), d23 = wave_sum(lam[128 + ln_] * lam[192 + ln_]);
            const float lmbda = __expf(d01) - __expf(d23) + lambda_init, oscale = 1.0f - lambda_init;
            float sw[4];
#pragma unroll
            for (int d0 = 0; d0 < 4; ++d0) sw[d0] = subln[d0 * 32 + r32] * oscale;
#pragma unroll
            for (int r = 0; r < 16; ++r) { const int i = crow(r, hi); const float inv = __builtin_amdgcn_rcpf(li_l[i]); const float* p = scr + (size_t)(wid * 32 + i) * 128 + r32;
                float v[4]; float ss = 0.f;
#pragma unroll
                for (int d0 = 0; d0 < 4; ++d0) { v[d0] = p[d0 * 32] - lmbda * (o[d0][r] * inv); ss += v[d0] * v[d0]; }
#pragma unroll
                for (int s = 1; s < 32; s <<= 1) ss += __shfl_xor(ss, s);
                const float rinv = rsqrtf(ss * (1.0f / 128.0f) + SUBLN_EPS);
                bf16_t* q = ob + (size_t)(b * SEQ + qb * 256 + wid * 32 + i) * 1024 + h * 128 + r32;
#pragma unroll
                for (int d0 = 0; d0 < 4; ++d0) q[d0 * 32] = (bf16_t)(cvtpk(v[d0] * rinv * sw[d0], 0.f) & 0xffffu); }
        }
    }
};

struct PolB2 {
    static constexpr float SCALE = 0.125f;
    const bf16_t* proj; unsigned char* ob; const float* subln; const float* lam; float lambda_init; int b, h, qb;
    __device__ __forceinline__ const bf16_t* tok(int pos) const { return proj + (size_t)(b * SEQ + pos) * PROJ_PITCH; }
    __device__ __forceinline__ const bf16_t* q_row(int mp, int i) const { return tok(qb * 256 + i) + OFF_QB + (2 * h + mp) * 64; }
    __device__ __forceinline__ int ntiles() const { return SEQ / 64; }
    __device__ __forceinline__ const bf16_t* k_row(int mp, int t, int kk) const { return tok(64 * t + kk) + OFF_KB + (2 * h + mp) * 64; }
    __device__ __forceinline__ const bf16_t* v_row(int t, int kk) const { return tok(64 * t + kk) + OFF_VB + h * 128; }
    __device__ __forceinline__ void finish2(const f32x16* o0, const f32x16* o1, const LAS float* l0_l, const LAS float* l1_l, int wid, int r32, int hi) const {
        const int ln_ = r32 + 32 * hi; const float d01 = wave_sum(lam[ln_] * lam[64 + ln_]), d23 = wave_sum(lam[128 + ln_] * lam[192 + ln_]);
        const float lmbda = __expf(d01) - __expf(d23) + lambda_init;
        float sw[4];
#pragma unroll
        for (int d0 = 0; d0 < 4; ++d0) sw[d0] = subln[d0 * 32 + r32] * QX;
#pragma unroll
        for (int r = 0; r < 16; ++r) { const int i = crow(r, hi); const float inv0 = __builtin_amdgcn_rcpf(l0_l[i]), inv1 = lmbda * __builtin_amdgcn_rcpf(l1_l[i]);
            float v[4]; float ss = 0.f;
#pragma unroll
            for (int d0 = 0; d0 < 4; ++d0) { v[d0] = o0[d0][r] * inv0 - o1[d0][r] * inv1; ss += v[d0] * v[d0]; }
#pragma unroll
            for (int s = 1; s < 32; s <<= 1) ss += __shfl_xor(ss, s);
            const float rinv = rsqrtf(ss * (1.0f / 128.0f) + SUBLN_EPS);
            unsigned char* q = ob + (size_t)(b * SEQ + qb * 256 + wid * 32 + i) * 1024 + h * 128 + r32;
#pragma unroll
            for (int d0 = 0; d0 < 4; ++d0) { int t = (int)__builtin_rintf(v[d0] * rinv * sw[d0]); t = t < -127 ? -127 : (t > 127 ? 127 : t); q[d0 * 32] = (unsigned char)t; } }
    }
};

#ifndef ATT_MASK
#define ATT_MASK 15
#endif
#define ATT_ON(k) ((ATT_MASK >> (k)) & 1)
#ifndef ATT_REP
#define ATT_REP 0
#endif
#define ATT_NREP(k) (((ATT_REP >> (k)) & 1) ? 2 : 1)
struct Ptrs { const bf16_t* proj; bf16_t* ag; float* lse; unsigned char* ob; unsigned char* oc; unsigned char* od; const float* lam; const float* subln; const float* sink; const float* rpb; float lambda_init;
#if defined(STAMP_SEL)
    unsigned long long* stamp;
#endif
};
__device__ __forceinline__ void attn_phase(const Ptrs& X, LAS char* lds, const int tid, const int vcu, const int G, const int wgid) {
    const int lane = tid & 63;
    if (ATT_ON(0)) for (int rep = 0; rep < ATT_NREP(0); ++rep) {
        for (int u = vcu; u < 512; u += G) {
            PolB2 P{X.proj, X.ob, X.subln, X.lam, X.lambda_init, u >> 7, (u >> 4) & 7, u & 15};
#if defined(STAMP_SEL)
            attn_unit_b3<PolB2>(P, lds, tid, (wgid == STAMP_WG && u == vcu && rep == 0) ? X.stamp : nullptr);
#else
            attn_unit_b3<PolB2>(P, lds, tid);
#endif
        }
    }
    if (ATT_ON(1)) for (int rep = 0; rep < ATT_NREP(1); ++rep) for (int u = vcu; u < 512; u += G) {
        const int rb = u & 15, h = (u >> 4) & 7, b = u >> 7; int lo = rb * 4 - 4; lo = lo < 0 ? 0 : (lo > 56 ? 56 : lo); int hi_ = rb * 4 + 3 - 4; hi_ = hi_ < 0 ? 0 : (hi_ > 56 ? 56 : hi_); hi_ += 7;
        { LAS float* T = (LAS float*)(lds + TABOFF); for (int i = tid; i < 465; i += 512) T[i] = X.rpb[h * 465 + i] * (1.0f / PolD::SCALE); }
        PolD P{X.proj, X.od, b, h, rb, lo, hi_ - lo + 1};
        attn_unit<128, PolD>(P, lds, tid);
    }
    if (ATT_ON(2)) for (int rep = 0; rep < ATT_NREP(2); ++rep) for (int u = vcu; u < 512; u += G) {
        const int qb = u & 63, kvh = (u >> 6) & 1, b = u >> 7;
        PolC2 P{X.proj, X.oc, X.sink, b, kvh, qb};
        attn_unit<128, PolC2>(P, lds, tid);
    }
    if (ATT_ON(3)) for (int rep = 0; rep < ATT_NREP(3); ++rep) for (int u = vcu; u < 1152; u += G) {
        const int g = u / 384, v = u % 384, w16 = v & 15, bh = v >> 4, h6 = bh % 6, b = bh / 6;
        const int r = g == 0 ? 1 : (g == 1 ? 4 : 16), L = SEQ / r;
        const int qb = w16 / r, tlo = qb == 0 ? 1 : 0; int thi = (L - qb * 256 + 64 + 63) / 64; thi = thi > 6 ? 6 : thi;
        PolA P{X.proj, (unsigned char*)X.ag + (size_t)g * MTOK * 768, X.lse + (size_t)g * MTOK * 6, b, g * 6 + h6, w16 % r, r, L, qb, tlo, thi - tlo};
        attn_unit<128, PolA>(P, lds, tid);
    }
}
#undef ATT_SBAR
}

struct InPtrs { const float *x, *w_in, *b_gate, *w_branch, *w_out, *diff_lambda, *diff_subln, *sink_logit, *na_rpb, *w_router, *w_exp_gate, *w_exp_up, *w_exp_down, *ln_gain, *ln_bias; };

__device__ __forceinline__ void prologue_phase(const InPtrs& I, unsigned char* ws, LAS unsigned char* lds, int gw, int NGW, int wave, int lane) {
    LAS unsigned char* scr = lds + wave * 9216;
    { const f32x4* xs = (const f32x4*)I.x;
      for (size_t i = (size_t)gw * 64 + lane; i < (size_t)MTOK * DM / 8; i += (size_t)NGW * 64) {
          const f32x4 a = xs[2 * i], b = xs[2 * i + 1];
          u32x2 q; q.x = q8x4(a[0], a[1], a[2], a[3], QX); q.y = q8x4(b[0], b[1], b[2], b[3], QX); ((u32x2*)(ws + WS_X8))[i] = q; } }
    { float* r128 = (float*)(ws + WS_ROPE128); float* r64 = (float*)(ws + WS_ROPE64);
      for (int i = gw * 64 + lane; i < SEQ * 64 + SEQ * 32; i += NGW * 64) {
          int pos, ii, half; float* dst;
          if (i < SEQ * 64) { pos = i >> 6; ii = i & 63; half = 64; dst = r128 + 2 * (size_t)i; } else { const int k = i - SEQ * 64; pos = k >> 5; ii = k & 31; half = 32; dst = r64 + 2 * (size_t)k; }
          const float inv = (float)pow(10000.0, -(double)ii / (double)half); const float ang = (float)pos * inv;
          dst[0] = (float)cos((double)ang); dst[1] = (float)sin((double)ang); } }
    bf16_t* WIN = (bf16_t*)(ws + WS_WIN); bf16_t* WOUT = (bf16_t*)(ws + WS_WOUT); bf16_t* WGU = (bf16_t*)(ws + WS_WGU); bf16_t* WDN = (bf16_t*)(ws + WS_WDN);
    constexpr int N1 = DEPTH * 32 * 356, N2 = DEPTH * 60 * 32, N3 = DEPTH * 32 * 32, N4 = DEPTH * NEXP * 32 * 32, N5 = DEPTH * NEXP * 16 * 32;
    for (int it = gw; it < N1 + N2 + N3 + N4 + N5; it += NGW) {
        int r = it;
        if (r < N1) { const int sub = r & 15, grp = r >> 4; const int nb = (grp % 89) * 4 + (sub & 3), kb = ((grp / 89) & 7) * 4 + (sub >> 2), l = grp / (89 * 8); const int n = nb * 64 + lane;
            const int c0 = nb * 64;
            if (c0 >= 14592) tr_item8(I.w_in + (size_t)l * DM * IN_TOTAL, IN_TOTAL, n, kb * 64, (unsigned char*)(ws + WS_W8G) + ((size_t)l * 8192 + (c0 - 14592)) * DM + kb * 64, DM, QWG, scr, lane);
            else { const bool isv = (c0 >= 4608 && c0 < 6912) || (c0 >= 8960 && c0 < 9984) || (c0 >= 11264 && c0 < 11520) || (c0 >= 13568);
                tr_item8(I.w_in + (size_t)l * DM * IN_TOTAL, IN_TOTAL, win_src_col(n), kb * 64, (unsigned char*)(ws + WS_W8Q) + ((size_t)l * 14592 + c0) * DM + kb * 64, DM, isv ? QWU : QWG, scr, lane); }
            continue; }
        r -= N1;
        if (r < N2) { const int nb = r % 32, kbg = (r / 32) % 60, l = r / (32 * 60); const int n = nb * 64 + lane;
            int ro, Kb, kb; if (kbg < 12) { ro = 0; Kb = 768; kb = kbg; } else { const int q = (kbg - 12) >> 4; ro = 768 + 1024 * q; Kb = 1024; kb = (kbg - 12) & 15; }
            const int brn = kbg < 12 ? 0 : 1 + ((kbg - 12) >> 4); (void)Kb;
            tr_item8(I.w_branch + ((size_t)l * BR_TOTAL + ro) * DM, DM, n, kb * 64, (unsigned char*)(ws + WS_W8BR) + ((size_t)(l * 4 + brn) * DM + nb * 64) * 1024 + kb * 64, 1024, brn == 0 ? QWBA : QWBC, scr, lane);
            continue; }
        r -= N2;
        if (r < N3) { const int nb = r % 32, kb = (r / 32) % 32, l = r / (32 * 32); const int n = nb * 64 + lane;
            tr_item8(I.w_out + (size_t)l * DM * DM, DM, n, kb * 64, (unsigned char*)WOUT + ((size_t)l * DM + nb * 64) * DM + kb * 64, DM, QWU, scr, lane); continue; }
        r -= N3;
        if (r < N4) { const int sub = r & 15, grp = r >> 4; const int nb = (grp & 7) * 4 + (sub & 3), kb = ((grp >> 3) & 7) * 4 + (sub >> 2), le = grp >> 6; const int n = nb * 64 + lane, pn = n >> 8, bj = (n >> 7) & 1, jj = n & 127;
            tr_item8((bj ? I.w_exp_up : I.w_exp_gate) + (size_t)le * DM * DEXP, DEXP, pn * 128 + jj, kb * 64, (unsigned char*)WGU + ((size_t)le * 2048 + nb * 64) * DM + kb * 64, DM, bj ? QWU : QWG, scr, lane); continue; }
        r -= N4;
        { const int sub = r & 15, grp = r >> 4; const int nb = (grp & 7) * 4 + (sub & 3), kb = ((grp >> 3) & 3) * 4 + (sub >> 2), le = grp >> 5; const int n = nb * 64 + lane;
            tr_item8(I.w_exp_down + (size_t)le * DEXP * DM, DM, n, kb * 64, (unsigned char*)WDN + ((size_t)le * DM + nb * 64) * DEXP + kb * 64, DEXP, QWD, scr, lane); }
    }
}

struct Args { const float* in[15]; float* out; unsigned char* ws; int ph_lo, ph_hi; };
__global__ void __launch_bounds__(NWAVES * 64, LB_WAVES) fwd(Args args) {
    extern __shared__ __attribute__((aligned(16))) unsigned char lds_raw[];
    LAS unsigned char* lds = (LAS unsigned char*)lds_raw;
    for (int u = threadIdx.x; u < (LDS_BYTES - LDSCTL_OFF) / 4; u += NWAVES * 64) ((LAS unsigned*)(lds + LDSCTL_OFF))[u] = 0u;
    __syncthreads();
    unsigned* ctl = (unsigned*)(args.ws + WS_CTL);
    XcdBarrier bar = xcd_barrier_post(ctl + CW_BAR, (volatile LAS unsigned*)(lds + LDSCTL_OFF));
    const int lo = args.ph_lo, hi = args.ph_hi;
#ifndef SCALAR_ATTN
#define SCALAR_ATTN 0
#endif
#ifndef REP_MASK
#define REP_MASK 0
#endif
#define NREP(k) (((REP_MASK >> (k)) & 1) ? 2 : 1)
#ifndef PH_MASK
#define PH_MASK 0xFFFF
#endif
#define PHON(k) ((PH_MASK >> (k)) & 1)
#define IN(k) (lo <= (k) && (k) < hi)
#define PHASE_LOCALS long zz = 0; asm volatile("" : "+s"(zz)); unsigned char* const ws = args.ws + zz; int tid = threadIdx.x; asm volatile("" : "+v"(tid)); int bx = blockIdx.x, G = gridDim.x; asm volatile("" : "+s"(bx), "+s"(G)); \
    const int lane = tid & 63, wave = __builtin_amdgcn_readfirstlane(tid >> 6); const int vcu = (G % 8 == 0) ? (bx % 8) * (G / 8) + bx / 8 : bx; \
    const int gw = vcu * NWAVES + wave, NGW = G * NWAVES; (void)lane; (void)gw; (void)NGW
#if defined(STAMP_SEL)
#define SEAM(k) do { if (IN(k) && IN((k) + 1)) { const unsigned long long b0_ = __builtin_amdgcn_s_memrealtime(); xcd_barrier(bar); \
    if (__builtin_amdgcn_readfirstlane((int)blockIdx.x) == STAMP_WG && threadIdx.x == 0) { unsigned long long* st_ = (unsigned long long*)(args.ws + WS_CTL + 65536); st_[20] += __builtin_amdgcn_s_memrealtime() - b0_; } } } while (0)
#else
#define SEAM(k) do { if (IN(k) && IN((k) + 1)) xcd_barrier(bar); } while (0)
#endif

#define XF ((float*)(ws + WS_XF))
#define XB ((bf16_t*)(ws + WS_XB))
#define PROJ ((bf16_t*)(ws + WS_PROJ))
#define OA ((bf16_t*)(ws + WS_OA))
#define OB ((bf16_t*)(ws + WS_OB))
#define OC ((bf16_t*)(ws + WS_OC))
#define OD ((bf16_t*)(ws + WS_OD))
#define AG ((bf16_t*)(ws + WS_AG))
#define LSE ((float*)(ws + WS_LSE))
#define MIXED ((bf16_t*)(ws + WS_MIXED))
#define PRELN ((float*)(ws + WS_PRELN))
#define XG ((bf16_t*)(ws + WS_XG))
#define HB ((bf16_t*)(ws + WS_H))
#define YB ((bf16_t*)(ws + WS_Y))
#define AFF ((float*)(ws + WS_AFF))
#define IDX ((int*)(ws + WS_IDX))
#define GV ((float*)(ws + WS_GV))
#define SLOT ((int*)(ws + WS_SLOT))

    if (PHON(0) && IN(0)) for (int rep = 0; rep < NREP(0); ++rep) { PHASE_LOCALS;
        InPtrs I; I.x = args.in[0 + zz]; I.w_in = args.in[1 + zz]; I.b_gate = args.in[2 + zz]; I.w_branch = args.in[3 + zz]; I.w_out = args.in[4 + zz]; I.diff_lambda = args.in[5 + zz]; I.diff_subln = args.in[6 + zz];
        I.sink_logit = args.in[7 + zz]; I.na_rpb = args.in[8 + zz]; I.w_router = args.in[9 + zz]; I.w_exp_gate = args.in[10 + zz]; I.w_exp_up = args.in[11 + zz]; I.w_exp_down = args.in[12 + zz]; I.ln_gain = args.in[13 + zz]; I.ln_bias = args.in[14 + zz];
        prologue_phase(I, ws, lds, gw, NGW, wave, lane); if (rep == NREP(0) - 1) SEAM(0); else xcd_barrier(bar); }

    for (int l = 0; l < DEPTH; ++l) {
        const int pb = 1 + l * NPL;
        if (PHON(1) && IN(pb + 0)) for (int rep = 0; rep < NREP(1); ++rep) { PHASE_LOCALS;
            { pg8::Gemm g{(const bf16_t*)(ws + WS_X8), (const bf16_t*)(ws + WS_W8Q + (size_t)l * 14592 * DM), MTOK, 14592, DM / 2, 0, 0, 0, nullptr STAMP_ARG(nullptr)}; pg8::StaticOrder S; S.init(MTOK, 14592, G, bx);
              pg8::EpiProjT<true> E{PROJ, (const float*)(ws + WS_ROPE128), (const float*)(ws + WS_ROPE64), 0, 1 << 30, 0, 1.0f / (QX * QWG), 1.0f / (QX * QWU)};
              pg8::gemm_phase<pg8::EpiProjT<true>, pg8::StaticOrder, true, true, false, true>(lds, g, S, E, tid); }
            { pg8::Gemm g{(const bf16_t*)(ws + WS_X8), (const bf16_t*)(ws + WS_W8G + (size_t)l * 8192 * DM), MTOK, 8192, DM / 2, 0, 0, 0, nullptr STAMP_ARG(nullptr)}; pg8::StaticOrder S; S.init(MTOK, 8192, G, bx); if (G == 256) { S.skip_lo = 1792; S.skip_hi = 1856; }
              pg8::EpiGate8 E{(unsigned char*)(ws + WS_GATE), args.in[2 + zz] + (size_t)l * 8192, 1.0f / (QX * QWG)};
              int tid2 = tid; asm volatile("" : "+v"(tid2));
              pg8::gemm_phase<pg8::EpiGate8, pg8::StaticOrder, true, true, false, true>(lds, g, S, E, tid2); }
            if (rep == NREP(1) - 1) SEAM(pb + 0); else xcd_barrier(bar);
        }
        if (PHON(2) && IN(pb + 1)) for (int rep = 0; rep < NREP(2); ++rep) { PHASE_LOCALS;
            const float li = l == 0 ? 0.2f : (l == 1 ? 0.35550906759096926f : (l == 2 ? 0.47071301834358416f : 0.5560582041556405f));
#if SCALAR_ATTN
            { AttnPtrs P{PROJ, AG, LSE, nullptr, nullptr, nullptr, nullptr, nullptr, nullptr, nullptr, li}; scalar_attn_phase<0>(P, lds, gw, NGW, wave, lane); }
            { AttnPtrs P{PROJ, nullptr, nullptr, OB, nullptr, nullptr, args.in[5 + zz] + l * 256, args.in[6 + zz] + l * 128, nullptr, nullptr, li}; scalar_attn_phase<1>(P, lds, gw, NGW, wave, lane); }
            { AttnPtrs P{PROJ, nullptr, nullptr, nullptr, OC, nullptr, nullptr, nullptr, args.in[7 + zz] + l * 8, nullptr, li}; scalar_attn_phase<2>(P, lds, gw, NGW, wave, lane); }
            { AttnPtrs P{PROJ, nullptr, nullptr, nullptr, nullptr, OD, nullptr, nullptr, nullptr, args.in[8 + zz] + (size_t)l * 8 * 465, li}; scalar_attn_phase<3>(P, lds, gw, NGW, wave, lane); }
#else
            att::Ptrs X{PROJ, AG, LSE, (unsigned char*)(ws + WS_O8 + (size_t)1 * MTOK * 1024), (unsigned char*)(ws + WS_O8 + (size_t)2 * MTOK * 1024), (unsigned char*)(ws + WS_O8 + (size_t)3 * MTOK * 1024), args.in[5 + zz] + l * 256, args.in[6 + zz] + l * 128, args.in[7 + zz] + l * 8, args.in[8 + zz] + (size_t)l * 8 * 465, li STAMP_ARG((unsigned long long*)(ws + WS_CTL + 65536))};
            att::attn_phase(X, (LAS char*)lds, tid, vcu, G, bx);
            if (G == 256 && vcu >= 128 && vcu < 192) {
                pg8::Gemm g{(const bf16_t*)(ws + WS_X8), (const bf16_t*)(ws + WS_W8G + (size_t)l * 8192 * DM), MTOK, 8192, DM / 2, 0, 0, 0, nullptr STAMP_ARG(nullptr)}; pg8::StaticOrder S; S.init(MTOK, 8192, G, bx); S.only = 1792 + (vcu - 128);
                pg8::EpiGate8 E{(unsigned char*)(ws + WS_GATE), args.in[2 + zz] + (size_t)l * 8192, 1.0f / (QX * QWG)};
                int tid3 = tid; asm volatile("" : "+v"(tid3));
                pg8::gemm_phase<pg8::EpiGate8, pg8::StaticOrder, true, true, false, true>((LAS unsigned char*)lds, g, S, E, tid3); }
#endif
            if (rep == NREP(2) - 1) SEAM(pb + 1); else xcd_barrier(bar);
        }
        if (PHON(3) && IN(pb + 2)) for (int rep = 0; rep < NREP(3); ++rep) { PHASE_LOCALS; combine_a_phase((const unsigned char*)AG, LSE, (unsigned*)(ws + WS_O8), gw, NGW, lane); if (rep == NREP(3) - 1) SEAM(pb + 2); else xcd_barrier(bar); }
        if (PHON(4) && IN(pb + 3)) for (int rep = 0; rep < NREP(4); ++rep) { PHASE_LOCALS;
            { const float one_m_li = 1.0f - (l == 0 ? 0.2f : (l == 1 ? 0.35550906759096926f : (l == 2 ? 0.47071301834358416f : 0.5560582041556405f)));
              const float qm = 127.0f / (6.0f * 0.2275f * one_m_li);
              pg8::Gemm g{(const bf16_t*)(ws + WS_O8), (const bf16_t*)(ws + WS_W8BR + (size_t)l * 4 * DM * 1024), MTOK, DM, 512, 0, (size_t)MTOK * 1024, (size_t)DM * 1024, nullptr STAMP_ARG(nullptr)}; pg8::BranchOrder4 S; S.init(MTOK, DM, G, bx);
              pg8::EpiGate4 E{MIXED, (const unsigned char*)(ws + WS_GATE), 1.0f / (QO * QWBA), one_m_li / (QX * QWBC), 1.0f / (QO * QWBC), (unsigned char*)(ws + WS_MIXED8), qm};
              pg8::gemm_phase<pg8::EpiGate4, pg8::BranchOrder4, true, true, false, true>(lds, g, S, E, tid); }
            if (rep == NREP(4) - 1) SEAM(pb + 3); else xcd_barrier(bar);
        }
        if (PHON(5) && IN(pb + 4)) for (int rep = 0; rep < NREP(5); ++rep) { PHASE_LOCALS;
            const float one_m_li = 1.0f - (l == 0 ? 0.2f : (l == 1 ? 0.35550906759096926f : (l == 2 ? 0.47071301834358416f : 0.5560582041556405f)));
            const float qm = 127.0f / (6.0f * 0.2275f * one_m_li);
            pg8::Gemm g{(const bf16_t*)(ws + WS_MIXED8), (const bf16_t*)(ws + WS_WOUT + (size_t)l * DM * DM), MTOK, DM, DM / 2, 0, 0, 0, nullptr STAMP_ARG(nullptr)}; pg8::StaticOrder S; S.init(MTOK, DM, G, bx);
            pg8::EpiResid E{(bf16_t*)PRELN, l == 0 ? args.in[0 + zz] : (const float*)nullptr, (const bf16_t*)XF, ALPHA, 1.0f / (qm * QWU)};
            pg8::gemm_phase<pg8::EpiResid, pg8::StaticOrder, true, true, false, true>(lds, g, S, E, tid);
            if (rep == NREP(5) - 1) SEAM(pb + 4); else xcd_barrier(bar);
        }
        if (PHON(6) && IN(pb + 5)) for (int rep = 0; rep < NREP(6); ++rep) { PHASE_LOCALS; ln1_router_phase((const bf16_t*)PRELN, args.in[13 + zz] + (size_t)(l * 2) * DM, args.in[14 + zz] + (size_t)(l * 2) * DM, args.in[9 + zz] + (size_t)l * DM * NEXP, (float*)(ws + WS_STATS), (unsigned*)(ws + WS_X8), AFF, lds, tid, gw, NGW, lane); if (rep == NREP(6) - 1) SEAM(pb + 5); else xcd_barrier(bar); }
        if (PHON(7) && IN(pb + 6)) for (int rep = 0; rep < NREP(7); ++rep) { PHASE_LOCALS; topk_phase(AFF, IDX, GV, SLOT, lds, tid, wave, lane, bx, G); if (rep == NREP(7) - 1) SEAM(pb + 6); else xcd_barrier(bar); }
        if (PHON(9) && IN(pb + 7)) for (int rep = 0; rep < NREP(9); ++rep) { PHASE_LOCALS;
            pg8::Gemm g{(const bf16_t*)(ws + WS_X8), (const bf16_t*)(ws + WS_WGU + (size_t)l * NEXP * 2048 * DM), NGRP * CAP, 2048, DM / 2, (size_t)2048 * DM, 0, 0, IDX STAMP_ARG(nullptr)};
            pg8::StaticOrder S; S.init(NGRP * CAP, 2048, G, bx);
            pg8::EpiSwiGLU E{(unsigned char*)(ws + WS_H), 1.0f / (QX * QWG), 1.0f / (QX * QWU), QH};
            pg8::gemm_phase<pg8::EpiSwiGLU, pg8::StaticOrder, true, true, true, true>(lds, g, S, E, tid);
            if (rep == NREP(9) - 1) SEAM(pb + 7); else xcd_barrier(bar);
        }
        if (PHON(10) && IN(pb + 8)) for (int rep = 0; rep < NREP(10); ++rep) { PHASE_LOCALS;
            pg8::Gemm g{(const bf16_t*)(ws + WS_H), (const bf16_t*)(ws + WS_WDN + (size_t)l * NEXP * DM * DEXP), NGRP * CAP, DM, DEXP / 2, (size_t)DM * DEXP, 0, 0, nullptr STAMP_ARG(nullptr)};
            pg8::StaticOrder S; S.init(NGRP * CAP, DM, G, bx);
            pg8::EpiDown E{(unsigned char*)YB, QY / (QH * QWD)};
            pg8::gemm_phase<pg8::EpiDown, pg8::StaticOrder, true, true, false, true>(lds, g, S, E, tid);
            if (rep == NREP(10) - 1) SEAM(pb + 8); else xcd_barrier(bar);
        }
        if (PHON(11) && IN(pb + 9)) for (int rep = 0; rep < NREP(11); ++rep) { PHASE_LOCALS;
            if (NREP(11) == 2 && rep == 0) ln2_phase((const bf16_t*)PRELN, (const float*)(ws + WS_STATS), args.in[13 + zz] + (size_t)(l * 2) * DM, args.in[14 + zz] + (size_t)(l * 2) * DM, (const unsigned char*)YB, GV, SLOT, args.in[13 + zz] + (size_t)(l * 2 + 1) * DM, args.in[14 + zz] + (size_t)(l * 2 + 1) * DM, (float*)(ws + WS_O8), (bf16_t*)(ws + WS_O8), MIXED, (unsigned char*)(ws + WS_AG), gw, NGW, lane); else
            ln2_phase((const bf16_t*)PRELN, (const float*)(ws + WS_STATS), args.in[13 + zz] + (size_t)(l * 2) * DM, args.in[14 + zz] + (size_t)(l * 2) * DM, (const unsigned char*)YB, GV, SLOT, args.in[13 + zz] + (size_t)(l * 2 + 1) * DM, args.in[14 + zz] + (size_t)(l * 2 + 1) * DM, (l == DEPTH - 1) ? args.out : XF, (bf16_t*)XF, XB, (l == DEPTH - 1) ? (unsigned char*)nullptr : (unsigned char*)(ws + WS_X8), gw, NGW, lane);
            if (rep == NREP(11) - 1) SEAM(pb + 9); else xcd_barrier(bar);
#if defined(PROBE_XBAR)
            for (int xb_ = 0; xb_ < PROBE_XBAR; ++xb_) xcd_barrier(bar);
#endif
#if defined(STAMP_SEL)
            if (l == DEPTH - 1 && bx == STAMP_WG && tid == 0) { asm volatile("s_waitcnt vmcnt(0)" ::: "memory");
                const unsigned long long* st = (const unsigned long long*)(ws + WS_CTL + 65536);
                float val = 0.f;
                if (STAMP_SEL == 1) val = (float)(st[1] - st[0]) * (1.0f / 32.0f);
                if (STAMP_SEL == 2) val = (float)(st[2] - st[1]);
                if (STAMP_SEL == 3) val = (float)(st[2] - st[0]) / ((float)(st[4] - st[3]) * 0.01f);
                if (STAMP_SEL == 4) val = (float)(st[12] - st[10]) * (1.0f / 63.0f);
                if (STAMP_SEL == 5) val = (float)(st[13] - st[12]);
                if (STAMP_SEL == 7) val = (float)st[20] * 0.01f;
                if (STAMP_SEL == 6) val = (float)(st[12] - st[10]) / ((float)(st[15] - st[14]) * 0.01f);
                const unsigned long long w0 = __builtin_amdgcn_s_memrealtime(), wt = (unsigned long long)(val * (float)STAMP_SCALE);
                while (__builtin_amdgcn_s_memrealtime() - w0 < wt) __builtin_amdgcn_s_sleep(16); }
#endif
        }
    }
#undef IN
#undef SEAM
}

#ifndef MK_ONE_LAUNCH
#define MK_ONE_LAUNCH 1
#endif
extern "C" void kernel_launch(void* const* d_in, const int* in_sizes, int n_in, void* d_out, int out_size, void* d_ws, size_t ws_size, hipStream_t stream) {
    static int grid = 0;
    if (grid == 0) {
        if (n_in != 15 || out_size != MTOK * DM || ws_size < WS_END) { fprintf(stderr, "kernel_launch: unexpected shapes (n_in %d out %d ws %zu, need ws >= %zu)\n", n_in, out_size, ws_size, (size_t)WS_END); grid = -1; return; }
        int dev = 0, cus = 0, per_cu = 0;
        if (hipGetDevice(&dev) != hipSuccess || hipDeviceGetAttribute(&cus, hipDeviceAttributeMultiprocessorCount, dev) != hipSuccess) { grid = -1; return; }
        if (hipFuncSetAttribute((const void*)fwd, hipFuncAttributeMaxDynamicSharedMemorySize, LDS_BYTES) != hipSuccess) { fprintf(stderr, "kernel_launch: hipFuncSetAttribute failed\n"); grid = -1; return; }
        if (hipOccupancyMaxActiveBlocksPerMultiprocessor(&per_cu, (const void*)fwd, NWAVES * 64, LDS_BYTES) != hipSuccess || per_cu < 1) { fprintf(stderr, "kernel_launch: occupancy query says %d\n", per_cu); }
        (void)hipGetLastError();
        grid = cus;
    }
    if (grid < 0) return;
    if (hipMemsetAsync((char*)d_ws + WS_CTL, 0, CTL_ZERO_BYTES, stream) != hipSuccess) return;
    Args a{};
    for (int i = 0; i < 15; ++i) a.in[i] = (const float*)d_in[i];
    a.out = (float*)d_out; a.ws = (unsigned char*)d_ws;
#if MK_ONE_LAUNCH
    a.ph_lo = 0; a.ph_hi = NPHASES;
    hipLaunchKernelGGL(fwd, dim3(grid), dim3(NWAVES * 64), LDS_BYTES, stream, a);
#else
    for (int p = 0; p < NPHASES; ++p) { a.ph_lo = p; a.ph_hi = p + 1; hipLaunchKernelGGL(fwd, dim3(grid), dim3(NWAVES * 64), LDS_BYTES, stream, a); }
#endif
}
```

```cpp
#include <hip/hip_runtime.h>
#include <cstdio>
#include <cstdint>
#include <cmath>
#define B3_PRIO 1
namespace pg8 {
#define PG8_LAS __attribute__((address_space(3)))
typedef unsigned short bf16_t;
typedef short bf16x8 __attribute__((ext_vector_type(8)));
typedef float f32x4 __attribute__((ext_vector_type(4)));
typedef unsigned u32x4 __attribute__((ext_vector_type(4)));
typedef unsigned u32x2 __attribute__((ext_vector_type(2)));
typedef _Float16 f16x8 __attribute__((ext_vector_type(8)));
typedef int i32x4 __attribute__((ext_vector_type(4)));
constexpr int BM = 256, BK = 64, HALF = 128, HTB = HALF * BK * 2  , STAGE_BYTES = 8 * HTB, NXCD = 8, WGM = 8;

__host__ __device__ __forceinline__ int lds_byte(int r, int c) { const int st = (r >> 4) * 2 + (c >> 5), rr = r & 15, cc = c & 31, ob = rr * 64 + cc * 2; return st * 1024 + (ob ^ (((ob >> 9) & 1) << 5)); }
__host__ __device__ __forceinline__ void stage_rc(int b, int& R, int& C) { const int st = b / 1024, sb = b % 1024, swz = sb ^ (((sb >> 9) & 1) << 5); R = (st >> 1) * 16 + swz / 64; C = (st & 1) * 32 + (swz % 64) / 2; }
__host__ __device__ __forceinline__ int perm32(int rho) { const int n = rho >> 4, i = rho & 15; return 8 * (i >> 2) + 4 * n + (i & 3); }

struct Unit { int pm, pn, br; };
struct Gemm { const bf16_t* A; const bf16_t* Bt; int M, N, K; size_t gstride; size_t a_brstride, b_brstride; const int* gidx;
#if defined(STAMP_SEL)
    unsigned long long* stamp;
#endif
};

struct StaticOrder {
    int nM, nN, nwg, G, c;
    __host__ __device__ void init(int M, int N, int G_, int c_) { nM = M / BM; nN = N / BM; nwg = nM * nN; G = G_; c = c_; }
    int skip_lo = 1 << 30, skip_hi = 0, only = -1;
    __host__ __device__ bool next(int i, Unit& u) const {
        long L = (long)i * G + c;
        if (only >= 0) { if (i != 0) return false; L = only; }
        if (L >= nwg || (L >= skip_lo && L < skip_hi && only < 0)) return false;
        int wgid = (int)L; { const int q = nwg / NXCD, r = nwg % NXCD, xcd = wgid % NXCD, off = wgid / NXCD; wgid = (xcd < r ? xcd * (q + 1) : r * (q + 1) + (xcd - r) * q) + off; }
        const int nig = WGM * nN, gid = wgid / nig, fm = gid * WGM, gsz = (nM - fm) < WGM ? (nM - fm) : WGM;
        u.pm = fm + ((wgid % nig) % gsz); u.pn = (wgid % nig) / gsz; u.br = 0; return true;
    }
    __device__ __forceinline__ int ntiles(const Unit&, int nt_full) const { return nt_full; }
    __device__ __forceinline__ void a_ready(const Unit&) const {}
    __device__ __forceinline__ void done(const Unit&) const {}
};
struct BranchOrder4 : StaticOrder {
    __device__ bool next(int i, Unit& u) const { if (!StaticOrder::next(i >> 2, u)) return false; u.br = i & 3; return true; }
    __device__ __forceinline__ int ntiles(const Unit& u, int) const { return u.br == 0 ? 6 : 8; }
};

__device__ __forceinline__ unsigned cvt_pk_bf16(float lo, float hi) { unsigned r; asm volatile("v_cvt_pk_bf16_f32 %0, %1, %2" : "=v"(r) : "v"(lo), "v"(hi)); return r; }
__device__ __forceinline__ float bflo(unsigned w) { return __uint_as_float(w << 16); }
__device__ __forceinline__ float bfhi(unsigned w) { return __uint_as_float(w & 0xffff0000u); }
typedef _Float16 h16x2 __attribute__((ext_vector_type(2)));
__device__ __forceinline__ unsigned pk_f16(float a, float b) { const h16x2 h = {(_Float16)a, (_Float16)b}; return __builtin_bit_cast(unsigned, h); }
__device__ __forceinline__ float f16lo(unsigned w) { return (float)__builtin_bit_cast(h16x2, w)[0]; }
__device__ __forceinline__ float f16hi(unsigned w) { return (float)__builtin_bit_cast(h16x2, w)[1]; }
__device__ __forceinline__ float sigmoidf_(float x) { return 1.0f / (1.0f + __expf(-x)); }
__device__ __forceinline__ unsigned q8x4e(float a, float b, float c, float d, float s) {
    const float ca = fminf(fmaxf(a * s, -127.0f), 127.0f) + 12582912.0f, cb = fminf(fmaxf(b * s, -127.0f), 127.0f) + 12582912.0f;
    const float cc = fminf(fmaxf(c * s, -127.0f), 127.0f) + 12582912.0f, cd = fminf(fmaxf(d * s, -127.0f), 127.0f) + 12582912.0f;
    const unsigned lo = __builtin_amdgcn_perm(__float_as_uint(cb), __float_as_uint(ca), 0x0c0c0400u), hi = __builtin_amdgcn_perm(__float_as_uint(cd), __float_as_uint(cc), 0x0c0c0400u);
    return __builtin_amdgcn_perm(hi, lo, 0x05040100u);
}

template <bool I8> struct EpiProjT {
    static constexpr bool PERM = true, AFTER_DRAIN = false, RMW = false;
    bf16_t* O; const float* rope128; const float* rope64; int cbase, csplit, cskip; float inv_qk, inv_v;
    __device__ __forceinline__ void operator()(const f32x4 (&acc)[2][2][4][2], const Unit& u, int wr, int wc, int fr, int fq) const {
        const int ct = u.pn * BM; const int colt = cbase + ct + (ct >= csplit ? cskip : 0);
        int mode;
        if (colt < 4608) mode = 1; else if (colt < 6912) mode = 0; else if (colt < 8960) mode = 2; else if (colt < 9984) mode = 0; else if (colt < 11264) mode = 1; else mode = 0;
        const bool isv = (colt >= 4608 && colt < 6912) || (colt >= 8960 && colt < 9984) || (colt >= 11264 && colt < 11520) || (colt >= 13568);
        const float inv = isv ? inv_v : inv_qk;
        const int row0 = u.pm * BM + wr * 64 + fr, col0 = colt + wc * 32 + 8 * fq;
        const int i128 = 16 * wc + 4 * fq, i64 = 16 * (wc & 1) + 4 * fq;
        f32x4 cs0[2][4], cs1[2][4];
        if (mode == 1 || mode == 2) {
#pragma unroll
            for (int ai = 0; ai < 2; ++ai)
#pragma unroll
                for (int m = 0; m < 4; ++m) { const int pos = (row0 + ai * HALF + m * 16) & 4095;
                    const f32x4* t = (mode == 1) ? (const f32x4*)(rope128 + ((size_t)pos * 64 + i128) * 2) : (const f32x4*)(rope64 + ((size_t)pos * 32 + i64) * 2);
                    cs0[ai][m] = t[0]; cs1[ai][m] = t[1]; }
        }
#pragma unroll
        for (int ai = 0; ai < 2; ++ai)
#pragma unroll
            for (int m = 0; m < 4; ++m) {
                const int row = row0 + ai * HALF + m * 16;
                bf16_t* rowp = O + (size_t)row * 14592 + col0;
#pragma unroll
                for (int bj = 0; bj < 2; ++bj) {
                    f32x4 v0 = acc[ai][bj][m][0], v1 = acc[ai][bj][m][1];
                    if constexpr (I8) { const i32x4 i0 = __builtin_bit_cast(i32x4, v0), i1 = __builtin_bit_cast(i32x4, v1);
                        v0 = (f32x4){(float)i0[0], (float)i0[1], (float)i0[2], (float)i0[3]} * inv; v1 = (f32x4){(float)i1[0], (float)i1[1], (float)i1[2], (float)i1[3]} * inv; }
                    if (mode == 1 || mode == 2) {
                        const f32x4 c0 = cs0[ai][m], c1 = cs1[ai][m];
                        f32x4 r0, r1;
                        r0[0] = v0[0] * c0[0] - v0[1] * c0[1]; r0[1] = v0[1] * c0[0] + v0[0] * c0[1];
                        r0[2] = v0[2] * c0[2] - v0[3] * c0[3]; r0[3] = v0[3] * c0[2] + v0[2] * c0[3];
                        r1[0] = v1[0] * c1[0] - v1[1] * c1[1]; r1[1] = v1[1] * c1[0] + v1[0] * c1[1];
                        r1[2] = v1[2] * c1[2] - v1[3] * c1[3]; r1[3] = v1[3] * c1[2] + v1[2] * c1[3];
                        v0 = r0; v1 = r1;
                    }
                    {
                        u32x4 w; w.x = cvt_pk_bf16(v0[0], v0[1]); w.y = cvt_pk_bf16(v0[2], v0[3]); w.z = cvt_pk_bf16(v1[0], v1[1]); w.w = cvt_pk_bf16(v1[2], v1[3]);
                        *(u32x4*)(rowp + bj * HALF) = w;
                    }
                }
            }
    }
};
struct EpiGate8 {
    static constexpr bool PERM = true, AFTER_DRAIN = false, RMW = false;
    unsigned char* G8; const float* bgate; float inv;
    __device__ __forceinline__ void operator()(const f32x4 (&acc)[2][2][4][2], const Unit& u, int wr, int wc, int fr, int fq) const {
        const int row0 = u.pm * BM + wr * 64 + fr, col0 = u.pn * BM + wc * 32 + 8 * fq;
        const float ninv = -inv * 1.4426950408889634f;
        f32x4 gb[2][2];
#pragma unroll
        for (int bj = 0; bj < 2; ++bj)
#pragma unroll
            for (int n = 0; n < 2; ++n) gb[bj][n] = *(const f32x4*)(bgate + col0 + bj * HALF + 4 * n) * (-1.4426950408889634f);
#pragma unroll
        for (int ai = 0; ai < 2; ++ai)
#pragma unroll
            for (int m = 0; m < 4; ++m) { unsigned char* growp = G8 + (size_t)(row0 + ai * HALF + m * 16) * 8192 + col0;
#pragma unroll
                for (int bj = 0; bj < 2; ++bj) { const i32x4 a0 = __builtin_bit_cast(i32x4, acc[ai][bj][m][0]), a1 = __builtin_bit_cast(i32x4, acc[ai][bj][m][1]);
                    unsigned q[8];
#pragma unroll
                    for (int j = 0; j < 4; ++j) {
                        const float e0 = __builtin_amdgcn_exp2f(fmaf((float)a0[j], ninv, gb[bj][0][j])), e1 = __builtin_amdgcn_exp2f(fmaf((float)a1[j], ninv, gb[bj][1][j]));
                        q[j] = __float_as_uint(__builtin_amdgcn_rcpf(fmaf(e0, 1.0f / 255.0f, 1.0f / 255.0f)) + 12582912.0f);
                        q[4 + j] = __float_as_uint(__builtin_amdgcn_rcpf(fmaf(e1, 1.0f / 255.0f, 1.0f / 255.0f)) + 12582912.0f); }
                    u32x2 wq;
                    wq.x = __builtin_amdgcn_perm(__builtin_amdgcn_perm(q[3], q[2], 0x0c0c0400u), __builtin_amdgcn_perm(q[1], q[0], 0x0c0c0400u), 0x05040100u);
                    wq.y = __builtin_amdgcn_perm(__builtin_amdgcn_perm(q[7], q[6], 0x0c0c0400u), __builtin_amdgcn_perm(q[5], q[4], 0x0c0c0400u), 0x05040100u);
                    *(u32x2*)(growp + bj * HALF) = wq; } }
    }
};
struct EpiGate4 {
    static constexpr bool PERM = true, AFTER_DRAIN = false, RMW = true;
    bf16_t* mixed; const unsigned char* gate; float inv_a, inv_b, inv_cd; unsigned char* mixed8; float qm;
    __device__ __forceinline__ void operator()(const f32x4 (&acc)[2][2][4][2], const Unit& u, int wr, int wc, int fr, int fq) const {
        const int row0 = u.pm * BM + wr * 64 + fr, col0 = u.pn * BM + wc * 32 + 8 * fq;
        const unsigned char* gate_b = gate + u.br * 2048; const bool first = u.br == 0, last = u.br == 3;
        const float sc = (inv_cd + (u.br == 0 ? 1.0f : 0.0f) * (inv_a - inv_cd) + (u.br == 1 ? 1.0f : 0.0f) * (inv_b - inv_cd)) * (1.0f / 255.0f);
#pragma unroll
        for (int ai = 0; ai < 2; ++ai) {
            u32x2 g[4][2]; u32x4 p[4][2];
#pragma unroll
            for (int m = 0; m < 4; ++m) { const int row = row0 + ai * HALF + m * 16;
#pragma unroll
                for (int bj = 0; bj < 2; ++bj) { g[m][bj] = *(const u32x2*)(gate_b + (size_t)row * 8192 + col0 + bj * HALF);
                    p[m][bj] = (u32x4){0u, 0u, 0u, 0u}; if (!first) p[m][bj] = *(const u32x4*)(mixed + (size_t)row * 2048 + col0 + bj * HALF); } }
#pragma unroll
            for (int m = 0; m < 4; ++m) { const int row = row0 + ai * HALF + m * 16; bf16_t* mp = mixed + (size_t)row * 2048 + col0;
#pragma unroll
                for (int bj = 0; bj < 2; ++bj) {
                    const u32x2 gg = g[m][bj]; const u32x4 pp = p[m][bj]; const i32x4 i0 = __builtin_bit_cast(i32x4, acc[ai][bj][m][0]), i1 = __builtin_bit_cast(i32x4, acc[ai][bj][m][1]);
                    const f32x4 v0 = (f32x4){(float)i0[0], (float)i0[1], (float)i0[2], (float)i0[3]} * sc, v1 = (f32x4){(float)i1[0], (float)i1[1], (float)i1[2], (float)i1[3]} * sc;
                    const float s0 = bflo(pp.x) + (float)(gg.x & 0xffu) * v0[0], s1 = bfhi(pp.x) + (float)((gg.x >> 8) & 0xffu) * v0[1], s2 = bflo(pp.y) + (float)((gg.x >> 16) & 0xffu) * v0[2], s3 = bfhi(pp.y) + (float)(gg.x >> 24) * v0[3];
                    const float s4 = bflo(pp.z) + (float)(gg.y & 0xffu) * v1[0], s5 = bfhi(pp.z) + (float)((gg.y >> 8) & 0xffu) * v1[1], s6 = bflo(pp.w) + (float)((gg.y >> 16) & 0xffu) * v1[2], s7 = bfhi(pp.w) + (float)(gg.y >> 24) * v1[3];
                    if (last) { u32x2 q8; q8.x = q8x4e(s0, s1, s2, s3, qm); q8.y = q8x4e(s4, s5, s6, s7, qm); *(u32x2*)(mixed8 + (size_t)row * 2048 + col0 + bj * HALF) = q8; }
                    else { u32x4 w; w.x = cvt_pk_bf16(s0, s1); w.y = cvt_pk_bf16(s2, s3); w.z = cvt_pk_bf16(s4, s5); w.w = cvt_pk_bf16(s6, s7); *(u32x4*)(mp + bj * HALF) = w; }
                } }
        }
    }
};
struct EpiResid {
    static constexpr bool PERM = false, AFTER_DRAIN = false, RMW = false;
    bf16_t* out; const float* xf; const bf16_t* xh; float alpha, inv;
    __device__ __forceinline__ void operator()(const f32x4 (&acc)[2][2][4][2], const Unit& u, int wr, int wc, int fr, int fq) const {
        const int row0 = u.pm * BM + wr * 64 + fr, col0 = u.pn * BM + wc * 32 + 4 * fq;
#pragma unroll
        for (int ai = 0; ai < 2; ++ai) {
            f32x4 x[4][2][2];
#pragma unroll
            for (int m = 0; m < 4; ++m) { const size_t off = (size_t)(row0 + ai * HALF + m * 16) * 2048 + col0;
#pragma unroll
                for (int bj = 0; bj < 2; ++bj)
#pragma unroll
                    for (int n = 0; n < 2; ++n) { if (xf) x[m][bj][n] = *(const f32x4*)(xf + off + bj * HALF + n * 16);
                        else { const u32x2 w = *(const u32x2*)(xh + off + bj * HALF + n * 16); x[m][bj][n] = (f32x4){f16lo(w.x), f16hi(w.x), f16lo(w.y), f16hi(w.y)}; } } }
#pragma unroll
            for (int m = 0; m < 4; ++m) { const size_t off = (size_t)(row0 + ai * HALF + m * 16) * 2048 + col0;
#pragma unroll
                for (int bj = 0; bj < 2; ++bj)
#pragma unroll
                    for (int n = 0; n < 2; ++n) { const i32x4 ia = __builtin_bit_cast(i32x4, acc[ai][bj][m][n]); const f32x4 r = x[m][bj][n] * alpha + (f32x4){(float)ia[0], (float)ia[1], (float)ia[2], (float)ia[3]} * inv;
                        u32x2 w; w.x = pk_f16(r[0], r[1]); w.y = pk_f16(r[2], r[3]); *(u32x2*)(out + off + bj * HALF + n * 16) = w; } }
        }
    }
};
struct EpiSwiGLU {
    static constexpr bool PERM = true, AFTER_DRAIN = false, RMW = false;
    unsigned char* H; float inv_g, inv_u, qh;
    __device__ __forceinline__ void operator()(const f32x4 (&acc)[2][2][4][2], const Unit& u, int wr, int wc, int fr, int fq) const {
        const int row0 = u.pm * BM + wr * 64 + fr, col0 = u.pn * HALF + wc * 32 + 8 * fq;
        const float ksc = qh * inv_g * inv_u, kexp = -inv_g * 1.4426950408889634f;
#pragma unroll
        for (int ai = 0; ai < 2; ++ai)
#pragma unroll
            for (int m = 0; m < 4; ++m) {
                unsigned char* hp = H + (size_t)(row0 + ai * HALF + m * 16) * 1024 + col0;
                f32x4 h0, h1;
                const i32x4 ig0 = __builtin_bit_cast(i32x4, acc[ai][0][m][0]), ig1 = __builtin_bit_cast(i32x4, acc[ai][0][m][1]), iu0 = __builtin_bit_cast(i32x4, acc[ai][1][m][0]), iu1 = __builtin_bit_cast(i32x4, acc[ai][1][m][1]);
#pragma unroll
                for (int j = 0; j < 4; ++j) { const float fg0 = (float)ig0[j], fg1 = (float)ig1[j];
                    h0[j] = fg0 * (float)iu0[j] * ksc * __builtin_amdgcn_rcpf(1.0f + __builtin_amdgcn_exp2f(fg0 * kexp));
                    h1[j] = fg1 * (float)iu1[j] * ksc * __builtin_amdgcn_rcpf(1.0f + __builtin_amdgcn_exp2f(fg1 * kexp)); }
                u32x2 w; w.x = q8x4e(h0[0], h0[1], h0[2], h0[3], 1.0f); w.y = q8x4e(h1[0], h1[1], h1[2], h1[3], 1.0f);
                *(u32x2*)hp = w;
            }
    }
};
struct EpiDown {
    static constexpr bool PERM = true, AFTER_DRAIN = false, RMW = false;
    unsigned char* Y; float sc;
    __device__ __forceinline__ void operator()(const f32x4 (&acc)[2][2][4][2], const Unit& u, int wr, int wc, int fr, int fq) const {
        const int row0 = u.pm * BM + wr * 64 + fr, col0 = u.pn * BM + wc * 32 + 8 * fq;
#pragma unroll
        for (int ai = 0; ai < 2; ++ai)
#pragma unroll
            for (int m = 0; m < 4; ++m) {
                const int row = row0 + ai * HALF + m * 16;
                unsigned char* yp = Y + (size_t)row * 2048 + col0;
#pragma unroll
                for (int bj = 0; bj < 2; ++bj) { const i32x4 i0 = __builtin_bit_cast(i32x4, acc[ai][bj][m][0]), i1 = __builtin_bit_cast(i32x4, acc[ai][bj][m][1]);
                    u32x2 w; w.x = q8x4e((float)i0[0], (float)i0[1], (float)i0[2], (float)i0[3], sc) ^ 0x80808080u; w.y = q8x4e((float)i1[0], (float)i1[1], (float)i1[2], (float)i1[3], sc) ^ 0x80808080u;
                    *(u32x2*)(yp + bj * HALF) = w; }
            }
    }
};

template <class Epi, class Sched, bool ALIGN_EPI = false, bool SP2 = false, bool GATHER = false, bool I8 = false, bool F16 = false>
__device__ __forceinline__ void gemm_phase(PG8_LAS unsigned char* lds, const Gemm g, const Sched& S, const Epi& E, const int tid) {
    const int wid = __builtin_amdgcn_readfirstlane(tid >> 6), lane = tid & 63, wr = wid >> 2, wc = wid & 3, fr = lane & 15, fq = lane >> 4;
    const int K = g.K, nt = K / BK;
    unsigned voffA[2], voffB[2];
#pragma unroll
    for (int i = 0; i < 2; ++i) { int R, C; stage_rc(tid * 16 + i * 8192, R, C); const int Rb = Epi::PERM ? ((R & ~31) + perm32(R & 31)) : R;
        voffA[i] = (unsigned)(R * K + C) * 2u; voffB[i] = (unsigned)(Rb * K + C) * 2u; }
    unsigned gcur[2][2] = {{0u, 0u}, {0u, 0u}}, gnx[2][2] = {{0u, 0u}, {0u, 0u}};
#define PG8_GOFF(dst, U) do { _Pragma("unroll") for (int _h = 0; _h < 2; ++_h) _Pragma("unroll") for (int _i = 0; _i < 2; ++_i) { int R_, C_; stage_rc(tid * 16 + _i * 8192, R_, C_); \
        const int r_ = (U).pm * BM + _h * HALF + R_; const int tok_ = g.gidx[r_]; dst[_h][_i] = (unsigned)(((r_ >> 13) * 4096 + tok_) * K + C_) * 2u; } } while (0)
    const size_t kstep = (size_t)(BK * 2);
    const size_t hstep = (size_t)HALF * K * 2;
    const size_t tstep = 2 * hstep;
    const unsigned ldsw = (unsigned)wid * 1024u;
    const int aoff = lds_byte(wr * 64 + fr, fq * 8), boff = lds_byte(wc * 32 + fr, fq * 8);
#define PG8_SA(b, h) (((b) * 2 + (h)) * HTB)
#define PG8_SB(b, h) ((4 + (b) * 2 + (h)) * HTB)
#define PG8_STAGE(bufoff, gbase, voff) do { _Pragma("unroll") for (int _i = 0; _i < 2; ++_i) \
        __builtin_amdgcn_global_load_lds((const unsigned*)((const char*)(gbase) + (voff)[_i]), (PG8_LAS unsigned*)(lds + (bufoff) + ldsw + _i * 8192), 16, 0, 0); } while (0)
#define PG8_LDA(dst, b, h) do { _Pragma("unroll") for (int m = 0; m < 4; ++m) _Pragma("unroll") for (int k = 0; k < 2; ++k) dst[m][k] = *(const PG8_LAS bf16x8*)(lds + PG8_SA(b, h) + aoff + m * 2048 + k * 1024); } while (0)
#define PG8_LDB(dst, b, h) do { _Pragma("unroll") for (int n = 0; n < 2; ++n) _Pragma("unroll") for (int k = 0; k < 2; ++k) dst[n][k] = *(const PG8_LAS bf16x8*)(lds + PG8_SB(b, h) + boff + n * 2048 + k * 1024); } while (0)
#define PG8_MMA(ai, bj, At, Bt) do { __builtin_amdgcn_s_setprio(1); _Pragma("unroll") for (int m = 0; m < 4; ++m) _Pragma("unroll") for (int n = 0; n < 2; ++n) _Pragma("unroll") for (int k = 0; k < 2; ++k) { \
        if constexpr (I8) acc[ai][bj][m][n] = __builtin_bit_cast(f32x4, __builtin_amdgcn_mfma_i32_16x16x64_i8(__builtin_bit_cast(i32x4, Bt[n][k]), __builtin_bit_cast(i32x4, At[m][k]), __builtin_bit_cast(i32x4, acc[ai][bj][m][n]), 0, 0, 0)); \
        else if constexpr (F16) acc[ai][bj][m][n] = __builtin_amdgcn_mfma_f32_16x16x32_f16(__builtin_bit_cast(f16x8, Bt[n][k]), __builtin_bit_cast(f16x8, At[m][k]), acc[ai][bj][m][n], 0, 0, 0); \
        else acc[ai][bj][m][n] = __builtin_amdgcn_mfma_f32_16x16x32_bf16(Bt[n][k], At[m][k], acc[ai][bj][m][n], 0, 0, 0); } \
        __builtin_amdgcn_s_setprio(0); } while (0)
#define PG8_STA(bufoff, gbase, h, nx) do { if constexpr (GATHER) { unsigned vo_[2]; vo_[0] = (nx) ? gnx[h][0] : gcur[h][0]; vo_[1] = (nx) ? gnx[h][1] : gcur[h][1]; PG8_STAGE(bufoff, gbase, vo_); } \
        else { PG8_STAGE(bufoff, (gbase) + (h) * hstep, voffA); } } while (0)
#define PG8_WAIT_V(n) asm volatile("s_waitcnt vmcnt(" #n ")" ::: "memory")
#define PG8_WAIT_L(n) asm volatile("s_waitcnt lgkmcnt(" #n ")" ::: "memory")
#define PG8_BAR __builtin_amdgcn_s_barrier()
#define PG8_SCHED __builtin_amdgcn_sched_barrier(0)
    Unit cur, nxt; int ui = 0;
    if (!S.next(0, cur)) return;
    f32x4 acc[2][2][4][2];
#pragma unroll
    for (int a = 0; a < 2; ++a)
#pragma unroll
        for (int b = 0; b < 2; ++b)
#pragma unroll
            for (int m = 0; m < 4; ++m)
#pragma unroll
                for (int n = 0; n < 2; ++n) acc[a][b][m][n] = (f32x4){0.f, 0.f, 0.f, 0.f};
    bf16x8 At[4][2], B0[2][2], B1[2][2];
    const char* cA = (const char*)g.A + (size_t)cur.br * g.a_brstride + (GATHER ? (size_t)0 : (size_t)cur.pm * tstep); const char* cB = (const char*)g.Bt + (size_t)cur.br * g.b_brstride + (size_t)((cur.pm >> 1) & 15) * g.gstride + (size_t)cur.pn * tstep;
    S.a_ready(cur);
    if constexpr (GATHER) PG8_GOFF(gcur, cur);
    if constexpr (SP2) {
        PG8_STAGE(PG8_SB(0, 0), cB, voffB); PG8_STAGE(PG8_SB(0, 1), cB + hstep, voffB); PG8_STA(PG8_SA(0, 0), cA, 0, false); PG8_STA(PG8_SA(0, 1), cA, 1, false);
        if (wr == 1) PG8_BAR;
        PG8_WAIT_V(2); PG8_BAR;
        PG8_STAGE(PG8_SB(1, 0), cB + kstep, voffB); PG8_STA(PG8_SA(1, 0), cA + kstep, 0, false); PG8_STAGE(PG8_SB(1, 1), cB + hstep + kstep, voffB);
        PG8_WAIT_V(6); PG8_BAR;
    } else {
        PG8_STAGE(PG8_SB(0, 0), cB, voffB); PG8_STAGE(PG8_SA(0, 0), cA, voffA); PG8_STAGE(PG8_SB(0, 1), cB + hstep, voffB); PG8_STAGE(PG8_SA(0, 1), cA + hstep, voffA);
        if (wr == 1) PG8_BAR;
        PG8_WAIT_V(4); PG8_BAR;
        PG8_STAGE(PG8_SB(1, 0), cB + kstep, voffB); PG8_STAGE(PG8_SA(1, 0), cA + kstep, voffA); PG8_STAGE(PG8_SB(1, 1), cB + hstep + kstep, voffB);
        PG8_WAIT_V(6); PG8_BAR;
    }
#if defined(STAMP_SEL)
    unsigned long long st_t0 = 0, st_t1 = 0, st_t2 = 0, st_r0 = 0, st_r1 = 0;
#endif
    for (;;) {
        const bool has_next = S.next(ui + 1, nxt);
#if defined(STAMP_SEL)
        if (g.stamp && ui == 5) { st_t0 = __builtin_amdgcn_s_memtime(); st_r0 = __builtin_amdgcn_s_memrealtime(); }
#endif
        const char* nA = has_next ? (const char*)g.A + (size_t)nxt.br * g.a_brstride + (GATHER ? (size_t)0 : (size_t)nxt.pm * tstep) : cA; const char* nB = has_next ? (const char*)g.Bt + (size_t)nxt.br * g.b_brstride + (size_t)((nxt.pm >> 1) & 15) * g.gstride + (size_t)nxt.pn * tstep : cB;
        const int ntu = S.ntiles(cur, nt);
        if constexpr (GATHER) { if (has_next) PG8_GOFF(gnx, nxt); else { gnx[0][0] = gcur[0][0]; gnx[0][1] = gcur[0][1]; gnx[1][0] = gcur[1][0]; gnx[1][1] = gcur[1][1]; } }
        for (int t = 0; t < ntu; t += 2) {
            const bool last = (t == ntu - 2);
            const char* a1 = cA + (size_t)(t + 1) * kstep;
            const char* a2 = last ? nA : cA + (size_t)(t + 2) * kstep; const char* b2 = last ? nB : cB + (size_t)(t + 2) * kstep;
            const char* a3 = a2 + kstep; const char* b3 = b2 + kstep;
            if (last && has_next) S.a_ready(nxt);
            if constexpr (SP2) {
            PG8_LDB(B0, 0, 0); PG8_LDB(B1, 0, 1); PG8_SCHED; PG8_LDA(At, 0, 0); PG8_STA(PG8_SA(1, 1), a1, 1, false);
            PG8_WAIT_V(8); PG8_WAIT_L(0); PG8_BAR; PG8_MMA(0, 0, At, B0); PG8_MMA(0, 1, At, B1); PG8_BAR; PG8_SCHED;
            PG8_LDA(At, 0, 1); PG8_STAGE(PG8_SB(0, 0), b2, voffB); PG8_STAGE(PG8_SB(0, 1), b2 + hstep, voffB); PG8_STA(PG8_SA(0, 0), a2, 0, last);
            PG8_WAIT_V(8); PG8_WAIT_L(0); PG8_BAR; PG8_MMA(1, 0, At, B0); PG8_MMA(1, 1, At, B1); PG8_BAR; PG8_SCHED;
            PG8_LDB(B0, 1, 0); PG8_LDB(B1, 1, 1); PG8_SCHED; PG8_LDA(At, 1, 0); PG8_STA(PG8_SA(0, 1), a2, 1, last);
            PG8_WAIT_V(8); PG8_WAIT_L(0); PG8_BAR; PG8_MMA(0, 0, At, B0); PG8_MMA(0, 1, At, B1); PG8_BAR; PG8_SCHED;
            PG8_LDA(At, 1, 1); PG8_STAGE(PG8_SB(1, 0), b3, voffB); PG8_STAGE(PG8_SB(1, 1), b3 + hstep, voffB); PG8_STA(PG8_SA(1, 0), a3, 0, last);
            PG8_WAIT_V(8); PG8_WAIT_L(0); PG8_BAR; PG8_MMA(1, 0, At, B0); PG8_MMA(1, 1, At, B1); PG8_BAR; PG8_SCHED;
            } else {
            PG8_LDB(B0, 0, 0); PG8_SCHED; PG8_LDA(At, 0, 0); PG8_STAGE(PG8_SA(1, 1), a1 + hstep, voffA);
            PG8_WAIT_L(8); PG8_BAR; PG8_WAIT_L(0); PG8_MMA(0, 0, At, B0); PG8_BAR; PG8_SCHED;
            PG8_LDB(B1, 0, 1); PG8_STAGE(PG8_SB(0, 0), b2, voffB);
            PG8_BAR; PG8_WAIT_L(0); PG8_MMA(0, 1, At, B1); PG8_BAR;
            PG8_LDA(At, 0, 1); PG8_STAGE(PG8_SA(0, 0), a2, voffA);
            PG8_BAR; PG8_WAIT_L(0); PG8_MMA(1, 0, At, B0); PG8_BAR; PG8_SCHED;
            PG8_STAGE(PG8_SB(0, 1), b2 + hstep, voffB);
            PG8_WAIT_V(6); PG8_BAR; PG8_MMA(1, 1, At, B1); PG8_BAR;
            PG8_LDB(B0, 1, 0); PG8_SCHED; PG8_LDA(At, 1, 0); PG8_STAGE(PG8_SA(0, 1), a2 + hstep, voffA);
            PG8_WAIT_L(8); PG8_BAR; PG8_WAIT_L(0); PG8_MMA(0, 0, At, B0); PG8_BAR; PG8_SCHED;
            PG8_LDB(B1, 1, 1); PG8_STAGE(PG8_SB(1, 0), b3, voffB);
            PG8_BAR; PG8_WAIT_L(0); PG8_MMA(0, 1, At, B1); PG8_BAR;
            PG8_LDA(At, 1, 1); PG8_STAGE(PG8_SA(1, 0), a3, voffA);
            PG8_BAR; PG8_WAIT_L(0); PG8_MMA(1, 0, At, B0); PG8_BAR; PG8_SCHED;
            PG8_STAGE(PG8_SB(1, 1), b3 + hstep, voffB);
            PG8_WAIT_V(6); PG8_BAR; PG8_MMA(1, 1, At, B1); PG8_BAR;
            }
        }
#if defined(STAMP_SEL)
        if (g.stamp && ui == 5) st_t1 = __builtin_amdgcn_s_memtime();
#endif
        if constexpr (ALIGN_EPI) { if (wr == 0) PG8_BAR; }
        if constexpr (!Epi::AFTER_DRAIN) { E(acc, cur, wr, wc, fr, fq);
#if defined(PROBE_EPI2)
            if constexpr (!Epi::RMW) { asm volatile("" ::: "memory"); E(acc, cur, wr, wc, fr, fq); }
#endif
            S.done(cur); }
#if defined(STAMP_SEL)
        if (g.stamp && ui == 5) { st_t2 = __builtin_amdgcn_s_memtime(); st_r1 = __builtin_amdgcn_s_memrealtime(); }
#endif
        if (!has_next) break;
#pragma unroll
        for (int a = 0; a < 2; ++a)
#pragma unroll
            for (int b = 0; b < 2; ++b)
#pragma unroll
                for (int m = 0; m < 4; ++m)
#pragma unroll
                    for (int n = 0; n < 2; ++n) acc[a][b][m][n] = (f32x4){0.f, 0.f, 0.f, 0.f};
        cur = nxt; cA = nA; cB = nB; ++ui;
        if constexpr (GATHER) { gcur[0][0] = gnx[0][0]; gcur[0][1] = gnx[0][1]; gcur[1][0] = gnx[1][0]; gcur[1][1] = gnx[1][1]; }
        if constexpr (ALIGN_EPI) { if (wr == 1) PG8_BAR; }
    }
    PG8_WAIT_V(0);
    if constexpr (!ALIGN_EPI) { if (wr == 0) PG8_BAR; }
    PG8_BAR;
    if constexpr (Epi::AFTER_DRAIN) { E.fused(acc, cur, wr, wc, fr, fq, lds, wid, lane); S.done(cur); }
#if defined(STAMP_SEL)
    if (g.stamp && tid == 0) { g.stamp[0] = st_t0; g.stamp[1] = st_t1; g.stamp[2] = st_t2; g.stamp[3] = st_r0; g.stamp[4] = st_r1; }
#endif
#undef PG8_SA
#undef PG8_SB
#undef PG8_STAGE
#undef PG8_LDA
#undef PG8_LDB
#undef PG8_MMA
#undef PG8_STA
#undef PG8_GOFF
#undef PG8_WAIT_V
#undef PG8_WAIT_L
#undef PG8_BAR
#undef PG8_SCHED
}
}

#if defined(STAMP_SEL)
#define STAMP_ARG(x) , x
#else
#define STAMP_ARG(x)
#endif

constexpr int DM = 2048, NBATCH = 4, SEQ = 4096, DEPTH = 4, MTOK = NBATCH * SEQ;
constexpr int IN_TOTAL = 22784, PROJ_PITCH = 14592;
constexpr int OFF_QA = 0, OFF_KA = 2304, OFF_VA = 4608, OFF_QB = 6912, OFF_KB = 7936, OFF_VB = 8960, OFF_QC = 9984, OFF_KC = 11008, OFF_VC = 11264, OFF_QD = 11520, OFF_KD = 12544, OFF_VD = 13568, OFF_GATE = 14592;
constexpr int BR_TOTAL = 3840;
constexpr int NEXP = 16, CAP = 512, DEXP = 1024, NGRP = NBATCH * NEXP;
constexpr float LN_EPS = 1e-5f, SUBLN_EPS = 1e-5f;
constexpr float ALPHA = 1.6817928305074290f;
constexpr size_t MiB = 1u << 20;
constexpr size_t WS_CTL = 0, CTL_ZERO_BYTES = 1 * MiB;
constexpr size_t WS_ROPE128 = 1 * MiB, WS_ROPE64 = 3 * MiB, WS_AFF = 4 * MiB, WS_IDX = 5 * MiB, WS_GV = 5 * MiB + 131072, WS_SLOT = 6 * MiB, WS_LSE = 7 * MiB, WS_STATS = 9 * MiB;
constexpr size_t WS_XF = 16 * MiB, WS_XB = 144 * MiB;
constexpr size_t WS_X8 = 208 * MiB;
constexpr size_t WS_W8G = 240 * MiB;
constexpr float QSIG = 4.0f;
constexpr float QX = 127.0f / QSIG, QWG = 127.0f / (QSIG * 0.022097086912079608f), QWU = 127.0f / (QSIG * 0.022097086912079608f * 0.42044820762685725f),
                QO = 127.0f / 0.5f, QWBA = 127.0f / (QSIG * 0.42044820762685725f * 0.036084391824351615f), QWBC = 127.0f / (QSIG * 0.42044820762685725f * 0.03125f),
                QY = 127.0f / (5.0f * 0.1054f), QH = 127.0f / 4.0f, QWD = 127.0f / (QSIG * 0.03125f * 0.42044820762685725f);
constexpr size_t WS_O4 = 2552 * MiB, WS_OA = WS_O4, WS_OB = WS_O4 + 32 * MiB, WS_OC = WS_O4 + 64 * MiB, WS_OD = WS_O4 + 96 * MiB;
constexpr size_t WS_AG = 328 * MiB;
constexpr size_t WS_MIXED8 = 400 * MiB;
constexpr size_t WS_MIXED = 432 * MiB;
constexpr size_t WS_PRELN = 496 * MiB;
constexpr size_t WS_PROJ = 624 * MiB;
constexpr size_t WS_GATE = WS_PROJ + 456 * MiB;
constexpr size_t WS_XG = WS_PROJ, WS_H = WS_PROJ + 128 * MiB, WS_Y = WS_PROJ + 192 * MiB;
constexpr size_t WS_W8Q = 1336 * MiB;
constexpr size_t WS_WIN = 1432 * MiB;
constexpr size_t WS_W8BR = 1692 * MiB;
constexpr size_t WS_O8 = 2616 * MiB;
constexpr size_t WS_WOUT = 1752 * MiB;
constexpr size_t WS_WGU = 1784 * MiB;
constexpr size_t WS_WDN = 2296 * MiB;
constexpr size_t WS_END = 2744 * MiB;
static_assert(WS_PROJ + (size_t)MTOK * IN_TOTAL * 2 == WS_W8Q && WS_W8Q + (size_t)DEPTH * 11520 * DM <= WS_WIN && WS_WIN + (size_t)DEPTH * 3072 * DM * 2 <= 1692 * MiB, "ws map");
constexpr int CW_BAR = 4096;
constexpr int LDS_BYTES = 155648, LDSCTL_OFF = 155136;
constexpr int NWAVES = 8;
#ifndef LB_WAVES
#define LB_WAVES 2
#endif
constexpr int NPL = 10, NPHASES = 1 + DEPTH * NPL;

#define GAS __attribute__((address_space(1)))
#define LAS __attribute__((address_space(3)))
typedef unsigned short bf16_t;
typedef float f32x4 __attribute__((ext_vector_type(4)));
typedef float f32x2 __attribute__((ext_vector_type(2)));
typedef unsigned u32x4 __attribute__((ext_vector_type(4)));
typedef unsigned u32x2 __attribute__((ext_vector_type(2)));
using pg8::cvt_pk_bf16; using pg8::bflo; using pg8::bfhi; using pg8::pk_f16; using pg8::f16lo; using pg8::f16hi;
__device__ __forceinline__ float bf2f(bf16_t h) { return __uint_as_float(((unsigned)h) << 16); }
__device__ __forceinline__ float wave_sum(float v) {
#define WS_DPP(x, ctrl) __builtin_bit_cast(float, __builtin_amdgcn_update_dpp(0, __builtin_bit_cast(int, (x)), (ctrl), 0xF, 0xF, true))
    v += WS_DPP(v, 0xB1); v += WS_DPP(v, 0x4E); v += WS_DPP(v, 0x141); v += WS_DPP(v, 0x140);
#undef WS_DPP
    const int b = __builtin_bit_cast(int, v);
    return (__builtin_bit_cast(float, __builtin_amdgcn_readlane(b, 0)) + __builtin_bit_cast(float, __builtin_amdgcn_readlane(b, 16))) + (__builtin_bit_cast(float, __builtin_amdgcn_readlane(b, 32)) + __builtin_bit_cast(float, __builtin_amdgcn_readlane(b, 48)));
}
__device__ __forceinline__ float wave_max(float v) {
#define WS_DPP(x, ctrl) __builtin_bit_cast(float, __builtin_amdgcn_update_dpp(0, __builtin_bit_cast(int, (x)), (ctrl), 0xF, 0xF, true))
    v = fmaxf(v, WS_DPP(v, 0xB1)); v = fmaxf(v, WS_DPP(v, 0x4E)); v = fmaxf(v, WS_DPP(v, 0x141)); v = fmaxf(v, WS_DPP(v, 0x140));
#undef WS_DPP
    const int b = __builtin_bit_cast(int, v);
    return fmaxf(fmaxf(__builtin_bit_cast(float, __builtin_amdgcn_readlane(b, 0)), __builtin_bit_cast(float, __builtin_amdgcn_readlane(b, 16))), fmaxf(__builtin_bit_cast(float, __builtin_amdgcn_readlane(b, 32)), __builtin_bit_cast(float, __builtin_amdgcn_readlane(b, 48))));
}
__device__ __forceinline__ int wave_sum_i(int v) {
#pragma unroll
    for (int o = 1; o < 64; o <<= 1) v += __shfl_xor(v, o);
    return v;
}

#define XB_TMO      128
#define XB_XCNT(j)  (256  + 64 * (j))
#define XB_XSUB(j)  (1280 + 64 * (j))
#define XB_XGEN(j)  (2304 + 64 * (j))
#define XB_TOP      3328
#define XB_TOPGEN   3392
#define XCD_BAR_WORDS 3456
#define XB_SPIN_CAP (1u << 23)

__device__ __forceinline__ unsigned xb_ld(unsigned* p)              { return __hip_atomic_load(p, __ATOMIC_RELAXED, __HIP_MEMORY_SCOPE_AGENT); }
__device__ __forceinline__ unsigned xb_add(unsigned* p, unsigned v) { return __hip_atomic_fetch_add(p, v, __ATOMIC_RELAXED, __HIP_MEMORY_SCOPE_AGENT); }
__device__ __forceinline__ unsigned xb_xcc_id() { return (unsigned)__builtin_amdgcn_s_getreg((3 << 11) | 20) & 0xFu; }
#define XB_SPIN(cond, bar) do { unsigned _sp = 0; while (cond) { __builtin_amdgcn_s_sleep(1); \
    if ((++_sp & 255u) == 0u) { if (xb_ld(&(bar)[XB_TMO])) break; if (_sp > XB_SPIN_CAP) { atomicAdd(&(bar)[XB_TMO], 1u); break; } } } } while (0)

struct XcdBarrier {
    unsigned* bar; unsigned x;
    volatile LAS unsigned* st;
};
__device__ __forceinline__ XcdBarrier xcd_barrier_post(unsigned* bar, volatile LAS unsigned* st) {
    XcdBarrier b; b.bar = bar; b.x = xb_xcc_id(); b.st = st;
    if (threadIdx.x == 0) (void)xb_add(&bar[XB_XCNT(b.x)], 1u);
    return b;
}
__device__ __forceinline__ void xcd_barrier_complete(unsigned* bar, unsigned x, unsigned& nloc, unsigned& nx) {
    const unsigned G = gridDim.x * gridDim.y * gridDim.z;
    unsigned sum, cnt, mine, sp = 0u;
    for (;;) {
        sum = 0u; cnt = 0u; mine = 0u;
#pragma unroll
        for (unsigned j = 0; j < 16; ++j) { const unsigned c = xb_ld(&bar[XB_XCNT(j)]); sum += c; cnt += (c > 0u) ? 1u : 0u; mine = (j == x) ? c : mine; }
        if (sum == G) break;
        __builtin_amdgcn_s_sleep(1);
        if ((++sp & 255u) == 0u) { if (xb_ld(&bar[XB_TMO])) break; if (sp > XB_SPIN_CAP) { atomicAdd(&bar[XB_TMO], 1u); break; } }
    }
    nloc = mine > 0u ? mine : 1u; nx = cnt > 0u ? cnt : 1u;
}
__device__ __forceinline__ void xcd_barrier(const XcdBarrier& b) {
    asm volatile("s_waitcnt vmcnt(0)" ::: "memory");
    __syncthreads();
    if (threadIdx.x == 0) {
        unsigned* bar = b.bar;
        __builtin_amdgcn_s_waitcnt(0);
        unsigned nloc = b.st[0], nx = b.st[1];
        if (nloc == 0u) { xcd_barrier_complete(bar, b.x, nloc, nx); b.st[0] = nloc; b.st[1] = nx; }
        const unsigned old = xb_add(&bar[XB_XSUB(b.x)], 1u);
        const unsigned gen = old / nloc;
        if (old + 1u == (gen + 1u) * nloc) {
            __builtin_amdgcn_fence(__ATOMIC_RELEASE, "agent");
            asm volatile("s_waitcnt vmcnt(0)" ::: "memory");
            const unsigned og = xb_add(&bar[XB_TOP], 1u);
            const unsigned tg = og / nx;
            if (og + 1u == (tg + 1u) * nx) xb_add(&bar[XB_TOPGEN], 1u);
            else XB_SPIN(xb_ld(&bar[XB_TOPGEN]) == tg, bar);
            __builtin_amdgcn_fence(__ATOMIC_ACQUIRE, "agent");
            xb_add(&bar[XB_XGEN(b.x)], 1u);
            asm volatile("s_waitcnt vmcnt(0)" ::: "memory");
        } else {
            XB_SPIN(xb_ld(&bar[XB_XGEN(b.x)]) == gen, bar);
            __builtin_amdgcn_fence(__ATOMIC_ACQUIRE, "agent");
            asm volatile("s_waitcnt vmcnt(0)" ::: "memory");
        }
    }
    __syncthreads();
}

__device__ __forceinline__ int win_src_col(int n) {
    if (n < OFF_VA || (n >= OFF_QC && n < OFF_VC)) { const int hb = n & ~127, j = n & 127; return hb + (j >> 1) + (j & 1) * 64; }
    if (n >= OFF_QB && n < OFF_VB) { const int hb = n & ~63, j = n & 63; return hb + (j >> 1) + (j & 1) * 32; }
    return n;
}
__device__ __forceinline__ void tr_item(const float* __restrict__ src, size_t ld, int srccol, int k0, bf16_t* __restrict__ dst_tile, size_t dld, LAS unsigned char* scr, int lane) {
    const float* p = src + (size_t)k0 * ld + srccol;
    float v[64];
#pragma unroll
    for (int j = 0; j < 64; ++j) v[j] = __builtin_nontemporal_load(p + (size_t)j * ld);
    __builtin_amdgcn_sched_barrier(0);
#pragma unroll
    for (int kk = 0; kk < 8; ++kk) { const int o = kk * 8;
        u32x4 w; w.x = pk_f16(v[o + 0], v[o + 1]); w.y = pk_f16(v[o + 2], v[o + 3]); w.z = pk_f16(v[o + 4], v[o + 5]); w.w = pk_f16(v[o + 6], v[o + 7]);
        *(LAS u32x4*)(scr + lane * 144 + kk * 16) = w;
    }
    bf16_t* d = dst_tile + (size_t)(lane >> 3) * dld + (lane & 7) * 8;
#pragma unroll
    for (int i = 0; i < 8; ++i) { const u32x4 w = *(const LAS u32x4*)(scr + (8 * i + (lane >> 3)) * 144 + (lane & 7) * 16); *(u32x4*)(d + (size_t)(8 * i) * dld) = w; }
}
__device__ __forceinline__ unsigned q8x4(float a, float b, float c, float d, float s) {
    const float ca = fminf(fmaxf(a * s, -127.0f), 127.0f) + 12582912.0f, cb = fminf(fmaxf(b * s, -127.0f), 127.0f) + 12582912.0f;
    const float cc = fminf(fmaxf(c * s, -127.0f), 127.0f) + 12582912.0f, cd = fminf(fmaxf(d * s, -127.0f), 127.0f) + 12582912.0f;
    const unsigned lo = __builtin_amdgcn_perm(__float_as_uint(cb), __float_as_uint(ca), 0x0c0c0400u), hi = __builtin_amdgcn_perm(__float_as_uint(cd), __float_as_uint(cc), 0x0c0c0400u);
    return __builtin_amdgcn_perm(hi, lo, 0x05040100u);
}
__device__ __forceinline__ void tr_item8(const float* __restrict__ src, size_t ld, int srccol, int k0, unsigned char* __restrict__ dst_tile, size_t dld, float scale, LAS unsigned char* scr, int lane) {
    const float* p = src + (size_t)k0 * ld + srccol;
    float v[64];
#pragma unroll
    for (int j = 0; j < 64; ++j) v[j] = __builtin_nontemporal_load(p + (size_t)j * ld);
    __builtin_amdgcn_sched_barrier(0);
#pragma unroll
    for (int kk = 0; kk < 4; ++kk) { const int o = kk * 16;
        u32x4 w; w.x = q8x4(v[o + 0], v[o + 1], v[o + 2], v[o + 3], scale); w.y = q8x4(v[o + 4], v[o + 5], v[o + 6], v[o + 7], scale); w.z = q8x4(v[o + 8], v[o + 9], v[o + 10], v[o + 11], scale); w.w = q8x4(v[o + 12], v[o + 13], v[o + 14], v[o + 15], scale);
        *(LAS u32x4*)(scr + lane * 80 + kk * 16) = w;
    }
    unsigned char* d = dst_tile + (size_t)(lane >> 2) * dld + (lane & 3) * 16;
#pragma unroll
    for (int i = 0; i < 4; ++i) { const u32x4 w = *(const LAS u32x4*)(scr + (16 * i + (lane >> 2)) * 80 + (lane & 3) * 16); *(u32x4*)(d + (size_t)(16 * i) * dld) = w; }
}

struct KeyA { int s, r;
    __device__ __forceinline__ int pos(int idx, float& bias) const { bias = 0.f; const int p = s + r * (idx - 64); return (p >= 0 && p < SEQ) ? p : -1; } };
struct KeyB {
    __device__ __forceinline__ int pos(int idx, float& bias) const { bias = 0.f; return idx; } };
struct KeyC { int s;
    __device__ __forceinline__ int pos(int idx, float& bias) const { bias = 0.f; const int p = s + idx - 128; return (p >= 0 && p < SEQ) ? p : -1; } };
struct KeyD { int r, c, rs, cs; const float* rpb;
    __device__ __forceinline__ int pos(int idx, float& bias) const { const int kr = rs + (idx >> 4), kc = cs + (idx & 15); int dc = kc - c; dc = dc < -15 ? -15 : (dc > 15 ? 15 : dc);
        bias = rpb[(kr - r + 7) * 31 + dc + 15]; return kr * 64 + kc; } };

template <int DK, class KF>
__device__ __forceinline__ void sattn(const bf16_t* q, const bf16_t* kb, const bf16_t* vb, const KF& kf, int nkeys, float scale, bool has_sink, float sink,
                                      LAS float* sq, LAS float* ss, int lane, float& o0, float& o1, float& m_out, float& l_out) {
    for (int d = lane; d < DK; d += 64) sq[d] = bf2f(q[d]);
    asm volatile("s_waitcnt lgkmcnt(0)" ::: "memory");
    float mx = -1e30f;
    for (int idx = lane; idx < nkeys; idx += 64) {
        float bias; const int p = kf.pos(idx, bias); float s = -1e30f;
        if (p >= 0) {
            const u32x4* kr = (const u32x4*)(kb + (size_t)p * PROJ_PITCH); float acc = 0.f;
#pragma unroll
            for (int d8 = 0; d8 < DK / 8; ++d8) { const u32x4 w = kr[d8]; const LAS f32x4* qq = (const LAS f32x4*)(sq + d8 * 8); const f32x4 qa = qq[0], qb = qq[1];
                acc += qa[0] * bflo(w.x) + qa[1] * bfhi(w.x) + qa[2] * bflo(w.y) + qa[3] * bfhi(w.y) + qb[0] * bflo(w.z) + qb[1] * bfhi(w.z) + qb[2] * bflo(w.w) + qb[3] * bfhi(w.w); }
            s = acc * scale + bias;
        }
        ss[idx] = s; mx = fmaxf(mx, s);
    }
    mx = wave_max(mx); if (has_sink) mx = fmaxf(mx, sink);
    float sum = 0.f;
    for (int idx = lane; idx < nkeys; idx += 64) { const float s = ss[idx]; const float p = (s > -1e29f) ? __expf(s - mx) : 0.f; ss[idx] = p; sum += p; }
    sum = wave_sum(sum); if (has_sink) sum += __expf(sink - mx);
    asm volatile("s_waitcnt lgkmcnt(0)" ::: "memory");
    o0 = 0.f; o1 = 0.f;
    for (int idx = 0; idx < nkeys; ++idx) {
        const float p = ss[idx];
        if (p != 0.f) { float bias; const int pp = kf.pos(idx, bias); const unsigned w = *(const unsigned*)(vb + (size_t)pp * PROJ_PITCH + 2 * lane); o0 += p * bflo(w); o1 += p * bfhi(w); }
    }
    const float inv = 1.0f / sum; o0 *= inv; o1 *= inv; m_out = mx; l_out = sum;
    asm volatile("s_waitcnt lgkmcnt(0)" ::: "memory");
}

struct AttnPtrs { const bf16_t* proj; bf16_t* ag; float* lse; bf16_t* ob; bf16_t* oc; bf16_t* od; const float* lam; const float* subln; const float* sink; const float* rpb; float lambda_init; };

template <int WHICH>
__device__ __forceinline__ void scalar_attn_phase(const AttnPtrs& P, LAS unsigned char* lds, int gw, int NGW, int wave, int lane) {
    LAS float* sq = (LAS float*)(lds + wave * 16896); LAS float* ss = sq + 128;
    constexpr int NH = WHICH == 0 ? 18 : 8;
    float lmbda = 0.f;
    if constexpr (WHICH == 1) { const float d01 = wave_sum(P.lam[lane] * P.lam[64 + lane]), d23 = wave_sum(P.lam[128 + lane] * P.lam[192 + lane]); lmbda = __expf(d01) - __expf(d23) + P.lambda_init; }
    for (int task = gw; task < NH * MTOK; task += NGW) {
        const int hs = task / MTOK, row = task % MTOK, b = row >> 12, s = row & 4095;
        const bf16_t* prow = P.proj + (size_t)row * PROJ_PITCH; const bf16_t* pb = P.proj + (size_t)(b * SEQ) * PROJ_PITCH;
        float o0, o1, mm, ll;
        if constexpr (WHICH == 0) {
            const int hh = hs, g = hh / 6, r = (g == 0) ? 1 : ((g == 1) ? 4 : 16); KeyA kf{s, r};
            sattn<128>(prow + OFF_QA + hh * 128, pb + OFF_KA + hh * 128, pb + OFF_VA + hh * 128, kf, 129, 0.08838834764831845f, false, 0.f, sq, ss, lane, o0, o1, mm, ll);
            *(unsigned*)(P.ag + ((size_t)g * MTOK + row) * 768 + (hh % 6) * 128 + 2 * lane) = cvt_pk_bf16(o0, o1);
            if (lane == 0) P.lse[((size_t)g * MTOK + row) * 6 + (hh % 6)] = mm + __logf(ll);
        } else if constexpr (WHICH == 1) {
            const int h = hs; KeyB kf; float a0, a1, b0, b1;
            sattn<64>(prow + OFF_QB + (2 * h) * 64, pb + OFF_KB + (2 * h) * 64, pb + OFF_VB + h * 128, kf, SEQ, 0.125f, false, 0.f, sq, ss, lane, a0, a1, mm, ll);
            sattn<64>(prow + OFF_QB + (2 * h + 1) * 64, pb + OFF_KB + (2 * h + 1) * 64, pb + OFF_VB + h * 128, kf, SEQ, 0.125f, false, 0.f, sq, ss, lane, b0, b1, mm, ll);
            const float v0 = a0 - lmbda * b0, v1 = a1 - lmbda * b1;
            const float rinv = rsqrtf(wave_sum(v0 * v0 + v1 * v1) * (1.0f / 128.0f) + SUBLN_EPS) * (1.0f - P.lambda_init);
            *(unsigned*)(P.ob + (size_t)row * 1024 + h * 128 + 2 * lane) = cvt_pk_bf16(v0 * rinv * P.subln[2 * lane], v1 * rinv * P.subln[2 * lane + 1]);
        } else if constexpr (WHICH == 2) {
            const int qh = hs, kvh = qh >> 2; KeyC kf{s};
            sattn<128>(prow + OFF_QC + qh * 128, pb + OFF_KC + kvh * 128, pb + OFF_VC + kvh * 128, kf, 257, 0.08838834764831845f, true, P.sink[qh], sq, ss, lane, o0, o1, mm, ll);
            *(unsigned*)(P.oc + (size_t)row * 1024 + qh * 128 + 2 * lane) = cvt_pk_bf16(o0, o1);
        } else {
            const int h = hs, r = s >> 6, c = s & 63; int rs = r - 4; rs = rs < 0 ? 0 : (rs > 56 ? 56 : rs); int cs = c - 8; cs = cs < 0 ? 0 : (cs > 48 ? 48 : cs);
            KeyD kf{r, c, rs, cs, P.rpb + h * 465};
            sattn<128>(prow + OFF_QD + h * 128, pb + OFF_KD + h * 128, pb + OFF_VD + h * 128, kf, 128, 0.08838834764831845f, false, 0.f, sq, ss, lane, o0, o1, mm, ll);
            *(unsigned*)(P.od + (size_t)row * 1024 + h * 128 + 2 * lane) = cvt_pk_bf16(o0, o1);
        }
    }
}

__device__ __forceinline__ void combine_a_phase(const unsigned char* ag, const float* lse, unsigned* oa8, int gw, int NGW, int lane) {
    for (int row0 = gw; row0 < MTOK; row0 += 4 * NGW) {
        float lc[4][3][3]; unsigned ac[4][3][3];
#pragma unroll
        for (int u = 0; u < 4; ++u) { const int row = row0 + u * NGW; if (row < MTOK) {
#pragma unroll
            for (int j = 0; j < 3; ++j) { const int e = 4 * lane + 256 * j, head = e >> 7;
#pragma unroll
                for (int g = 0; g < 3; ++g) { lc[u][j][g] = lse[((size_t)g * MTOK + row) * 6 + head]; ac[u][j][g] = *(const unsigned*)(ag + ((size_t)g * MTOK + row) * 768 + e); } } } }
#pragma unroll
        for (int u = 0; u < 4; ++u) { const int row = row0 + u * NGW; if (row >= MTOK) break;
#pragma unroll
            for (int j = 0; j < 3; ++j) {
                const int e = 4 * lane + 256 * j;
                const float l0 = lc[u][j][0], l1 = lc[u][j][1], l2 = lc[u][j][2];
                const float mx = fmaxf(l0, fmaxf(l1, l2)); float w0 = __expf(l0 - mx), w1 = __expf(l1 - mx), w2 = __expf(l2 - mx); const float inv = 1.0f / (w0 + w1 + w2); w0 *= inv; w1 *= inv; w2 *= inv;
                const unsigned a0 = ac[u][j][0], a1 = ac[u][j][1], a2 = ac[u][j][2];
#define CMB_B(w_, k_) ((float)(int)(signed char)(((w_) >> (8 * (k_))) & 0xffu))
                oa8[(size_t)row * 256 + (e >> 2)] = q8x4(w0 * CMB_B(a0, 0) + w1 * CMB_B(a1, 0) + w2 * CMB_B(a2, 0), w0 * CMB_B(a0, 1) + w1 * CMB_B(a1, 1) + w2 * CMB_B(a2, 1),
                                                      w0 * CMB_B(a0, 2) + w1 * CMB_B(a1, 2) + w2 * CMB_B(a2, 2), w0 * CMB_B(a0, 3) + w1 * CMB_B(a1, 3) + w2 * CMB_B(a2, 3), 1.0f);
#undef CMB_B
            } }
    }
}
__device__ __forceinline__ void ln1_router_phase(const bf16_t* preln, const float* gain, const float* bias, const float* wr, float* stats, unsigned* x8, float* aff,
                                                 LAS unsigned char* lds, int tid, int gw, int NGW, int lane) {
    LAS float* W = (LAS float*)lds;
    u32x2 vn[8];
    if (gw < MTOK) {
#pragma unroll
        for (int j = 0; j < 8; ++j) vn[j] = *(const u32x2*)(preln + (size_t)gw * DM + 4 * lane + 256 * j);
    }
    f32x4 g[8], bb[8];
#pragma unroll
    for (int j = 0; j < 8; ++j) { g[j] = *(const f32x4*)(gain + 256 * j + 4 * lane); bb[j] = *(const f32x4*)(bias + 256 * j + 4 * lane); }
    { f32x4 w4[16];
#pragma unroll
      for (int it = 0; it < 16; ++it) w4[it] = *(const f32x4*)(wr + 4 * (size_t)(tid + it * (NWAVES * 64)));
#pragma unroll
      for (int it = 0; it < 16; ++it) { const int i4 = tid + it * (NWAVES * 64), k = i4 >> 2, e0 = (i4 & 3) * 4;
          W[(e0 + 0) * DM + k] = w4[it][0]; W[(e0 + 1) * DM + k] = w4[it][1]; W[(e0 + 2) * DM + k] = w4[it][2]; W[(e0 + 3) * DM + k] = w4[it][3]; } }
    __syncthreads();
    for (int row = gw; row < MTOK; row += NGW) {
        f32x4 v[8]; float s = 0.f;
#pragma unroll
        for (int j = 0; j < 8; ++j) { v[j] = (f32x4){f16lo(vn[j].x), f16hi(vn[j].x), f16lo(vn[j].y), f16hi(vn[j].y)}; s += (v[j][0] + v[j][1]) + (v[j][2] + v[j][3]); }
        if (row + NGW < MTOK) {
#pragma unroll
            for (int j = 0; j < 8; ++j) vn[j] = *(const u32x2*)(preln + (size_t)(row + NGW) * DM + 4 * lane + 256 * j);
        }
        const float mean = wave_sum(s) * (1.0f / DM); float q = 0.f;
#pragma unroll
        for (int j = 0; j < 8; ++j) { v[j] = v[j] - mean; q += (v[j][0] * v[j][0] + v[j][1] * v[j][1]) + (v[j][2] * v[j][2] + v[j][3] * v[j][3]); }
        const float rstd = rsqrtf(wave_sum(q) * (1.0f / DM) + LN_EPS);
        if (lane == 0) *(f32x2*)(stats + 2 * (size_t)row) = (f32x2){mean, rstd};
        unsigned* x8o = x8 + (size_t)row * (DM / 4) + lane;
#pragma unroll
        for (int j = 0; j < 8; ++j) { v[j] = v[j] * rstd * g[j] + bb[j]; x8o[64 * j] = q8x4(v[j][0], v[j][1], v[j][2], v[j][3], QX); }
        float a[16];
        f32x4 wa[8], wb[8];
#define LN1_LDW(dst, e) do { _Pragma("unroll") for (int j = 0; j < 8; ++j) dst[j] = *(const LAS f32x4*)(W + (e) * DM + 256 * j + 4 * lane); } while (0)
#define LN1_DOT(src, e) do { f32x2 t2 = {0.f, 0.f}; _Pragma("unroll") for (int j = 0; j < 8; ++j) { \
            t2 = __builtin_elementwise_fma((f32x2){v[j][0], v[j][1]}, (f32x2){src[j][0], src[j][1]}, t2); t2 = __builtin_elementwise_fma((f32x2){v[j][2], v[j][3]}, (f32x2){src[j][2], src[j][3]}, t2); } \
            a[e] = t2[0] + t2[1]; } while (0)
        LN1_LDW(wa, 0);
#pragma unroll
        for (int e = 0; e < 16; e += 2) {
            LN1_LDW(wb, e + 1); asm volatile("" ::: "memory"); LN1_DOT(wa, e); asm volatile("" ::: "memory");
            if (e + 2 < 16) LN1_LDW(wa, e + 2);
            asm volatile("" ::: "memory"); LN1_DOT(wb, e + 1); asm volatile("" ::: "memory"); }
#undef LN1_LDW
#undef LN1_DOT
        float r8[8], r4[4], r2[2], r1;
        { const bool up = (lane & 32) != 0;
#pragma unroll
          for (int i = 0; i < 8; ++i) { const float keep = up ? a[i + 8] : a[i], send = up ? a[i] : a[i + 8]; r8[i] = keep + __shfl_xor(send, 32); } }
        { const bool up = (lane & 16) != 0;
#pragma unroll
          for (int i = 0; i < 4; ++i) { const float keep = up ? r8[i + 4] : r8[i], send = up ? r8[i] : r8[i + 4]; r4[i] = keep + __shfl_xor(send, 16); } }
        { const bool up = (lane & 8) != 0;
#pragma unroll
          for (int i = 0; i < 2; ++i) { const float keep = up ? r4[i + 2] : r4[i], send = up ? r4[i] : r4[i + 2]; r2[i] = keep + __shfl_xor(send, 8); } }
        { const bool up = (lane & 4) != 0; const float keep = up ? r2[1] : r2[0], send = up ? r2[0] : r2[1]; r1 = keep + __shfl_xor(send, 4); }
        r1 += __shfl_xor(r1, 1); r1 += __shfl_xor(r1, 2);
        const float mx = wave_max(r1);
        const float ex = expf(r1 - mx); const float den = wave_sum(ex) * 0.25f;
        const int eidx = ((lane >> 5) & 1) * 8 + ((lane >> 4) & 1) * 4 + ((lane >> 3) & 1) * 2 + ((lane >> 2) & 1);
        if ((lane & 3) == 0) aff[((size_t)(row >> 12) * NEXP + eidx) * SEQ + (row & 4095)] = ex / den;
    }
    __syncthreads();
}
__device__ __forceinline__ void topk_phase(const float* aff, int* idxo, float* gvo, int* sloto, LAS unsigned char* lds, int tid, int wave, int lane, int wg, int G) {
    LAS int* cnt = (LAS int*)lds;
    for (int be = wg; be < NGRP; be += G) {
        const float* a = aff + (size_t)be * SEQ + tid * 8;
        const f32x4 a0 = *(const f32x4*)a, a1 = *(const f32x4*)(a + 4);
        unsigned v[8] = {__float_as_uint(a0[0]), __float_as_uint(a0[1]), __float_as_uint(a0[2]), __float_as_uint(a0[3]), __float_as_uint(a1[0]), __float_as_uint(a1[1]), __float_as_uint(a1[2]), __float_as_uint(a1[3])};
        unsigned T = 0u;
        for (int bit = 30; bit >= 0; --bit) {
            const unsigned cand = T | (1u << bit); int c = 0;
#pragma unroll
            for (int k = 0; k < 8; ++k) c += __popcll(__ballot(v[k] >= cand));
            if (lane == 0) cnt[(bit & 1) * 8 + wave] = c;
            __syncthreads();
            int tot = 0;
#pragma unroll
            for (int w = 0; w < 8; ++w) tot += cnt[(bit & 1) * 8 + w];
            if (tot >= CAP) T = cand;
        }
        int ngt = 0, neq = 0;
#pragma unroll
        for (int k = 0; k < 8; ++k) { ngt += (v[k] > T) ? 1 : 0; neq += (v[k] == T) ? 1 : 0; }
        int sgt = ngt, seq = neq;
#pragma unroll
        for (int o = 1; o < 64; o <<= 1) { const int tg = __shfl_up(sgt, o), te = __shfl_up(seq, o); if (lane >= o) { sgt += tg; seq += te; } }
        __syncthreads();
        if (lane == 63) { cnt[64 + wave] = sgt; cnt[64 + 8 + wave] = seq; }
        __syncthreads();
        int pgt = sgt - ngt, peq = seq - neq, totgt = 0;
#pragma unroll
        for (int w = 0; w < 8; ++w) { const int tg = cnt[64 + w], te = cnt[64 + 8 + w]; if (w < wave) { pgt += tg; peq += te; } totgt += tg; }
        const int need = CAP - totgt;
        const int b = be >> 4, e = be & 15;
#pragma unroll
        for (int k = 0; k < 8; ++k) {
            const bool gt = v[k] > T, eq = v[k] == T; const bool sel = gt || (eq && peq < need);
            const int slot = pgt + (peq < need ? peq : need);
            const int tok = tid * 8 + k;
            if (sel) { idxo[be * CAP + slot] = tok; gvo[be * CAP + slot] = __uint_as_float(v[k]); }
            sloto[((size_t)b * SEQ + tok) * NEXP + e] = sel ? slot : -1;
            pgt += gt ? 1 : 0; peq += eq ? 1 : 0;
        }
        __syncthreads();
    }
}
__device__ __forceinline__ void gather_phase(const bf16_t* xb, const int* idx, bf16_t* xg, int gw, int NGW, int lane) {
    for (int r = gw; r < NGRP * CAP; r += NGW) {
        const int be = r >> 9, b = be >> 4; const int tok = idx[r];
        const u32x4* src = (const u32x4*)(xb + ((size_t)b * SEQ + tok) * DM); u32x4* dst = (u32x4*)(xg + (size_t)r * DM);
#pragma unroll
        for (int j = 0; j < 4; ++j) dst[64 * j + lane] = src[64 * j + lane];
    }
}
__device__ __forceinline__ void ln2_phase(const bf16_t* x1, const float* stats, const float* gain1, const float* bias1, const unsigned char* y, const float* gvp, const int* slot, const float* gain, const float* bias, float* xo_base, bf16_t* xh, bf16_t* xb, unsigned char* x8, int gw, int NGW, int lane, LAS unsigned char* lds, int tid) {
    LAS float* V4 = (LAS float*)lds;
    for (int i = tid; i < DM / 4; i += NWAVES * 64) { *(LAS f32x4*)(V4 + 4 * i) = *(const f32x4*)(gain1 + 4 * i); *(LAS f32x4*)(V4 + DM + 4 * i) = *(const f32x4*)(bias1 + 4 * i);
        *(LAS f32x4*)(V4 + 2 * DM + 4 * i) = *(const f32x4*)(gain + 4 * i); *(LAS f32x4*)(V4 + 3 * DM + 4 * i) = *(const f32x4*)(bias + 4 * i); }
    __syncthreads();
    u32x4 xn[4]; int slot_n = -1;
    if (gw < MTOK) { slot_n = slot[(size_t)gw * NEXP + (lane & 15)];
#pragma unroll
        for (int j = 0; j < 4; ++j) xn[j] = *(const u32x4*)(x1 + (size_t)gw * DM + 512 * j + 8 * lane); }
    for (int row = gw; row < MTOK; row += NGW) {
        const int b = row >> 12; const int myslot = slot_n;
        unsigned v4a_ = (unsigned)(__UINTPTR_TYPE__)V4; asm volatile("" : "+v"(v4a_)); LAS float* V4r = (LAS float*)(__UINTPTR_TYPE__)v4a_;
        f32x4 xc[8];
#pragma unroll
        for (int j = 0; j < 4; ++j) { xc[2 * j] = (f32x4){f16lo(xn[j].x), f16hi(xn[j].x), f16lo(xn[j].y), f16hi(xn[j].y)}; xc[2 * j + 1] = (f32x4){f16lo(xn[j].z), f16hi(xn[j].z), f16lo(xn[j].w), f16hi(xn[j].w)}; }
        unsigned hits = (unsigned)(__ballot(myslot >= 0) & 0xffffull);
        const bool h0 = hits != 0u; const int e0 = h0 ? __builtin_ctz(hits) : 0; if (h0) hits &= hits - 1;
        const bool h1 = hits != 0u; const int e1 = h1 ? __builtin_ctz(hits) : e0; if (h1) hits &= hits - 1;
        int sl0 = __shfl(myslot, e0), sl1 = __shfl(myslot, e1); sl0 = sl0 < 0 ? 0 : sl0; sl1 = sl1 < 0 ? 0 : sl1;
        const f32x2 st = *(const f32x2*)(stats + 2 * (size_t)row);
        f32x4 ga[4], gb[4], ba[4], bv[4];
#pragma unroll
        for (int j = 0; j < 4; ++j) { ga[j] = *(const LAS f32x4*)(V4r + 512 * j + 8 * lane); gb[j] = *(const LAS f32x4*)(V4r + 512 * j + 8 * lane + 4);
            ba[j] = *(const LAS f32x4*)(V4r + DM + 512 * j + 8 * lane); bv[j] = *(const LAS f32x4*)(V4r + DM + 512 * j + 8 * lane + 4); }
        u32x2 ya[4], yb[4]; float ga_, gb_;
        { const size_t r0_ = (size_t)(b * NEXP + e0) * CAP + sl0, r1_ = (size_t)(b * NEXP + e1) * CAP + sl1;
          const unsigned char* yr0 = y + r0_ * DM + 8 * lane; const unsigned char* yr1 = y + r1_ * DM + 8 * lane;
          ga_ = gvp[r0_]; gb_ = gvp[r1_];
#pragma unroll
          for (int j = 0; j < 4; ++j) ya[j] = *(const u32x2*)(yr0 + 512 * j);
#pragma unroll
          for (int j = 0; j < 4; ++j) yb[j] = *(const u32x2*)(yr1 + 512 * j); }
        if (row + NGW < MTOK) { slot_n = slot[(size_t)(row + NGW) * NEXP + (lane & 15)];
#pragma unroll
            for (int j = 0; j < 4; ++j) xn[j] = *(const u32x4*)(x1 + (size_t)(row + NGW) * DM + 512 * j + 8 * lane); }
#pragma unroll
        for (int j = 0; j < 4; ++j) { xc[2 * j] = (xc[2 * j] - st[0]) * st[1] * ga[j] + ba[j]; xc[2 * j + 1] = (xc[2 * j + 1] - st[0]) * st[1] * gb[j] + bv[j]; }
        f32x4 acc[8];
#pragma unroll
        for (int j = 0; j < 8; ++j) acc[j] = (f32x4){0.f, 0.f, 0.f, 0.f};
#define LN2_ACC(Y_, j, gs) do { acc[2 * j][0] = fmaf((float)((Y_).x & 0xffu), gs, acc[2 * j][0]); acc[2 * j][1] = fmaf((float)(((Y_).x >> 8) & 0xffu), gs, acc[2 * j][1]); \
            acc[2 * j][2] = fmaf((float)(((Y_).x >> 16) & 0xffu), gs, acc[2 * j][2]); acc[2 * j][3] = fmaf((float)((Y_).x >> 24), gs, acc[2 * j][3]); \
            acc[2 * j + 1][0] = fmaf((float)((Y_).y & 0xffu), gs, acc[2 * j + 1][0]); acc[2 * j + 1][1] = fmaf((float)(((Y_).y >> 8) & 0xffu), gs, acc[2 * j + 1][1]); \
            acc[2 * j + 1][2] = fmaf((float)(((Y_).y >> 16) & 0xffu), gs, acc[2 * j + 1][2]); acc[2 * j + 1][3] = fmaf((float)((Y_).y >> 24), gs, acc[2 * j + 1][3]); } while (0)
        float corr = 0.f;
        if (h0) { const float gs = ga_ * (1.0f / QY); corr += 128.0f * gs;
#pragma unroll
            for (int j = 0; j < 4; ++j) LN2_ACC(ya[j], j, gs); }
        if (h1) { const float gs = gb_ * (1.0f / QY); corr += 128.0f * gs;
#pragma unroll
            for (int j = 0; j < 4; ++j) LN2_ACC(yb[j], j, gs); }
        while (hits) {
            const int e = __builtin_ctz(hits); hits &= hits - 1;
            const int sl = __shfl(myslot, e);
            const size_t r_ = (size_t)(b * NEXP + e) * CAP + sl; const unsigned char* yr = y + r_ * DM + 8 * lane;
            const float gs = gvp[r_] * (1.0f / QY); corr += 128.0f * gs;
#pragma unroll
            for (int j = 0; j < 4; ++j) { const u32x2 w = *(const u32x2*)(yr + 512 * j); LN2_ACC(w, j, gs); }
        }
#undef LN2_ACC
        float s = 0.f;
#pragma unroll
        for (int j = 0; j < 8; ++j) { acc[j] = xc[j] * ALPHA + (acc[j] - corr); s += (acc[j][0] + acc[j][1]) + (acc[j][2] + acc[j][3]); }
        const float mean = wave_sum(s) * (1.0f / DM); float q = 0.f;
#pragma unroll
        for (int j = 0; j < 8; ++j) { acc[j] = acc[j] - mean; q += (acc[j][0] * acc[j][0] + acc[j][1] * acc[j][1]) + (acc[j][2] * acc[j][2] + acc[j][3] * acc[j][3]); }
        const float rstd = rsqrtf(wave_sum(q) * (1.0f / DM) + LN_EPS);
        float* xo = xo_base + (size_t)row * DM + 8 * lane; (void)xb; bf16_t* xho = xh + (size_t)row * DM + 8 * lane;
#pragma unroll
        for (int j = 0; j < 4; ++j) { const f32x4 g0 = *(const LAS f32x4*)(V4r + 2 * DM + 512 * j + 8 * lane), g1 = *(const LAS f32x4*)(V4r + 2 * DM + 512 * j + 8 * lane + 4), b0 = *(const LAS f32x4*)(V4r + 3 * DM + 512 * j + 8 * lane), b1 = *(const LAS f32x4*)(V4r + 3 * DM + 512 * j + 8 * lane + 4);
            const f32x4 o0 = acc[2 * j] * rstd * g0 + b0, o1 = acc[2 * j + 1] * rstd * g1 + b1;
            if (!x8) { *(f32x4*)(xo + 512 * j) = o0; *(f32x4*)(xo + 512 * j + 4) = o1; }
            else { u32x4 hw; hw.x = pk_f16(o0[0], o0[1]); hw.y = pk_f16(o0[2], o0[3]); hw.z = pk_f16(o1[0], o1[1]); hw.w = pk_f16(o1[2], o1[3]); *(u32x4*)(xho + 512 * j) = hw; }
            if (x8) {
                u32x2 q; q.x = q8x4(o0[0], o0[1], o0[2], o0[3], QX); q.y = q8x4(o1[0], o1[1], o1[2], o1[3], QX); *(u32x2*)(x8 + (size_t)row * DM + 8 * lane + 512 * j) = q; } }
    }    __syncthreads();
}

namespace att {
typedef short bf16x8 __attribute__((ext_vector_type(8)));
typedef short s16x4 __attribute__((ext_vector_type(4)));
typedef float f32x16 __attribute__((ext_vector_type(16)));
constexpr int VBYTES = 16384, KOFF = 2 * VBYTES, WSOFF = 65536, TABOFF = WSOFF + 2048, QOFF = TABOFF + 2048, ATTN_LDS = QOFF + 32768;
constexpr float NEG = -1e30f, M0 = -1e29f;
#define ATT_SBAR() __builtin_amdgcn_sched_barrier(0)
__device__ __forceinline__ int crow(int r, int hi) { return (r & 3) + 8 * (r >> 2) + 4 * hi; }
__device__ __forceinline__ unsigned cvtpk(float lo, float hi) { unsigned r; asm volatile("v_cvt_pk_bf16_f32 %0, %1, %2" : "=v"(r) : "v"(lo), "v"(hi)); return r; }
__device__ __forceinline__ int kswz128(int row, int colB) { return row * 256 + (colB ^ ((row & 7) << 4)); }
__device__ __forceinline__ int kswz64(int row, int colB) { return row * 128 + (colB ^ (((row >> 1) & 7) << 4)); }

__device__ __forceinline__ void partialSM(f32x16& p0, f32x16& p1, float& m_reg, float& mn, float& alpha, const float C, const float thr_raw) {
    float pmax = p0[0];
#pragma unroll
    for (int r = 1; r < 16; ++r) pmax = fmaxf(pmax, p0[r]);
#pragma unroll
    for (int r = 0; r < 16; ++r) pmax = fmaxf(pmax, p1[r]);
    { auto rr = __builtin_amdgcn_permlane32_swap(__float_as_uint(pmax), __float_as_uint(pmax), false, false); pmax = fmaxf(__uint_as_float(rr[0]), __uint_as_float(rr[1])); }
    if (__all(pmax - m_reg <= thr_raw)) { mn = m_reg; alpha = 1.f; }
    else { mn = fmaxf(m_reg, pmax); alpha = __builtin_amdgcn_exp2f((m_reg - mn) * C); m_reg = mn; }
    const float mnC = -mn * C;
#pragma unroll
    for (int r = 0; r < 16; ++r) p0[r] = fmaf(p0[r], C, mnC);
#pragma unroll
    for (int r = 0; r < 16; ++r) p1[r] = fmaf(p1[r], C, mnC);
#pragma unroll
    for (int r = 0; r < 16; ++r) p0[r] = __builtin_amdgcn_exp2f(p0[r]);
}
__device__ __forceinline__ void finishSM(f32x16& p0, f32x16& p1, float alpha, float& l_reg, bf16x8& pa0, bf16x8& pa1, bf16x8& pa2, bf16x8& pa3) {
#pragma unroll
    for (int r = 0; r < 16; ++r) p1[r] = __builtin_amdgcn_exp2f(p1[r]);
    float ps = 0;
#pragma unroll
    for (int r = 0; r < 16; ++r) ps += p0[r];
#pragma unroll
    for (int r = 0; r < 16; ++r) ps += p1[r];
    { auto rr = __builtin_amdgcn_permlane32_swap(__float_as_uint(ps), __float_as_uint(ps), false, false); ps = __uint_as_float(rr[0]) + __uint_as_float(rr[1]); }
    l_reg = l_reg * alpha + ps;
#define ATT_PK4(P, BASE, OUT) do { unsigned a0 = cvtpk(P[BASE + 0], P[BASE + 1]), a1 = cvtpk(P[BASE + 2], P[BASE + 3]);   \
    unsigned b0 = cvtpk(P[BASE + 4], P[BASE + 5]), b1 = cvtpk(P[BASE + 6], P[BASE + 7]);                              \
    auto r0 = __builtin_amdgcn_permlane32_swap(a0, b0, false, false); auto r1 = __builtin_amdgcn_permlane32_swap(a1, b1, false, false); \
    u32x4 w = {r0[0], r1[0], r0[1], r1[1]}; OUT = __builtin_bit_cast(bf16x8, w); } while (0)
    ATT_PK4(p0, 0, pa0); ATT_PK4(p0, 8, pa1); ATT_PK4(p1, 0, pa2); ATT_PK4(p1, 8, pa3);
#undef ATT_PK4
}
template <int DK>
__device__ __forceinline__ void qkt(f32x16& p0, f32x16& p1, const LAS char* Ks, const bf16x8* qr, int r32, int hi) {
    p0 = f32x16{}; p1 = f32x16{};
#pragma unroll
    for (int d0 = 0; d0 < DK / 16; ++d0) { const int cb = (d0 * 16 + hi * 8) * 2;
        const bf16x8 b0 = *(const LAS bf16x8*)(Ks + (DK == 128 ? kswz128(r32, cb) : kswz64(r32, cb)));
        const bf16x8 b1 = *(const LAS bf16x8*)(Ks + (DK == 128 ? kswz128(32 + r32, cb) : kswz64(32 + r32, cb)));
        p0 = __builtin_amdgcn_mfma_f32_32x32x16_bf16(b0, qr[d0], p0, 0, 0, 0);
        p1 = __builtin_amdgcn_mfma_f32_32x32x16_bf16(b1, qr[d0], p1, 0, 0, 0); }
}
__device__ __forceinline__ void qkt64_ldsq(f32x16& p0, f32x16& p1, const LAS char* Ks, const LAS char* qb_l, int r32, int hi) {
    unsigned qa = (unsigned)(__UINTPTR_TYPE__)qb_l; asm volatile("" : "+v"(qa)); const LAS char* qp = (const LAS char*)(__UINTPTR_TYPE__)qa;
    p0 = f32x16{}; p1 = f32x16{};
#pragma unroll
    for (int d0 = 0; d0 < 4; ++d0) { const int cb = (d0 * 16 + hi * 8) * 2;
        const bf16x8 q = *(const LAS bf16x8*)(qp + d0 * 1024);
        const bf16x8 b0 = *(const LAS bf16x8*)(Ks + kswz64(r32, cb));
        const bf16x8 b1 = *(const LAS bf16x8*)(Ks + kswz64(32 + r32, cb));
        p0 = __builtin_amdgcn_mfma_f32_32x32x16_bf16(b0, q, p0, 0, 0, 0);
        p1 = __builtin_amdgcn_mfma_f32_32x32x16_bf16(b1, q, p1, 0, 0, 0); }
}
__device__ __forceinline__ int v_st(int k, int c) { const int kk = (k & ~0xC) | ((k & 4) << 1) | ((k & 8) >> 1); return ((kk >> 3) * 4 + (c >> 5)) * 512 + ((kk & 7) * 32 + (c & 31)) * 2; }
__device__ __forceinline__ int v_rd_base(int lane) { return ((lane & 3) << 3) | (((lane >> 2) & 3) << 6) | (((lane >> 4) & 1) << 5) | (((lane >> 5) & 1) << 8); }
constexpr int v_rd_off(int d0, int ks, int half) { return d0 * 512 + ks * 4096 + half * 2048; }
template <int OFF> __device__ __forceinline__ s16x4 tr_read(int vb) { s16x4 r; asm volatile("ds_read_b64_tr_b16 %0, %1 offset:%2" : "=&v"(r) : "v"(vb), "i"(OFF) : "memory"); return r; }
template <int D0> __device__ __forceinline__ void pv_one(f32x16& od, int vb, bf16x8 pa0, bf16x8 pa1, bf16x8 pa2, bf16x8 pa3) {
    const s16x4 l0 = tr_read<v_rd_off(D0, 0, 0)>(vb), h0 = tr_read<v_rd_off(D0, 0, 1)>(vb), l1 = tr_read<v_rd_off(D0, 1, 0)>(vb), h1 = tr_read<v_rd_off(D0, 1, 1)>(vb);
    const s16x4 l2 = tr_read<v_rd_off(D0, 2, 0)>(vb), h2 = tr_read<v_rd_off(D0, 2, 1)>(vb), l3 = tr_read<v_rd_off(D0, 3, 0)>(vb), h3 = tr_read<v_rd_off(D0, 3, 1)>(vb);
    asm volatile("s_waitcnt lgkmcnt(0)" ::: "memory"); ATT_SBAR();
#define ATT_PK(L, H) (bf16x8){L[0], L[1], L[2], L[3], H[0], H[1], H[2], H[3]}
    od = __builtin_amdgcn_mfma_f32_32x32x16_bf16(pa0, ATT_PK(l0, h0), od, 0, 0, 0);
    od = __builtin_amdgcn_mfma_f32_32x32x16_bf16(pa1, ATT_PK(l1, h1), od, 0, 0, 0);
    od = __builtin_amdgcn_mfma_f32_32x32x16_bf16(pa2, ATT_PK(l2, h2), od, 0, 0, 0);
    od = __builtin_amdgcn_mfma_f32_32x32x16_bf16(pa3, ATT_PK(l3, h3), od, 0, 0, 0);
#undef ATT_PK
}
__device__ __forceinline__ void pv_d0(f32x16* o, int vb, bf16x8 pa0, bf16x8 pa1, bf16x8 pa2, bf16x8 pa3) {
    pv_one<0>(o[0], vb, pa0, pa1, pa2, pa3); pv_one<1>(o[1], vb, pa0, pa1, pa2, pa3); pv_one<2>(o[2], vb, pa0, pa1, pa2, pa3); pv_one<3>(o[3], vb, pa0, pa1, pa2, pa3);
}

template <int DK, class Pol>
__device__ __forceinline__ void attn_unit(const Pol& P, LAS char* lds, const int tid_in) {
    int tid = tid_in; asm volatile("" : "+v"(tid));
    const int wid = __builtin_amdgcn_readfirstlane(tid >> 6), lane = tid & 63, r32 = lane & 31, hi = lane >> 5;
    LAS char* V_lds = lds; LAS char* K_lds = lds + KOFF; constexpr int KBYTES = 64 * DK * 2;
    LAS float* wsx = (LAS float*)(lds + WSOFF) + wid * 64; LAS float* li_l = wsx; LAS float* al_l = wsx + 32;
    const float C = Pol::SCALE * 1.4426950408889634f, thr_raw = 8.0f / Pol::SCALE;
    float m_reg = P.m0w(wid), l_reg = P.l0(); f32x16 o[4] = {}; bf16x8 qr[DK / 16];
    { const bf16_t* qp = P.q_row(wid * 32 + r32) + hi * 8;
#pragma unroll
      for (int d0 = 0; d0 < DK / 16; ++d0) qr[d0] = *(const bf16x8*)(qp + d0 * 16); }
    const int sr = tid >> 4, sc = (tid & 15) * 8, vst0 = v_st(sr, sc), vst1 = v_st(32 + sr, sc);
    const int k64r = tid >> 3, k64c = (tid & 7) * 8;
    const int vb0 = (int)(unsigned)(__UINTPTR_TYPE__)V_lds + v_rd_base(lane);
    bf16x8 aV0, aV1, aK0, aK1, bV0, bV1, bK0, bK1;
#define ATT_LOADX(V0, V1, K0, K1, t) do { V0 = *(const bf16x8*)(P.v_row((t), sr) + sc); V1 = *(const bf16x8*)(P.v_row((t), 32 + sr) + sc); \
        if constexpr (DK == 128) { K0 = *(const bf16x8*)(P.k_row((t), sr) + sc); K1 = *(const bf16x8*)(P.k_row((t), 32 + sr) + sc); } \
        else { K0 = *(const bf16x8*)(P.k_row((t), k64r) + k64c); K1 = K0; } } while (0)
#define ATT_WRITEX(V0, V1, K0, K1, b) do { *(LAS bf16x8*)(V_lds + (b) * VBYTES + vst0) = V0; *(LAS bf16x8*)(V_lds + (b) * VBYTES + vst1) = V1; \
        if constexpr (DK == 128) { *(LAS bf16x8*)(K_lds + (b) * KBYTES + kswz128(sr, sc * 2)) = K0; *(LAS bf16x8*)(K_lds + (b) * KBYTES + kswz128(32 + sr, sc * 2)) = K1; } \
        else { *(LAS bf16x8*)(K_lds + (b) * KBYTES + kswz64(k64r, k64c * 2)) = K0; } } while (0)
#define ATT_COMPUTE(t, b) do { if (P.wave_needs((t), wid)) { \
            f32x16 p0, p1; float mn, alpha; bf16x8 pa0, pa1, pa2, pa3; \
            qkt<DK>(p0, p1, K_lds + (b) * KBYTES, qr, r32, hi); \
            P.mask(p0, p1, (t), wid, r32, hi, lds); \
            partialSM(p0, p1, m_reg, mn, alpha, C, thr_raw); \
            if (__any(alpha < 1.f)) { if (hi == 0) al_l[r32] = alpha; asm volatile("s_waitcnt lgkmcnt(0)" ::: "memory"); \
                _Pragma("unroll") for (int d = 0; d < 4; ++d) _Pragma("unroll") for (int r = 0; r < 16; ++r) o[d][r] *= al_l[crow(r, hi)]; } \
            finishSM(p0, p1, alpha, l_reg, pa0, pa1, pa2, pa3); ATT_SBAR(); \
            pv_d0(o, vb0 + (b) * VBYTES, pa0, pa1, pa2, pa3); } } while (0)
    const int NT = P.ntiles();
    ATT_LOADX(aV0, aV1, aK0, aK1, 0);
    if (NT > 1) ATT_LOADX(bV0, bV1, bK0, bK1, 1);
    for (int t = 0; t < NT; t += 2) {
        ATT_WRITEX(aV0, aV1, aK0, aK1, 0);
        __syncthreads();
        if (t + 2 < NT) ATT_LOADX(aV0, aV1, aK0, aK1, t + 2);
        ATT_COMPUTE(t, 0);
        if (t + 1 < NT) {
            ATT_WRITEX(bV0, bV1, bK0, bK1, 1);
            __syncthreads();
            if (t + 3 < NT) ATT_LOADX(bV0, bV1, bK0, bK1, t + 3);
            ATT_COMPUTE(t + 1, 1);
        }
    }
#undef ATT_LOADX
#undef ATT_WRITEX
#undef ATT_COMPUTE
    if (hi == 0) li_l[r32] = l_reg;
    asm volatile("s_waitcnt lgkmcnt(0)" ::: "memory");
    P.finish(o, m_reg, l_reg, li_l, wid, r32, hi);
    __syncthreads();
}

template <class Pol>
__device__ __forceinline__ void attn_unit_dense64(const Pol& P, LAS char* lds, const int tid_in) {
    int tid = tid_in; asm volatile("" : "+v"(tid));
    const int wid = __builtin_amdgcn_readfirstlane(tid >> 6), lane = tid & 63, r32 = lane & 31, hi = lane >> 5;
    LAS char* V_lds = lds; LAS char* K_lds = lds + KOFF; constexpr int KBYTES = 64 * 64 * 2;
    LAS float* wsx = (LAS float*)(lds + WSOFF) + wid * 64; LAS float* li_l = wsx; LAS float* al_l = wsx + 32;
    const float C = Pol::SCALE * 1.4426950408889634f, thr_raw = 8.0f / Pol::SCALE;
    float m_reg = M0, l_reg = 0.f; f32x16 o[4] = {};
    LAS char* qb_l = lds + QOFF + wid * 4096 + lane * 16;
    { const bf16_t* qp = P.q_row(wid * 32 + r32) + hi * 8;
#pragma unroll
      for (int d0 = 0; d0 < 4; ++d0) *(LAS bf16x8*)(qb_l + d0 * 1024) = *(const bf16x8*)(qp + d0 * 16); }
    const int sr = tid >> 4, sc = (tid & 15) * 8, vst0 = v_st(sr, sc), vst1 = v_st(32 + sr, sc);
    const int k64r = tid >> 3, k64c = (tid & 7) * 8, kst = kswz64(k64r, k64c * 2);
    const int vb0 = (int)(unsigned)(__UINTPTR_TYPE__)V_lds + v_rd_base(lane);
    bf16x8 sAv0, sAv1, sAk, sBv0, sBv1, sBk;
#define D64_LOADA(t) do { sAv0 = *(const bf16x8*)(P.v_row((t), sr) + sc); sAv1 = *(const bf16x8*)(P.v_row((t), 32 + sr) + sc); sAk = *(const bf16x8*)(P.k_row((t), k64r) + k64c); } while (0)
#define D64_LOADB(t) do { sBv0 = *(const bf16x8*)(P.v_row((t), sr) + sc); sBv1 = *(const bf16x8*)(P.v_row((t), 32 + sr) + sc); sBk = *(const bf16x8*)(P.k_row((t), k64r) + k64c); } while (0)
#define D64_WRITEA() do { *(LAS bf16x8*)(V_lds + vst0) = sAv0; *(LAS bf16x8*)(V_lds + vst1) = sAv1; *(LAS bf16x8*)(K_lds + kst) = sAk; } while (0)
#define D64_WRITEB() do { *(LAS bf16x8*)(V_lds + VBYTES + vst0) = sBv0; *(LAS bf16x8*)(V_lds + VBYTES + vst1) = sBv1; *(LAS bf16x8*)(K_lds + KBYTES + kst) = sBk; } while (0)
#define D64_WAIT() asm volatile("s_waitcnt vmcnt(3)" ::: "memory")
#define D64_RESC(a) do { if (__any((a) < 1.f)) { if (hi == 0) al_l[r32] = (a); asm volatile("s_waitcnt lgkmcnt(0)" ::: "memory"); \
    _Pragma("unroll") for (int d = 0; d < 4; ++d) _Pragma("unroll") for (int r = 0; r < 16; ++r) o[d][r] *= al_l[crow(r, hi)]; } } while (0)
    f32x16 pA0, pA1, pB0, pB1; float mnA, mnB, alA, alB; bf16x8 pa0, pa1, pa2, pa3; const int NT = P.ntiles();
    D64_LOADA(0); asm volatile("s_waitcnt vmcnt(0)" ::: "memory"); D64_WRITEA(); __syncthreads();
    qkt64_ldsq(pA0, pA1, K_lds, qb_l, r32, hi); partialSM(pA0, pA1, m_reg, mnA, alA, C, thr_raw);
    D64_LOADB(1); D64_LOADA(2);
    D64_WAIT(); D64_WRITEB(); __syncthreads();
#if defined(STAMP_SEL)
    unsigned long long sa0 = 0, sa1 = 0, sa2 = 0, sr0 = 0, sr1 = 0; if (P.stamp) { sa0 = __builtin_amdgcn_s_memtime(); sr0 = __builtin_amdgcn_s_memrealtime(); }
#endif
    for (int j = 1; j + 1 < NT; j += 2) {
        ATT_SBAR(); qkt64_ldsq(pB0, pB1, K_lds + KBYTES, qb_l, r32, hi);
        finishSM(pA0, pA1, alA, l_reg, pa0, pa1, pa2, pa3); ATT_SBAR();
        D64_LOADB(j + 2); ATT_SBAR();
        pv_d0(o, vb0, pa0, pa1, pa2, pa3); partialSM(pB0, pB1, m_reg, mnB, alB, C, thr_raw);
        __syncthreads(); D64_WAIT(); D64_WRITEA();
        D64_RESC(alB); __syncthreads();
        ATT_SBAR(); qkt64_ldsq(pA0, pA1, K_lds, qb_l, r32, hi);
        finishSM(pB0, pB1, alB, l_reg, pa0, pa1, pa2, pa3); ATT_SBAR();
        if (j + 3 < NT) D64_LOADA(j + 3); ATT_SBAR();
        pv_d0(o, vb0 + VBYTES, pa0, pa1, pa2, pa3); partialSM(pA0, pA1, m_reg, mnA, alA, C, thr_raw);
        __syncthreads(); D64_WAIT(); D64_WRITEB();
        D64_RESC(alA); __syncthreads();
    }
    ATT_SBAR(); qkt64_ldsq(pB0, pB1, K_lds + KBYTES, qb_l, r32, hi);
    finishSM(pA0, pA1, alA, l_reg, pa0, pa1, pa2, pa3); ATT_SBAR();
    pv_d0(o, vb0, pa0, pa1, pa2, pa3); partialSM(pB0, pB1, m_reg, mnB, alB, C, thr_raw);
    __syncthreads(); D64_RESC(alB);
    finishSM(pB0, pB1, alB, l_reg, pa0, pa1, pa2, pa3); ATT_SBAR();
    pv_d0(o, vb0 + VBYTES, pa0, pa1, pa2, pa3);
#undef D64_LOADA
#undef D64_LOADB
#undef D64_WRITEA
#undef D64_WRITEB
#undef D64_WAIT
#undef D64_RESC
#if defined(STAMP_SEL)
    if (P.stamp) { sa1 = __builtin_amdgcn_s_memtime(); sr1 = __builtin_amdgcn_s_memrealtime(); }
#endif
    if (hi == 0) li_l[r32] = l_reg;
    asm volatile("s_waitcnt lgkmcnt(0)" ::: "memory");
    P.finish(o, m_reg, l_reg, li_l, wid, r32, hi);
    __syncthreads();
#if defined(STAMP_SEL)
    if (P.stamp && tid == 0) { sa2 = __builtin_amdgcn_s_memtime(); P.stamp[10] = sa0; P.stamp[12] = sa1; P.stamp[13] = sa2; P.stamp[14] = sr0; P.stamp[15] = sr1; }
#endif
}

typedef short v4i16_t __attribute__((ext_vector_type(4)));
__device__ __forceinline__ s16x4 vtr(const LAS char* p) { return __builtin_bit_cast(s16x4, __builtin_amdgcn_ds_read_tr16_b64_v4i16((LAS v4i16_t*)p)); }
template <class Pol>
__device__ __forceinline__ void attn_unit_b2(const Pol& P, LAS char* lds, const int tid_in) {
    int tid = tid_in; asm volatile("" : "+v"(tid));
    const int wid = __builtin_amdgcn_readfirstlane(tid >> 6), lane = tid & 63, r32 = lane & 31, hi = lane >> 5;
    const bool trail = wid >= 4;
    constexpr int KB = 8192, VB = 16384, KR = 3 * VB, WSB = KR + 3 * KB;
    LAS char* V_lds = lds; LAS char* K_lds = lds + KR;
    LAS float* wsx = (LAS float*)(lds + WSB) + wid * 64; LAS float* li_l = wsx; LAS float* al_l = wsx + 32;
    const float C = Pol::SCALE * 1.4426950408889634f, thr_raw = 8.0f / Pol::SCALE;
    float m_reg = M0, l_reg = 0.f; f32x16 o[4] = {}; bf16x8 qr[4];
    { const bf16_t* qp = P.q_row(wid * 32 + r32) + hi * 8;
#pragma unroll
      for (int d0 = 0; d0 < 4; ++d0) qr[d0] = *(const bf16x8*)(qp + d0 * 16); }
    const int sr = tid >> 4, sc = (tid & 15) * 8, vst0 = v_st(sr, sc), vst1 = v_st(32 + sr, sc);
    const int k64r = tid >> 3, k64c = (tid & 7) * 8, kst = kswz64(k64r, k64c * 2);
    const LAS char* vrd = V_lds + v_rd_base(lane);
    bf16x8 sAv0, sAv1, sAk, sBv0, sBv1, sBk;
#define B2_LOADA(t) do { sAv0 = *(const bf16x8*)(P.v_row((t), sr) + sc); sAv1 = *(const bf16x8*)(P.v_row((t), 32 + sr) + sc); sAk = *(const bf16x8*)(P.k_row((t), k64r) + k64c); } while (0)
#define B2_LOADB(t) do { sBv0 = *(const bf16x8*)(P.v_row((t), sr) + sc); sBv1 = *(const bf16x8*)(P.v_row((t), 32 + sr) + sc); sBk = *(const bf16x8*)(P.k_row((t), k64r) + k64c); } while (0)
#define B2_WRITEA(r) do { *(LAS bf16x8*)(V_lds + (r) * VB + vst0) = sAv0; *(LAS bf16x8*)(V_lds + (r) * VB + vst1) = sAv1; *(LAS bf16x8*)(K_lds + (r) * KB + kst) = sAk; } while (0)
#define B2_WRITEB(r) do { *(LAS bf16x8*)(V_lds + (r) * VB + vst0) = sBv0; *(LAS bf16x8*)(V_lds + (r) * VB + vst1) = sBv1; *(LAS bf16x8*)(K_lds + (r) * KB + kst) = sBk; } while (0)
#define B2_BAR() do { asm volatile("s_waitcnt lgkmcnt(0)" ::: "memory"); __builtin_amdgcn_sched_barrier(0); __builtin_amdgcn_s_barrier(); __builtin_amdgcn_sched_barrier(0); } while (0)
#define B2_QK(r) do { const LAS char* Ks_ = K_lds + (r) * KB; p0 = f32x16{}; p1 = f32x16{}; \
    _Pragma("unroll") for (int d0 = 0; d0 < 4; ++d0) { const int cb = (d0 * 16 + hi * 8) * 2; \
        const bf16x8 b0 = *(const LAS bf16x8*)(Ks_ + kswz64(r32, cb)); const bf16x8 b1 = *(const LAS bf16x8*)(Ks_ + kswz64(32 + r32, cb)); \
        p0 = __builtin_amdgcn_mfma_f32_32x32x16_bf16(b0, qr[d0], p0, 0, 0, 0); p1 = __builtin_amdgcn_mfma_f32_32x32x16_bf16(b1, qr[d0], p1, 0, 0, 0); } } while (0)
#define B2_PKV(L, H) (bf16x8){L[0], L[1], L[2], L[3], H[0], H[1], H[2], H[3]}
#define B2_PV(r) do { const LAS char* vb_ = vrd + (r) * VB; \
    _Pragma("unroll") for (int d0 = 0; d0 < 4; ++d0) { \
        const s16x4 l0 = vtr(vb_ + v_rd_off(d0, 0, 0)), h0 = vtr(vb_ + v_rd_off(d0, 0, 1)), l1 = vtr(vb_ + v_rd_off(d0, 1, 0)), h1 = vtr(vb_ + v_rd_off(d0, 1, 1)); \
        const s16x4 l2 = vtr(vb_ + v_rd_off(d0, 2, 0)), h2 = vtr(vb_ + v_rd_off(d0, 2, 1)), l3 = vtr(vb_ + v_rd_off(d0, 3, 0)), h3 = vtr(vb_ + v_rd_off(d0, 3, 1)); \
        o[d0] = __builtin_amdgcn_mfma_f32_32x32x16_bf16(pa0, B2_PKV(l0, h0), o[d0], 0, 0, 0); o[d0] = __builtin_amdgcn_mfma_f32_32x32x16_bf16(pa1, B2_PKV(l1, h1), o[d0], 0, 0, 0); \
        o[d0] = __builtin_amdgcn_mfma_f32_32x32x16_bf16(pa2, B2_PKV(l2, h2), o[d0], 0, 0, 0); o[d0] = __builtin_amdgcn_mfma_f32_32x32x16_bf16(pa3, B2_PKV(l3, h3), o[d0], 0, 0, 0); } } while (0)
#define B2_SM() do { float mn_, alpha_; partialSM(p0, p1, m_reg, mn_, alpha_, C, thr_raw); \
    if (__any(alpha_ < 1.f)) { if (hi == 0) al_l[r32] = alpha_; asm volatile("s_waitcnt lgkmcnt(0)" ::: "memory"); \
        _Pragma("unroll") for (int d = 0; d < 4; ++d) _Pragma("unroll") for (int r = 0; r < 16; ++r) o[d][r] *= al_l[crow(r, hi)]; } \
    finishSM(p0, p1, alpha_, l_reg, pa0, pa1, pa2, pa3); } while (0)
    f32x16 p0, p1; bf16x8 pa0, pa1, pa2, pa3; const int NT = P.ntiles();
    B2_LOADA(0); B2_LOADB(1);
    B2_WRITEA(0);
    B2_LOADA(2);
    B2_BAR();
    if (trail) B2_BAR();
    B2_QK(0); B2_WRITEB(1); B2_LOADB(3);
    B2_BAR();
    B2_SM();
    B2_BAR();
    int rk = 1, rv = 0, rw = 2;
    for (int j = 1; j < NT - 1; j += 2) {
        B2_QK(rk); B2_PV(rv); B2_WRITEA(rw); if (j + 3 < NT) B2_LOADA(j + 3);
        B2_BAR();
        B2_SM();
        B2_BAR();
        rv = rk; rk = rw; rw = (rw == 2) ? 0 : rw + 1;
        B2_QK(rk); B2_PV(rv); B2_WRITEB(rw); if (j + 4 < NT) B2_LOADB(j + 4);
        B2_BAR();
        B2_SM();
        B2_BAR();
        rv = rk; rk = rw; rw = (rw == 2) ? 0 : rw + 1;
    }
    B2_QK(rk); B2_PV(rv);
    B2_BAR();
    B2_SM();
    B2_BAR();
    rv = rk;
    B2_PV(rv);
    if (!trail) B2_BAR();
#undef B2_LOADA
#undef B2_LOADB
#undef B2_WRITEA
#undef B2_WRITEB
#undef B2_QK
#undef B2_PKV
#undef B2_PV
#undef B2_SM
    if (hi == 0) li_l[r32] = l_reg;
    asm volatile("s_waitcnt lgkmcnt(0)" ::: "memory");
    P.finish(o, m_reg, l_reg, li_l, wid, r32, hi);
    __syncthreads();
#undef B2_BAR
}

template <class Pol>
__device__ __forceinline__ void attn_unit_b3(const Pol& P, LAS char* lds, const int tid_in, unsigned long long* stamp_ = nullptr) {
    int tid = tid_in; asm volatile("" : "+v"(tid));
    const int wid = __builtin_amdgcn_readfirstlane(tid >> 6), lane = tid & 63, r32 = lane & 31, hi = lane >> 5;
    constexpr int KB = 8192, VB = 16384, K0OFF = 3 * VB, K1OFF = K0OFF + 2 * KB, WS3 = K1OFF + 2 * KB, Q3OFF = WS3 + 2048;
    static_assert(Q3OFF + 65536 <= LDSCTL_OFF, "mixer B LDS image overlaps the control words");
    LAS char* V_lds = lds;
    LAS float* wsx = (LAS float*)(lds + WS3) + wid * 64; LAS float* li_l = wsx; LAS float* al_l = wsx + 32;
    const float C = Pol::SCALE * 1.4426950408889634f, thr_raw = 8.0f / Pol::SCALE;
    float m0 = M0, l0 = 0.f, m1 = M0, l1 = 0.f; f32x16 o0[4] = {}, o1[4] = {};
    LAS char* qb_l = lds + Q3OFF + wid * 8192 + lane * 16;
#pragma unroll
    for (int mp = 0; mp < 2; ++mp) { const bf16_t* qp = P.q_row(mp, wid * 32 + r32) + hi * 8;
#pragma unroll
        for (int d0 = 0; d0 < 4; ++d0) *(LAS bf16x8*)(qb_l + mp * 4096 + d0 * 1024) = *(const bf16x8*)(qp + d0 * 16); }
    const int sr = tid >> 4, sc = (tid & 15) * 8, vst0 = v_st(sr, sc), vst1 = v_st(32 + sr, sc);
    const int k64r = tid >> 3, k64c = (tid & 7) * 8, kst = kswz64(k64r, k64c * 2);
    const int vb0 = (int)(unsigned)(__UINTPTR_TYPE__)V_lds + v_rd_base(lane);
    bf16x8 aV0, aV1, aK0, aK1;
#define B3_LOAD(V0, V1, K0, K1, t) do { V0 = *(const bf16x8*)(P.v_row((t), sr) + sc); V1 = *(const bf16x8*)(P.v_row((t), 32 + sr) + sc); \
        K0 = *(const bf16x8*)(P.k_row(0, (t), k64r) + k64c); K1 = *(const bf16x8*)(P.k_row(1, (t), k64r) + k64c); } while (0)
#define B3_WRITE(V0, V1, K0, K1, b, vs_) do { *(LAS bf16x8*)(V_lds + (vs_) * VB + vst0) = V0; *(LAS bf16x8*)(V_lds + (vs_) * VB + vst1) = V1; \
        *(LAS bf16x8*)(lds + K0OFF + (b) * KB + kst) = K0; *(LAS bf16x8*)(lds + K1OFF + (b) * KB + kst) = K1; } while (0)
#if defined(B3_PRIO) && B3_PRIO == 1
#define B3_P1() do { __builtin_amdgcn_s_setprio(1); ATT_SBAR(); } while (0)
#define B3_P0() do { ATT_SBAR(); __builtin_amdgcn_s_setprio(0); } while (0)
#else
#define B3_P1() do { } while (0)
#define B3_P0() do { } while (0)
#endif
#define B3_QS(KOFF_, QO_, m_, l_, o_, b, A0, A1, A2, A3) do { f32x16 p0, p1; float mn, alpha; \
        B3_P1(); qkt64_ldsq(p0, p1, lds + (KOFF_) + (b) * KB, qb_l + (QO_), r32, hi); B3_P0(); \
        partialSM(p0, p1, m_, mn, alpha, C, thr_raw); \
        if (__any(alpha < 1.f)) { if (hi == 0) al_l[r32] = alpha; asm volatile("s_waitcnt lgkmcnt(0)" ::: "memory"); \
            _Pragma("unroll") for (int d = 0; d < 4; ++d) _Pragma("unroll") for (int r = 0; r < 16; ++r) o_[d][r] *= al_l[crow(r, hi)]; } \
        finishSM(p0, p1, alpha, l_, A0, A1, A2, A3); ATT_SBAR(); } while (0)
#define B3_PV(o_, vs_, A0, A1, A2, A3) do { B3_P1(); pv_d0(o_, vb0 + (vs_) * VB, A0, A1, A2, A3); B3_P0(); } while (0)
#define B3_MAP(KOFF_, QO_, m_, l_, o_, b, vs_) do { bf16x8 pa0, pa1, pa2, pa3; B3_QS(KOFF_, QO_, m_, l_, o_, b, pa0, pa1, pa2, pa3); B3_PV(o_, vs_, pa0, pa1, pa2, pa3); } while (0)
    const int NT = P.ntiles();
    const bool young = wid >= 4;
    bf16x8 c0 = {}, c1 = {}, c2 = {}, c3 = {};
    int vs = 0, vprev = 0;
#if defined(STAMP_SEL)
    unsigned long long sa0 = 0, sa1 = 0, sr0 = 0, sr1 = 0; if (stamp_) { sa0 = __builtin_amdgcn_s_memtime(); sr0 = __builtin_amdgcn_s_memrealtime(); }
#endif
    B3_LOAD(aV0, aV1, aK0, aK1, 0);
    for (int t = 0; t < NT; ++t) {
        const int b = t & 1;
        B3_WRITE(aV0, aV1, aK0, aK1, b, vs);
        __syncthreads();
        if (t + 1 < NT) B3_LOAD(aV0, aV1, aK0, aK1, t + 1);
        if (young && t > 0) B3_PV(o1, vprev, c0, c1, c2, c3);
        B3_MAP(K0OFF, 0, m0, l0, o0, b, vs);
        B3_QS(K1OFF, 4096, m1, l1, o1, b, c0, c1, c2, c3);
        if (!young) B3_PV(o1, vs, c0, c1, c2, c3);
        vprev = vs; vs = (vs == 2) ? 0 : vs + 1;
    }
    if (young) B3_PV(o1, vprev, c0, c1, c2, c3);
#if defined(STAMP_SEL)
    if (stamp_ && wid == STAMP_WAVE) { sa1 = __builtin_amdgcn_s_memtime(); sr1 = __builtin_amdgcn_s_memrealtime(); if (lane == 0) { stamp_[10] = sa0; stamp_[12] = sa1; stamp_[13] = sa1; stamp_[14] = sr0; stamp_[15] = sr1; } }
#endif
#undef B3_LOAD
#undef B3_WRITE
#undef B3_MAP
#undef B3_QS
#undef B3_PV
#undef B3_P1
#undef B3_P0
    if (hi == 0) { li_l[r32] = l0; al_l[r32] = l1; }
    asm volatile("s_waitcnt lgkmcnt(0)" ::: "memory");
    P.finish2(o0, o1, li_l, al_l, wid, r32, hi);
    __syncthreads();
}

template <class RowFn>
__device__ __forceinline__ void store_o_i8(const f32x16* o, const LAS float* li_l, int wid, int r32, int hi, float qo, const RowFn& orow) {
#pragma unroll
    for (int r = 0; r < 16; ++r) { const int i = crow(r, hi); const float inv = __builtin_amdgcn_rcpf(li_l[i]) * qo; unsigned char* p = orow(wid * 32 + i) + r32;
#pragma unroll
        for (int d0 = 0; d0 < 4; ++d0) { int q = (int)__builtin_rintf(o[d0][r] * inv); q = q < -127 ? -127 : (q > 127 ? 127 : q); p[d0 * 32] = (unsigned char)q; } }
}
template <class RowFn>
__device__ __forceinline__ void store_o_bf16(const f32x16* o, const LAS float* li_l, int wid, int r32, int hi, const RowFn& orow) {
#pragma unroll
    for (int r = 0; r < 16; ++r) { const int i = crow(r, hi); const float inv = __builtin_amdgcn_rcpf(li_l[i]); bf16_t* p = orow(wid * 32 + i) + r32;
#pragma unroll
        for (int d0 = 0; d0 < 4; ++d0) p[d0 * 32] = (bf16_t)(cvtpk(o[d0][r] * inv, 0.f) & 0xffffu); }
}
struct PolA {
    static constexpr float SCALE = 0.08838834764831845f;
    const bf16_t* proj; unsigned char* ag; float* lse;
    int b, hh, j, r, L, qb, tlo, nt;
    __device__ __forceinline__ const bf16_t* tok(int pos) const { return proj + (size_t)(b * SEQ + pos) * PROJ_PITCH; }
    __device__ __forceinline__ const bf16_t* q_row(int i) const { return tok(j + r * (qb * 256 + i)) + OFF_QA + hh * 128; }
    __device__ __forceinline__ int ntiles() const { return nt; }
    __device__ __forceinline__ int kidx(int t, int kk) const { int ki = qb * 256 - 64 + 64 * (t + tlo) + kk; ki = ki < 0 ? 0 : (ki > L - 1 ? L - 1 : ki); return j + r * ki; }
    __device__ __forceinline__ const bf16_t* k_row(int t, int kk) const { return tok(kidx(t, kk)) + OFF_KA + hh * 128; }
    __device__ __forceinline__ const bf16_t* v_row(int t, int kk) const { return tok(kidx(t, kk)) + OFF_VA + hh * 128; }
    __device__ __forceinline__ bool wave_needs(int t, int wid) const { const int kbase = qb * 256 - 64 + 64 * (t + tlo), q0 = qb * 256 + wid * 32; return kbase <= q0 + 95 && kbase + 63 >= q0 - 64; }
    __device__ __forceinline__ void mask(f32x16& p0, f32x16& p1, int t, int wid, int r32, int hi, LAS char*) const {
        const int qi = qb * 256 + wid * 32 + r32; const int lo = qi - 64 < 0 ? 0 : qi - 64, hi_ = qi + 64 > L - 1 ? L - 1 : qi + 64;
        const unsigned span = (unsigned)(hi_ - lo); const int t0 = qb * 256 - 64 + 64 * (t + tlo) + 4 * hi - lo;
#pragma unroll
        for (int r = 0; r < 16; ++r) { const int kk = (r & 3) + 8 * (r >> 2);
            p0[r] = ((unsigned)(t0 + kk) <= span) ? p0[r] : NEG; p1[r] = ((unsigned)(t0 + kk + 32) <= span) ? p1[r] : NEG; }
    }
    __device__ __forceinline__ float m0w(int) const { return M0; }
    __device__ __forceinline__ float l0() const { return 0.f; }
    __device__ __forceinline__ void finish(const f32x16* o, float m_reg, float l_reg, const LAS float* li_l, int wid, int r32, int hi) const {
        const int h6 = hh % 6;
        store_o_i8(o, li_l, wid, r32, hi, QO, [&](int i) { return ag + (size_t)(b * SEQ + j + r * (qb * 256 + i)) * 768 + h6 * 128; });
        if (hi == 0) lse[(size_t)(b * SEQ + j + r * (qb * 256 + wid * 32 + r32)) * 6 + h6] = m_reg * SCALE + __logf(l_reg);
    }
};
struct PolC2 {
    static constexpr float SCALE = 0.08838834764831845f;
    const bf16_t* proj; unsigned char* oc; const float* sinkp; int b, kvh, qb;
    __device__ __forceinline__ const bf16_t* tok(int pos) const { return proj + (size_t)(b * SEQ + pos) * PROJ_PITCH; }
    __device__ __forceinline__ const bf16_t* q_row(int i) const { return tok(qb * 64 + (i & 63)) + OFF_QC + (kvh * 4 + (i >> 6)) * 128; }
    __device__ __forceinline__ int ntiles() const { return 5; }
    __device__ __forceinline__ int kpos(int t, int kk) const { int k = qb * 64 - 128 + 64 * t + kk; return k < 0 ? 0 : (k > SEQ - 1 ? SEQ - 1 : k); }
    __device__ __forceinline__ const bf16_t* k_row(int t, int kk) const { return tok(kpos(t, kk)) + OFF_KC + kvh * 128; }
    __device__ __forceinline__ const bf16_t* v_row(int t, int kk) const { return tok(kpos(t, kk)) + OFF_VC + kvh * 128; }
    __device__ __forceinline__ bool wave_needs(int t, int) const { const int kbase = qb * 64 - 128 + 64 * t; return kbase + 63 >= 0 && kbase < SEQ; }
    __device__ __forceinline__ void mask(f32x16& p0, f32x16& p1, int t, int wid, int r32, int hi, LAS char*) const {
        const int qi = qb * 64 + (wid & 1) * 32 + r32; const int lo = qi - 128 < 0 ? 0 : qi - 128, hi_ = qi + 128 > SEQ - 1 ? SEQ - 1 : qi + 128;
        const unsigned span = (unsigned)(hi_ - lo); const int t0 = qb * 64 - 128 + 64 * t + 4 * hi - lo;
#pragma unroll
        for (int r = 0; r < 16; ++r) { const int kk = (r & 3) + 8 * (r >> 2);
            p0[r] = ((unsigned)(t0 + kk) <= span) ? p0[r] : NEG; p1[r] = ((unsigned)(t0 + kk + 32) <= span) ? p1[r] : NEG; }
    }
    __device__ __forceinline__ float m0w(int wid) const { return sinkp[kvh * 4 + (wid >> 1)] * (1.0f / SCALE); }
    __device__ __forceinline__ float l0() const { return 1.f; }
    __device__ __forceinline__ void finish(const f32x16* o, float, float, const LAS float* li_l, int wid, int r32, int hi) const {
        store_o_i8(o, li_l, wid, r32, hi, QO, [&](int i) { return oc + (size_t)(b * SEQ + qb * 64 + (i & 63)) * 1024 + (kvh * 4 + (i >> 6)) * 128; });
    }
};
struct PolD {
    static constexpr float SCALE = 0.08838834764831845f;
    const bf16_t* proj; unsigned char* od; int b, h, rb, lo, nt;
    __device__ __forceinline__ const bf16_t* tok(int pos) const { return proj + (size_t)(b * SEQ + pos) * PROJ_PITCH; }
    __device__ __forceinline__ const bf16_t* q_row(int i) const { return tok(rb * 256 + i) + OFF_QD + h * 128; }
    __device__ __forceinline__ int ntiles() const { return nt; }
    __device__ __forceinline__ const bf16_t* k_row(int t, int kk) const { return tok((lo + t) * 64 + kk) + OFF_KD + h * 128; }
    __device__ __forceinline__ const bf16_t* v_row(int t, int kk) const { return tok((lo + t) * 64 + kk) + OFF_VD + h * 128; }
    __device__ __forceinline__ bool wave_needs(int t, int wid) const { const int qr_ = rb * 4 + (wid >> 1); int rs = qr_ - 4; rs = rs < 0 ? 0 : (rs > 56 ? 56 : rs); const int kr = lo + t; return kr >= rs && kr < rs + 8; }
    __device__ __forceinline__ void mask(f32x16& p0, f32x16& p1, int t, int wid, int r32, int hi, LAS char* lds) const {
        const int qr_ = rb * 4 + (wid >> 1), qc = 32 * (wid & 1) + r32, kr = lo + t; int cs = qc - 8; cs = cs < 0 ? 0 : (cs > 48 ? 48 : cs);
        const LAS float* T = (const LAS float*)(lds + TABOFF) + (kr - qr_ + 7) * 31 + 15 - qc + 4 * hi; const int kc0 = 4 * hi - cs;
#pragma unroll
        for (int r = 0; r < 16; ++r) { const int kk = (r & 3) + 8 * (r >> 2);
            const float b0 = T[kk], b1 = T[kk + 32];
            p0[r] = ((unsigned)(kc0 + kk) < 16u) ? p0[r] + b0 : NEG; p1[r] = ((unsigned)(kc0 + kk + 32) < 16u) ? p1[r] + b1 : NEG; }
    }
    __device__ __forceinline__ float m0w(int) const { return M0; }
    __device__ __forceinline__ float l0() const { return 0.f; }
    __device__ __forceinline__ void finish(const f32x16* o, float, float, const LAS float* li_l, int wid, int r32, int hi) const {
        store_o_i8(o, li_l, wid, r32, hi, QO, [&](int i) { return od + (size_t)(b * SEQ + rb * 256 + i) * 1024 + h * 128; });
    }
};
struct PolB {
    static constexpr float SCALE = 0.125f;
    const bf16_t* proj; bf16_t* ob; float* scr; const float* subln; const float* lam; float lambda_init; int b, h, qb, map;
#if defined(STAMP_SEL)
    unsigned long long* stamp;
#endif
    __device__ __forceinline__ const bf16_t* tok(int pos) const { return proj + (size_t)(b * SEQ + pos) * PROJ_PITCH; }
    __device__ __forceinline__ const bf16_t* q_row(int i) const { return tok(qb * 256 + i) + OFF_QB + (2 * h + map) * 64; }
    __device__ __forceinline__ int ntiles() const { return SEQ / 64; }
    __device__ __forceinline__ const bf16_t* k_row(int t, int kk) const { return tok(64 * t + kk) + OFF_KB + (2 * h + map) * 64; }
    __device__ __forceinline__ const bf16_t* v_row(int t, int kk) const { return tok(64 * t + kk) + OFF_VB + h * 128; }
    __device__ __forceinline__ bool wave_needs(int, int) const { return true; }
    __device__ __forceinline__ void mask(f32x16&, f32x16&, int, int, int, int, LAS char*) const {}
    __device__ __forceinline__ float m0w(int) const { return M0; }
    __device__ __forceinline__ float l0() const { return 0.f; }
    __device__ __forceinline__ void finish(const f32x16* o, float, float, const LAS float* li_l, int wid, int r32, int hi) const {
        if (map == 0) {
#pragma unroll
            for (int r = 0; r < 16; ++r) { const int i = crow(r, hi); const float inv = __builtin_amdgcn_rcpf(li_l[i]); float* p = scr + (size_t)(wid * 32 + i) * 128 + r32;
#pragma unroll
                for (int d0 = 0; d0 < 4; ++d0) p[d0 * 32] = o[d0][r] * inv; }
        } else {
            const int ln_ = r32 + 32 * hi; const float d01 = wave_sum(lam[ln_] * lam[64 + ln_]), d23 = wave_sum(lam[128 + ln_] * lam[192 + ln_]);
            const float lmbda = __expf(d01) - __expf(d23) + lambda_init, oscale = 1.0f - lambda_init;
            float sw[4];
#pragma unroll
            for (int d0 = 0; d0 < 4; ++d0) sw[d0] = subln[d0 * 32 + r32] * oscale;
#pragma unroll
            for (int r = 0; r < 16; ++r) { const int i = crow(r, hi); const float inv = __builtin_amdgcn_rcpf(li_l[i]); const float* p = scr + (size_t)(wid * 32 + i) * 128 + r32;
                float v[4]; float ss = 0.f;
#pragma unroll
                for (int d0 = 0; d0 < 4; ++d0) { v[d0] = p[d0 * 32] - lmbda * (o[d0][r] * inv); ss += v[d0] * v[d0]; }
#pragma unroll
                for (int s = 1; s < 32; s <<= 1) ss += __shfl_xor(ss, s);
                const float rinv = rsqrtf(ss * (1.0f / 128.0f) + SUBLN_EPS);
                bf16_t* q = ob + (size_t)(b * SEQ + qb * 256 + wid * 32 + i) * 1024 + h * 128 + r32;
#pragma unroll
                for (int d0 = 0; d0 < 4; ++d0) q[d0 * 32] = (bf16_t)(cvtpk(v[d0] * rinv * sw[d0], 0.f) & 0xffffu); }
        }
    }
};

struct PolB2 {
    static constexpr float SCALE = 0.125f;
    const bf16_t* proj; unsigned char* ob; const float* subln; const float* lam; float lambda_init; int b, h, qb;
    __device__ __forceinline__ const bf16_t* tok(int pos) const { return proj + (size_t)(b * SEQ + pos) * PROJ_PITCH; }
    __device__ __forceinline__ const bf16_t* q_row(int mp, int i) const { return tok(qb * 256 + i) + OFF_QB + (2 * h + mp) * 64; }
    __device__ __forceinline__ int ntiles() const { return SEQ / 64; }
    __device__ __forceinline__ const bf16_t* k_row(int mp, int t, int kk) const { return tok(64 * t + kk) + OFF_KB + (2 * h + mp) * 64; }
    __device__ __forceinline__ const bf16_t* v_row(int t, int kk) const { return tok(64 * t + kk) + OFF_VB + h * 128; }
    __device__ __forceinline__ void finish2(const f32x16* o0, const f32x16* o1, const LAS float* l0_l, const LAS float* l1_l, int wid, int r32, int hi) const {
        const int ln_ = r32 + 32 * hi; const float d01 = wave_sum(lam[ln_] * lam[64 + ln_]), d23 = wave_sum(lam[128 + ln_] * lam[192 + ln_]);
        const float lmbda = __expf(d01) - __expf(d23) + lambda_init;
        float sw[4];
#pragma unroll
        for (int d0 = 0; d0 < 4; ++d0) sw[d0] = subln[d0 * 32 + r32] * QX;
#pragma unroll
        for (int r = 0; r < 16; ++r) { const int i = crow(r, hi); const float inv0 = __builtin_amdgcn_rcpf(l0_l[i]), inv1 = lmbda * __builtin_amdgcn_rcpf(l1_l[i]);
            float v[4]; float ss = 0.f;
#pragma unroll
            for (int d0 = 0; d0 < 4; ++d0) { v[d0] = o0[d0][r] * inv0 - o1[d0][r] * inv1; ss += v[d0] * v[d0]; }
#pragma unroll
            for (int s = 1; s < 32; s <<= 1) ss += __shfl_xor(ss, s);
            const float rinv = rsqrtf(ss * (1.0f / 128.0f) + SUBLN_EPS);
            unsigned char* q = ob + (size_t)(b * SEQ + qb * 256 + wid * 32 + i) * 1024 + h * 128 + r32;
#pragma unroll
            for (int d0 = 0; d0 < 4; ++d0) { int t = (int)__builtin_rintf(v[d0] * rinv * sw[d0]); t = t < -127 ? -127 : (t > 127 ? 127 : t); q[d0 * 32] = (unsigned char)t; } }
    }
};

#ifndef ATT_MASK
#define ATT_MASK 15
#endif
#define ATT_ON(k) ((ATT_MASK >> (k)) & 1)
#ifndef ATT_REP
#define ATT_REP 0
#endif
#define ATT_NREP(k) (((ATT_REP >> (k)) & 1) ? 2 : 1)
struct Ptrs { const bf16_t* proj; bf16_t* ag; float* lse; unsigned char* ob; unsigned char* oc; unsigned char* od; const float* lam; const float* subln; const float* sink; const float* rpb; float lambda_init;
#if defined(STAMP_SEL)
    unsigned long long* stamp;
#endif
};
__device__ __forceinline__ void attn_phase(const Ptrs& X, LAS char* lds, const int tid, const int vcu, const int G, const int wgid) {
    const int lane = tid & 63;
    if (ATT_ON(0)) for (int rep = 0; rep < ATT_NREP(0); ++rep) {
        for (int u = vcu; u < 512; u += G) {
            PolB2 P{X.proj, X.ob, X.subln, X.lam, X.lambda_init, u >> 7, (u >> 4) & 7, u & 15};
#if defined(STAMP_SEL)
            attn_unit_b3<PolB2>(P, lds, tid, (wgid == STAMP_WG && u == vcu && rep == 0) ? X.stamp : nullptr);
#else
            attn_unit_b3<PolB2>(P, lds, tid);
#endif
        }
    }
    if (ATT_ON(1)) for (int rep = 0; rep < ATT_NREP(1); ++rep) for (int u = vcu; u < 512; u += G) {
        const int rb = u & 15, h = (u >> 4) & 7, b = u >> 7; int lo = rb * 4 - 4; lo = lo < 0 ? 0 : (lo > 56 ? 56 : lo); int hi_ = rb * 4 + 3 - 4; hi_ = hi_ < 0 ? 0 : (hi_ > 56 ? 56 : hi_); hi_ += 7;
        { LAS float* T = (LAS float*)(lds + TABOFF); for (int i = tid; i < 465; i += 512) T[i] = X.rpb[h * 465 + i] * (1.0f / PolD::SCALE); }
        PolD P{X.proj, X.od, b, h, rb, lo, hi_ - lo + 1};
        attn_unit<128, PolD>(P, lds, tid);
    }
    if (ATT_ON(2)) for (int rep = 0; rep < ATT_NREP(2); ++rep) for (int u = vcu; u < 512; u += G) {
        const int qb = u & 63, kvh = (u >> 6) & 1, b = u >> 7;
        PolC2 P{X.proj, X.oc, X.sink, b, kvh, qb};
        attn_unit<128, PolC2>(P, lds, tid);
    }
    if (ATT_ON(3)) for (int rep = 0; rep < ATT_NREP(3); ++rep) for (int u = vcu; u < 1152; u += G) {
        const int g = u / 384, v = u % 384, w16 = v & 15, bh = v >> 4, h6 = bh % 6, b = bh / 6;
        const int r = g == 0 ? 1 : (g == 1 ? 4 : 16), L = SEQ / r;
        const int qb = w16 / r, tlo = qb == 0 ? 1 : 0; int thi = (L - qb * 256 + 64 + 63) / 64; thi = thi > 6 ? 6 : thi;
        PolA P{X.proj, (unsigned char*)X.ag + (size_t)g * MTOK * 768, X.lse + (size_t)g * MTOK * 6, b, g * 6 + h6, w16 % r, r, L, qb, tlo, thi - tlo};
        attn_unit<128, PolA>(P, lds, tid);
    }
}
#undef ATT_SBAR
}

struct InPtrs { const float *x, *w_in, *b_gate, *w_branch, *w_out, *diff_lambda, *diff_subln, *sink_logit, *na_rpb, *w_router, *w_exp_gate, *w_exp_up, *w_exp_down, *ln_gain, *ln_bias; };

__device__ __forceinline__ void prologue_phase(const InPtrs& I, unsigned char* ws, LAS unsigned char* lds, int gw, int NGW, int wave, int lane) {
    LAS unsigned char* scr = lds + wave * 9216;
    { const f32x4* xs = (const f32x4*)I.x;
      for (size_t i = (size_t)gw * 64 + lane; i < (size_t)MTOK * DM / 8; i += (size_t)NGW * 64) {
          const f32x4 a = xs[2 * i], b = xs[2 * i + 1];
          u32x2 q; q.x = q8x4(a[0], a[1], a[2], a[3], QX); q.y = q8x4(b[0], b[1], b[2], b[3], QX); ((u32x2*)(ws + WS_X8))[i] = q; } }
    { float* r128 = (float*)(ws + WS_ROPE128); float* r64 = (float*)(ws + WS_ROPE64);
      for (int i = gw * 64 + lane; i < SEQ * 64 + SEQ * 32; i += NGW * 64) {
          int pos, ii, half; float* dst;
          if (i < SEQ * 64) { pos = i >> 6; ii = i & 63; half = 64; dst = r128 + 2 * (size_t)i; } else { const int k = i - SEQ * 64; pos = k >> 5; ii = k & 31; half = 32; dst = r64 + 2 * (size_t)k; }
          const float inv = (float)pow(10000.0, -(double)ii / (double)half); const float ang = (float)pos * inv;
          dst[0] = (float)cos((double)ang); dst[1] = (float)sin((double)ang); } }
    bf16_t* WIN = (bf16_t*)(ws + WS_WIN); bf16_t* WOUT = (bf16_t*)(ws + WS_WOUT); bf16_t* WGU = (bf16_t*)(ws + WS_WGU); bf16_t* WDN = (bf16_t*)(ws + WS_WDN);
    constexpr int N1 = DEPTH * 32 * 356, N2 = DEPTH * 60 * 32, N3 = DEPTH * 32 * 32, N4 = DEPTH * NEXP * 32 * 32, N5 = DEPTH * NEXP * 16 * 32;
    for (int it = gw; it < N1 + N2 + N3 + N4 + N5; it += NGW) {
        int r = it;
        if (r < N1) { const int sub = r & 15, grp = r >> 4; const int nb = (grp % 89) * 4 + (sub & 3), kb = ((grp / 89) & 7) * 4 + (sub >> 2), l = grp / (89 * 8); const int n = nb * 64 + lane;
            const int c0 = nb * 64;
            if (c0 >= 14592) tr_item8(I.w_in + (size_t)l * DM * IN_TOTAL, IN_TOTAL, n, kb * 64, (unsigned char*)(ws + WS_W8G) + ((size_t)l * 8192 + (c0 - 14592)) * DM + kb * 64, DM, QWG, scr, lane);
            else { const bool isv = (c0 >= 4608 && c0 < 6912) || (c0 >= 8960 && c0 < 9984) || (c0 >= 11264 && c0 < 11520) || (c0 >= 13568);
                tr_item8(I.w_in + (size_t)l * DM * IN_TOTAL, IN_TOTAL, win_src_col(n), kb * 64, (unsigned char*)(ws + WS_W8Q) + ((size_t)l * 14592 + c0) * DM + kb * 64, DM, isv ? QWU : QWG, scr, lane); }
            continue; }
        r -= N1;
        if (r < N2) { const int nb = r % 32, kbg = (r / 32) % 60, l = r / (32 * 60); const int n = nb * 64 + lane;
            int ro, Kb, kb; if (kbg < 12) { ro = 0; Kb = 768; kb = kbg; } else { const int q = (kbg - 12) >> 4; ro = 768 + 1024 * q; Kb = 1024; kb = (kbg - 12) & 15; }
            const int brn = kbg < 12 ? 0 : 1 + ((kbg - 12) >> 4); (void)Kb;
            tr_item8(I.w_branch + ((size_t)l * BR_TOTAL + ro) * DM, DM, n, kb * 64, (unsigned char*)(ws + WS_W8BR) + ((size_t)(l * 4 + brn) * DM + nb * 64) * 1024 + kb * 64, 1024, brn == 0 ? QWBA : QWBC, scr, lane);
            continue; }
        r -= N2;
        if (r < N3) { const int nb = r % 32, kb = (r / 32) % 32, l = r / (32 * 32); const int n = nb * 64 + lane;
            tr_item8(I.w_out + (size_t)l * DM * DM, DM, n, kb * 64, (unsigned char*)WOUT + ((size_t)l * DM + nb * 64) * DM + kb * 64, DM, QWU, scr, lane); continue; }
        r -= N3;
        if (r < N4) { const int sub = r & 15, grp = r >> 4; const int nb = (grp & 7) * 4 + (sub & 3), kb = ((grp >> 3) & 7) * 4 + (sub >> 2), le = grp >> 6; const int n = nb * 64 + lane, pn = n >> 8, bj = (n >> 7) & 1, jj = n & 127;
            tr_item8((bj ? I.w_exp_up : I.w_exp_gate) + (size_t)le * DM * DEXP, DEXP, pn * 128 + jj, kb * 64, (unsigned char*)WGU + ((size_t)le * 2048 + nb * 64) * DM + kb * 64, DM, bj ? QWU : QWG, scr, lane); continue; }
        r -= N4;
        { const int sub = r & 15, grp = r >> 4; const int nb = (grp & 7) * 4 + (sub & 3), kb = ((grp >> 3) & 3) * 4 + (sub >> 2), le = grp >> 5; const int n = nb * 64 + lane;
            tr_item8(I.w_exp_down + (size_t)le * DEXP * DM, DM, n, kb * 64, (unsigned char*)WDN + ((size_t)le * DM + nb * 64) * DEXP + kb * 64, DEXP, QWD, scr, lane); }
    }
}

struct Args { const float* in[15]; float* out; unsigned char* ws; int ph_lo, ph_hi; };
__global__ void __launch_bounds__(NWAVES * 64, LB_WAVES) fwd(Args args) {
    extern __shared__ __attribute__((aligned(16))) unsigned char lds_raw[];
    LAS unsigned char* lds = (LAS unsigned char*)lds_raw;
    for (int u = threadIdx.x; u < (LDS_BYTES - LDSCTL_OFF) / 4; u += NWAVES * 64) ((LAS unsigned*)(lds + LDSCTL_OFF))[u] = 0u;
    __syncthreads();
    unsigned* ctl = (unsigned*)(args.ws + WS_CTL);
    XcdBarrier bar = xcd_barrier_post(ctl + CW_BAR, (volatile LAS unsigned*)(lds + LDSCTL_OFF));
    const int lo = args.ph_lo, hi = args.ph_hi;
#ifndef SCALAR_ATTN
#define SCALAR_ATTN 0
#endif
#ifndef REP_MASK
#define REP_MASK 0
#endif
#define NREP(k) (((REP_MASK >> (k)) & 1) ? 2 : 1)
#ifndef PH_MASK
#define PH_MASK 0xFFFF
#endif
#define PHON(k) ((PH_MASK >> (k)) & 1)
#define IN(k) (lo <= (k) && (k) < hi)
#define PHASE_LOCALS long zz = 0; asm volatile("" : "+s"(zz)); unsigned char* const ws = args.ws + zz; int tid = threadIdx.x; asm volatile("" : "+v"(tid)); int bx = blockIdx.x, G = gridDim.x; asm volatile("" : "+s"(bx), "+s"(G)); \
    const int lane = tid & 63, wave = __builtin_amdgcn_readfirstlane(tid >> 6); const int vcu = (G % 8 == 0) ? (bx % 8) * (G / 8) + bx / 8 : bx; \
    const int gw = vcu * NWAVES + wave, NGW = G * NWAVES; (void)lane; (void)gw; (void)NGW
#if defined(STAMP_SEL)
#define SEAM(k) do { if (IN(k) && IN((k) + 1)) { const unsigned long long b0_ = __builtin_amdgcn_s_memrealtime(); xcd_barrier(bar); \
    if (__builtin_amdgcn_readfirstlane((int)blockIdx.x) == STAMP_WG && threadIdx.x == 0) { unsigned long long* st_ = (unsigned long long*)(args.ws + WS_CTL + 65536); st_[20] += __builtin_amdgcn_s_memrealtime() - b0_; } } } while (0)
#else
#define SEAM(k) do { if (IN(k) && IN((k) + 1)) xcd_barrier(bar); } while (0)
#endif

#define XF ((float*)(ws + WS_XF))
#define XB ((bf16_t*)(ws + WS_XB))
#define PROJ ((bf16_t*)(ws + WS_PROJ))
#define OA ((bf16_t*)(ws + WS_OA))
#define OB ((bf16_t*)(ws + WS_OB))
#define OC ((bf16_t*)(ws + WS_OC))
#define OD ((bf16_t*)(ws + WS_OD))
#define AG ((bf16_t*)(ws + WS_AG))
#define LSE ((float*)(ws + WS_LSE))
#define MIXED ((bf16_t*)(ws + WS_MIXED))
#define PRELN ((float*)(ws + WS_PRELN))
#define XG ((bf16_t*)(ws + WS_XG))
#define HB ((bf16_t*)(ws + WS_H))
#define YB ((bf16_t*)(ws + WS_Y))
#define AFF ((float*)(ws + WS_AFF))
#define IDX ((int*)(ws + WS_IDX))
#define GV ((float*)(ws + WS_GV))
#define SLOT ((int*)(ws + WS_SLOT))

    if (PHON(0) && IN(0)) for (int rep = 0; rep < NREP(0); ++rep) { PHASE_LOCALS;
        InPtrs I; I.x = args.in[0 + zz]; I.w_in = args.in[1 + zz]; I.b_gate = args.in[2 + zz]; I.w_branch = args.in[3 + zz]; I.w_out = args.in[4 + zz]; I.diff_lambda = args.in[5 + zz]; I.diff_subln = args.in[6 + zz];
        I.sink_logit = args.in[7 + zz]; I.na_rpb = args.in[8 + zz]; I.w_router = args.in[9 + zz]; I.w_exp_gate = args.in[10 + zz]; I.w_exp_up = args.in[11 + zz]; I.w_exp_down = args.in[12 + zz]; I.ln_gain = args.in[13 + zz]; I.ln_bias = args.in[14 + zz];
        prologue_phase(I, ws, lds, gw, NGW, wave, lane); if (rep == NREP(0) - 1) SEAM(0); else xcd_barrier(bar); }

    for (int l = 0; l < DEPTH; ++l) {
        const int pb = 1 + l * NPL;
        if (PHON(1) && IN(pb + 0)) for (int rep = 0; rep < NREP(1); ++rep) { PHASE_LOCALS;
            { pg8::Gemm g{(const bf16_t*)(ws + WS_X8), (const bf16_t*)(ws + WS_W8Q + (size_t)l * 14592 * DM), MTOK, 14592, DM / 2, 0, 0, 0, nullptr STAMP_ARG(nullptr)}; pg8::StaticOrder S; S.init(MTOK, 14592, G, bx);
              pg8::EpiProjT<true> E{PROJ, (const float*)(ws + WS_ROPE128), (const float*)(ws + WS_ROPE64), 0, 1 << 30, 0, 1.0f / (QX * QWG), 1.0f / (QX * QWU)};
              pg8::gemm_phase<pg8::EpiProjT<true>, pg8::StaticOrder, true, true, false, true>(lds, g, S, E, tid); }
            { pg8::Gemm g{(const bf16_t*)(ws + WS_X8), (const bf16_t*)(ws + WS_W8G + (size_t)l * 8192 * DM), MTOK, 8192, DM / 2, 0, 0, 0, nullptr STAMP_ARG(nullptr)}; pg8::StaticOrder S; S.init(MTOK, 8192, G, bx); if (G == 256) { S.skip_lo = 1792; S.skip_hi = 1856; }
              pg8::EpiGate8 E{(unsigned char*)(ws + WS_GATE), args.in[2 + zz] + (size_t)l * 8192, 1.0f / (QX * QWG)};
              int tid2 = tid; asm volatile("" : "+v"(tid2));
              pg8::gemm_phase<pg8::EpiGate8, pg8::StaticOrder, true, true, false, true>(lds, g, S, E, tid2); }
            if (rep == NREP(1) - 1) SEAM(pb + 0); else xcd_barrier(bar);
        }
        if (PHON(2) && IN(pb + 1)) for (int rep = 0; rep < NREP(2); ++rep) { PHASE_LOCALS;
            const float li = l == 0 ? 0.2f : (l == 1 ? 0.35550906759096926f : (l == 2 ? 0.47071301834358416f : 0.5560582041556405f));
#if SCALAR_ATTN
            { AttnPtrs P{PROJ, AG, LSE, nullptr, nullptr, nullptr, nullptr, nullptr, nullptr, nullptr, li}; scalar_attn_phase<0>(P, lds, gw, NGW, wave, lane); }
            { AttnPtrs P{PROJ, nullptr, nullptr, OB, nullptr, nullptr, args.in[5 + zz] + l * 256, args.in[6 + zz] + l * 128, nullptr, nullptr, li}; scalar_attn_phase<1>(P, lds, gw, NGW, wave, lane); }
            { AttnPtrs P{PROJ, nullptr, nullptr, nullptr, OC, nullptr, nullptr, nullptr, args.in[7 + zz] + l * 8, nullptr, li}; scalar_attn_phase<2>(P, lds, gw, NGW, wave, lane); }
            { AttnPtrs P{PROJ, nullptr, nullptr, nullptr, nullptr, OD, nullptr, nullptr, nullptr, args.in[8 + zz] + (size_t)l * 8 * 465, li}; scalar_attn_phase<3>(P, lds, gw, NGW, wave, lane); }
#else
            att::Ptrs X{PROJ, AG, LSE, (unsigned char*)(ws + WS_O8 + (size_t)1 * MTOK * 1024), (unsigned char*)(ws + WS_O8 + (size_t)2 * MTOK * 1024), (unsigned char*)(ws + WS_O8 + (size_t)3 * MTOK * 1024), args.in[5 + zz] + l * 256, args.in[6 + zz] + l * 128, args.in[7 + zz] + l * 8, args.in[8 + zz] + (size_t)l * 8 * 465, li STAMP_ARG((unsigned long long*)(ws + WS_CTL + 65536))};
            att::attn_phase(X, (LAS char*)lds, tid, vcu, G, bx);
            if (G == 256 && vcu >= 128 && vcu < 192) {
                pg8::Gemm g{(const bf16_t*)(ws + WS_X8), (const bf16_t*)(ws + WS_W8G + (size_t)l * 8192 * DM), MTOK, 8192, DM / 2, 0, 0, 0, nullptr STAMP_ARG(nullptr)}; pg8::StaticOrder S; S.init(MTOK, 8192, G, bx); S.only = 1792 + (vcu - 128);
                pg8::EpiGate8 E{(unsigned char*)(ws + WS_GATE), args.in[2 + zz] + (size_t)l * 8192, 1.0f / (QX * QWG)};
                int tid3 = tid; asm volatile("" : "+v"(tid3));
                pg8::gemm_phase<pg8::EpiGate8, pg8::StaticOrder, true, true, false, true>((LAS unsigned char*)lds, g, S, E, tid3); }
#endif
            if (rep == NREP(2) - 1) SEAM(pb + 1); else xcd_barrier(bar);
        }
        if (PHON(3) && IN(pb + 2)) for (int rep = 0; rep < NREP(3); ++rep) { PHASE_LOCALS; combine_a_phase((const unsigned char*)AG, LSE, (unsigned*)(ws + WS_O8), gw, NGW, lane); if (rep == NREP(3) - 1) SEAM(pb + 2); else xcd_barrier(bar); }
        if (PHON(4) && IN(pb + 3)) for (int rep = 0; rep < NREP(4); ++rep) { PHASE_LOCALS;
            { const float one_m_li = 1.0f - (l == 0 ? 0.2f : (l == 1 ? 0.35550906759096926f : (l == 2 ? 0.47071301834358416f : 0.5560582041556405f)));
              const float qm = 127.0f / (6.0f * 0.2275f * one_m_li);
              pg8::Gemm g{(const bf16_t*)(ws + WS_O8), (const bf16_t*)(ws + WS_W8BR + (size_t)l * 4 * DM * 1024), MTOK, DM, 512, 0, (size_t)MTOK * 1024, (size_t)DM * 1024, nullptr STAMP_ARG(nullptr)}; pg8::BranchOrder4 S; S.init(MTOK, DM, G, bx);
              pg8::EpiGate4 E{MIXED, (const unsigned char*)(ws + WS_GATE), 1.0f / (QO * QWBA), one_m_li / (QX * QWBC), 1.0f / (QO * QWBC), (unsigned char*)(ws + WS_MIXED8), qm};
              pg8::gemm_phase<pg8::EpiGate4, pg8::BranchOrder4, true, true, false, true>(lds, g, S, E, tid); }
            if (rep == NREP(4) - 1) SEAM(pb + 3); else xcd_barrier(bar);
        }
        if (PHON(5) && IN(pb + 4)) for (int rep = 0; rep < NREP(5); ++rep) { PHASE_LOCALS;
            const float one_m_li = 1.0f - (l == 0 ? 0.2f : (l == 1 ? 0.35550906759096926f : (l == 2 ? 0.47071301834358416f : 0.5560582041556405f)));
            const float qm = 127.0f / (6.0f * 0.2275f * one_m_li);
            pg8::Gemm g{(const bf16_t*)(ws + WS_MIXED8), (const bf16_t*)(ws + WS_WOUT + (size_t)l * DM * DM), MTOK, DM, DM / 2, 0, 0, 0, nullptr STAMP_ARG(nullptr)}; pg8::StaticOrder S; S.init(MTOK, DM, G, bx);
            pg8::EpiResid E{(bf16_t*)PRELN, l == 0 ? args.in[0 + zz] : (const float*)nullptr, (const bf16_t*)XF, ALPHA, 1.0f / (qm * QWU)};
            pg8::gemm_phase<pg8::EpiResid, pg8::StaticOrder, true, true, false, true>(lds, g, S, E, tid);
            if (rep == NREP(5) - 1) SEAM(pb + 4); else xcd_barrier(bar);
        }
        if (PHON(6) && IN(pb + 5)) for (int rep = 0; rep < NREP(6); ++rep) { PHASE_LOCALS; ln1_router_phase((const bf16_t*)PRELN, args.in[13 + zz] + (size_t)(l * 2) * DM, args.in[14 + zz] + (size_t)(l * 2) * DM, args.in[9 + zz] + (size_t)l * DM * NEXP, (float*)(ws + WS_STATS), (unsigned*)(ws + WS_X8), AFF, lds, tid, gw, NGW, lane); if (rep == NREP(6) - 1) SEAM(pb + 5); else xcd_barrier(bar); }
        if (PHON(7) && IN(pb + 6)) for (int rep = 0; rep < NREP(7); ++rep) { PHASE_LOCALS; topk_phase(AFF, IDX, GV, SLOT, lds, tid, wave, lane, bx, G); if (rep == NREP(7) - 1) SEAM(pb + 6); else xcd_barrier(bar); }
        if (PHON(9) && IN(pb + 7)) for (int rep = 0; rep < NREP(9); ++rep) { PHASE_LOCALS;
            pg8::Gemm g{(const bf16_t*)(ws + WS_X8), (const bf16_t*)(ws + WS_WGU + (size_t)l * NEXP * 2048 * DM), NGRP * CAP, 2048, DM / 2, (size_t)2048 * DM, 0, 0, IDX STAMP_ARG(nullptr)};
            pg8::StaticOrder S; S.init(NGRP * CAP, 2048, G, bx);
            pg8::EpiSwiGLU E{(unsigned char*)(ws + WS_H), 1.0f / (QX * QWG), 1.0f / (QX * QWU), QH};
            pg8::gemm_phase<pg8::EpiSwiGLU, pg8::StaticOrder, true, true, true, true>(lds, g, S, E, tid);
            if (rep == NREP(9) - 1) SEAM(pb + 7); else xcd_barrier(bar);
        }
        if (PHON(10) && IN(pb + 8)) for (int rep = 0; rep < NREP(10); ++rep) { PHASE_LOCALS;
            pg8::Gemm g{(const bf16_t*)(ws + WS_H), (const bf16_t*)(ws + WS_WDN + (size_t)l * NEXP * DM * DEXP), NGRP * CAP, DM, DEXP / 2, (size_t)DM * DEXP, 0, 0, nullptr STAMP_ARG(nullptr)};
            pg8::StaticOrder S; S.init(NGRP * CAP, DM, G, bx);
            pg8::EpiDown E{(unsigned char*)YB, QY / (QH * QWD)};
            pg8::gemm_phase<pg8::EpiDown, pg8::StaticOrder, true, true, false, true>(lds, g, S, E, tid);
            if (rep == NREP(10) - 1) SEAM(pb + 8); else xcd_barrier(bar);
        }
        if (PHON(11) && IN(pb + 9)) for (int rep = 0; rep < NREP(11); ++rep) { PHASE_LOCALS;
            if (NREP(11) == 2 && rep == 0) ln2_phase((const bf16_t*)PRELN, (const float*)(ws + WS_STATS), args.in[13 + zz] + (size_t)(l * 2) * DM, args.in[14 + zz] + (size_t)(l * 2) * DM, (const unsigned char*)YB, GV, SLOT, args.in[13 + zz] + (size_t)(l * 2 + 1) * DM, args.in[14 + zz] + (size_t)(l * 2 + 1) * DM, (float*)(ws + WS_O8), (bf16_t*)(ws + WS_O8), MIXED, (unsigned char*)(ws + WS_AG), gw, NGW, lane, lds, tid); else
            ln2_phase((const bf16_t*)PRELN, (const float*)(ws + WS_STATS), args.in[13 + zz] + (size_t)(l * 2) * DM, args.in[14 + zz] + (size_t)(l * 2) * DM, (const unsigned char*)YB, GV, SLOT, args.in[13 + zz] + (size_t)(l * 2 + 1) * DM, args.in[14 + zz] + (size_t)(l * 2 + 1) * DM, (l == DEPTH - 1) ? args.out : XF, (bf16_t*)XF, XB, (l == DEPTH - 1) ? (unsigned char*)nullptr : (unsigned char*)(ws + WS_X8), gw, NGW, lane, lds, tid);
            if (rep == NREP(11) - 1) SEAM(pb + 9); else xcd_barrier(bar);
#if defined(PROBE_XBAR)
            for (int xb_ = 0; xb_ < PROBE_XBAR; ++xb_) xcd_barrier(bar);
#endif
#if defined(STAMP_SEL)
            if (l == DEPTH - 1 && bx == STAMP_WG && tid == 0) { asm volatile("s_waitcnt vmcnt(0)" ::: "memory");
                const unsigned long long* st = (const unsigned long long*)(ws + WS_CTL + 65536);
                float val = 0.f;
                if (STAMP_SEL == 1) val = (float)(st[1] - st[0]) * (1.0f / 32.0f);
                if (STAMP_SEL == 2) val = (float)(st[2] - st[1]);
                if (STAMP_SEL == 3) val = (float)(st[2] - st[0]) / ((float)(st[4] - st[3]) * 0.01f);
                if (STAMP_SEL == 4) val = (float)(st[12] - st[10]) * (1.0f / 63.0f);
                if (STAMP_SEL == 5) val = (float)(st[13] - st[12]);
                if (STAMP_SEL == 7) val = (float)st[20] * 0.01f;
                if (STAMP_SEL == 6) val = (float)(st[12] - st[10]) / ((float)(st[15] - st[14]) * 0.01f);
                const unsigned long long w0 = __builtin_amdgcn_s_memrealtime(), wt = (unsigned long long)(val * (float)STAMP_SCALE);
                while (__builtin_amdgcn_s_memrealtime() - w0 < wt) __builtin_amdgcn_s_sleep(16); }
#endif
        }
    }
#undef IN
#undef SEAM
}

#ifndef MK_ONE_LAUNCH
#define MK_ONE_LAUNCH 1
#endif
extern "C" void kernel_launch(void* const* d_in, const int* in_sizes, int n_in, void* d_out, int out_size, void* d_ws, size_t ws_size, hipStream_t stream) {
    static int grid = 0;
    if (grid == 0) {
        if (n_in != 15 || out_size != MTOK * DM || ws_size < WS_END) { fprintf(stderr, "kernel_launch: unexpected shapes (n_in %d out %d ws %zu, need ws >= %zu)\n", n_in, out_size, ws_size, (size_t)WS_END); grid = -1; return; }
        int dev = 0, cus = 0, per_cu = 0;
        if (hipGetDevice(&dev) != hipSuccess || hipDeviceGetAttribute(&cus, hipDeviceAttributeMultiprocessorCount, dev) != hipSuccess) { grid = -1; return; }
        if (hipFuncSetAttribute((const void*)fwd, hipFuncAttributeMaxDynamicSharedMemorySize, LDS_BYTES) != hipSuccess) { fprintf(stderr, "kernel_launch: hipFuncSetAttribute failed\n"); grid = -1; return; }
        if (hipOccupancyMaxActiveBlocksPerMultiprocessor(&per_cu, (const void*)fwd, NWAVES * 64, LDS_BYTES) != hipSuccess || per_cu < 1) { fprintf(stderr, "kernel_launch: occupancy query says %d\n", per_cu); }
        (void)hipGetLastError();
        grid = cus;
    }
    if (grid < 0) return;
    if (hipMemsetAsync((char*)d_ws + WS_CTL, 0, CTL_ZERO_BYTES, stream) != hipSuccess) return;
    Args a{};
    for (int i = 0; i < 15; ++i) a.in[i] = (const float*)d_in[i];
    a.out = (float*)d_out; a.ws = (unsigned char*)d_ws;
#if MK_ONE_LAUNCH
    a.ph_lo = 0; a.ph_hi = NPHASES;
    hipLaunchKernelGGL(fwd, dim3(grid), dim3(NWAVES * 64), LDS_BYTES, stream, a);
#else
    for (int p = 0; p < NPHASES; ++p) { a.ph_lo = p; a.ph_hi = p + 1; hipLaunchKernelGGL(fwd, dim3(grid), dim3(NWAVES * 64), LDS_BYTES, stream, a); }
#endif
}
```
